# Optimizing an MI355X kernel written in HIP

```python
import math
import jax, jax.numpy as jnp
from jax import lax
import numpy as np

D_MODEL = 1024
BATCH = 2
SEQ = 8192
DEPTH = 2

HEAD_DIM = 64
BLOCK = 128
EPS = 1e-6
NEG = -1e30
A_HEADS = 8
A_KV_HEADS = 2
IDX_HEADS = 8
IDX_DIM = 64
TOPK_MAX = 256
LRU_WIDTH = 512
LRU_BLOCKS = 8
CONV_WIDTH = 4
LRU_C = 8.0
C_HEADS = 8
Q_LORA = 256
KV_LORA = 128
QK_NOPE = 64
QK_ROPE = 32
V_DIM = 64
ROPE_THETA = 10000.0
D_HEADS = 8
D_KV_HEADS = 2
WINDOW = 128
N_BRANCH = 4
BRANCH_WIDTH = 512
N_ALIBI = A_HEADS + D_HEADS
D_FF = 2816
IN_SPLITS = (A_HEADS * HEAD_DIM, A_KV_HEADS * HEAD_DIM, A_KV_HEADS * HEAD_DIM,
             IDX_HEADS * IDX_DIM, IDX_DIM, IDX_HEADS,
             LRU_WIDTH, LRU_WIDTH,
             Q_LORA, KV_LORA + QK_ROPE,
             D_HEADS * HEAD_DIM, D_KV_HEADS * HEAD_DIM, D_KV_HEADS * HEAD_DIM,
             N_BRANCH * D_MODEL)
IN_WIDTH = sum(IN_SPLITS)

kernel_name = "hybrid_gated_dsa_rglru_mla_swa_macaron"


def rmsnorm(x, g):
    xf = x.astype(jnp.float32)
    y = xf * lax.rsqrt(jnp.mean(xf * xf, axis=-1, keepdims=True) + EPS)
    return (y * g.astype(jnp.float32)).astype(x.dtype)


def alibi_slopes():
    i = jnp.arange(1, N_ALIBI + 1, dtype=jnp.float32)
    return 2.0 ** (-8.0 * i / N_ALIBI)


def rope(x, pos):
    half = QK_ROPE // 2
    inv = ROPE_THETA ** (-jnp.arange(half, dtype=jnp.float32) / half)
    ang = pos.astype(jnp.float32)[:, None] * inv[None, :]
    cos, sin = jnp.cos(ang)[:, None, :], jnp.sin(ang)[:, None, :]
    xf = x.astype(jnp.float32)
    x1, x2 = xf[..., :half], xf[..., half:]
    return jnp.concatenate([x1 * cos - x2 * sin, x2 * cos + x1 * sin], axis=-1).astype(x.dtype)


def to_blocks(t, nb):
    return jnp.moveaxis(t.reshape(t.shape[0], nb, BLOCK, *t.shape[2:]), 1, 0)


def from_blocks(t):
    t = jnp.moveaxis(t, 0, 1)
    return t.reshape(t.shape[0], -1, t.shape[-1])


gather_rows = jax.vmap(lambda rows, idx: rows[idx])


def swiglu(h, w_in, w_out):
    gate, up = jnp.split(h @ w_in, 2, axis=-1)
    return (jax.nn.silu(gate) * up) @ w_out


def dsa_attention(q, k, v, qi, ki, wi, slopes):
    B, S, H, Dh = q.shape
    G = k.shape[2]
    R = H // G
    nb = S // BLOCK
    topk = min(TOPK_MAX, S // 4)
    scale = Dh ** -0.5
    key_pos = jnp.arange(S)
    slopes_gr = slopes.reshape(G, R).astype(jnp.float32)
    ki32 = ki.astype(jnp.float32)

    def one_block(args):
        qb, qib, wib, start = args
        qpos = start + jnp.arange(BLOCK)
        causal = key_pos[None, :] <= qpos[:, None]
        dots = jnp.einsum('bthd,bsd->bths', qib.astype(jnp.float32), ki32)
        iscore = jnp.einsum('bth,bths->bts', wib.astype(jnp.float32), jax.nn.relu(dots))
        iscore = jnp.where(causal[None], iscore, -jnp.inf)
        _, sel = lax.top_k(iscore, topk)
        ksel = gather_rows(k, sel)
        vsel = gather_rows(v, sel)
        dist = qpos[None, :, None] - sel
        valid = dist >= 0
        s = jnp.einsum('btgrd,btkgd->btgrk', qb.reshape(B, BLOCK, G, R, Dh), ksel).astype(jnp.float32) * scale
        s = s - slopes_gr[None, None, :, :, None] * dist.astype(jnp.float32)[:, :, None, None, :]
        s = jnp.where(valid[:, :, None, None, :], s, NEG)
        p = jax.nn.softmax(s, axis=-1).astype(v.dtype)
        o = jnp.einsum('btgrk,btkgd->btgrd', p, vsel)
        return o.reshape(B, BLOCK, H * Dh)

    starts = jnp.arange(nb, dtype=jnp.int32) * BLOCK
    out = lax.map(one_block, (to_blocks(q, nb), to_blocks(qi, nb), to_blocks(wi, nb), starts))
    return from_blocks(out)


def rglru_branch(xr, xg, conv_w, conv_b, wa, ba, wx, bx, lam):
    B, S, W = xr.shape
    xc = lax.conv_general_dilated(xr, conv_w.astype(xr.dtype).reshape(CONV_WIDTH, 1, W),
                                  window_strides=(1,), padding=[(CONV_WIDTH - 1, 0)],
                                  dimension_numbers=('NWC', 'WIO', 'NWC'),
                                  feature_group_count=W) + conv_b
    xb = xc.reshape(B, S, LRU_BLOCKS, W // LRU_BLOCKS)
    r = jax.nn.sigmoid((jnp.einsum('bsni,nij->bsnj', xb, wa).reshape(B, S, W) + ba).astype(jnp.float32))
    i = jax.nn.sigmoid((jnp.einsum('bsni,nij->bsnj', xb, wx).reshape(B, S, W) + bx).astype(jnp.float32))
    log_a = -LRU_C * r * jax.nn.softplus(-lam.astype(jnp.float32))
    a = jnp.exp(log_a)
    b = jnp.sqrt(-jnp.expm1(2.0 * log_a)) * (i * xc.astype(jnp.float32))

    def combine(left, right):
        a_l, b_l = left
        a_r, b_r = right
        return a_l * a_r, a_r * b_l + b_r

    _, h = lax.associative_scan(combine, (a, b), axis=1)
    return h.astype(xr.dtype) * jax.nn.gelu(xg)


def causal_block_attention(q, k, v, scale):
    B, S, H, _ = q.shape
    nb = S // BLOCK
    key_pos = jnp.arange(S)

    def one_block(args):
        qb, start = args
        qpos = start + jnp.arange(BLOCK)
        s = jnp.einsum('bthd,bshd->bhts', qb, k).astype(jnp.float32) * scale
        s = jnp.where((key_pos[None, :] <= qpos[:, None])[None, None], s, NEG)
        p = jax.nn.softmax(s, axis=-1).astype(v.dtype)
        return jnp.einsum('bhts,bshd->bthd', p, v).reshape(B, BLOCK, -1)

    starts = jnp.arange(nb, dtype=jnp.int32) * BLOCK
    return from_blocks(lax.map(one_block, (to_blocks(q, nb), starts)))


def mla_attention(cq, ckv_full, g_q, g_kv, w_uq, w_ukv):
    B, S, _ = cq.shape
    q = (rmsnorm(cq, g_q) @ w_uq).reshape(B, S, C_HEADS, QK_NOPE + QK_ROPE)
    c_kv, k_rope = ckv_full[..., :KV_LORA], ckv_full[..., KV_LORA:]
    kv = (rmsnorm(c_kv, g_kv) @ w_ukv).reshape(B, S, C_HEADS, QK_NOPE + V_DIM)
    k_nope, v = kv[..., :QK_NOPE], kv[..., QK_NOPE:]
    pos = jnp.arange(S)
    q = jnp.concatenate([q[..., :QK_NOPE], rope(q[..., QK_NOPE:], pos)], axis=-1)
    k_rope = jnp.broadcast_to(rope(k_rope[:, :, None, :], pos), (B, S, C_HEADS, QK_ROPE))
    k = jnp.concatenate([k_nope, k_rope], axis=-1)
    return causal_block_attention(q, k, v, (QK_NOPE + QK_ROPE) ** -0.5)


def sliding_window_attention(q, k, v, sinks, slopes):
    B, S, H, Dh = q.shape
    G = k.shape[2]
    R = H // G
    nb = S // BLOCK
    qb = q.reshape(B, nb, BLOCK, G, R, Dh)
    kb = k.reshape(B, nb, BLOCK, G, Dh)
    vb = v.reshape(B, nb, BLOCK, G, Dh)
    prev = lambda t: jnp.concatenate([jnp.zeros_like(t[:, :1]), t[:, :-1]], axis=1)
    kw = jnp.concatenate([prev(kb), kb], axis=2)
    vw = jnp.concatenate([prev(vb), vb], axis=2)
    blk = jnp.arange(nb)[:, None] * BLOCK
    qpos = blk + jnp.arange(BLOCK)[None, :]
    kpos = blk - BLOCK + jnp.arange(2 * BLOCK)[None, :]
    dist = qpos[:, :, None] - kpos[:, None, :]
    valid = (kpos[:, None, :] >= 0) & (dist >= 0) & (dist < WINDOW)
    s = jnp.einsum('bntgrd,bnkgd->bngrtk', qb, kw).astype(jnp.float32) * (Dh ** -0.5)
    s = s - slopes.reshape(G, R).astype(jnp.float32)[None, None, :, :, None, None] * dist.astype(jnp.float32)[None, :, None, None, :, :]
    s = jnp.where(valid[None, :, None, None], s, NEG)
    sink = jnp.broadcast_to(sinks.reshape(G, R).astype(jnp.float32)[None, None, :, :, None, None], s.shape[:-1] + (1,))
    p = jax.nn.softmax(jnp.concatenate([s, sink], axis=-1), axis=-1)[..., :-1].astype(v.dtype)
    o = jnp.einsum('bngrtk,bnkgd->bntgrd', p, vw)
    return o.reshape(B, S, H * Dh)


def token_mixer(h, w_in, conv_w, conv_b, lru_wa, lru_ba, lru_wx, lru_bx, lru_lambda,
                mla_g_q, mla_g_kv, mla_w_uq, mla_w_ukv, swa_sinks, w_branch, w_out):
    B, S, _ = h.shape
    z = h @ w_in
    splits = np.cumsum(IN_SPLITS)[:-1].tolist()
    (a_q, a_k, a_v, i_q, i_k, i_w, r_x, r_g, c_q, c_kv, d_q, d_k, d_v, gates) = jnp.split(z, splits, axis=-1)
    slopes = alibi_slopes()
    slopes_d, slopes_a = slopes[:D_HEADS], slopes[D_HEADS:]
    y_a = dsa_attention(a_q.reshape(B, S, A_HEADS, HEAD_DIM), a_k.reshape(B, S, A_KV_HEADS, HEAD_DIM),
                        a_v.reshape(B, S, A_KV_HEADS, HEAD_DIM), i_q.reshape(B, S, IDX_HEADS, IDX_DIM),
                        i_k, i_w, slopes_a)
    y_b = rglru_branch(r_x, r_g, conv_w, conv_b, lru_wa, lru_ba, lru_wx, lru_bx, lru_lambda)
    y_c = mla_attention(c_q, c_kv, mla_g_q, mla_g_kv, mla_w_uq, mla_w_ukv)
    y_d = sliding_window_attention(d_q.reshape(B, S, D_HEADS, HEAD_DIM), d_k.reshape(B, S, D_KV_HEADS, HEAD_DIM),
                                   d_v.reshape(B, S, D_KV_HEADS, HEAD_DIM), swa_sinks, slopes_d)
    ys = jnp.stack([y_a, y_b, y_c, y_d], axis=2)
    proj = jnp.einsum('bsnw,nwd->bsnd', ys, w_branch)
    g = jax.nn.sigmoid(gates.reshape(B, S, N_BRANCH, D_MODEL))
    return jnp.sum(g * proj, axis=2) @ w_out


def sandwich(x, y_fn, g_pre, g_post, shift, scale, gate, resid_w):
    h = rmsnorm(x, g_pre) * (1.0 + scale) + shift
    return x + resid_w * gate * rmsnorm(y_fn(h), g_post)


def setup_inputs(seed: int = 0) -> dict:
    key = jax.random.key(seed)
    ks = jax.random.split(key, 24)
    f32 = jnp.float32
    nrm = lambda k, shape, fan_in: jax.random.normal(k, shape, f32) * (fan_in ** -0.5)
    bw = LRU_WIDTH // LRU_BLOCKS
    u = jax.random.uniform(ks[14], (DEPTH, LRU_WIDTH), f32, 0.9, 0.999)
    s = u ** (1.0 / LRU_C)
    lru_lambda = jnp.log(s) - jnp.log1p(-s)
    return {
        "x": jax.random.normal(ks[0], (BATCH, SEQ, D_MODEL), f32),
        "c": jax.random.normal(ks[1], (BATCH, D_MODEL), f32),
        "w_ada": 0.5 * nrm(ks[2], (DEPTH, D_MODEL, 9 * D_MODEL), D_MODEL),
        "b_ada": 0.02 * jax.random.normal(ks[3], (DEPTH, 9 * D_MODEL), f32),
        "norm_g": 1.0 + 0.05 * jax.random.normal(ks[4], (DEPTH, 6, D_MODEL), f32),
        "ffn1_w_in": nrm(ks[5], (DEPTH, D_MODEL, 2 * D_FF), D_MODEL),
        "ffn1_w_out": nrm(ks[6], (DEPTH, D_FF, D_MODEL), D_FF),
        "w_in": nrm(ks[7], (DEPTH, D_MODEL, IN_WIDTH), D_MODEL),
        "conv_w": nrm(ks[8], (DEPTH, CONV_WIDTH, LRU_WIDTH), CONV_WIDTH),
        "conv_b": 0.02 * jax.random.normal(ks[9], (DEPTH, LRU_WIDTH), f32),
        "lru_wa": nrm(ks[10], (DEPTH, LRU_BLOCKS, bw, bw), bw),
        "lru_ba": 0.02 * jax.random.normal(ks[11], (DEPTH, LRU_WIDTH), f32),
        "lru_wx": nrm(ks[12], (DEPTH, LRU_BLOCKS, bw, bw), bw),
        "lru_bx": 0.02 * jax.random.normal(ks[13], (DEPTH, LRU_WIDTH), f32),
        "lru_lambda": lru_lambda,
        "mla_g_q": 1.0 + 0.05 * jax.random.normal(ks[15], (DEPTH, Q_LORA), f32),
        "mla_g_kv": 1.0 + 0.05 * jax.random.normal(ks[16], (DEPTH, KV_LORA), f32),
        "mla_w_uq": nrm(ks[17], (DEPTH, Q_LORA, C_HEADS * (QK_NOPE + QK_ROPE)), Q_LORA),
        "mla_w_ukv": nrm(ks[18], (DEPTH, KV_LORA, C_HEADS * (QK_NOPE + V_DIM)), KV_LORA),
        "swa_sinks": 0.5 * jax.random.normal(ks[19], (DEPTH, D_HEADS), f32),
        "w_branch": nrm(ks[20], (DEPTH, N_BRANCH, BRANCH_WIDTH, D_MODEL), BRANCH_WIDTH),
        "w_out": nrm(ks[21], (DEPTH, D_MODEL, D_MODEL), D_MODEL),
        "ffn2_w_in": nrm(ks[22], (DEPTH, D_MODEL, 2 * D_FF), D_MODEL),
        "ffn2_w_out": nrm(ks[23], (DEPTH, D_FF, D_MODEL), D_FF),
    }


def reference(x, c, w_ada, b_ada, norm_g, ffn1_w_in, ffn1_w_out, w_in, conv_w, conv_b,
              lru_wa, lru_ba, lru_wx, lru_bx, lru_lambda, mla_g_q, mla_g_kv, mla_w_uq, mla_w_ukv,
              swa_sinks, w_branch, w_out, ffn2_w_in, ffn2_w_out):
    B = x.shape[0]
    for l in range(DEPTH):
        mod = (jax.nn.silu(c) @ w_ada[l] + b_ada[l]).reshape(B, 9, 1, D_MODEL)
        g = norm_g[l]
        x = sandwich(x, lambda h: swiglu(h, ffn1_w_in[l], ffn1_w_out[l]),
                     g[0], g[1], mod[:, 0], mod[:, 1], mod[:, 2], 0.5)
        x = sandwich(x, lambda h: token_mixer(h, w_in[l], conv_w[l], conv_b[l], lru_wa[l], lru_ba[l],
                                              lru_wx[l], lru_bx[l], lru_lambda[l], mla_g_q[l], mla_g_kv[l],
                                              mla_w_uq[l], mla_w_ukv[l], swa_sinks[l], w_branch[l], w_out[l]),
                     g[2], g[3], mod[:, 3], mod[:, 4], mod[:, 5], 1.0)
        x = sandwich(x, lambda h: swiglu(h, ffn2_w_in[l], ffn2_w_out[l]),
                     g[4], g[5], mod[:, 6], mod[:, 7], mod[:, 8], 0.5)
    return x
```

```cpp
#include <hip/hip_runtime.h>
#include <cstdio>
#include <cstdint>

#ifndef DBG_FADUP
#define DBG_FADUP -1
#endif
#ifndef DBG_DUP
#define DBG_DUP -1
#endif
#ifndef MK_ONE_LAUNCH
#define MK_ONE_LAUNCH 1
#endif

#define LAS __attribute__((address_space(3)))
#define GAS __attribute__((address_space(1)))
typedef unsigned short bf16_t;
typedef short bf16x8 __attribute__((ext_vector_type(8)));
typedef float f32x4 __attribute__((ext_vector_type(4)));
typedef float f32x2 __attribute__((ext_vector_type(2)));
typedef float f32x16 __attribute__((ext_vector_type(16)));
typedef unsigned u32x4 __attribute__((ext_vector_type(4)));
typedef unsigned u32x2 __attribute__((ext_vector_type(2)));

constexpr int BATCH = 2, SEQ = 8192, DM = 1024, DEPTH = 2, M = BATCH * SEQ;
constexpr int DFF = 2816, ZP = 3584, NG = 4096;
constexpr float EPS = 1e-6f;
constexpr float LOG2E = 1.4426950408889634f;
constexpr int ZC_AQ = 0, ZC_AK = 512, ZC_AV = 640, ZC_DQ = 768, ZC_DK = 1280, ZC_DV = 1408, ZC_RX = 1536, ZC_RG = 2048, ZC_IQ = 2560, ZC_IK = 3072, ZC_IW = 3136, ZC_CQ = 3168, ZC_CKV = 3424;

constexpr size_t MiB = 1u << 20;
constexpr size_t WS_CTL = 0, CTL_ZERO_BYTES = 65536;
constexpr size_t WS_MOD = 1 * MiB;
constexpr size_t WS_ROPE = 2 * MiB;
constexpr size_t WS_LRUS = 3 * MiB;
constexpr size_t WS_KROPE = 4 * MiB;
constexpr size_t WS_RS = 5 * MiB;
constexpr size_t WS_W = 8 * MiB;
constexpr size_t W_W1 = 0, W_W2 = 11534336, W_IN = 17301504, W_G = 24641536, W_UQ = 33030144, W_UKV = 33423360, W_BR = 33685504, W_O = 37879808;
constexpr size_t WS_R1 = 48 * MiB;
constexpr size_t WS_YB = 184 * MiB;
constexpr size_t WS_XN = 248 * MiB;
constexpr size_t WS_R2 = 280 * MiB;
constexpr size_t WS_END = 340 * MiB;
constexpr int CW_TMO = 0, CW_BAR = 4096;

constexpr int RING_BYTES = 131072, EXTRA_OFF = 131072, EXTRA_BYTES = 24576, LDSCTL_OFF = EXTRA_OFF + EXTRA_BYTES, LDS_BYTES = LDSCTL_OFF + 512;
constexpr int NWAVES = 8;

#define RLX_AGENT __ATOMIC_RELAXED, __HIP_MEMORY_SCOPE_AGENT
#define LDS_WAIT() asm volatile("s_waitcnt lgkmcnt(0)" ::: "memory")
#define VM_WAIT() asm volatile("s_waitcnt vmcnt(0)" ::: "memory")
__device__ __forceinline__ unsigned f2bf(float f) { unsigned u = __builtin_bit_cast(unsigned, f); return (u + 0x7fffu + ((u >> 16) & 1u)) >> 16; }
__device__ __forceinline__ unsigned pk2(float lo, float hi) { return f2bf(lo) | (f2bf(hi) << 16); }
__device__ __forceinline__ float bf_lo(unsigned w) { return __builtin_bit_cast(float, w << 16); }
__device__ __forceinline__ float bf_hi(unsigned w) { return __builtin_bit_cast(float, w & 0xffff0000u); }
__device__ __forceinline__ float bf2f(bf16_t b) { return __builtin_bit_cast(float, (unsigned)b << 16); }
typedef float cvt_f32x2 __attribute__((ext_vector_type(2)));
typedef __bf16 cvt_bf16x2 __attribute__((ext_vector_type(2)));
__device__ __forceinline__ unsigned cvt_pk_bf16(float lo, float hi) { return __builtin_bit_cast(unsigned, __builtin_convertvector(((cvt_f32x2){lo, hi}), cvt_bf16x2)); }
__device__ __forceinline__ float wave_sum(float v) {
#pragma unroll
    for (int o = 1; o < 64; o <<= 1) v += __shfl_xor(v, o);
    return v;
}
__device__ __forceinline__ float fast_sigmoid(float x) { return __builtin_amdgcn_rcpf(1.0f + __builtin_amdgcn_exp2f(-x * LOG2E)); }

#define XB_TMO      128
#define XB_XCNT(j)  (256  + 64 * (j))
#define XB_XSUB(j)  (1280 + 64 * (j))
#define XB_XGEN(j)  (2304 + 64 * (j))
#define XB_TOP      3328
#define XB_TOPGEN   3392
#define XCD_BAR_WORDS 3456
#define XB_SPIN_CAP (1u << 18)
__device__ __forceinline__ unsigned xb_ld(unsigned* p)              { return __hip_atomic_load(p, __ATOMIC_RELAXED, __HIP_MEMORY_SCOPE_AGENT); }
__device__ __forceinline__ unsigned xb_add(unsigned* p, unsigned v) { return __hip_atomic_fetch_add(p, v, __ATOMIC_RELAXED, __HIP_MEMORY_SCOPE_AGENT); }
__device__ __forceinline__ unsigned xb_xcc_id() { return (unsigned)__builtin_amdgcn_s_getreg((3 << 11) | 20) & 0xFu; }
#define XB_SPIN(cond, bar) do { unsigned _sp = 0; while (cond) { __builtin_amdgcn_s_sleep(1); \
    if ((++_sp & 255u) == 0u) { if (xb_ld(&(bar)[XB_TMO])) break; if (_sp > XB_SPIN_CAP) { atomicAdd(&(bar)[XB_TMO], 1u); break; } } } } while (0)
struct XcdBarrier { unsigned* bar; unsigned x; volatile LAS unsigned* st; };
__device__ __forceinline__ XcdBarrier xcd_barrier_post(unsigned* bar, volatile LAS unsigned* st) {
    XcdBarrier b; b.bar = bar; b.x = xb_xcc_id(); b.st = st;
    if (threadIdx.x == 0) (void)xb_add(&bar[XB_XCNT(b.x)], 1u);
    return b;
}
__device__ __forceinline__ void xcd_barrier_complete(unsigned* bar, unsigned x, unsigned& nloc, unsigned& nx) {
    const unsigned G = gridDim.x * gridDim.y * gridDim.z;
    unsigned sum, cnt, mine, sp = 0u;
    for (;;) {
        sum = 0u; cnt = 0u; mine = 0u;
#pragma unroll
        for (unsigned j = 0; j < 16; ++j) { const unsigned c = xb_ld(&bar[XB_XCNT(j)]); sum += c; cnt += (c > 0u) ? 1u : 0u; mine = (j == x) ? c : mine; }
        if (sum == G) break;
        __builtin_amdgcn_s_sleep(1);
        if ((++sp & 255u) == 0u) { if (xb_ld(&bar[XB_TMO])) break; if (sp > XB_SPIN_CAP) { atomicAdd(&bar[XB_TMO], 1u); break; } }
    }
    nloc = mine > 0u ? mine : 1u; nx = cnt > 0u ? cnt : 1u;
}
__device__ __forceinline__ void xcd_barrier(const XcdBarrier& b) {
    asm volatile("s_waitcnt vmcnt(0)" ::: "memory");
    __syncthreads();
    if (threadIdx.x == 0) {
        unsigned* bar = b.bar;
        __builtin_amdgcn_s_waitcnt(0);
        unsigned nloc = b.st[0], nx = b.st[1];
        if (nloc == 0u) { xcd_barrier_complete(bar, b.x, nloc, nx); b.st[0] = nloc; b.st[1] = nx; }
        const unsigned old = xb_add(&bar[XB_XSUB(b.x)], 1u);
        const unsigned gen = old / nloc;
        if (old + 1u == (gen + 1u) * nloc) {
            __builtin_amdgcn_fence(__ATOMIC_RELEASE, "agent");
            asm volatile("s_waitcnt vmcnt(0)" ::: "memory");
            const unsigned og = xb_add(&bar[XB_TOP], 1u);
            const unsigned tg = og / nx;
            if (og + 1u == (tg + 1u) * nx) xb_add(&bar[XB_TOPGEN], 1u);
            else XB_SPIN(xb_ld(&bar[XB_TOPGEN]) == tg, bar);
            __builtin_amdgcn_fence(__ATOMIC_ACQUIRE, "agent");
            xb_add(&bar[XB_XGEN(b.x)], 1u);
            asm volatile("s_waitcnt vmcnt(0)" ::: "memory");
        } else {
            XB_SPIN(xb_ld(&bar[XB_XGEN(b.x)]) == gen, bar);
            __builtin_amdgcn_fence(__ATOMIC_ACQUIRE, "agent");
            asm volatile("s_waitcnt vmcnt(0)" ::: "memory");
        }
    }
    __syncthreads();
}

namespace pg8 {
constexpr int BM = 256, BK = 64, HALF = 128, HTB = HALF * BK * 2, STAGE_BYTES = 8 * HTB, NXCD = 8, WGM = 8;
__host__ __device__ __forceinline__ int lds_byte(int r, int c) { const int st = (r >> 4) * 2 + (c >> 5), rr = r & 15, cc = c & 31, ob = rr * 64 + cc * 2; return st * 1024 + (ob ^ (((ob >> 9) & 1) << 5)); }
__host__ __device__ __forceinline__ void stage_rc(int b, int& R, int& C) { const int st = b / 1024, sb = b % 1024, swz = sb ^ (((sb >> 9) & 1) << 5); R = (st >> 1) * 16 + swz / 64; C = (st & 1) * 32 + (swz % 64) / 2; }
__host__ __device__ __forceinline__ int perm32(int rho) { const int n = rho >> 4, i = rho & 15; return 8 * (i >> 2) + 4 * n + (i & 3); }

struct Unit { int pm, pn, ka, kb, sub; };
struct Gemm { const bf16_t* A; const bf16_t* Bt; int lda, ldb, K; };

struct StaticOrder {
    int nM, nN, nwg, G, c;
    __device__ void init(int M_, int N_, int G_, int c_) { nM = M_ / BM; nN = N_ / BM; nwg = nM * nN; G = G_; c = c_; }
    __device__ bool tile(int i, Unit& u) const {
        const long L = (long)i * G + c; if (L >= nwg) return false;
        int wgid = (int)L; { const int q = nwg / NXCD, r = nwg % NXCD, xcd = wgid % NXCD, off = wgid / NXCD; wgid = (xcd < r ? xcd * (q + 1) : r * (q + 1) + (xcd - r) * q) + off; }
        const int nig = WGM * nN, gid = wgid / nig, fm = gid * WGM, gsz = (nM - fm) < WGM ? (nM - fm) : WGM;
        u.pm = fm + ((wgid % nig) % gsz); u.pn = (wgid % nig) / gsz; return true;
    }
    __device__ bool next(int i, Unit& u) const { u.ka = 0; u.kb = 0; u.sub = 0; return tile(i, u); }
};
struct ChainOrder {
    StaticOrder so;
    __device__ bool next(int i, Unit& u) const { const int s = i & 3; u.ka = 512 * s; u.kb = 512 * s; u.sub = s; return so.tile(i >> 2, u); }
};

template <int ACT  > struct EpiBf16 {
    static constexpr bool PERM = true, CHAIN = false;
    bf16_t* O; int ldc;
    __device__ __forceinline__ void operator()(f32x4 (&acc)[2][2][4][2], const Unit& u, int wr, int wc, int fr, int fq) const {
        const int row0 = u.pm * BM + wr * 64 + fr, col0 = u.pn * BM + wc * 32 + 8 * fq;
#pragma unroll
        for (int ai = 0; ai < 2; ++ai)
#pragma unroll
            for (int m = 0; m < 4; ++m) { bf16_t* rowp = O + (size_t)(row0 + ai * HALF + m * 16) * ldc + col0;
#pragma unroll
                for (int bj = 0; bj < 2; ++bj) { f32x4 v0 = acc[ai][bj][m][0], v1 = acc[ai][bj][m][1];
                    if (ACT == 2) {
#pragma unroll
                        for (int e = 0; e < 4; ++e) { v0[e] = __builtin_fmaxf(fast_sigmoid(v0[e]), 1e-30f); v1[e] = __builtin_fmaxf(fast_sigmoid(v1[e]), 1e-30f); } }
                    u32x4 w; w.x = cvt_pk_bf16(v0[0], v0[1]); w.y = cvt_pk_bf16(v0[2], v0[3]); w.z = cvt_pk_bf16(v1[0], v1[1]); w.w = cvt_pk_bf16(v1[2], v1[3]);
                    *(u32x4*)(rowp + bj * HALF) = w; } }
    }
};
struct EpiSwiglu {
    static constexpr bool PERM = true, CHAIN = false;
    bf16_t* O; int ldc;
    __device__ __forceinline__ void operator()(f32x4 (&acc)[2][2][4][2], const Unit& u, int wr, int wc, int fr, int fq) const {
        const int row0 = u.pm * BM + wr * 64 + fr, col0 = u.pn * HALF + wc * 32 + 8 * fq;
#pragma unroll
        for (int ai = 0; ai < 2; ++ai)
#pragma unroll
            for (int m = 0; m < 4; ++m) { bf16_t* rowp = O + (size_t)(row0 + ai * HALF + m * 16) * ldc + col0;
                float h[8];
#pragma unroll
                for (int n = 0; n < 2; ++n)
#pragma unroll
                    for (int e = 0; e < 4; ++e) { const float g = acc[ai][0][m][n][e], up = acc[ai][1][m][n][e]; h[4 * n + e] = g * fast_sigmoid(g) * up; }
                u32x4 w; w.x = cvt_pk_bf16(h[0], h[1]); w.y = cvt_pk_bf16(h[2], h[3]); w.z = cvt_pk_bf16(h[4], h[5]); w.w = cvt_pk_bf16(h[6], h[7]);
                *(u32x4*)rowp = w; }
    }
};

struct EpiMlaQ {
    static constexpr bool PERM = true, CHAIN = false;
    bf16_t* O; int ldc; const f32x2* rt;
    __device__ __forceinline__ void operator()(f32x4 (&acc)[2][2][4][2], const Unit& u, int wr, int wc, int fr, int fq) const {
        const int row0 = u.pm * BM + wr * 64 + fr, col0 = u.pn * BM + wc * 32 + 8 * fq;
        const int k3 = __builtin_amdgcn_readfirstlane((u.pn * 8 + wc) % 3); const int rbj = k3 == 2 ? 0 : (k3 == 1 ? 1 : -1);
        f32x4 cs[2][4][2];
        { const GAS f32x4* tp = (const GAS f32x4*)(rt + (size_t)(row0 & (SEQ - 1)) * 16 + 4 * fq); asm volatile("" : "+v"(tp));
#pragma unroll
          for (int ai = 0; ai < 2; ++ai)
#pragma unroll
              for (int m = 0; m < 4; ++m) { cs[ai][m][0] = tp[(ai * HALF + m * 16) * 8]; cs[ai][m][1] = tp[(ai * HALF + m * 16) * 8 + 1]; } }
#pragma unroll
        for (int ai = 0; ai < 2; ++ai)
#pragma unroll
            for (int m = 0; m < 4; ++m) { const int row = row0 + ai * HALF + m * 16; bf16_t* rowp = O + (size_t)row * ldc + col0;
#pragma unroll
                for (int bj = 0; bj < 2; ++bj) {
                    float v[8];
#pragma unroll
                    for (int e = 0; e < 4; ++e) { v[e] = acc[ai][bj][m][0][e]; v[4 + e] = acc[ai][bj][m][1][e]; }
                    if (bj == rbj) {
#pragma unroll
                        for (int pp = 0; pp < 4; ++pp) { const f32x4 q = cs[ai][m][pp >> 1]; const float co = q[2 * (pp & 1)], si = q[2 * (pp & 1) + 1];
                            const float x1 = v[2 * pp], x2 = v[2 * pp + 1]; v[2 * pp] = x1 * co - x2 * si; v[2 * pp + 1] = x2 * co + x1 * si; } }
                    u32x4 w; w.x = cvt_pk_bf16(v[0], v[1]); w.y = cvt_pk_bf16(v[2], v[3]); w.z = cvt_pk_bf16(v[4], v[5]); w.w = cvt_pk_bf16(v[6], v[7]);
                    *(u32x4*)(rowp + bj * HALF) = w; } }
    }
};
struct EpiRowScale {
    static constexpr bool PERM = true, CHAIN = false;
    bf16_t* O; int ldc; const float* rs;
    __device__ __forceinline__ void operator()(f32x4 (&acc)[2][2][4][2], const Unit& u, int wr, int wc, int fr, int fq) const {
        const int row0 = u.pm * BM + wr * 64 + fr, col0 = u.pn * BM + wc * 32 + 8 * fq;
#pragma unroll
        for (int ai = 0; ai < 2; ++ai)
#pragma unroll
            for (int m = 0; m < 4; ++m) { const int row = row0 + ai * HALF + m * 16; const float sc = rs[row]; bf16_t* rowp = O + (size_t)row * ldc + col0;
#pragma unroll
                for (int bj = 0; bj < 2; ++bj) { const f32x4 v0 = acc[ai][bj][m][0] * sc, v1 = acc[ai][bj][m][1] * sc;
                    u32x4 w; w.x = cvt_pk_bf16(v0[0], v0[1]); w.y = cvt_pk_bf16(v0[2], v0[3]); w.z = cvt_pk_bf16(v1[0], v1[1]); w.w = cvt_pk_bf16(v1[2], v1[3]);
                    *(u32x4*)(rowp + bj * HALF) = w; } }
    }
};
struct EpiGateMerge {
    static constexpr bool PERM = true, CHAIN = true;
    const bf16_t* G; bf16_t* O; int ldc;
    __device__ __forceinline__ void operator()(f32x4 (&acc)[2][2][4][2], const Unit& u, int wr, int wc, int fr, int fq) const {
        const int row0 = u.pm * BM + wr * 64 + fr, col0 = u.pn * BM + wc * 32 + 8 * fq; const int s = u.sub;
#pragma unroll
        for (int ai = 0; ai < 2; ++ai) {
            u32x4 ga[4][2], gb[4][2];
            const GAS bf16_t* gp0 = (const GAS bf16_t*)G + (size_t)(row0 + ai * HALF) * NG + 1024 * s + col0; asm volatile("" : "+v"(gp0));
#pragma unroll
            for (int m = 0; m < 4; ++m)
#pragma unroll
                for (int bj = 0; bj < 2; ++bj) { ga[m][bj] = *(const GAS u32x4*)(gp0 + (size_t)(m * 16) * NG + bj * HALF); gb[m][bj] = ga[m][bj]; }
            if (s < 3) {
#pragma unroll
                for (int m = 0; m < 4; ++m)
#pragma unroll
                    for (int bj = 0; bj < 2; ++bj) gb[m][bj] = *(const GAS u32x4*)(gp0 + (size_t)(m * 16) * NG + 1024 + bj * HALF); }
#pragma unroll
            for (int m = 0; m < 4; ++m) { const int row = row0 + ai * HALF + m * 16;
#pragma unroll
                for (int bj = 0; bj < 2; ++bj) {
                    const u32x4 gA = ga[m][bj];
                    float f[8] = {bf_lo(gA.x), bf_hi(gA.x), bf_lo(gA.y), bf_hi(gA.y), bf_lo(gA.z), bf_hi(gA.z), bf_lo(gA.w), bf_hi(gA.w)};
                    if (s < 3) { const u32x4 gB = gb[m][bj];
                        const float d[8] = {bf_lo(gB.x), bf_hi(gB.x), bf_lo(gB.y), bf_hi(gB.y), bf_lo(gB.z), bf_hi(gB.z), bf_lo(gB.w), bf_hi(gB.w)};
#pragma unroll
                        for (int e = 0; e < 8; ++e) f[e] = f[e] * __builtin_amdgcn_rcpf(d[e]); }
#pragma unroll
                    for (int e = 0; e < 4; ++e) { acc[ai][bj][m][0][e] *= f[e]; acc[ai][bj][m][1][e] *= f[4 + e]; }
                    if (s == 3) { const f32x4 v0 = acc[ai][bj][m][0], v1 = acc[ai][bj][m][1];
                        u32x4 w; w.x = cvt_pk_bf16(v0[0], v0[1]); w.y = cvt_pk_bf16(v0[2], v0[3]); w.z = cvt_pk_bf16(v1[0], v1[1]); w.w = cvt_pk_bf16(v1[2], v1[3]);
                        *(u32x4*)(O + (size_t)row * ldc + col0 + bj * HALF) = w; } } } }
    }
};

template <class Epi, class Sched, bool ALIGN_EPI>
__device__ __forceinline__ void gemm_phase(LAS unsigned char* lds, const int tid, const Gemm g, const Sched& S, const Epi& E) {
    const int wid = __builtin_amdgcn_readfirstlane(tid >> 6), lane = tid & 63, wr = wid >> 2, wc = wid & 3, fr = lane & 15, fq = lane >> 4;
    const int nt = g.K / BK;
    unsigned voffA[2], voffB[2];
#pragma unroll
    for (int i = 0; i < 2; ++i) { int R, C; stage_rc(tid * 16 + i * 8192, R, C); const int Rb = Epi::PERM ? ((R & ~31) + perm32(R & 31)) : R;
        voffA[i] = (unsigned)(R * g.lda + C) * 2u; voffB[i] = (unsigned)(Rb * g.ldb + C) * 2u; }
    const size_t kstep = (size_t)(BK * 2);
    const size_t hstepA = (size_t)HALF * g.lda * 2, hstepB = (size_t)HALF * g.ldb * 2;
    const unsigned ldsw = (unsigned)wid * 1024u;
    const int aoff = lds_byte(wr * 64 + fr, fq * 8), boff = lds_byte(wc * 32 + fr, fq * 8);
#define PG8_SA(b, h) (((b) * 2 + (h)) * HTB)
#define PG8_SB(b, h) ((4 + (b) * 2 + (h)) * HTB)
#define PG8_STAGE(bufoff, gbase, voff) do { _Pragma("unroll") for (int _i = 0; _i < 2; ++_i) \
        __builtin_amdgcn_global_load_lds((const unsigned*)((const char*)(gbase) + (voff)[_i]), (LAS unsigned*)(lds + (bufoff) + ldsw + _i * 8192), 16, 0, 0); } while (0)
#define PG8_LDA(dst, b, h) do { _Pragma("unroll") for (int m = 0; m < 4; ++m) _Pragma("unroll") for (int k = 0; k < 2; ++k) dst[m][k] = *(const LAS bf16x8*)(lds + PG8_SA(b, h) + aoff + m * 2048 + k * 1024); } while (0)
#define PG8_LDB(dst, b, h) do { _Pragma("unroll") for (int n = 0; n < 2; ++n) _Pragma("unroll") for (int k = 0; k < 2; ++k) dst[n][k] = *(const LAS bf16x8*)(lds + PG8_SB(b, h) + boff + n * 2048 + k * 1024); } while (0)
#define PG8_MMA(ai, bj, At, Bt) do { __builtin_amdgcn_s_setprio(1); _Pragma("unroll") for (int m = 0; m < 4; ++m) _Pragma("unroll") for (int n = 0; n < 2; ++n) _Pragma("unroll") for (int k = 0; k < 2; ++k) \
        acc[ai][bj][m][n] = __builtin_amdgcn_mfma_f32_16x16x32_bf16(Bt[n][k], At[m][k], acc[ai][bj][m][n], 0, 0, 0); __builtin_amdgcn_s_setprio(0); } while (0)
#define PG8_WAIT_V(n) asm volatile("s_waitcnt vmcnt(" #n ")" ::: "memory")
#define PG8_WAIT_L(n) asm volatile("s_waitcnt lgkmcnt(" #n ")" ::: "memory")
#define PG8_BAR __builtin_amdgcn_s_barrier()
#define PG8_SCHED __builtin_amdgcn_sched_barrier(0)
#define PG8_UA(u) ((const char*)g.A + (size_t)(u).pm * 2 * hstepA + (size_t)(u).ka * 2)
#define PG8_UB(u) ((const char*)g.Bt + (size_t)(u).pn * 2 * hstepB + (size_t)(u).kb * 2)
    Unit cur, nxt; int ui = 0;
    if (!S.next(0, cur)) return;
    f32x4 acc[2][2][4][2];
#pragma unroll
    for (int a = 0; a < 2; ++a)
#pragma unroll
        for (int b = 0; b < 2; ++b)
#pragma unroll
            for (int m = 0; m < 4; ++m)
#pragma unroll
                for (int n = 0; n < 2; ++n) acc[a][b][m][n] = (f32x4){0.f, 0.f, 0.f, 0.f};
    bf16x8 At[4][2], B0[2][2], B1[2][2];
    const char* cA = PG8_UA(cur); const char* cB = PG8_UB(cur);
    PG8_STAGE(PG8_SB(0, 0), cB, voffB); PG8_STAGE(PG8_SB(0, 1), cB + hstepB, voffB); PG8_STAGE(PG8_SA(0, 0), cA, voffA); PG8_STAGE(PG8_SA(0, 1), cA + hstepA, voffA);
    if (wr == 1) PG8_BAR;
    PG8_WAIT_V(2); PG8_BAR;
    PG8_STAGE(PG8_SB(1, 0), cB + kstep, voffB); PG8_STAGE(PG8_SA(1, 0), cA + kstep, voffA); PG8_STAGE(PG8_SB(1, 1), cB + hstepB + kstep, voffB);
    PG8_WAIT_V(6); PG8_BAR;
    for (;;) {
        const bool has_next = S.next(ui + 1, nxt);
        const char* nA = has_next ? PG8_UA(nxt) : cA; const char* nB = has_next ? PG8_UB(nxt) : cB;
        for (int t = 0; t < nt; t += 2) {
            const bool last = (t == nt - 2);
            const char* a1 = cA + (size_t)(t + 1) * kstep;
            const char* a2 = last ? nA : cA + (size_t)(t + 2) * kstep; const char* b2 = last ? nB : cB + (size_t)(t + 2) * kstep;
            const char* a3 = a2 + kstep; const char* b3 = b2 + kstep;
            PG8_LDB(B0, 0, 0); PG8_LDB(B1, 0, 1); PG8_SCHED; PG8_LDA(At, 0, 0); PG8_STAGE(PG8_SA(1, 1), a1 + hstepA, voffA);
            PG8_WAIT_V(8); PG8_WAIT_L(0); PG8_BAR; PG8_MMA(0, 0, At, B0); PG8_MMA(0, 1, At, B1); PG8_BAR; PG8_SCHED;
            PG8_LDA(At, 0, 1); PG8_STAGE(PG8_SB(0, 0), b2, voffB); PG8_STAGE(PG8_SB(0, 1), b2 + hstepB, voffB); PG8_STAGE(PG8_SA(0, 0), a2, voffA);
            PG8_WAIT_V(8); PG8_WAIT_L(0); PG8_BAR; PG8_MMA(1, 0, At, B0); PG8_MMA(1, 1, At, B1); PG8_BAR; PG8_SCHED;
            PG8_LDB(B0, 1, 0); PG8_LDB(B1, 1, 1); PG8_SCHED; PG8_LDA(At, 1, 0); PG8_STAGE(PG8_SA(0, 1), a2 + hstepA, voffA);
            PG8_WAIT_V(8); PG8_WAIT_L(0); PG8_BAR; PG8_MMA(0, 0, At, B0); PG8_MMA(0, 1, At, B1); PG8_BAR; PG8_SCHED;
            PG8_LDA(At, 1, 1); PG8_STAGE(PG8_SB(1, 0), b3, voffB); PG8_STAGE(PG8_SB(1, 1), b3 + hstepB, voffB); PG8_STAGE(PG8_SA(1, 0), a3, voffA);
            PG8_WAIT_V(8); PG8_WAIT_L(0); PG8_BAR; PG8_MMA(1, 0, At, B0); PG8_MMA(1, 1, At, B1); PG8_BAR; PG8_SCHED;
        }
        if constexpr (ALIGN_EPI) { if (wr == 0) PG8_BAR; }
        { int fr_ = fr, fq_ = fq; asm volatile("" : "+v"(fr_), "+v"(fq_));
          E(acc, cur, wr, wc, fr_, fq_); }
        if (!has_next) break;
        if (!(Epi::CHAIN && cur.sub != 3)) {
#pragma unroll
            for (int a = 0; a < 2; ++a)
#pragma unroll
                for (int b = 0; b < 2; ++b)
#pragma unroll
                    for (int m = 0; m < 4; ++m)
#pragma unroll
                        for (int n = 0; n < 2; ++n) acc[a][b][m][n] = (f32x4){0.f, 0.f, 0.f, 0.f};
        }
        cur = nxt; cA = nA; cB = nB; ++ui;
        if constexpr (ALIGN_EPI) { if (wr == 1) PG8_BAR; }
    }
    PG8_WAIT_V(0);
    if constexpr (!ALIGN_EPI) { if (wr == 0) PG8_BAR; }
    PG8_BAR;
#undef PG8_SA
#undef PG8_SB
#undef PG8_STAGE
#undef PG8_LDA
#undef PG8_LDB
#undef PG8_MMA
#undef PG8_WAIT_V
#undef PG8_WAIT_L
#undef PG8_BAR
#undef PG8_SCHED
#undef PG8_UA
#undef PG8_UB
}
}

struct Args { const float* in[24]; float* out; unsigned char* ws; int ph_lo, ph_hi, li, pad; };
struct Frame {
    LAS unsigned char* lds;
    int tid, lane, wave, vcu, G;
    const Args* a;
    int zz;
    __device__ __forceinline__ const float* in(int i) const { return (const float*)(const GAS float*)karg(8 * i); }
    __device__ __forceinline__ unsigned long long karg(int byte_off) const { unsigned long long p; asm volatile("s_load_dwordx2 %0, %1, %2\n\ts_waitcnt lgkmcnt(0)" : "=s"(p) : "s"(__builtin_amdgcn_kernarg_segment_ptr()), "s"(byte_off)); return p; }
    __device__ __forceinline__ unsigned char* wsp(size_t off = 0) const { return (unsigned char*)((GAS unsigned char*)karg(25 * 8) + off); }
    __device__ __forceinline__ float* outp() const { return (float*)(GAS float*)karg(24 * 8); }
};
#define IN_X 0
#define IN_C 1
#define IN_WADA 2
#define IN_BADA 3
#define IN_NORMG 4
#define IN_F1IN 5
#define IN_F1OUT 6
#define IN_WIN 7
#define IN_CONVW 8
#define IN_CONVB 9
#define IN_LRUWA 10
#define IN_LRUBA 11
#define IN_LRUWX 12
#define IN_LRUBX 13
#define IN_LRULAM 14
#define IN_GQ 15
#define IN_GKV 16
#define IN_WUQ 17
#define IN_WUKV 18
#define IN_SINKS 19
#define IN_WBR 20
#define IN_WOUT 21
#define IN_F2IN 22
#define IN_F2OUT 23

struct CvtSeg { const float* src; int ldn, col0, ncols, K; bf16_t* dst; int ldk, koff, drow0, mode; float scale; const float* kgain; };
__device__ __forceinline__ int cvt_row(const CvtSeg& s, int n) {
    if (s.mode == 1) { const int half = n >= DFF ? 1 : 0, j = n - DFF * half; return 256 * (j >> 7) + 128 * half + (j & 127); }
    if (s.mode == 2) { const int h = n / 96, c = n - 96 * h; return 96 * h + (c < 64 ? c : (c < 80 ? 64 + 2 * (c - 64) : 64 + 2 * (c - 80) + 1)); }
    return s.drow0 + n;
}
__device__ __forceinline__ void cvt_load(const CvtSeg& s, int item, int lane, f32x4 (&v)[16]) {
    const int nblk = (s.ncols + 63) >> 6, kb = item / nblk, nb = item - kb * nblk, k0 = 64 * kb, n0 = 64 * nb;
    const int nl = n0 + 4 * (lane & 15); const bool okc = nl < s.ncols;
    const GAS float* sp = (const GAS float*)s.src + (size_t)(k0 + (lane >> 4)) * s.ldn + s.col0 + (okc ? nl : 0); const size_t step = (size_t)4 * s.ldn;
#pragma unroll
    for (int i = 0; i < 16; ++i) { v[i] = *(const GAS f32x4*)sp; sp += step; asm volatile("" : "+v"(sp)); }
}
__device__ __forceinline__ void cvt_finish(const CvtSeg& s, LAS float* scr, int item, int lane, f32x4 (&v)[16]) {
    const int nblk = (s.ncols + 63) >> 6, kb = item / nblk, nb = item - kb * nblk, k0 = 64 * kb, n0 = 64 * nb;
    const int nl = n0 + 4 * (lane & 15); const bool okc = nl < s.ncols;
    const float sc_ = okc ? s.scale : 0.0f;
#pragma unroll
    for (int i = 0; i < 16; ++i) { const int kk = 4 * i + (lane >> 4);
        v[i] *= sc_; if (s.kgain) v[i] *= s.kgain[k0 + kk];
        LAS float* p = scr + kk * 65 + 4 * (lane & 15); p[0] = v[i].x; p[1] = v[i].y; p[2] = v[i].z; p[3] = v[i].w; }
    LDS_WAIT(); asm volatile("" ::: "memory");
    const int c = lane & 7;
#pragma unroll
    for (int j = 0; j < 8; ++j) { const int n = (lane >> 3) + 8 * j; const LAS float* p = scr + (8 * c) * 65 + n;
        u32x4 o; o.x = pk2(p[0 * 65], p[1 * 65]); o.y = pk2(p[2 * 65], p[3 * 65]); o.z = pk2(p[4 * 65], p[5 * 65]); o.w = pk2(p[6 * 65], p[7 * 65]);
        if (n0 + n < s.ncols) *(u32x4*)(s.dst + (size_t)cvt_row(s, n0 + n) * s.ldk + s.koff + k0 + 8 * c) = o; }
    LDS_WAIT(); asm volatile("" ::: "memory");
}
constexpr int NSEG_A = 24, NSEG_B = 2;
__device__ const int SEG_C0[15] = {0, 512, 640, 768, 1280, 1344, 1352, 1864, 2376, 2632, 2792, 3304, 3432, 3560, 0};
__device__ const int SEG_NC[15] = {512, 128, 128, 512, 64, 8, 512, 512, 256, 160, 512, 128, 128, 4096, 24};
__device__ const int SEG_DR[15] = {ZC_AQ, ZC_AK, ZC_AV, ZC_IQ, ZC_IK, ZC_IW, ZC_RX, ZC_RG, ZC_CQ, ZC_CKV, ZC_DQ, ZC_DK, ZC_DV, 0, ZC_IW + 8};
__device__ __forceinline__ void get_seg(const Frame& F, int l, int set, int si, CvtSeg& s) {
    bf16_t* W = (bf16_t*)(F.wsp(WS_W));
    s.kgain = nullptr; s.scale = 1.f; s.mode = 0; s.koff = 0; s.drow0 = 0; s.col0 = 0;
    if (si < 2) {
        const float* win_ = set ? F.in(IN_F2IN) : F.in(IN_F1IN); const float* wout_ = set ? F.in(IN_F2OUT) : F.in(IN_F1OUT);
        if (si == 0) { s.src = win_ + (size_t)l * DM * 2 * DFF; s.ldn = 2 * DFF; s.ncols = 2 * DFF; s.K = DM; s.dst = W + W_W1 / 2; s.ldk = DM; s.mode = 1; }
        else { s.src = wout_ + (size_t)l * DFF * DM; s.ldn = DM; s.ncols = DM; s.K = DFF; s.dst = W + W_W2 / 2; s.ldk = DFF; }
        return;
    }
    const float QS = 0.125f * LOG2E;
    int k = si - 2;
    if (k < 15) {
        s.src = F.in(IN_WIN) + (size_t)l * DM * 7656; s.ldn = 7656; s.col0 = SEG_C0[k];        s.ncols = SEG_NC[k]; s.K = DM; s.ldk = DM; s.drow0 = SEG_DR[k];
        s.dst = (k == 13) ? (W + W_G / 2) : (W + W_IN / 2);
        if (k == 0 || k == 10) s.scale = QS;
        if (k == 14) s.scale = 0.0f;
        return;
    }
    k -= 15;
    if (k == 0) { s.src = F.in(IN_WUQ) + (size_t)l * 256 * 768; s.ldn = 768; s.ncols = 768; s.K = 256; s.dst = W + W_UQ / 2; s.ldk = 256; s.mode = 2; s.scale = 0.10206207261596575f * LOG2E; s.kgain = F.in(IN_GQ) + l * 256; return; }
    if (k == 1) { s.src = F.in(IN_WUKV) + (size_t)l * 128 * 1024; s.ldn = 1024; s.ncols = 1024; s.K = 128; s.dst = W + W_UKV / 2; s.ldk = 128; s.kgain = F.in(IN_GKV) + l * 128; return; }
    if (k < 6) { const int n = k - 2; s.src = F.in(IN_WBR) + ((size_t)l * 4 + n) * 512 * 1024; s.ldn = 1024; s.ncols = 1024; s.K = 512; s.dst = W + W_BR / 2; s.ldk = 2048; s.koff = 512 * n; return; }
    s.src = F.in(IN_WOUT) + (size_t)l * DM * DM; s.ldn = DM; s.ncols = DM; s.K = DM; s.dst = W + W_O / 2; s.ldk = DM;
}
__device__ __forceinline__ void convert_weights(const Frame& F, int l, int set, int si0, int si1, int gw, int NGW) {
    LAS float* scr = (LAS float*)(F.lds + F.wave * 16896);
    int base = 0;
#ifdef DBG_CVTDUP
    for (int rep4_ = 0; rep4_ < 2; ++rep4_) { base = 0;
#endif
    for (int si = si0; si < si1; ++si) {
        CvtSeg s; get_seg(F, l, set, si, s);
        const int nit = (s.K >> 6) * ((s.ncols + 63) >> 6);
        int it = (gw - base % NGW + NGW) % NGW;
        for (; it < nit; it += 2 * NGW) {
            f32x4 va[16], vb[16]; const bool hb = it + NGW < nit;
            cvt_load(s, it, F.lane, va); if (hb) cvt_load(s, it + NGW, F.lane, vb);
            cvt_finish(s, scr, it, F.lane, va); if (hb) cvt_finish(s, scr, it + NGW, F.lane, vb); }
        base += nit;
    }
#ifdef DBG_CVTDUP
    }
#endif
}

__device__ __forceinline__ void mod_unit(const Frame& F, int unit) {
    const int l = unit / 72, cb = unit % 72, ks = F.tid >> 5, cg = F.tid & 31;
    const float* wa = F.in(IN_WADA) + (size_t)l * DM * 9216 + 128 * cb + 4 * cg;
    const float* c0 = F.in(IN_C); const float* c1 = c0 + DM;
    f32x4 a0 = {0.f, 0.f, 0.f, 0.f}, a1 = {0.f, 0.f, 0.f, 0.f};
    const GAS float* wp = (const GAS float*)wa + (size_t)(64 * ks) * 9216;
    for (int kb = 64 * ks; kb < 64 * ks + 64; kb += 16) {
        f32x4 w[16];
#pragma unroll
        for (int i = 0; i < 16; ++i) { w[i] = *(const GAS f32x4*)wp; wp += 9216; asm volatile("" : "+v"(wp)); }
#pragma unroll
        for (int i = 0; i < 16; ++i) { const float x0 = c0[kb + i], x1 = c1[kb + i];
            const float s0 = x0 / (1.f + __expf(-x0)), s1 = x1 / (1.f + __expf(-x1));
            a0 += w[i] * s0; a1 += w[i] * s1; }
    }
    LAS f32x4* red = (LAS f32x4*)F.lds;
    red[(ks * 32 + cg) * 2 + 0] = a0; red[(ks * 32 + cg) * 2 + 1] = a1;
    __syncthreads();
    if (F.tid < 64) { const int g2 = F.tid >> 1, b = F.tid & 1; f32x4 s = {0.f, 0.f, 0.f, 0.f};
#pragma unroll
        for (int q = 0; q < 16; ++q) s += red[(q * 32 + g2) * 2 + b];
        const f32x4 bb = *(const f32x4*)(F.in(IN_BADA) + (size_t)l * 9216 + 128 * cb + 4 * g2);
        float* mo = (float*)(F.wsp(WS_MOD)) + ((size_t)(l * 2 + b)) * 9216 + 128 * cb + 4 * g2;
        *(f32x4*)mo = s + bb; }
    __syncthreads();
}
__device__ __forceinline__ void rope_table(const Frame& F) {
    const double inv[16] = {1.0, 0.56234132519034907, 0.31622776601683794, 0.17782794100389229, 0.10000000000000001, 0.056234132519034911, 0.031622776601683791, 0.017782794100389229,
                            0.01, 0.005623413251903491, 0.0031622776601683794, 0.0017782794100389228, 0.001, 0.0005623413251903491, 0.00031622776601683794, 0.00017782794100389227};
    const int gid = F.vcu * 512 + F.tid;
    for (int e = gid; e < SEQ * 16; e += F.G * 512) {
        const int pos = e >> 4, j = e & 15;
        double th = 1.0;
#pragma unroll
        for (int q = 0; q < 16; ++q) th = (j == q) ? inv[q] : th;
        const double t2 = th * th; double cs = 1.0, sn = th, tc = 1.0, ts = th;
#pragma unroll
        for (int n = 1; n <= 12; ++n) { tc *= -t2 / (double)((2 * n - 1) * (2 * n)); ts *= -t2 / (double)((2 * n) * (2 * n + 1)); cs += tc; sn += ts; }
        double rc = 1.0, rs = 0.0;
#pragma unroll
        for (int bit = 0; bit < 13; ++bit) {
            if ((pos >> bit) & 1) { const double nc = rc * cs - rs * sn, ns = rc * sn + rs * cs; rc = nc; rs = ns; }
            const double c2 = cs * cs - sn * sn, s2 = 2.0 * cs * sn; cs = c2; sn = s2;
        }
        ((f32x2*)(F.wsp(WS_ROPE)))[e] = (f32x2){(float)rc, (float)rs};
    }
}
template <bool HAS_Y, bool HAS_NEXT>
__device__ __forceinline__ void norm_pass(const Frame& F, const bf16_t* Y, const float* xs, float* xd, const float* gpost, const float* gate, float rw,
                                          const float* gpre, const float* scale, const float* shift, bf16_t* XN) {
    const int gw = F.vcu * NWAVES + F.wave, NGW = F.G * NWAVES;
    constexpr int R = 4;
    for (int m0 = gw; m0 < M; m0 += R * NGW) {
        f32x4 v[R][4]; u32x2 yw[R][4];
#pragma unroll
        for (int r = 0; r < R; ++r) { const int m = (m0 + r * NGW < M) ? m0 + r * NGW : m0;
            const GAS f32x4* xr = (const GAS f32x4*)(xs + (size_t)m * DM) + F.lane;
#pragma unroll
            for (int j = 0; j < 4; ++j) v[r][j] = xr[64 * j];
            if (HAS_Y) { const GAS u32x2* yr = (const GAS u32x2*)(Y + (size_t)m * DM) + F.lane;
#pragma unroll
                for (int j = 0; j < 4; ++j) yw[r][j] = yr[64 * j]; } }
        const int b = m0 >> 13;
        f32x4 cpost[4], cpre[4], csh[4];
#pragma unroll
        for (int j = 0; j < 4; ++j) {
            if (HAS_Y) { const f32x4 gp = *(const f32x4*)(gpost + 4 * F.lane + 256 * j); const f32x4 gt = *(const f32x4*)(gate + (size_t)b * 9216 + 4 * F.lane + 256 * j); cpost[j] = (gt * rw) * gp; }
            if (HAS_NEXT) { const f32x4 gp = *(const f32x4*)(gpre + 4 * F.lane + 256 * j); const f32x4 sc = *(const f32x4*)(scale + (size_t)b * 9216 + 4 * F.lane + 256 * j);
                cpre[j] = gp * (sc + 1.0f); csh[j] = *(const f32x4*)(shift + (size_t)b * 9216 + 4 * F.lane + 256 * j); } }
#pragma unroll
        for (int r = 0; r < R; ++r) { const int m = m0 + r * NGW; if (m < M) {
        if (HAS_Y) {
            f32x4 y[4]; float ss = 0.f;
#pragma unroll
            for (int j = 0; j < 4; ++j) { const u32x2 w = yw[r][j]; y[j] = (f32x4){bf_lo(w.x), bf_hi(w.x), bf_lo(w.y), bf_hi(w.y)}; ss += (y[j].x * y[j].x + y[j].y * y[j].y) + (y[j].z * y[j].z + y[j].w * y[j].w); }
            const float rstd = 1.0f / sqrtf(wave_sum(ss) * (1.f / DM) + EPS);
#pragma unroll
            for (int j = 0; j < 4; ++j) v[r][j] += cpost[j] * (y[j] * rstd);
            GAS f32x4* xo = (GAS f32x4*)(xd + (size_t)m * DM) + F.lane;
#pragma unroll
            for (int j = 0; j < 4; ++j) xo[64 * j] = v[r][j];
        }
        if (HAS_NEXT) {
            float ss = 0.f;
#pragma unroll
            for (int j = 0; j < 4; ++j) ss += (v[r][j].x * v[r][j].x + v[r][j].y * v[r][j].y) + (v[r][j].z * v[r][j].z + v[r][j].w * v[r][j].w);
            const float rstd = 1.0f / sqrtf(wave_sum(ss) * (1.f / DM) + EPS);
            GAS u32x2* o8 = (GAS u32x2*)(XN + (size_t)m * DM) + F.lane;
#pragma unroll
            for (int j = 0; j < 4; ++j) {
                const f32x4 o = (v[r][j] * rstd) * cpre[j] + csh[j];
                u32x2 w; w.x = pk2(o.x, o.y); w.y = pk2(o.z, o.w); o8[64 * j] = w; }
        } } }
    }
}


__device__ __forceinline__ void mla_prep(const Frame& F, const bf16_t* Z, bf16_t* CQN, bf16_t* CKN, bf16_t* KR, bf16_t* KIT, const f32x2* rt) {
    const int gw = F.vcu * NWAVES + F.wave, NGW = F.G * NWAVES, lane = F.lane;
    constexpr int R = 4;
    for (int m0 = gw; m0 < M; m0 += R * NGW) {
        u32x4 wq[R], wk[R]; float xa[R], xb[R]; f32x2 cs[R];
#pragma unroll
        for (int r = 0; r < R; ++r) { const int m = (m0 + r * NGW < M) ? m0 + r * NGW : m0; const bf16_t* zr = Z + (size_t)m * ZP;
            wq[r] = (u32x4){0u, 0u, 0u, 0u}; wk[r] = wq[r]; xa[r] = 0.f; xb[r] = 0.f; cs[r] = (f32x2){0.f, 0.f};
            if (lane < 48) wq[r] = *(const u32x4*)(zr + (lane < 32 ? ZC_CQ + 8 * lane : ZC_CKV + 8 * (lane - 32)));
            else { const int j = lane - 48; xa[r] = bf2f(zr[ZC_CKV + 128 + j]); xb[r] = bf2f(zr[ZC_CKV + 144 + j]); cs[r] = rt[(size_t)(m & (SEQ - 1)) * 16 + j]; }
            if (lane < 8) wk[r] = *(const u32x4*)(zr + ZC_IK + 8 * lane); }
#pragma unroll
        for (int r = 0; r < R; ++r) { const int m = m0 + r * NGW; if (m < M) {
        float s1 = 0.f, s2 = 0.f; float a[8] = {0.f, 0.f, 0.f, 0.f, 0.f, 0.f, 0.f, 0.f};
        if (lane < 48) { const u32x4 w = wq[r];
            a[0] = bf_lo(w.x); a[1] = bf_hi(w.x); a[2] = bf_lo(w.y); a[3] = bf_hi(w.y); a[4] = bf_lo(w.z); a[5] = bf_hi(w.z); a[6] = bf_lo(w.w); a[7] = bf_hi(w.w);
            const float s = (a[0] * a[0] + a[1] * a[1]) + (a[2] * a[2] + a[3] * a[3]) + (a[4] * a[4] + a[5] * a[5]) + (a[6] * a[6] + a[7] * a[7]);
            if (lane < 32) s1 = s; else s2 = s; }
        else { const int j = lane - 48; const float x1 = xa[r], x2 = xb[r];
            *(unsigned*)(KR + (size_t)m * 32 + 2 * j) = pk2(x1 * cs[r].x - x2 * cs[r].y, x2 * cs[r].x + x1 * cs[r].y); }
        if (lane < 8) *(u32x4*)(KIT + (size_t)(m >> 5) * 2048 + lane * 256 + (m & 31) * 8) = wk[r];
        s1 = wave_sum(s1); s2 = wave_sum(s2);
        const float r1 = 1.0f / sqrtf(s1 * (1.f / 256.f) + EPS), r2 = 1.0f / sqrtf(s2 * (1.f / 128.f) + EPS);
        if (lane < 48) { const float rr = lane < 32 ? r1 : r2;
            u32x4 o; o.x = pk2(a[0] * rr, a[1] * rr); o.y = pk2(a[2] * rr, a[3] * rr); o.z = pk2(a[4] * rr, a[5] * rr); o.w = pk2(a[6] * rr, a[7] * rr);
            if (lane < 32) *(u32x4*)(CQN + (size_t)m * 256 + 8 * lane) = o; else *(u32x4*)(CKN + (size_t)m * 128 + 8 * (lane - 32)) = o; }
        } }
    }
}

template <bool PASS2>
__device__ __forceinline__ void lru_unit(const Frame& F, int l, int unit, const bf16_t* Z, f32x2* S, bf16_t* YB) {
    constexpr int XS = 520;
    const int b = unit >> 7, k = unit & 127, c = F.tid, n = F.wave, lane = F.lane, r32 = lane & 31, hi = lane >> 5;
    const size_t m0 = (size_t)b * SEQ + 64 * k;
    LAS float* xcs = (LAS float*)F.lds;
    { const float* cw = F.in(IN_CONVW) + (size_t)l * 4 * 512 + c;
      const float w0 = cw[0], w1 = cw[512], w2 = cw[1024], w3 = cw[1536], cb = F.in(IN_CONVB)[l * 512 + c];
      const bf16_t* xr = Z + m0 * ZP + ZC_RX + c;
      float x3 = 0.f, x2 = 0.f, x1 = 0.f;
      if (k > 0) { x3 = bf2f(xr[-3 * (long)ZP]); x2 = bf2f(xr[-2 * (long)ZP]); x1 = bf2f(xr[-1 * (long)ZP]); }
      bf16_t xin[64];
      { const GAS bf16_t* xg = (const GAS bf16_t*)xr;
#pragma unroll
        for (int i = 0; i < 64; ++i) { xin[i] = *xg; xg += ZP; asm volatile("" : "+v"(xg)); } }
#pragma unroll
      for (int i0 = 0; i0 < 64; i0 += 16) {
          LAS float* xw = xcs + c + i0 * XS; asm volatile("" : "+v"(xw));
#pragma unroll
          for (int i = 0; i < 16; ++i) { const float x0 = bf2f(xin[i0 + i]); xw[i * XS] = cb + w0 * x3 + w1 * x2 + w2 * x1 + w3 * x0; x3 = x2; x2 = x1; x1 = x0; } } }
    __syncthreads();
#pragma unroll
    for (int ct = 0; ct < 2; ++ct) {
        __builtin_amdgcn_sched_barrier(0);
        const int ch = 64 * n + 32 * ct + r32;
        const float lam = F.in(IN_LRULAM)[l * 512 + ch]; const float ex_ = __expf(-lam);
        const float splus = lam < -20.f ? -lam : (ex_ < 0.1f ? ex_ * (1.0f - ex_ * (0.5f - ex_ * (0.33333334f - ex_ * (0.25f - ex_ * 0.2f)))) : __logf(1.0f + ex_));
        const float sp8 = -8.0f * LOG2E * splus, bia = F.in(IN_LRUBA)[l * 512 + ch], bix = F.in(IN_LRUBX)[l * 512 + ch];
        float hst = 0.f, apr = 1.f;
        if (PASS2) { const f32x2* sp = S + (size_t)b * 128 * 512 + ch;
            const int kh = (k + 1) >> 1, q0_ = hi ? kh : 0, q1_ = hi ? k : kh;
            float Am = 1.f, Bm = 0.f;
            for (int qb_ = 0; qb_ < kh; qb_ += 32) {
                const GAS f32x2* sq = (const GAS f32x2*)sp + (size_t)(q0_ + qb_) * 512; asm volatile("" : "+v"(sq));
                f32x2 ab[32];
#pragma unroll
                for (int e = 0; e < 32; ++e) { ab[e] = *sq; sq += 512; asm volatile("" : "+v"(sq)); }
#pragma unroll
                for (int e = 0; e < 32; ++e) { const bool v_ = q0_ + qb_ + e < q1_; const float bn = ab[e].x * Bm + ab[e].y, an = ab[e].x * Am; Bm = v_ ? bn : Bm; Am = v_ ? an : Am; } }
            float b0_ = Bm, b1_ = Bm, a0_ = Am, a1_ = Am;
            asm volatile("s_nop 1\n\tv_permlane32_swap_b32 %0, %1\n\tv_permlane32_swap_b32 %2, %3\n\ts_nop 1" : "+v"(b0_), "+v"(b1_), "+v"(a0_), "+v"(a1_));
            hst = a1_ * b0_ + b1_; }
        u32x4 wf[2][4];
        { float wv[2][4][8];
#pragma unroll
          for (int g = 0; g < 2; ++g) {
              const GAS float* pw = (const GAS float*)((g ? F.in(IN_LRUWX) : F.in(IN_LRUWA)) + ((size_t)l * 8 + n) * 4096 + (8 * hi) * 64 + 32 * ct + r32);
              asm volatile("" : "+v"(pw));
#pragma unroll
              for (int ks = 0; ks < 4; ++ks)
#pragma unroll
                  for (int e = 0; e < 8; ++e) wv[g][ks][e] = pw[(16 * ks + e) * 64]; }
#pragma unroll
          for (int g = 0; g < 2; ++g)
#pragma unroll
              for (int ks = 0; ks < 4; ++ks) wf[g][ks] = (u32x4){pk2(wv[g][ks][0], wv[g][ks][1]), pk2(wv[g][ks][2], wv[g][ks][3]), pk2(wv[g][ks][4], wv[g][ks][5]), pk2(wv[g][ks][6], wv[g][ks][7])}; }
        __builtin_amdgcn_sched_barrier(0);
        f32x16 D[2][2];
#pragma unroll
        for (int rt = 0; rt < 2; ++rt)
#pragma unroll
            for (int r = 0; r < 16; ++r) { D[0][rt][r] = bia; D[1][rt][r] = bix; }
#pragma unroll
        for (int rt = 0; rt < 2; ++rt)
#pragma unroll
            for (int ks = 0; ks < 4; ++ks) {
                const LAS f32x4* ap = (const LAS f32x4*)(xcs + (32 * rt + r32) * XS + 64 * n + 16 * ks + 8 * hi);
                const f32x4 a0 = ap[0], a1 = ap[1];
                const u32x4 af = (u32x4){pk2(a0.x, a0.y), pk2(a0.z, a0.w), pk2(a1.x, a1.y), pk2(a1.z, a1.w)};
#pragma unroll
                for (int g = 0; g < 2; ++g) D[g][rt] = __builtin_amdgcn_mfma_f32_32x32x16_bf16(__builtin_bit_cast(bf16x8, af), __builtin_bit_cast(bf16x8, wf[g][ks]), D[g][rt], 0, 0, 0);
            }
        __builtin_amdgcn_sched_barrier(0);
#pragma unroll
        for (int rt = 0; rt < 2; ++rt) {
            const LAS float* xo = xcs + (32 * rt + 4 * hi) * XS + ch;
#pragma unroll
            for (int r = 0; r < 16; ++r) {
                const float rr = fast_sigmoid(D[0][rt][r]), ig = fast_sigmoid(D[1][rt][r]);
                const float l2a = sp8 * rr, a = __builtin_amdgcn_exp2f(l2a), xx = 1.3862943611198906f * l2a;
                const float poly = -xx * (1.0f + xx * (0.5f + xx * (0.16666667f + xx * (0.041666668f + xx * 0.008333334f)))), direct = 1.0f - a * a;
                const float one_m_a2 = (xx > -0.1f) ? poly : direct;
                D[0][rt][r] = a; D[1][rt][r] = __builtin_amdgcn_sqrtf(one_m_a2) * (ig * xo[((r & 3) + 8 * (r >> 2)) * XS]);
            } }
#pragma unroll
        for (int rt = 0; rt < 2; ++rt)
#pragma unroll
            for (int rg = 0; rg < 4; ++rg)
#pragma unroll
                for (int owner = 0; owner < 2; ++owner) {
                    float h = hst, ap = apr;
#pragma unroll
                    for (int e = 0; e < 4; ++e) { const int r = 4 * rg + e; h = D[0][rt][r] * h + D[1][rt][r]; ap *= D[0][rt][r]; D[1][rt][r] = (hi == owner) ? h : D[1][rt][r]; }
                    float h0_ = h, h1_ = h, a0_ = ap, a1_ = ap;
                    asm volatile("s_nop 1\n\tv_permlane32_swap_b32 %0, %1\n\tv_permlane32_swap_b32 %2, %3\n\ts_nop 1" : "+v"(h0_), "+v"(h1_), "+v"(a0_), "+v"(a1_));
                    hst = owner ? h1_ : h0_; apr = owner ? a1_ : a0_;
                }
        if (!PASS2) { if (hi == 0) S[((size_t)b * 128 + k) * 512 + ch] = (f32x2){apr, hst}; }
        else {
#pragma unroll
            for (int rt = 0; rt < 2; ++rt) {
                bf16_t gin[16];
                const GAS bf16_t* zb = (const GAS bf16_t*)(Z + (m0 + 32 * rt + 4 * hi) * ZP + ZC_RG + ch); GAS bf16_t* yb = (GAS bf16_t*)(YB + (m0 + 32 * rt + 4 * hi) * 2048 + 512 + ch);
                asm volatile("" : "+v"(zb), "+v"(yb));
#pragma unroll
                for (int r = 0; r < 16; ++r) gin[r] = zb[(size_t)((r & 3) + 8 * (r >> 2)) * ZP];
#pragma unroll
                for (int r = 0; r < 16; ++r) { const float g = bf2f(gin[r]);
                    const float tg = 0.7978845608028654f * (g + 0.044715f * g * g * g);
                    const float th = 1.0f - 2.0f * __builtin_amdgcn_rcpf(1.0f + __builtin_amdgcn_exp2f(2.0f * LOG2E * tg));
                    yb[(size_t)((r & 3) + 8 * (r >> 2)) * 2048] = (bf16_t)f2bf(D[1][rt][r] * (0.5f * g * (1.0f + th))); }
            }
        }
    }
    __syncthreads();
}

namespace fa {
constexpr int KB96 = 12288, VB = 8192, STG = KB96 + VB, NSLOT = 4, LDS_WS = NSLOT * STG, LDS_OST = LDS_WS + 8 * 256, LDS_TOTAL = LDS_OST + 8 * 4096;
constexpr float THR = 8.0f;
__device__ __forceinline__ int crow(int r, int hi) { return (r & 3) + 8 * (r >> 2) + 4 * hi; }
__device__ __forceinline__ void glds16(const void* g, unsigned lds_base) {
    unsigned sv; asm volatile("s_mov_b32 %0, m0\n\ts_mov_b32 m0, %2\n\ts_nop 0\n\tglobal_load_lds_dwordx4 %1, off\n\ts_mov_b32 m0, %0" : "=&s"(sv) : "v"(g), "s"(lds_base) : "memory"); }
typedef short v4i16_t __attribute__((ext_vector_type(4)));
typedef __attribute__((address_space(3))) const char* lds_cptr;
__device__ __forceinline__ v4i16_t vtr(lds_cptr p) { return __builtin_amdgcn_ds_read_tr16_b64_v4i16((__attribute__((address_space(3))) v4i16_t*)p); }
#define FA_MFMA(a, b, c) __builtin_amdgcn_mfma_f32_32x32x16_bf16(a, b, c, 0, 0, 0)
__device__ __forceinline__ float xhalf_max(float x) { float a = x, b = x; asm volatile("s_nop 1\n\tv_permlane32_swap_b32 %0, %1\n\ts_nop 1" : "+v"(a), "+v"(b)); return __builtin_fmaxf(a, b); }
__device__ __forceinline__ float keep_or_ninf(int m, float x) { float r; asm("v_bfi_b32 %0, %1, %2, %3" : "=v"(r) : "v"(m), "v"(x), "s"(0xff800000u)); return r; }

struct Ptrs { const bf16_t* Q; int ldq; const bf16_t* K; int ldk; const bf16_t* KR; const bf16_t* V; int ldv; bf16_t* O; int ldo; const unsigned* MK; float slope2; float sink2; };

template <int MODE>
__device__ __forceinline__ void unit(const Frame& F, const Ptrs& P, int b, int qb) {
    constexpr int DK = (MODE == 0) ? 96 : 64, ND0 = DK / 16;
    const int lane = F.lane, r32 = lane & 31, hi = lane >> 5, wid = F.wave;
    const long rowbase = (long)b * SEQ; const int q0 = qb * 256;
    const int qidx = q0 + 32 * wid + r32;
    const unsigned lds0 = (unsigned)(uintptr_t)F.lds;
    LAS float* wsf = (LAS float*)(F.lds + LDS_WS) + wid * 64;
    int t_lo, t_hi, key_base;
    if (MODE == 2) { key_base = q0 - 128; t_lo = (qb == 0) ? 2 : 0; t_hi = 6; } else { key_base = 0; t_lo = 0; t_hi = 4 * qb + 4; }
    const bf16_t* ksrc = P.K + (rowbase + lane) * (long)P.ldk + wid * 8;
    const bf16_t* krsrc = (MODE == 0) ? P.KR + (rowbase + lane) * 32L + (wid & 3) * 8 : nullptr;
    const bf16_t* vsrc = P.V + (rowbase + 16 * (wid & 3) + (lane >> 2)) * (long)P.ldv + (wid >> 2) * 32 + (lane & 3) * 8;
    const unsigned kdst = lds0 + wid * 1024, krdst = lds0 + (8 + (wid & 3)) * 1024, vdst = lds0 + KB96 + wid * 1024;
#define FA_DMA(t, soff) do { const long k0_ = key_base + 64L * (t); \
        glds16(ksrc + k0_ * P.ldk, (unsigned)__builtin_amdgcn_readfirstlane(kdst + (soff))); \
        if (MODE == 0 && krw) glds16(krsrc + k0_ * 32, (unsigned)__builtin_amdgcn_readfirstlane(krdst + (soff)));        \
        glds16(vsrc + k0_ * P.ldv, (unsigned)__builtin_amdgcn_readfirstlane(vdst + (soff))); } while (0)
    const bool krw = __builtin_amdgcn_readfirstlane(wid) < 4;
    if (!krw) asm volatile("s_setprio 1");
    FA_DMA(t_lo, 0);
    if (t_lo + 1 < t_hi) FA_DMA(t_lo + 1, STG);
    bf16x8 qr[ND0];
    { const bf16_t* Qw = P.Q + (rowbase + q0 + 32 * wid + r32) * (long)P.ldq + hi * 8;
#pragma unroll
      for (int d0 = 0; d0 < ND0; ++d0) qr[d0] = *(const bf16x8*)(Qw + d0 * 16); }
    float lrun = (MODE == 2 && hi == 0) ? 1.0f : 0.0f;
    f32x16 negm = {};
    float mref = (MODE == 2) ? P.sink2 : (MODE == 1) ? -1.0e4f : 0.0f;
    f32x16 o0 = {}, o1 = {};
    const lds_cptr kp0 = (lds_cptr)F.lds + hi * 1024 + r32 * 16;
    const lds_cptr vp0 = (lds_cptr)F.lds + KB96 + ((lane >> 4) & 1) * 32 + (lane & 3) * 8 + (4 * hi + ((lane & 15) >> 2)) * 64;
    const unsigned* mkrow = (MODE == 1) ? P.MK + (size_t)(rowbase + qidx) * 256 : nullptr;
#define FA_KLOAD(soff) do { const lds_cptr kp_ = kp0 + (soff); \
        _Pragma("unroll") for (int d0 = 0; d0 < ND0; ++d0) { kf[2 * d0] = *(const __attribute__((address_space(3))) bf16x8*)(kp_ + d0 * 2048); kf[2 * d0 + 1] = *(const __attribute__((address_space(3))) bf16x8*)(kp_ + d0 * 2048 + 512); } } while (0)
#define FA_QKMMA(A, B) do { A = FA_MFMA(kf[0], qr[0], negm); B = FA_MFMA(kf[1], qr[0], negm);        \
        _Pragma("unroll") for (int d0 = 1; d0 < ND0; ++d0) { A = FA_MFMA(kf[2 * d0], qr[d0], A); B = FA_MFMA(kf[2 * d0 + 1], qr[d0], B); } } while (0)
#define FA_BIAS(A, B, key0, mw) do { const int kl_ = (key0) + 4 * hi; \
        if (MODE != 0) { const float bq_ = P.slope2 * (float)(kl_ - qidx) - mref;        \
            _Pragma("unroll") for (int r = 0; r < 16; ++r) { const float cr_ = P.slope2 * (float)((r & 3) + 8 * (r >> 2)); A[r] += bq_ + cr_; B[r] += bq_ + cr_ + 32.0f * P.slope2; } } \
        if (MODE == 1) { const unsigned w0_ = (mw).x >> (4 * hi), w1_ = (mw).y >> (4 * hi);        \
            _Pragma("unroll") for (int r = 0; r < 16; ++r) { const int pos_ = (r & 3) + 8 * (r >> 2); \
                A[r] = keep_or_ninf(__builtin_amdgcn_sbfe((int)w0_, pos_, 1), A[r]); B[r] = keep_or_ninf(__builtin_amdgcn_sbfe((int)w1_, pos_, 1), B[r]); } } \
        if (MODE == 2) { _Pragma("unroll") for (int r = 0; r < 16; ++r) { const int d_ = qidx - (kl_ + (r & 3) + 8 * (r >> 2)); if (d_ < 0 || d_ >= 128) A[r] = -INFINITY; if (d_ - 32 < 0 || d_ - 32 >= 128) B[r] = -INFINITY; } } \
        _Pragma("unroll") for (int i_ = 0; i_ < 8; ++i_) { __builtin_amdgcn_sched_group_barrier(0x8, 1, 0); __builtin_amdgcn_sched_group_barrier(0x2, (MODE == 1) ? 8 : (MODE == 2) ? 12 : 2, 0); }        \
        if (MODE != 2 && (key0) + 63 > q0 + 32 * wid) { asm volatile("; diagonal tile" ::: "memory");        \
            _Pragma("unroll") for (int r = 0; r < 16; ++r) { const int kv_ = kl_ + (r & 3) + 8 * (r >> 2); if (kv_ > qidx) A[r] = -INFINITY; if (kv_ + 32 > qidx) B[r] = -INFINITY; } } \
        } while (0)
    u32x2 mw = {0u, 0u}, mw_n = {0u, 0u}, mw_nn = {0u, 0u};
    if (MODE == 1) { mw = *(const u32x2*)(mkrow + 2 * t_lo); if (t_lo + 1 < t_hi) mw_n = *(const u32x2*)(mkrow + 2 * (t_lo + 1)); }
    if (t_lo + 1 < t_hi) asm volatile("s_waitcnt vmcnt(%0) lgkmcnt(0)\n\ts_barrier" :: "n"(2) : "memory"); else asm volatile("s_waitcnt vmcnt(0) lgkmcnt(0)\n\ts_barrier" ::: "memory");
    f32x16 p0, p1, n0 = {}, n1 = {}; bf16x8 kf[2 * ND0];
    u32x4 pw0 = {0u, 0u, 0u, 0u}, pw1 = pw0, pw2 = pw0, pw3 = pw0;
    FA_KLOAD(0); __builtin_amdgcn_sched_barrier(0); FA_QKMMA(p0, p1);
    int s_prev = 3 * STG, s_cur = 0, s_nxt = STG, s_nn = 2 * STG;
#define FA_MX3(a, b, c) __builtin_fmaxf(__builtin_fmaxf((a), (b)), (c))
#define FA_TOP(t) do { if ((t) + 1 < t_hi) { \
            asm volatile("s_waitcnt vmcnt(0) lgkmcnt(0)\n\ts_barrier" ::: "memory");       \
            if ((t) + 2 < t_hi) { FA_DMA((t) + 2, s_nn); if (MODE == 1) mw_nn = *(const u32x2*)(mkrow + 2 * ((t) + 2)); } \
            } } while (0)
#define FA_PV(soff, KL) do { const lds_cptr vp_ = vp0 + (soff); bf16x8 vf[8]; \
        _Pragma("unroll") for (int i = 0; i < 8; ++i) { const v4i16_t lo_ = vtr(vp_ + (i >> 2) * 4096 + (i & 3) * 1024), hi_ = vtr(vp_ + (i >> 2) * 4096 + (i & 3) * 1024 + 512); vf[i] = (bf16x8){lo_[0], lo_[1], lo_[2], lo_[3], hi_[0], hi_[1], hi_[2], hi_[3]}; } \
        __builtin_amdgcn_sched_barrier(0); if (KL) FA_KLOAD(s_nxt); \
        o0 = FA_MFMA(__builtin_bit_cast(bf16x8, pw0), vf[0], o0); o1 = FA_MFMA(__builtin_bit_cast(bf16x8, pw0), vf[4], o1); \
        o0 = FA_MFMA(__builtin_bit_cast(bf16x8, pw1), vf[1], o0); o1 = FA_MFMA(__builtin_bit_cast(bf16x8, pw1), vf[5], o1); \
        o0 = FA_MFMA(__builtin_bit_cast(bf16x8, pw2), vf[2], o0); o1 = FA_MFMA(__builtin_bit_cast(bf16x8, pw2), vf[6], o1); \
        o0 = FA_MFMA(__builtin_bit_cast(bf16x8, pw3), vf[3], o0); o1 = FA_MFMA(__builtin_bit_cast(bf16x8, pw3), vf[7], o1); } while (0)
#define FA_SOFTMAX(t, FIRST) do { \
        float rma = FA_MX3(p0[0], p0[1], p1[0]), rmb = FA_MX3(p0[2], p0[3], p1[1]); rma = FA_MX3(rma, p1[2], p1[3]); \
        _Pragma("unroll") for (int r = 4; r < 16; r += 4) { rma = FA_MX3(rma, p0[r], p0[r + 1]); rmb = FA_MX3(rmb, p0[r + 2], p0[r + 3]); rma = FA_MX3(rma, p1[r], p1[r + 1]); rmb = FA_MX3(rmb, p1[r + 2], p1[r + 3]); } \
        float rm = xhalf_max(__builtin_fmaxf(rma, rmb)); \
        float sacc = 0.f; \
        { const bool first0_ = (MODE == 0) && (FIRST);        \
          if (first0_ || __any(rm > THR)) { float dl = (rm > THR) ? rm : 0.0f; if (first0_) dl = (rm == -INFINITY) ? 0.0f : rm; \
                mref += dl; \
                _Pragma("unroll") for (int r = 0; r < 16; ++r) { p0[r] -= dl; p1[r] -= dl; } \
                if (MODE == 0) { _Pragma("unroll") for (int r = 0; r < 16; ++r) negm[r] -= dl; } \
                if (!first0_) { const float alpha = __builtin_amdgcn_exp2f(-dl); lrun *= alpha; \
                    if (hi == 0) wsf[r32] = alpha; asm volatile("s_waitcnt lgkmcnt(0)" ::: "memory"); \
                    _Pragma("unroll") for (int r = 0; r < 16; ++r) { const float f = wsf[crow(r, hi)]; o0[r] *= f; o1[r] *= f; } } } \
          FA_QKMMA(n0, n1);        \
          _Pragma("unroll") for (int r = 0; r < 16; ++r) { p0[r] = __builtin_amdgcn_exp2f(p0[r]); p1[r] = __builtin_amdgcn_exp2f(p1[r]); sacc += p0[r] + p1[r]; } } \
        lrun += sacc; \
        pw0 = (u32x4){cvt_pk_bf16(p0[0], p0[1]), cvt_pk_bf16(p0[2], p0[3]), cvt_pk_bf16(p0[4], p0[5]), cvt_pk_bf16(p0[6], p0[7])}; \
        pw1 = (u32x4){cvt_pk_bf16(p0[8], p0[9]), cvt_pk_bf16(p0[10], p0[11]), cvt_pk_bf16(p0[12], p0[13]), cvt_pk_bf16(p0[14], p0[15])}; \
        pw2 = (u32x4){cvt_pk_bf16(p1[0], p1[1]), cvt_pk_bf16(p1[2], p1[3]), cvt_pk_bf16(p1[4], p1[5]), cvt_pk_bf16(p1[6], p1[7])}; \
        pw3 = (u32x4){cvt_pk_bf16(p1[8], p1[9]), cvt_pk_bf16(p1[10], p1[11]), cvt_pk_bf16(p1[12], p1[13]), cvt_pk_bf16(p1[14], p1[15])}; \
        p0 = n0; p1 = n1; \
        { const int tmp_ = s_prev; s_prev = s_cur; s_cur = s_nxt; s_nxt = s_nn; s_nn = tmp_; } mw = mw_n; mw_n = mw_nn; } while (0)
    FA_TOP(t_lo); if (t_lo + 1 < t_hi) FA_KLOAD(s_nxt);
    FA_BIAS(p0, p1, key_base + 64 * t_lo, mw);
    FA_SOFTMAX(t_lo, 1);
    for (int t = t_lo + 1; t < t_hi; ++t) {
        FA_TOP(t);
        FA_PV(s_prev, t + 1 < t_hi);
        FA_BIAS(p0, p1, key_base + 64 * t, mw);
        FA_SOFTMAX(t, 0);
    }
    FA_PV(s_prev, false);
#undef FA_MX3
#undef FA_TOP
#undef FA_PV
#undef FA_SOFTMAX
    lrun += __shfl_xor(lrun, 32);
    if (hi == 0) wsf[32 + r32] = lrun;
    asm volatile("s_waitcnt lgkmcnt(0)" ::: "memory");
    LAS bf16_t* stg = (LAS bf16_t*)(F.lds + LDS_OST) + wid * 2048;
#pragma unroll
    for (int r = 0; r < 16; ++r) { const int orow = crow(r, hi); const float rl = __builtin_amdgcn_rcpf(wsf[32 + orow]);
        stg[orow * 64 + r32] = (bf16_t)f2bf(o0[r] * rl); stg[orow * 64 + 32 + r32] = (bf16_t)f2bf(o1[r] * rl); }
    asm volatile("s_waitcnt lgkmcnt(0)" ::: "memory");
    bf16_t* Ow = P.O + (rowbase + q0 + 32 * wid) * (long)P.ldo;
#pragma unroll
    for (int i = 0; i < 4; ++i) { const int row = i * 8 + (lane >> 3), ch = lane & 7; *(u32x4*)(Ow + (long)row * P.ldo + ch * 8) = *(const LAS u32x4*)(stg + row * 64 + ch * 8); }
    asm volatile("s_setprio 0\n\ts_waitcnt lgkmcnt(0)\n\ts_barrier" ::: "memory");
#undef FA_DMA
#undef FA_KLOAD
#undef FA_QKMMA
#undef FA_BIAS
}
}

namespace fd {
using fa::lds_cptr; using fa::v4i16_t; using fa::vtr; using fa::glds16; using fa::crow;
constexpr int NSLOT = 3, SLOTB = 8192, LDS_K = 0, LDS_V = NSLOT * SLOTB, LDS_WS = 2 * NSLOT * SLOTB, LDS_OST = LDS_WS + 8 * 256, LDS_MSK = LDS_OST + 8 * 4096, LDS_TOTAL = LDS_MSK + 8 * 2048;
static_assert(LDS_TOTAL <= LDSCTL_OFF, "dsa unit LDS");
__device__ __forceinline__ float max3f(float a, float b, float c) { float r; asm("v_max3_f32 %0, %1, %2, %3" : "=v"(r) : "v"(a), "v"(b), "v"(c)); return r; }
__device__ __forceinline__ float max2f(float a, float b) { float r; asm("v_max_f32_e32 %0, %1, %2" : "=v"(r) : "v"(a), "v"(b)); return r; }
#define FD_SBAR() __builtin_amdgcn_sched_barrier(0)
__device__ __forceinline__ float and_mask(int m, float x) { float r; asm("v_and_b32 %0, %1, %2" : "=v"(r) : "v"(m), "v"(x)); return r; }
#define FD_WAIT_BAR(N) asm volatile("s_waitcnt vmcnt(" #N ") lgkmcnt(0)\n\ts_barrier" ::: "memory")
#define FD_MFMA(a, b, c) __builtin_amdgcn_mfma_f32_32x32x16_bf16(a, b, c, 0, 0, 0)
__device__ __forceinline__ void kload8(bf16x8* kf, lds_cptr kp) {
    kf[0] = *(const LAS bf16x8*)(kp);        kf[1] = *(const LAS bf16x8*)(kp + 512);  kf[2] = *(const LAS bf16x8*)(kp + 2048); kf[3] = *(const LAS bf16x8*)(kp + 2560);
    kf[4] = *(const LAS bf16x8*)(kp + 4096); kf[5] = *(const LAS bf16x8*)(kp + 4608); kf[6] = *(const LAS bf16x8*)(kp + 6144); kf[7] = *(const LAS bf16x8*)(kp + 6656); }
__device__ __forceinline__ void kload2(bf16x8* kf, lds_cptr kp, int j) { kf[2 * j] = *(const LAS bf16x8*)(kp + j * 2048); kf[2 * j + 1] = *(const LAS bf16x8*)(kp + j * 2048 + 512); }
__device__ __forceinline__ float rowmax(const f32x16& p0, const f32x16& p1) {
    float a = max3f(p0[0], p0[1], p1[0]), b = max3f(p0[2], p0[3], p1[1]); a = max3f(a, p1[2], p1[3]);
#pragma unroll
    for (int r = 4; r < 16; r += 4) { a = max3f(a, p0[r], p0[r + 1]); b = max3f(b, p0[r + 2], p0[r + 3]); a = max3f(a, p1[r], p1[r + 1]); b = max3f(b, p1[r + 2], p1[r + 3]); }
    return fa::xhalf_max(max2f(a, b)); }
__device__ __forceinline__ void cmask(f32x16& p0, f32x16& p1, int jb, int qrel, int hi) {
    const int kb = 64 * jb + 4 * hi;
#pragma unroll
    for (int r = 0; r < 16; ++r) { const int kv = kb + (r & 3) + 8 * (r >> 2); if (kv > qrel) p0[r] = -INFINITY; if (kv + 32 > qrel) p1[r] = -INFINITY; } }

template <int SWA>
__device__ __forceinline__ void unit(const Frame& F, const fa::Ptrs& P, int b, int qb) {
    const int lane = F.lane, r32 = lane & 31, hi = lane >> 5, wid = F.wave;
    const int q0 = qb * 256, qrel = wid * 32 + r32, qidx = q0 + qrel, kb0 = (SWA && qb > 0) ? q0 - 128 : 0;
    const long rowbase = (long)b * SEQ, krow0 = rowbase + kb0;
    LAS unsigned char* shm = F.lds; const unsigned lds0 = (unsigned)(uintptr_t)shm;
    LAS float* wsf = (LAS float*)(shm + LDS_WS) + wid * 64;
    const bf16_t* ksrc = P.K + (krow0 + lane) * (long)P.ldk + wid * 8;
    const bf16_t* vsrc = P.V + (krow0 + 16 * (wid & 3) + (lane >> 2)) * (long)P.ldv + (wid >> 2) * 32 + (lane & 3) * 8;
    const char* msrc = SWA ? nullptr : (const char*)P.MK + (rowbase + qidx) * 1024L;
    const unsigned kdst = lds0 + LDS_K + wid * 1024, vdst = lds0 + LDS_V + wid * 1024, mdst = lds0 + LDS_MSK + wid * 2048;
#define FD_DMA_K(t, slot) glds16(ksrc + (long)(t) * 64 * P.ldk, (unsigned)__builtin_amdgcn_readfirstlane(kdst + (slot)))
#define FD_DMA_V(t, slot) glds16(vsrc + (long)(t) * 64 * P.ldv, (unsigned)__builtin_amdgcn_readfirstlane(vdst + (slot)))
#define FD_DMA_M(t) glds16(msrc + 8 * (t), (unsigned)__builtin_amdgcn_readfirstlane(mdst + ((((t) >> 1) & 1) << 10)))
    const lds_cptr shm3 = (lds_cptr)shm; const lds_cptr kp0 = shm3 + LDS_K + hi * 1024 + r32 * 16; const lds_cptr vp0 = shm3 + LDS_V + ((lane >> 4) & 1) * 32 + (lane & 3) * 8 + (4 * hi + ((lane & 15) >> 2)) * 64;
    const LAS unsigned* mlds = (const LAS unsigned*)(shm + LDS_MSK + wid * 2048) + lane * 4;
    const int NT = SWA ? (qb > 0 ? 6 : 4) : (q0 + 256) / 64;
    if (!SWA) { FD_DMA_M(0); if (2 < NT) FD_DMA_M(2); }
    FD_DMA_K(0, 0); FD_DMA_V(0, 0); FD_DMA_K(1, SLOTB);
    bf16x8 qr[4];
    { const bf16_t* Qw = P.Q + (rowbase + qidx) * (long)P.ldq + hi * 8;
#pragma unroll
      for (int d0 = 0; d0 < 4; ++d0) qr[d0] = *(const bf16x8*)(Qw + d0 * 16); }
    u32x4 kxA = {0u, 0u, 0u, 0u}, kxB = kxA, qx = kxA; unsigned qs2 = 0u;
    if (hi == 0) {
        const unsigned klA = __builtin_bit_cast(unsigned, (float)r32) >> 16, klB = __builtin_bit_cast(unsigned, (float)(r32 + 32)) >> 16, one = 0x3f80u;
        kxA = (u32x4){klA | (klA << 16), klA | (one << 16), one | (one << 16), 0u}; kxB = (u32x4){klB | (klB << 16), klB | (one << 16), one | (one << 16), 0u};
        const unsigned s0_ = __builtin_bit_cast(unsigned, P.slope2) & 0xffff0000u; const float t1_ = P.slope2 - __builtin_bit_cast(float, s0_);
        const unsigned s1_ = __builtin_bit_cast(unsigned, t1_) & 0xffff0000u; const float t2_ = t1_ - __builtin_bit_cast(float, s1_);
        qx.x = (s0_ >> 16) | s1_; qs2 = __builtin_bit_cast(unsigned, t2_) >> 16; }
    float mhat = SWA ? P.sink2 : 0.f, l_reg = (SWA && hi == 0) ? 1.0f : 0.f; f32x16 o[2]; o[0] = f32x16{}; o[1] = f32x16{};
#define FD_QX(t) do { const float c_ = (hi == 0) ? __builtin_fmaf(P.slope2, (float)(kb0 + 64 * (t) - qidx), -mhat) : 0.0f; \
        const unsigned c0_ = __builtin_bit_cast(unsigned, c_) & 0xffff0000u; const float r1_ = c_ - __builtin_bit_cast(float, c0_); \
        const unsigned c1_ = __builtin_bit_cast(unsigned, r1_) & 0xffff0000u; const float r2_ = r1_ - __builtin_bit_cast(float, c1_); \
        const unsigned c2_ = __builtin_bit_cast(unsigned, r2_) & 0xffff0000u; \
        qx.y = qs2 | c0_; qx.z = __builtin_amdgcn_perm(c2_, c1_, 0x07060302u); } while (0)
#define FD_KX(k) __builtin_bit_cast(bf16x8, k)
#define FD_CMASK(P0, P1, t) do { if (!SWA) { const int jb_ = (t) - (NT - 4); if (jb_ >= 0) cmask(P0, P1, jb_, qrel, hi); } } while (0)
#define FD_MW(t) unsigned w0_, w1_; if (SWA) { const int d_ = qidx - kb0 - 64 * (t);        \
            const int lo_ = d_ - 127 < 0 ? 0 : d_ - 127, hi_ = d_ > 63 ? 63 : d_; \
            const unsigned long long m_ = (hi_ >= lo_) ? ((hi_ == 63 ? ~0ull : ((1ull << (hi_ + 1)) - 1ull)) & ~((1ull << lo_) - 1ull)) : 0ull; \
            w0_ = (unsigned)m_ >> (4 * hi); w1_ = (unsigned)(m_ >> 32) >> (4 * hi); } \
        else { w0_ = mlds[((((t) >> 1) & 1) << 8) + 2 * ((t) & 1)] >> (4 * hi); w1_ = mlds[((((t) >> 1) & 1) << 8) + 2 * ((t) & 1) + 1] >> (4 * hi); }
#define FD_AND(X, W, B) do { _Pragma("unroll") for (int e_ = 0; e_ < 4; ++e_) { const int r_ = (B) + e_; \
        X[r_] = and_mask(__builtin_amdgcn_sbfe((int)(W), (r_ & 3) + 8 * (r_ >> 2), 1), X[r_]); } } while (0)
    bool resc = false;
#define FD_RESC() do { if (resc) { asm volatile("s_waitcnt lgkmcnt(0)" ::: "memory"); \
        _Pragma("unroll") for (int d_ = 0; d_ < 2; ++d_) _Pragma("unroll") for (int r = 0; r < 16; ++r) o[d_][r] *= wsf[crow(r, hi)]; } } while (0)
    f32x16 pA0, pA1, pB0, pB1; bf16x8 kf[8];
    int sl_prev = 0, sl_cur = 0, sl_next = SLOTB;
#define FD_ROT() do { sl_prev = sl_cur; sl_cur = sl_next; sl_next = (sl_next == (NSLOT - 1) * SLOTB) ? 0 : sl_next + SLOTB; } while (0)
    FD_DMA_K(2, 2 * SLOTB);
    FD_WAIT_BAR(3);
    FD_QX(0);
    { kload8(kf, kp0);
      pA0 = FD_MFMA(FD_KX(kxA), FD_KX(qx), f32x16{}); pA1 = FD_MFMA(FD_KX(kxB), FD_KX(qx), f32x16{});
#pragma unroll
      for (int d0 = 0; d0 < 4; ++d0) { pA0 = FD_MFMA(kf[2 * d0], qr[d0], pA0); pA1 = FD_MFMA(kf[2 * d0 + 1], qr[d0], pA1); } }
    asm volatile("s_nop 15\n\ts_nop 7" : "+v"(pA0), "+v"(pA1));
    FD_CMASK(pA0, pA1, 0);
    { const float rm = rowmax(pA0, pA1); const float dl = SWA ? __builtin_fmaxf(rm, 0.f) : rm; mhat += dl;
      if (SWA) l_reg *= __builtin_amdgcn_exp2f(-dl);
#pragma unroll
      for (int r = 0; r < 16; ++r) { pA0[r] -= dl; pA1[r] -= dl; }
#pragma unroll
      for (int r = 0; r < 16; ++r) { pA0[r] = __builtin_amdgcn_exp2f(pA0[r]); pA1[r] = __builtin_amdgcn_exp2f(pA1[r]); }
      asm volatile("" : "+v"(pA0), "+v"(pA1)); FD_SBAR();
      FD_MW(0);
      FD_AND(pA0, w0_, 0); FD_AND(pA0, w0_, 4); FD_AND(pA0, w0_, 8); FD_AND(pA0, w0_, 12); FD_AND(pA1, w1_, 0); FD_AND(pA1, w1_, 4); FD_AND(pA1, w1_, 8); FD_AND(pA1, w1_, 12); }
    FD_WAIT_BAR(0);
    FD_DMA_K(3, 0); FD_DMA_V(1, SLOTB);
    FD_ROT();
    kload8(kf, kp0 + sl_cur);
    FD_WAIT_BAR(2);
    v4i16_t vlo[8], vhi[8]; u32x4 pw0, pw1, pw2, pw3;
#define FD_PKW(Pv, B) cvt_pk_bf16(Pv[B], Pv[(B) + 1])
#define FD_PAF(k) __builtin_bit_cast(bf16x8, pw##k)
#define FD_VFR(i) (bf16x8){vlo[i][0], vlo[i][1], vlo[i][2], vlo[i][3], vhi[i][0], vhi[i][1], vhi[i][2], vhi[i][3]}
#define FD_PIN(x) asm volatile("" : "+v"(x))
#define FD_MX3(a, b, c) __builtin_fmaxf(__builtin_fmaxf((a), (b)), (c))
#define FD_GAPA(MF, A0, A1, A2, A3, W0, W1, PW) do { MF; sacc += A0; sacc += A1; sacc += A2; sacc += A3; FD_PIN(sacc); W0; W1; FD_PIN(PW); FD_SBAR(); } while (0)
#define FD_GAPB(MF, X, B, Y, WY, BY) do { MF; X[B] = __builtin_amdgcn_exp2f(X[B]); X[(B) + 1] = __builtin_amdgcn_exp2f(X[(B) + 1]); X[(B) + 2] = __builtin_amdgcn_exp2f(X[(B) + 2]); X[(B) + 3] = __builtin_amdgcn_exp2f(X[(B) + 3]); \
        if ((BY) >= 0) { FD_AND(Y, WY, ((BY) >= 0 ? (BY) : 0)); FD_PIN(Y); } FD_PIN(X); FD_SBAR(); } while (0)
#define FD_VRD(i) do { vlo[i] = vtr(vp_ + (((i) >> 2) * 4096 + ((i) & 3) * 1024)); vhi[i] = vtr(vp_ + (((i) >> 2) * 4096 + ((i) & 3) * 1024 + 512)); } while (0)
#define FD_KRD(G, j) do { if (G) { kload2(kf, kp0 + sl_next, j); FD_SBAR(); } } while (0)
#define FD_STEP(C0, C1, P0, P1, t, GK, GV, GL, GM) do { FD_SBAR(); \
        const lds_cptr vp_ = vp0 + sl_prev; FD_QX(t); FD_MW(t); \
        FD_VRD(0); FD_SBAR(); float sacc = (P0[0] + P0[1]); \
        C0 = FD_MFMA(FD_KX(kxA), FD_KX(qx), f32x16{}); FD_SBAR(); C1 = FD_MFMA(FD_KX(kxB), FD_KX(qx), f32x16{}); FD_SBAR(); \
        FD_GAPA(C0 = FD_MFMA(kf[0], qr[0], C0), P0[2], P0[3], P0[4], P0[5],     pw0[0] = FD_PKW(P0, 0), pw0[1] = FD_PKW(P0, 2), pw0); \
        FD_VRD(4); FD_SBAR(); FD_GAPA(C1 = FD_MFMA(kf[1], qr[0], C1), P0[6], P0[7], P0[8], P0[9],     pw0[2] = FD_PKW(P0, 4), pw0[3] = FD_PKW(P0, 6), pw0); \
        FD_VRD(1); FD_SBAR(); FD_GAPA(C0 = FD_MFMA(kf[2], qr[1], C0), P0[10], P0[11], P0[12], P0[13], pw1[0] = FD_PKW(P0, 8), pw1[1] = FD_PKW(P0, 10), pw1); \
        FD_VRD(5); FD_SBAR(); FD_GAPA(C1 = FD_MFMA(kf[3], qr[1], C1), P0[14], P0[15], P1[0], P1[1],   pw1[2] = FD_PKW(P0, 12), pw1[3] = FD_PKW(P0, 14), pw1); \
        FD_VRD(2); FD_SBAR(); FD_GAPA(C0 = FD_MFMA(kf[4], qr[2], C0), P1[2], P1[3], P1[4], P1[5],     pw2[0] = FD_PKW(P1, 0), pw2[1] = FD_PKW(P1, 2), pw2); \
        FD_VRD(6); FD_SBAR(); FD_GAPA(C1 = FD_MFMA(kf[5], qr[2], C1), P1[6], P1[7], P1[8], P1[9],     pw2[2] = FD_PKW(P1, 4), pw2[3] = FD_PKW(P1, 6), pw2); \
        FD_VRD(3); FD_SBAR(); FD_GAPA(C0 = FD_MFMA(kf[6], qr[3], C0), P1[10], P1[11], P1[12], P1[13], pw3[0] = FD_PKW(P1, 8), pw3[1] = FD_PKW(P1, 10), pw3); \
        FD_VRD(7); FD_SBAR(); FD_GAPA(C1 = FD_MFMA(kf[7], qr[3], C1), P1[14], P1[15], 0.f, 0.f,       pw3[2] = FD_PKW(P1, 12), pw3[3] = FD_PKW(P1, 14), pw3); \
        l_reg += sacc; \
        if (GK) { FD_DMA_K((t) + 3, sl_cur); } if (GV) { FD_DMA_V((t) + 1, sl_next); } if (!SWA && (GM)) { FD_DMA_M((t) + 2); } \
        FD_CMASK(C0, C1, t); \
        { float a = FD_MX3(C0[0], C0[1], C1[0]), bb = FD_MX3(C0[2], C0[3], C1[1]); a = FD_MX3(a, C1[2], C1[3]); \
          _Pragma("unroll") for (int r = 4; r < 16; r += 4) { a = FD_MX3(a, C0[r], C0[r + 1]); bb = FD_MX3(bb, C0[r + 2], C0[r + 3]); a = FD_MX3(a, C1[r], C1[r + 1]); bb = FD_MX3(bb, C1[r + 2], C1[r + 3]); } \
          const float rm = fa::xhalf_max(__builtin_fmaxf(a, bb)); \
          resc = false; \
          if (__builtin_expect(__any(rm > 8.0f), 0)) { const float dl = __builtin_fmaxf(rm, 0.f); mhat += dl; \
              _Pragma("unroll") for (int r = 0; r < 16; ++r) { C0[r] -= dl; C1[r] -= dl; } \
              const float f = __builtin_amdgcn_exp2f(-dl); l_reg *= f; if (hi == 0) wsf[r32] = f; resc = true; } } \
        FD_SBAR(); \
        FD_GAPB(o[0] = FD_MFMA(FD_PAF(0), FD_VFR(0), o[0]), C0, 0, C0, w0_, -1); \
        FD_GAPB(o[1] = FD_MFMA(FD_PAF(0), FD_VFR(4), o[1]), C0, 4, C0, w0_, 0); \
        FD_KRD(GL, 0); FD_GAPB(o[0] = FD_MFMA(FD_PAF(1), FD_VFR(1), o[0]), C0, 8, C0, w0_, 4); \
        FD_KRD(GL, 1); FD_GAPB(o[1] = FD_MFMA(FD_PAF(1), FD_VFR(5), o[1]), C0, 12, C0, w0_, 8); \
        FD_KRD(GL, 2); FD_GAPB(o[0] = FD_MFMA(FD_PAF(2), FD_VFR(2), o[0]), C1, 0, C0, w0_, 12); \
        FD_KRD(GL, 3); FD_GAPB(o[1] = FD_MFMA(FD_PAF(2), FD_VFR(6), o[1]), C1, 4, C1, w1_, 0); \
        FD_GAPB(o[0] = FD_MFMA(FD_PAF(3), FD_VFR(3), o[0]), C1, 8, C1, w1_, 4); \
        FD_GAPB(o[1] = FD_MFMA(FD_PAF(3), FD_VFR(7), o[1]), C1, 12, C1, w1_, 8); \
        FD_AND(C1, w1_, 12); FD_PIN(C1); FD_SBAR(); \
        } while (0)
#define FD_ENDW(n_) do { if ((n_) == 3) { FD_WAIT_BAR(3); } else if ((n_) == 2) { FD_WAIT_BAR(2); } else if ((n_) == 1) { FD_WAIT_BAR(1); } else { FD_WAIT_BAR(0); } } while (0)
    int t = 1;
#undef FD_CMASK
#define FD_CMASK(P0, P1, t) do { } while (0)
    for (; t + 5 < NT; t += 2) {
        FD_STEP(pB0, pB1, pA0, pA1, t, true, true, true, false);     FD_WAIT_BAR(2); FD_RESC(); FD_ROT();
        FD_STEP(pA0, pA1, pB0, pB1, t + 1, true, true, true, true);  if (SWA) { FD_WAIT_BAR(2); } else { FD_WAIT_BAR(3); } FD_RESC(); FD_ROT();
    }
#undef FD_CMASK
#define FD_CMASK(P0, P1, t) do { const int jb_ = (t) - (NT - 4); if (jb_ >= 0) cmask(P0, P1, jb_, qrel, hi); } while (0)
    for (; t + 1 < NT; t += 2) {
        { const bool gk = t + 3 < NT, gv = t + 1 < NT; FD_STEP(pB0, pB1, pA0, pA1, t, gk, gv, gv, false); const int n_ = (t + 2 < NT) ? ((int)gk + (int)gv) : 0; FD_ENDW(n_); FD_RESC(); FD_ROT(); }
        { const bool gk = t + 4 < NT, gv = t + 2 < NT, gm = t + 3 < NT; FD_STEP(pA0, pA1, pB0, pB1, t + 1, gk, gv, gv, gm); const int n_ = (t + 3 < NT) ? ((int)gk + (int)gv + (SWA ? 0 : (int)gm)) : 0; FD_ENDW(n_); FD_RESC(); FD_ROT(); }
    }
    FD_STEP(pB0, pB1, pA0, pA1, NT - 1, false, false, false, false); FD_RESC();
    { float sacc = pB0[0] + pB0[1];
#pragma unroll
      for (int r = 2; r < 16; ++r) sacc += pB0[r];
#pragma unroll
      for (int r = 0; r < 16; ++r) sacc += pB1[r];
      l_reg += sacc;
      pw0 = (u32x4){FD_PKW(pB0, 0), FD_PKW(pB0, 2), FD_PKW(pB0, 4), FD_PKW(pB0, 6)}; pw1 = (u32x4){FD_PKW(pB0, 8), FD_PKW(pB0, 10), FD_PKW(pB0, 12), FD_PKW(pB0, 14)};
      pw2 = (u32x4){FD_PKW(pB1, 0), FD_PKW(pB1, 2), FD_PKW(pB1, 4), FD_PKW(pB1, 6)}; pw3 = (u32x4){FD_PKW(pB1, 8), FD_PKW(pB1, 10), FD_PKW(pB1, 12), FD_PKW(pB1, 14)};
      FD_SBAR();
      const lds_cptr vp_ = vp0 + sl_cur;
#pragma unroll
      for (int i = 0; i < 8; ++i) FD_VRD(i);
      o[0] = FD_MFMA(FD_PAF(0), FD_VFR(0), o[0]); o[1] = FD_MFMA(FD_PAF(0), FD_VFR(4), o[1]); o[0] = FD_MFMA(FD_PAF(1), FD_VFR(1), o[0]); o[1] = FD_MFMA(FD_PAF(1), FD_VFR(5), o[1]);
      o[0] = FD_MFMA(FD_PAF(2), FD_VFR(2), o[0]); o[1] = FD_MFMA(FD_PAF(2), FD_VFR(6), o[1]); o[0] = FD_MFMA(FD_PAF(3), FD_VFR(3), o[0]); o[1] = FD_MFMA(FD_PAF(3), FD_VFR(7), o[1]); }
    { float la_ = l_reg, lb_ = l_reg; asm volatile("s_nop 1\n\tv_permlane32_swap_b32 %0, %1\n\ts_nop 1" : "+v"(la_), "+v"(lb_)); l_reg = la_ + lb_; }
    if (hi == 0) wsf[32 + r32] = l_reg;
    asm volatile("s_waitcnt lgkmcnt(0)" ::: "memory");
    LAS bf16_t* stg = (LAS bf16_t*)(shm + LDS_OST) + wid * 2048;
#pragma unroll
    for (int r = 0; r < 16; ++r) { const int orow = crow(r, hi); const float rl = __builtin_amdgcn_rcpf(wsf[32 + orow]);
        stg[orow * 64 + r32] = (bf16_t)f2bf(o[0][r] * rl); stg[orow * 64 + 32 + r32] = (bf16_t)f2bf(o[1][r] * rl); }
    asm volatile("s_waitcnt lgkmcnt(0)" ::: "memory");
    bf16_t* Ow = P.O + (rowbase + q0 + 32 * wid) * (long)P.ldo;
#pragma unroll
    for (int i = 0; i < 4; ++i) { const int row = i * 8 + (lane >> 3), ch = lane & 7; *(u32x4*)(Ow + (long)row * P.ldo + ch * 8) = *(const LAS u32x4*)(stg + row * 64 + ch * 8); }
    asm volatile("s_waitcnt lgkmcnt(0)\n\ts_barrier" ::: "memory");
#undef FD_DMA_K
#undef FD_DMA_V
#undef FD_DMA_M
#undef FD_QX
#undef FD_KX
#undef FD_CMASK
#undef FD_MW
#undef FD_AND
#undef FD_RESC
#undef FD_ROT
#undef FD_PKW
#undef FD_PAF
#undef FD_VFR
#undef FD_PIN
#undef FD_MX3
#undef FD_GAPA
#undef FD_GAPB
#undef FD_VRD
#undef FD_KRD
#undef FD_STEP
#undef FD_ENDW
}
#undef FD_SBAR
#undef FD_WAIT_BAR
#undef FD_MFMA
}

namespace fm {
using fa::lds_cptr; using fa::v4i16_t; using fa::vtr; using fa::glds16; using fa::crow;
constexpr int NSLOT = 3, SLOTK = 12288, SLOTV = 8192, LDS_K = 0, LDS_V = NSLOT * SLOTK, LDS_WS = LDS_V + NSLOT * SLOTV, LDS_OST = LDS_WS + 8 * 256, LDS_TOTAL = LDS_OST + 8 * 4096;
static_assert(LDS_TOTAL <= LDSCTL_OFF, "mla unit LDS");
#define FM_SBAR() __builtin_amdgcn_sched_barrier(0)
#define FM_WAIT_BAR(N) asm volatile("s_waitcnt vmcnt(" #N ") lgkmcnt(0)\n\ts_barrier" ::: "memory")
#define FM_MFMA(a, b, c) __builtin_amdgcn_mfma_f32_32x32x16_bf16(a, b, c, 0, 0, 0)
__device__ __forceinline__ void kload2(bf16x8* kf, lds_cptr kp, int j) { kf[2 * j] = *(const LAS bf16x8*)(kp + j * 2048); kf[2 * j + 1] = *(const LAS bf16x8*)(kp + j * 2048 + 512); }

__device__ __forceinline__ void unit(const Frame& F, const fa::Ptrs& P, int b, int qb) {
    const int lane = F.lane, r32 = lane & 31, hi = lane >> 5, wid = F.wave;
    const long rowbase = (long)b * SEQ; const int q0 = qb * 256, qrel = wid * 32 + r32, qidx = q0 + qrel;
    LAS unsigned char* shm = F.lds; const unsigned lds0 = (unsigned)(uintptr_t)shm;
    LAS float* wsf = (LAS float*)(shm + LDS_WS) + wid * 64;
    const bf16_t* ksrc = P.K + (rowbase + lane) * (long)P.ldk + wid * 8;
    const bf16_t* krsrc = P.KR + (rowbase + lane) * 32L + (wid & 3) * 8;
    const bf16_t* vsrc = P.V + (rowbase + 16 * (wid & 3) + (lane >> 2)) * (long)P.ldv + (wid >> 2) * 32 + (lane & 3) * 8;
    const unsigned kdst = lds0 + LDS_K + wid * 1024, krdst = lds0 + LDS_K + (8 + (wid & 3)) * 1024, vdst = lds0 + LDS_V + wid * 1024;
#define FM_DMA_K(t, slot) do { glds16(ksrc + (long)(t) * 64 * P.ldk, (unsigned)__builtin_amdgcn_readfirstlane(kdst + (slot))); glds16(krsrc + (long)(t) * 64 * 32, (unsigned)__builtin_amdgcn_readfirstlane(krdst + (slot))); } while (0)
#define FM_DMA_V(t, slot) glds16(vsrc + (long)(t) * 64 * P.ldv, (unsigned)__builtin_amdgcn_readfirstlane(vdst + (slot)))
    const lds_cptr shm3 = (lds_cptr)shm; const lds_cptr kp0 = shm3 + LDS_K + hi * 1024 + r32 * 16; const lds_cptr vp0 = shm3 + LDS_V + ((lane >> 4) & 1) * 32 + (lane & 3) * 8 + (4 * hi + ((lane & 15) >> 2)) * 64;
    const int NT = (q0 + 256) / 64;
    FM_DMA_K(0, 0); FM_DMA_V(0, 0); FM_DMA_K(1, SLOTK);
    bf16x8 qr[6];
    { const bf16_t* Qw = P.Q + (rowbase + qidx) * (long)P.ldq + hi * 8;
#pragma unroll
      for (int d0 = 0; d0 < 6; ++d0) qr[d0] = *(const bf16x8*)(Qw + d0 * 16); }
    float mhat = 0.f, l_reg = 0.f; f32x16 o[2]; o[0] = f32x16{}; o[1] = f32x16{};
#define FM_CMASK(P0, P1, t) do { const int jb_ = (t) - (NT - 4); if (jb_ >= 0) fd::cmask(P0, P1, jb_, qrel, hi); } while (0)
    bool resc = false;
#define FM_RESC() do { if (resc) { asm volatile("s_waitcnt lgkmcnt(0)" ::: "memory"); \
        _Pragma("unroll") for (int d_ = 0; d_ < 2; ++d_) _Pragma("unroll") for (int r = 0; r < 16; ++r) o[d_][r] *= wsf[crow(r, hi)]; } } while (0)
    f32x16 pA0, pA1, pB0, pB1; bf16x8 kf[12];
    int kl_prev = 0, kl_cur = 0, kl_next = SLOTK, vl_prev = 0, vl_cur = 0, vl_next = SLOTV;
#define FM_ROT() do { kl_prev = kl_cur; kl_cur = kl_next; kl_next = (kl_next == (NSLOT - 1) * SLOTK) ? 0 : kl_next + SLOTK; vl_prev = vl_cur; vl_cur = vl_next; vl_next = (vl_next == (NSLOT - 1) * SLOTV) ? 0 : vl_next + SLOTV; } while (0)
    FM_DMA_K(2, 2 * SLOTK);
    FM_WAIT_BAR(5);
#pragma unroll
    for (int j = 0; j < 6; ++j) kload2(kf, kp0, j);
    pA0 = FM_MFMA(kf[0], qr[0], f32x16{}); pA1 = FM_MFMA(kf[1], qr[0], f32x16{});
#pragma unroll
    for (int d0 = 1; d0 < 6; ++d0) { pA0 = FM_MFMA(kf[2 * d0], qr[d0], pA0); pA1 = FM_MFMA(kf[2 * d0 + 1], qr[d0], pA1); }
    asm volatile("s_nop 15\n\ts_nop 7" : "+v"(pA0), "+v"(pA1));
    FM_CMASK(pA0, pA1, 0);
    { const float rm = fd::rowmax(pA0, pA1); const float dl = rm; mhat += dl;
#pragma unroll
      for (int r = 0; r < 16; ++r) { pA0[r] -= dl; pA1[r] -= dl; }
#pragma unroll
      for (int r = 0; r < 16; ++r) { pA0[r] = __builtin_amdgcn_exp2f(pA0[r]); pA1[r] = __builtin_amdgcn_exp2f(pA1[r]); } }
    FM_WAIT_BAR(0);
    FM_DMA_K(3, 0); FM_DMA_V(1, SLOTV);
    FM_ROT();
#pragma unroll
    for (int j = 0; j < 6; ++j) kload2(kf, kp0 + kl_cur, j);
    FM_WAIT_BAR(3);
    v4i16_t vlo[8], vhi[8]; u32x4 pw[4];
#define FM_VFR(i) (bf16x8){vlo[i][0], vlo[i][1], vlo[i][2], vlo[i][3], vhi[i][0], vhi[i][1], vhi[i][2], vhi[i][3]}
#define FM_PIN(x) asm volatile("" : "+v"(x))
#define FM_MX3(a, b, c) __builtin_fmaxf(__builtin_fmaxf((a), (b)), (c))
#define FM_VRD(i) do { vlo[i] = vtr(vp_ + (((i) >> 2) * 4096 + ((i) & 3) * 1024)); vhi[i] = vtr(vp_ + (((i) >> 2) * 4096 + ((i) & 3) * 1024 + 512)); } while (0)
#define FM_PE(P0, P1, e) (((e) < 16) ? P0[(e) & 15] : P1[(e) & 15])
#define FM_STEP(C0, C1, P0, P1, t, GK, GV, GL) do { FM_SBAR(); \
        const lds_cptr vp_ = vp0 + vl_prev; float sacc = (P0[0] + P0[1]); \
        _Pragma("unroll") for (int i_ = 0; i_ < 12; ++i_) { \
            if (i_ < 8) { const int vi_ = (i_ >> 1) + 4 * (i_ & 1); FM_VRD(vi_); FM_SBAR(); } \
            if (i_ == 0) C0 = FM_MFMA(kf[0], qr[0], f32x16{}); else if (i_ == 1) C1 = FM_MFMA(kf[1], qr[0], f32x16{}); \
            else if (i_ & 1) C1 = FM_MFMA(kf[i_], qr[i_ >> 1], C1); else C0 = FM_MFMA(kf[i_], qr[i_ >> 1], C0); \
            _Pragma("unroll") for (int e_ = 2 + (30 * i_) / 12; e_ < 2 + (30 * (i_ + 1)) / 12; ++e_) sacc += FM_PE(P0, P1, e_); \
            FM_PIN(sacc); \
            _Pragma("unroll") for (int j_ = (16 * i_) / 12; j_ < (16 * (i_ + 1)) / 12; ++j_) { pw[j_ >> 2][j_ & 3] = cvt_pk_bf16(FM_PE(P0, P1, 2 * j_), FM_PE(P0, P1, 2 * j_ + 1)); FM_PIN(pw[j_ >> 2]); } \
            FM_SBAR(); } \
        l_reg += sacc; \
        if (GK) { FM_DMA_K((t) + 3, kl_cur); } if (GV) { FM_DMA_V((t) + 1, vl_next); } \
        FM_CMASK(C0, C1, t); \
        { float a = FM_MX3(C0[0], C0[1], C1[0]), bb = FM_MX3(C0[2], C0[3], C1[1]); a = FM_MX3(a, C1[2], C1[3]); \
          _Pragma("unroll") for (int r = 4; r < 16; r += 4) { a = FM_MX3(a, C0[r], C0[r + 1]); bb = FM_MX3(bb, C0[r + 2], C0[r + 3]); a = FM_MX3(a, C1[r], C1[r + 1]); bb = FM_MX3(bb, C1[r + 2], C1[r + 3]); } \
          const float rm = fa::xhalf_max(__builtin_fmaxf(a, bb)); \
          resc = false; \
          if (__builtin_expect(__any(rm > mhat + 8.0f), 0)) { const float dl = (rm > mhat + 8.0f) ? rm - mhat : 0.f; mhat += dl;        \
              const float f = __builtin_amdgcn_exp2f(-dl); l_reg *= f; if (hi == 0) wsf[r32] = f; resc = true; } } \
        FM_SBAR(); \
        _Pragma("unroll") for (int j_ = 0; j_ < 8; ++j_) { \
            if ((GL) && j_ >= 1 && j_ <= 6) { kload2(kf, kp0 + kl_next, j_ - 1); FM_SBAR(); } \
            if (j_ & 1) o[1] = FM_MFMA(__builtin_bit_cast(bf16x8, pw[j_ >> 1]), FM_VFR(4 + (j_ >> 1)), o[1]); else o[0] = FM_MFMA(__builtin_bit_cast(bf16x8, pw[j_ >> 1]), FM_VFR(j_ >> 1), o[0]); \
            if (j_ < 4) { C0[4 * j_] = __builtin_amdgcn_exp2f(C0[4 * j_] - mhat); C0[4 * j_ + 1] = __builtin_amdgcn_exp2f(C0[4 * j_ + 1] - mhat); C0[4 * j_ + 2] = __builtin_amdgcn_exp2f(C0[4 * j_ + 2] - mhat); C0[4 * j_ + 3] = __builtin_amdgcn_exp2f(C0[4 * j_ + 3] - mhat); FM_PIN(C0); } \
            else { C1[4 * (j_ & 3)] = __builtin_amdgcn_exp2f(C1[4 * (j_ & 3)] - mhat); C1[4 * (j_ & 3) + 1] = __builtin_amdgcn_exp2f(C1[4 * (j_ & 3) + 1] - mhat); C1[4 * (j_ & 3) + 2] = __builtin_amdgcn_exp2f(C1[4 * (j_ & 3) + 2] - mhat); C1[4 * (j_ & 3) + 3] = __builtin_amdgcn_exp2f(C1[4 * (j_ & 3) + 3] - mhat); FM_PIN(C1); } \
            FM_SBAR(); } \
        } while (0)
#define FM_ENDW(n_) do { if ((n_) == 3) { FM_WAIT_BAR(3); } else if ((n_) == 2) { FM_WAIT_BAR(2); } else if ((n_) == 1) { FM_WAIT_BAR(1); } else { FM_WAIT_BAR(0); } } while (0)
    int t = 1;
#undef FM_CMASK
#define FM_CMASK(P0, P1, t) do { } while (0)
    for (; t + 5 < NT; t += 2) {
        FM_STEP(pB0, pB1, pA0, pA1, t, true, true, true);     FM_WAIT_BAR(3); FM_RESC(); FM_ROT();
        FM_STEP(pA0, pA1, pB0, pB1, t + 1, true, true, true); FM_WAIT_BAR(3); FM_RESC(); FM_ROT();
    }
#undef FM_CMASK
#define FM_CMASK(P0, P1, t) do { const int jb_ = (t) - (NT - 4); if (jb_ >= 0) fd::cmask(P0, P1, jb_, qrel, hi); } while (0)
    for (; t + 1 < NT; t += 2) {
        { const bool gk = t + 3 < NT, gv = t + 1 < NT; FM_STEP(pB0, pB1, pA0, pA1, t, gk, gv, gv); const int n_ = (t + 2 < NT) ? (2 * (int)gk + (int)gv) : 0; FM_ENDW(n_); FM_RESC(); FM_ROT(); }
        { const bool gk = t + 4 < NT, gv = t + 2 < NT; FM_STEP(pA0, pA1, pB0, pB1, t + 1, gk, gv, gv); const int n_ = (t + 3 < NT) ? (2 * (int)gk + (int)gv) : 0; FM_ENDW(n_); FM_RESC(); FM_ROT(); }
    }
    FM_STEP(pB0, pB1, pA0, pA1, NT - 1, false, false, false); FM_RESC();
    { float sacc = pB0[0] + pB0[1];
#pragma unroll
      for (int r = 2; r < 16; ++r) sacc += pB0[r];
#pragma unroll
      for (int r = 0; r < 16; ++r) sacc += pB1[r];
      l_reg += sacc;
#pragma unroll
      for (int j = 0; j < 16; ++j) pw[j >> 2][j & 3] = cvt_pk_bf16(FM_PE(pB0, pB1, 2 * j), FM_PE(pB0, pB1, 2 * j + 1));
      FM_SBAR();
      const lds_cptr vp_ = vp0 + vl_cur;
#pragma unroll
      for (int i = 0; i < 8; ++i) FM_VRD(i);
#pragma unroll
      for (int k = 0; k < 4; ++k) { o[0] = FM_MFMA(__builtin_bit_cast(bf16x8, pw[k]), FM_VFR(k), o[0]); o[1] = FM_MFMA(__builtin_bit_cast(bf16x8, pw[k]), FM_VFR(4 + k), o[1]); } }
    { float la_ = l_reg, lb_ = l_reg; asm volatile("s_nop 1\n\tv_permlane32_swap_b32 %0, %1\n\ts_nop 1" : "+v"(la_), "+v"(lb_)); l_reg = la_ + lb_; }
    if (hi == 0) wsf[32 + r32] = l_reg;
    asm volatile("s_waitcnt lgkmcnt(0)" ::: "memory");
    LAS bf16_t* stg = (LAS bf16_t*)(shm + LDS_OST) + wid * 2048;
#pragma unroll
    for (int r = 0; r < 16; ++r) { const int orow = crow(r, hi); const float rl = __builtin_amdgcn_rcpf(wsf[32 + orow]);
        stg[orow * 64 + r32] = (bf16_t)f2bf(o[0][r] * rl); stg[orow * 64 + 32 + r32] = (bf16_t)f2bf(o[1][r] * rl); }
    asm volatile("s_waitcnt lgkmcnt(0)" ::: "memory");
    bf16_t* Ow = P.O + (rowbase + q0 + 32 * wid) * (long)P.ldo;
#pragma unroll
    for (int i = 0; i < 4; ++i) { const int row = i * 8 + (lane >> 3), ch = lane & 7; *(u32x4*)(Ow + (long)row * P.ldo + ch * 8) = *(const LAS u32x4*)(stg + row * 64 + ch * 8); }
    asm volatile("s_waitcnt lgkmcnt(0)\n\ts_barrier" ::: "memory");
#undef FM_DMA_K
#undef FM_DMA_V
#undef FM_CMASK
#undef FM_RESC
#undef FM_ROT
#undef FM_VFR
#undef FM_PIN
#undef FM_MX3
#undef FM_VRD
#undef FM_PE
#undef FM_STEP
#undef FM_ENDW
}
#undef FM_SBAR
#undef FM_WAIT_BAR
#undef FM_MFMA
}


namespace ix {
__device__ __forceinline__ unsigned ordf(float f) { const unsigned u = __builtin_bit_cast(unsigned, f); return u ^ ((u >> 31) ? 0xFFFFFFFFu : 0x80000000u); }
constexpr int L_HIST = EXTRA_OFF, L_MK = EXTRA_OFF + 16384, L_CV = L_MK + 4096, L_CI = L_CV + 1024, L_RED = L_CI + 1024, L_SELW = L_RED + 256, L_FLAG = L_SELW + 64;
struct Pre { bf16x8 qi[4]; float w[2][8]; bf16x8 kbA[4], kbB[4]; };
__device__ __forceinline__ void preload(const Frame& F, const bf16_t* Z, const bf16_t* KIT, int b, int qu, Pre& pre) {
    const int lane = F.lane, r32 = lane & 31, hi = lane >> 5, wid = F.wave;
    const long rowbase = (long)b * SEQ; const int t0 = 4 * qu, ntile = (t0 >> 5) + 1, npair = (ntile + 1) >> 1;
    { const int rho = r32, hq = (rho >> 2) & 1, gq = rho >> 3, iq = rho & 3;
      const bf16_t* qp = Z + (rowbase + t0 + 2 * hq + (gq >> 1)) * (long)ZP + ZC_IQ + 64 * (4 * (gq & 1) + iq) + 8 * hi;
#pragma unroll
      for (int ks = 0; ks < 4; ++ks) pre.qi[ks] = *(const bf16x8*)(qp + 16 * ks);
#pragma unroll
      for (int q2 = 0; q2 < 2; ++q2) { const u32x4 ww = *(const u32x4*)(Z + (rowbase + t0 + 2 * hi + q2) * (long)ZP + ZC_IW);
          pre.w[q2][0] = bf_lo(ww.x); pre.w[q2][1] = bf_hi(ww.x); pre.w[q2][2] = bf_lo(ww.y); pre.w[q2][3] = bf_hi(ww.y); pre.w[q2][4] = bf_lo(ww.z); pre.w[q2][5] = bf_hi(ww.z); pre.w[q2][6] = bf_lo(ww.w); pre.w[q2][7] = bf_hi(ww.w); } }
    const bf16_t* kbase = KIT + (size_t)(rowbase >> 5) * 2048 + hi * 256 + r32 * 8;
    if (wid < npair) { const bf16_t* kp = kbase + (size_t)(2 * wid) * 2048;
#pragma unroll
        for (int ks = 0; ks < 4; ++ks) { pre.kbA[ks] = *(const bf16x8*)(kp + 512 * ks); pre.kbB[ks] = *(const bf16x8*)(kp + 2048 + 512 * ks); } }
    else {
#pragma unroll
        for (int ks = 0; ks < 4; ++ks) { pre.kbA[ks] = bf16x8{}; pre.kbB[ks] = bf16x8{}; } }
}
__device__ __forceinline__ float relu1(float x) { const int i = __builtin_bit_cast(int, x); return __builtin_bit_cast(float, i > 0 ? i : 0); }
#define IX_BAR() asm volatile("s_waitcnt lgkmcnt(0)\n\ts_barrier" ::: "memory")
__device__ __forceinline__ void unit(const Frame& F, const bf16_t* Z, const bf16_t* KIT, unsigned* MK, int b, int qu, Pre& pre, bool has_next, int nb, int nqu) {
    const int lane = F.lane, r32 = lane & 31, hi = lane >> 5, wid = F.wave;
    const long rowbase = (long)b * SEQ; const int t0 = 4 * qu, ntile = (t0 >> 5) + 1, nk32 = 32 * ntile, nblk = (nk32 + 63) >> 6;
    LAS float* sc = (LAS float*)F.lds;
    LAS unsigned* hist = (LAS unsigned*)(F.lds + L_HIST);
    LAS unsigned* mk = (LAS unsigned*)(F.lds + L_MK);
    LAS float* cval = (LAS float*)(F.lds + L_CV); LAS unsigned* cidx = (LAS unsigned*)(F.lds + L_CI);
    LAS float* red = (LAS float*)(F.lds + L_RED);
    LAS unsigned* selw = (LAS unsigned*)(F.lds + L_SELW);
    LAS unsigned* flag = (LAS unsigned*)(F.lds + L_FLAG);
    bf16x8 qi[4]; float w[2][8];
#pragma unroll
    for (int ks = 0; ks < 4; ++ks) qi[ks] = pre.qi[ks];
#pragma unroll
    for (int q2 = 0; q2 < 2; ++q2)
#pragma unroll
        for (int e = 0; e < 8; ++e) w[q2][e] = pre.w[q2][e];
    float vmaxA = -INFINITY, vmaxB = -INFINITY, vminA = INFINITY, vminB = INFINITY;
    bf16x8 kq[2][8];
    const int npair = (ntile + 1) >> 1;
    const bf16_t* kbase = KIT + (size_t)(rowbase >> 5) * 2048 + hi * 256 + r32 * 8;
#pragma unroll
    for (int ks = 0; ks < 4; ++ks) { kq[0][ks] = pre.kbA[ks]; kq[0][4 + ks] = pre.kbB[ks]; }
#define IX_LOADP(BUF, PP) do { const bf16_t* kp_ = kbase + (size_t)(2 * (PP)) * 2048; \
        _Pragma("unroll") for (int ks = 0; ks < 4; ++ks) { kq[BUF][ks] = *(const bf16x8*)(kp_ + 512 * ks); kq[BUF][4 + ks] = *(const bf16x8*)(kp_ + 2048 + 512 * ks); } } while (0)
    if (wid + NWAVES < npair) IX_LOADP(1, wid + NWAVES);
    else {
#pragma unroll
        for (int ks = 0; ks < 8; ++ks) kq[1][ks] = bf16x8{}; }
#define IX_ELEM(D, e, sa, sb) do { const float ra_ = relu1(D[e]), rb_ = relu1(D[8 + (e)]); sa = __builtin_fmaf(w[0][e], ra_, sa); sb = __builtin_fmaf(w[1][e], rb_, sb); } while (0)
#define IX_TAIL(sa, sb, S0) do { const int s = (S0) + r32;                       \
        if (s > t0 + 2 * hi) sa = -INFINITY; else { vmaxA = __builtin_fmaxf(vmaxA, sa); vminA = __builtin_fminf(vminA, sa); } \
        if (s > t0 + 2 * hi + 1) sb = -INFINITY; else { vmaxB = __builtin_fmaxf(vmaxB, sb); vminB = __builtin_fminf(vminB, sb); } \
        sc[(2 * hi) * 8192 + s] = sa; sc[(2 * hi + 1) * 8192 + s] = sb; } while (0)
#define IX_PIN2(x, y) asm volatile("" : "+v"(x), "+v"(y))
#define IX_MF(a, b, c) __builtin_amdgcn_mfma_f32_32x32x16_bf16(a, b, c, 0, 0, 0)
#define IX_GAP(MF, D, e0, sa, sb) do { MF; IX_ELEM(D, e0, sa, sb); IX_ELEM(D, (e0) + 1, sa, sb); IX_PIN2(sa, sb); __builtin_amdgcn_sched_barrier(0); } while (0)
#define IX_PIPE(cA, cB, nA, nB, KQ, P, HASN) do { const int s0_ = 64 * (P); float sa = 0.f, sb = 0.f; __builtin_amdgcn_sched_barrier(0); \
        if (HASN) { \
            IX_GAP(nA = IX_MF(qi[0], KQ[0], f32x16{}), cA, 0, sa, sb); IX_GAP(nB = IX_MF(qi[0], KQ[4], f32x16{}), cA, 2, sa, sb); \
            IX_GAP(nA = IX_MF(qi[1], KQ[1], nA), cA, 4, sa, sb);       IX_GAP(nB = IX_MF(qi[1], KQ[5], nB), cA, 6, sa, sb); \
            IX_TAIL(sa, sb, s0_); sa = 0.f; sb = 0.f; __builtin_amdgcn_sched_barrier(0); \
            IX_GAP(nA = IX_MF(qi[2], KQ[2], nA), cB, 0, sa, sb);       IX_GAP(nB = IX_MF(qi[2], KQ[6], nB), cB, 2, sa, sb); \
            IX_GAP(nA = IX_MF(qi[3], KQ[3], nA), cB, 4, sa, sb);       IX_GAP(nB = IX_MF(qi[3], KQ[7], nB), cB, 6, sa, sb); \
        } else { \
            IX_ELEM(cA, 0, sa, sb); IX_ELEM(cA, 1, sa, sb); IX_ELEM(cA, 2, sa, sb); IX_ELEM(cA, 3, sa, sb); IX_ELEM(cA, 4, sa, sb); IX_ELEM(cA, 5, sa, sb); IX_ELEM(cA, 6, sa, sb); IX_ELEM(cA, 7, sa, sb); \
            IX_TAIL(sa, sb, s0_); sa = 0.f; sb = 0.f; \
            IX_ELEM(cB, 0, sa, sb); IX_ELEM(cB, 1, sa, sb); IX_ELEM(cB, 2, sa, sb); IX_ELEM(cB, 3, sa, sb); IX_ELEM(cB, 4, sa, sb); IX_ELEM(cB, 5, sa, sb); IX_ELEM(cB, 6, sa, sb); IX_ELEM(cB, 7, sa, sb); \
        } \
        if (s0_ + 32 < nk32) IX_TAIL(sa, sb, s0_ + 32); __builtin_amdgcn_sched_barrier(0); } while (0)
    f32x16 dA = {}, dB = {}, eA = {}, eB = {};
    if (wid < npair) {
#pragma unroll
        for (int ks = 0; ks < 4; ++ks) { dA = IX_MF(qi[ks], kq[0][ks], dA); dB = IX_MF(qi[ks], kq[0][4 + ks], dB); }
        if (wid + 2 * NWAVES < npair) IX_LOADP(0, wid + 2 * NWAVES);
    }
    for (int p0_ = wid; p0_ < npair; p0_ += 2 * NWAVES) {
        { const int p = p0_, pn = p + NWAVES; const bool hn = pn < npair;
          IX_PIPE(dA, dB, eA, eB, kq[1], p, hn); if (pn + 2 * NWAVES < npair) IX_LOADP(1, pn + 2 * NWAVES); }
        { const int p = p0_ + NWAVES, pn = p + NWAVES; if (p < npair) { const bool hn = pn < npair;
          IX_PIPE(eA, eB, dA, dB, kq[0], p, hn); if (pn + 2 * NWAVES < npair) IX_LOADP(0, pn + 2 * NWAVES); } }
    }
#undef IX_LOADP
#undef IX_ELEM
#undef IX_TAIL
#undef IX_PIN2
#undef IX_MF
#undef IX_GAP
#undef IX_PIPE
    if (has_next) preload(F, Z, KIT, nb, nqu, pre);
    const bool need_sel = (t0 + 4 > 256);
    if (need_sel) {
#pragma unroll
        for (int o = 1; o < 32; o <<= 1) { vmaxA = __builtin_fmaxf(vmaxA, __shfl_xor(vmaxA, o)); vmaxB = __builtin_fmaxf(vmaxB, __shfl_xor(vmaxB, o));
                                           vminA = __builtin_fminf(vminA, __shfl_xor(vminA, o)); vminB = __builtin_fminf(vminB, __shfl_xor(vminB, o)); }
        if (r32 == 0) { red[wid * 8 + 2 * hi] = vmaxA; red[wid * 8 + 2 * hi + 1] = vmaxB; red[wid * 8 + 4 + 2 * hi] = vminA; red[wid * 8 + 5 + 2 * hi] = vminB; }
        hist[F.tid] = 0u; hist[F.tid + 512] = 0u; hist[F.tid + 1024] = 0u; hist[F.tid + 1536] = 0u; hist[F.tid + 2048] = 0u; hist[F.tid + 2560] = 0u; hist[F.tid + 3072] = 0u; hist[F.tid + 3584] = 0u;
        if (F.tid < 16) selw[F.tid] = 0u;
        if (F.tid == 0) flag[0] = 0u;
    }
    IX_BAR();
#if defined(DBG_DSA_SCORES)
    { float* dump = (float*)(F.wsp(WS_R2 + 56 * MiB));
      for (int qq = 0; qq < 4; ++qq) { const int tt = t0 + qq; int slot = -1;
          if (tt == 256) slot = 0; if (tt == 257) slot = 1; if (tt == 700) slot = 2; if (tt == 3001) slot = 3; if (tt == 8191) slot = 4;
          if (slot >= 0) for (int s = F.tid; s < nk32; s += 512) dump[((size_t)(b * 5 + slot)) * 8192 + s] = sc[qq * 8192 + s]; } }
#endif
    const int q = wid >> 1, sub = wid & 1, tq = t0 + q;
    if (!need_sel) {
        for (int blk = sub; blk < nblk; blk += 2) { const int s = 64 * blk + lane; const unsigned long long bal = __ballot(s <= tq);
            if (lane == 0) { mk[q * 256 + 2 * blk] = (unsigned)bal; mk[q * 256 + 2 * blk + 1] = (unsigned)(bal >> 32); } }
    } else {
        float maxv = red[q], minv = red[4 + q];
#pragma unroll
        for (int wv = 1; wv < 8; ++wv) { maxv = __builtin_fmaxf(maxv, red[wv * 8 + q]); minv = __builtin_fminf(minv, red[wv * 8 + 4 + q]); }
        const float rng = maxv - minv; const bool degenerate = !(rng > 0.f) || !(rng < 3.0e38f);
        const float scale = degenerate ? 0.f : 1023.99f / rng;
#ifdef DBG_FORCE_RADIX
        if (lane == 0) flag[0] = 1u;
#endif
        if (degenerate && lane == 0) flag[0] = 1u;
        { int idx = sub * 64 + lane;
          for (; idx + 384 <= tq; idx += 512) {
              const float v0 = sc[q * 8192 + idx], v1 = sc[q * 8192 + idx + 128], v2 = sc[q * 8192 + idx + 256], v3 = sc[q * 8192 + idx + 384];
              const int b0 = (int)((maxv - v0) * scale), b1 = (int)((maxv - v1) * scale), b2 = (int)((maxv - v2) * scale), b3 = (int)((maxv - v3) * scale);
              (void)__hip_atomic_fetch_add(&hist[q * 1024 + b0], 1u, __ATOMIC_RELAXED, __HIP_MEMORY_SCOPE_WORKGROUP); (void)__hip_atomic_fetch_add(&hist[q * 1024 + b1], 1u, __ATOMIC_RELAXED, __HIP_MEMORY_SCOPE_WORKGROUP);
              (void)__hip_atomic_fetch_add(&hist[q * 1024 + b2], 1u, __ATOMIC_RELAXED, __HIP_MEMORY_SCOPE_WORKGROUP); (void)__hip_atomic_fetch_add(&hist[q * 1024 + b3], 1u, __ATOMIC_RELAXED, __HIP_MEMORY_SCOPE_WORKGROUP); }
          for (; idx <= tq; idx += 128) {
              const int bin = (int)((maxv - sc[q * 8192 + idx]) * scale);
              (void)__hip_atomic_fetch_add(&hist[q * 1024 + bin], 1u, __ATOMIC_RELAXED, __HIP_MEMORY_SCOPE_WORKGROUP); } }
        IX_BAR();
        if (wid < 4) {
            const LAS u32x4* hp = (const LAS u32x4*)(hist + wid * 1024 + 16 * lane);
            const u32x4 h0 = hp[0], h1 = hp[1], h2 = hp[2], h3 = hp[3];
            const unsigned c[16] = {h0.x, h0.y, h0.z, h0.w, h1.x, h1.y, h1.z, h1.w, h2.x, h2.y, h2.z, h2.w, h3.x, h3.y, h3.z, h3.w};
            unsigned tot = 0u;
#pragma unroll
            for (int i = 0; i < 16; ++i) tot += c[i];
            unsigned incl = tot;
#pragma unroll
            for (int o = 1; o < 64; o <<= 1) { const unsigned v = __shfl_up(incl, o); if (lane >= o) incl += v; }
            const unsigned excl = incl - tot;
            if (excl < 256u && 256u <= incl) {
                unsigned run = excl, bsel = 0u, cnt = 0u; bool found = false;
#pragma unroll
                for (int i = 0; i < 16; ++i) { if (!found) { if (run + c[i] >= 256u) { bsel = 16u * lane + i; cnt = c[i]; found = true; } else run += c[i]; } }
                selw[wid * 4 + 0] = bsel; selw[wid * 4 + 1] = 256u - run; selw[wid * 4 + 2] = cnt;
                if (cnt > 64u) flag[0] = 1u;
            }
        }
        IX_BAR();
        if (flag[0] == 0u) {
            const unsigned B = selw[q * 4 + 0];
#define IX_EMIT(BLK, V) do { const int s_ = 64 * (BLK) + lane; const bool val_ = (s_ <= tq); const float v_ = val_ ? (V) : 0.f; \
                const unsigned bin_ = (unsigned)(int)((maxv - v_) * scale); const unsigned long long bal_ = __ballot(val_ && bin_ < B); \
                if (val_ && bin_ == B) { const unsigned pos_ = __hip_atomic_fetch_add(&selw[q * 4 + 3], 1u, __ATOMIC_RELAXED, __HIP_MEMORY_SCOPE_WORKGROUP); cval[q * 64 + (pos_ & 63u)] = v_; cidx[q * 64 + (pos_ & 63u)] = (unsigned)s_; } \
                if (lane == 0) { mk[q * 256 + 2 * (BLK)] = (unsigned)bal_; mk[q * 256 + 2 * (BLK) + 1] = (unsigned)(bal_ >> 32); } } while (0)
            { int blk = sub;
              for (; blk + 6 < nblk; blk += 8) {
                  const float v0 = sc[q * 8192 + 64 * blk + lane], v1 = sc[q * 8192 + 64 * (blk + 2) + lane], v2 = sc[q * 8192 + 64 * (blk + 4) + lane], v3 = sc[q * 8192 + 64 * (blk + 6) + lane];
                  IX_EMIT(blk, v0); IX_EMIT(blk + 2, v1); IX_EMIT(blk + 4, v2); IX_EMIT(blk + 6, v3); }
              for (; blk < nblk; blk += 2) { const float v0 = sc[q * 8192 + ((64 * blk + lane) & 8191)]; IX_EMIT(blk, v0); } }
#undef IX_EMIT
            IX_BAR();
            if (wid < 4) {
                const unsigned C = selw[wid * 4 + 3], need = selw[wid * 4 + 1];
                const float mv = (lane < (int)C) ? cval[wid * 64 + lane] : -INFINITY; const unsigned mi = (lane < (int)C) ? cidx[wid * 64 + lane] : 0xFFFFFFFFu;
                unsigned rank = 0u;
                for (unsigned j = 0; j < C; ++j) { const unsigned js = (unsigned)__builtin_amdgcn_readfirstlane((int)j);
                    const float vj = __builtin_bit_cast(float, __builtin_amdgcn_readlane(__builtin_bit_cast(int, mv), (int)js)); const unsigned ij = (unsigned)__builtin_amdgcn_readlane((int)mi, (int)js); rank += (vj > mv || (vj == mv && ij < mi)) ? 1u : 0u; }
                if (lane < (int)C && rank < need) (void)__hip_atomic_fetch_or(&mk[wid * 256 + (mi >> 5)], 1u << (mi & 31u), __ATOMIC_RELAXED, __HIP_MEMORY_SCOPE_WORKGROUP);
            }
        } else {
            if (F.tid < 4) { unsigned z_ = (unsigned)F.zz; asm volatile("" : "+v"(z_)); selw[F.tid * 4 + 0] = z_; selw[F.tid * 4 + 1] = 256u + z_; selw[F.tid * 4 + 2] = z_; }
#pragma unroll 1
            for (int pass = 0; pass < 4; ++pass) {
                const int shift = 24 - 8 * pass;
                IX_BAR();
                hist[F.tid] = 0u; hist[F.tid + 512] = 0u;
                IX_BAR();
                const unsigned prefix = selw[q * 4 + 0];
                for (int idx = sub * 64 + lane; idx < nk32; idx += 128) {
                    const unsigned u = ordf(sc[q * 8192 + idx]);
                    const bool match = (pass == 0) || ((u >> (shift + 8)) == (prefix >> (shift + 8)));
                    if (match) (void)__hip_atomic_fetch_add(&hist[q * 256 + ((u >> shift) & 255u)], 1u, __ATOMIC_RELAXED, __HIP_MEMORY_SCOPE_WORKGROUP);
                }
                IX_BAR();
                if (wid < 4) {
                    const unsigned kk = selw[wid * 4 + 1], pre = selw[wid * 4 + 0];
                    const unsigned c0 = hist[wid * 256 + 4 * lane], c1 = hist[wid * 256 + 4 * lane + 1], c2 = hist[wid * 256 + 4 * lane + 2], c3 = hist[wid * 256 + 4 * lane + 3];
                    const unsigned tot = c0 + c1 + c2 + c3; unsigned incl = tot;
#pragma unroll
                    for (int o = 1; o < 64; o <<= 1) { const unsigned v = __shfl_down(incl, o); if (lane + o < 64) incl += v; }
                    const unsigned excl = incl - tot;
                    if (excl < kk && kk <= incl) {
                        unsigned run = excl, dsel, cnt;
                        if (run + c3 >= kk) { dsel = 3; cnt = c3; } else { run += c3;
                            if (run + c2 >= kk) { dsel = 2; cnt = c2; } else { run += c2;
                                if (run + c1 >= kk) { dsel = 1; cnt = c1; } else { run += c1; dsel = 0; cnt = c0; } } }
                        selw[wid * 4 + 0] = pre | ((4u * lane + dsel) << shift); selw[wid * 4 + 1] = kk - run; selw[wid * 4 + 2] = cnt;
                    }
                }
            }
            IX_BAR();
            const unsigned thr = selw[q * 4 + 0], kk = selw[q * 4 + 1];
            unsigned eqseen = 0u;
            for (int blk = 0; blk < nblk; ++blk) {
                const int s = 64 * blk + lane;
                const unsigned u = (s < nk32) ? ordf(sc[q * 8192 + s]) : 0u;
                const bool val = (s <= tq);
                const unsigned long long gt = __ballot(val && u > thr), eq = __ballot(val && u == thr);
                unsigned long long take = 0ull, e = eq; unsigned left = (kk > eqseen) ? kk - eqseen : 0u;
                while (left && e) { const unsigned long long low = e & (~e + 1ull); take |= low; e ^= low; --left; }
                eqseen += (unsigned)__popcll(eq);
                if ((blk & 1) == sub && lane == 0) { const unsigned long long wv = gt | take; mk[q * 256 + 2 * blk] = (unsigned)wv; mk[q * 256 + 2 * blk + 1] = (unsigned)(wv >> 32); }
            }
        }
    }
    IX_BAR();
    { const int wq = F.tid >> 7, ww = (F.tid & 127) * 2;
      if (ww < 2 * nblk) *(u32x2*)(MK + (size_t)(rowbase + t0 + wq) * 256 + ww) = *(const LAS u32x2*)(mk + wq * 256 + ww); }
    IX_BAR();
}
}

constexpr int NPH = 16;
__global__ void __launch_bounds__(NWAVES * 64, 2) mk_fwd(Args args) {
    extern __shared__ __attribute__((aligned(16))) unsigned char lds[];
    Frame F;
    F.lds = (LAS unsigned char*)lds;
    F.tid = threadIdx.x; F.lane = F.tid & 63; F.wave = __builtin_amdgcn_readfirstlane(F.tid >> 6);
    const int wave0 = F.wave;
    F.G = gridDim.x; { const int bx = blockIdx.x; F.vcu = (F.G % 8 == 0) ? (bx % 8) * (F.G / 8) + bx / 8 : bx; }
    F.a = &args; F.zz = 0;
    volatile LAS unsigned* MISC = (volatile LAS unsigned*)(F.lds + LDSCTL_OFF);
    for (int u = F.tid; u < (LDS_BYTES - LDSCTL_OFF) / 4; u += NWAVES * 64) ((LAS unsigned*)(F.lds + LDSCTL_OFF))[u] = 0u;
    __syncthreads();
    XcdBarrier bar; bar.bar = (unsigned*)(args.ws + WS_CTL) + CW_BAR; bar.x = 0; bar.st = nullptr;
    if (MK_ONE_LAUNCH) bar = xcd_barrier_post((unsigned*)(args.ws + WS_CTL) + CW_BAR, MISC + 8);
    const int lo = args.ph_lo, hi = args.ph_hi;
#define IN(k) (lo <= (k) && (k) < hi)
#define SEAM(k) do { if (MK_ONE_LAUNCH && (k) + 1 < hi) { XcdBarrier b2_ = bar; asm volatile("" : "+s"(b2_.bar), "+s"(b2_.x)); xcd_barrier(b2_); } } while (0)
#define PHASE_BEGIN() do { asm volatile("s_mov_b32 %0, 0" : "=s"(F.zz)); F.wave = wave0 + F.zz; asm volatile("v_mbcnt_lo_u32_b32 %0, -1, 0\n\tv_mbcnt_hi_u32_b32 %0, -1, %0" : "=v"(F.lane)); F.tid = F.wave * 64 + F.lane; } while (0)
#define WSP(off, T) ((T*)(F.wsp(off)))

    for (int l = 0; l < DEPTH; ++l) {
        const int P = l * NPH;
        for (int rep_ = 0; rep_ < ((DBG_DUP == 0) ? 2 : 1); ++rep_) if (IN(P + 0)) {
            PHASE_BEGIN();
            if (l == 0) { for (int u = F.vcu; u < 144; u += F.G) { PHASE_BEGIN(); mod_unit(F, u); } PHASE_BEGIN(); rope_table(F); PHASE_BEGIN(); }
            convert_weights(F, l, 0, 0, 2, F.vcu * NWAVES + F.wave, F.G * NWAVES);
            SEAM(P + 0);
        }
        for (int rep_ = 0; rep_ < ((DBG_DUP == 1) ? 2 : 1); ++rep_) if (IN(P + 1)) {
            PHASE_BEGIN();
            const float* mod_l = WSP(WS_MOD, const float) + (size_t)l * 2 * 9216; const float* ng = F.in(IN_NORMG) + (size_t)l * 6 * DM;
            if (l == 0) { norm_pass<false, true>(F, nullptr, F.in(IN_X), nullptr, nullptr, nullptr, 0.f, ng + 0 * DM, mod_l + 1 * DM, mod_l + 0 * DM, WSP(WS_XN, bf16_t));
                SEAM(P + 1); }
        }
        for (int rep_ = 0; rep_ < ((DBG_DUP == 2) ? 2 : 1); ++rep_) if (IN(P + 2)) {
            PHASE_BEGIN();
            pg8::Gemm g{WSP(WS_XN, bf16_t), WSP(WS_W + W_W1, bf16_t), DM, DM, DM}; pg8::StaticOrder S; S.init(M, 2 * DFF, F.G, (int)blockIdx.x);
            pg8::EpiSwiglu E{WSP(WS_R1, bf16_t), DFF};
            pg8::gemm_phase<pg8::EpiSwiglu, pg8::StaticOrder, true>(F.lds, F.tid, g, S, E);
            { const int rem_ = (M / 256) * (2 * DFF / 256) % F.G;
              if (l == 0 && rem_ != 0 && (int)blockIdx.x >= rem_) { PHASE_BEGIN(); convert_weights(F, l, 0, 2, NSEG_A, ((int)blockIdx.x - rem_) * NWAVES + F.wave, (F.G - rem_) * NWAVES); } }
            SEAM(P + 2);
        }
        for (int rep_ = 0; rep_ < ((DBG_DUP == 3) ? 2 : 1); ++rep_) if (IN(P + 3)) {
            PHASE_BEGIN();
            pg8::Gemm g{WSP(WS_R1, bf16_t), WSP(WS_W + W_W2, bf16_t), DFF, DFF, DFF}; pg8::StaticOrder S; S.init(M, DM, F.G, (int)blockIdx.x);
            pg8::EpiBf16<0> E{WSP(WS_R2, bf16_t), DM};
            pg8::gemm_phase<pg8::EpiBf16<0>, pg8::StaticOrder, true>(F.lds, F.tid, g, S, E);
            SEAM(P + 3);
        }
        for (int rep_ = 0; rep_ < ((DBG_DUP == 4) ? 2 : 1); ++rep_) if (IN(P + 4)) {
            PHASE_BEGIN();
            const float* mod_l = WSP(WS_MOD, const float) + (size_t)l * 2 * 9216; const float* ng = F.in(IN_NORMG) + (size_t)l * 6 * DM;
            norm_pass<true, true>(F, WSP(WS_R2, bf16_t), l == 0 ? F.in(IN_X) : F.outp(), F.outp(), ng + 1 * DM, mod_l + 2 * DM, 0.5f, ng + 2 * DM, mod_l + 4 * DM, mod_l + 3 * DM, WSP(WS_XN, bf16_t));
            SEAM(P + 4);
        }
        for (int rep_ = 0; rep_ < ((DBG_DUP == 5) ? 2 : 1); ++rep_) if (IN(P + 5)) {
            PHASE_BEGIN();
            pg8::Gemm g{WSP(WS_XN, bf16_t), WSP(WS_W + W_IN, bf16_t), DM, DM, DM}; pg8::StaticOrder S; S.init(M, ZP, F.G, (int)blockIdx.x);
            pg8::EpiBf16<0> E{WSP(WS_R1, bf16_t), ZP};
            pg8::gemm_phase<pg8::EpiBf16<0>, pg8::StaticOrder, true>(F.lds, F.tid, g, S, E);
            { const int rem_ = (M / 256) * (ZP / 256) % F.G;
              if (rem_ != 0 && (int)blockIdx.x >= rem_) { PHASE_BEGIN(); convert_weights(F, l, 1, 0, NSEG_B, ((int)blockIdx.x - rem_) * NWAVES + F.wave, (F.G - rem_) * NWAVES); } }
            SEAM(P + 5);
        }
        for (int rep_ = 0; rep_ < ((DBG_DUP == 6) ? 2 : 1); ++rep_) if (IN(P + 6)) {
            PHASE_BEGIN();
            mla_prep(F, WSP(WS_R1, const bf16_t), WSP(WS_YB, bf16_t), WSP(WS_YB + 8 * MiB, bf16_t), WSP(WS_KROPE, bf16_t), WSP(WS_RS, bf16_t), WSP(WS_ROPE, const f32x2));
            __syncthreads();
            for (int u = F.vcu; u < 256; u += F.G) { PHASE_BEGIN(); lru_unit<false>(F, l, u, WSP(WS_R1, const bf16_t), WSP(WS_LRUS, f32x2), nullptr); }
            SEAM(P + 6);
        }
        for (int rep_ = 0; rep_ < ((DBG_DUP == 7) ? 2 : 1); ++rep_) if (IN(P + 7)) {
            PHASE_BEGIN();
            { pg8::Gemm g{WSP(WS_YB, bf16_t), WSP(WS_W + W_UQ, bf16_t), 256, 256, 256 + F.zz}; pg8::StaticOrder S; S.init(M, 768, F.G, (int)blockIdx.x);
              pg8::EpiMlaQ E{WSP(WS_R2, bf16_t), 768, WSP(WS_ROPE, const f32x2)};
              pg8::gemm_phase<pg8::EpiMlaQ, pg8::StaticOrder, true>(F.lds, F.tid, g, S, E); }
            PHASE_BEGIN();
            { pg8::Gemm g{WSP(WS_YB + 8 * MiB, bf16_t), WSP(WS_W + W_UKV, bf16_t), 128, 128, 128 + F.zz}; pg8::StaticOrder S; S.init(M, 1024, F.G, (int)blockIdx.x);
              pg8::EpiBf16<0> E{WSP(WS_R2 + 24 * MiB, bf16_t), 1024};
              pg8::gemm_phase<pg8::EpiBf16<0>, pg8::StaticOrder, true>(F.lds, F.tid, g, S, E); }
            __syncthreads();
            PHASE_BEGIN();
            for (int v = F.vcu; v < 256; v += F.G)
            { ix::Pre pre; const int U0 = v;
              ix::preload(F, WSP(WS_R1, const bf16_t), WSP(WS_RS, const bf16_t), U0 >> 11, U0 & 2047, pre);
              for (int i = 0; i < 16; ++i) { const int U = (i & 1) ? 4095 - ((i >> 1) * 256 + v) : (i >> 1) * 256 + v;
                  const int i2 = i + 1, U2 = (i2 & 1) ? 4095 - ((i2 >> 1) * 256 + v) : (i2 >> 1) * 256 + v;
                  PHASE_BEGIN();
                  ix::unit(F, WSP(WS_R1, const bf16_t), WSP(WS_RS, const bf16_t), WSP(WS_R1 + 112 * MiB, unsigned), U >> 11, U & 2047, pre, i2 < 16, (U2 >> 11) & 1, U2 & 2047); } }
            __syncthreads();
            SEAM(P + 7);
        }
        for (int rep_ = 0; rep_ < ((DBG_DUP == 8) ? 2 : 1); ++rep_) if (IN(P + 8)) {
            PHASE_BEGIN();
            for (unsigned v_ = (unsigned)(F.vcu + F.zz); v_ < 256u; v_ += 256u) { const int v = (int)v_;
                const int bh = v >> 4, b = bh >> 3, h = bh & 7, qa = v & 15;
                PHASE_BEGIN();
                const bf16_t* Z = WSP(WS_R1, const bf16_t); bf16_t* YB = WSP(WS_YB, bf16_t);
                { fa::Ptrs P_{WSP(WS_R2, const bf16_t) + 96 * h, 768, WSP(WS_R2 + 24 * MiB, const bf16_t) + 128 * h, 1024, WSP(WS_KROPE, const bf16_t), WSP(WS_R2 + 24 * MiB, const bf16_t) + 128 * h + 64, 1024,
                                YB + 1024 + 64 * h, 2048, nullptr, 0.f, 0.f};
                  for (int r3_ = 0; r3_ < ((DBG_FADUP == 0) ? 2 : 1); ++r3_) { fm::unit(F, P_, b, qa); PHASE_BEGIN(); fm::unit(F, P_, b, 31 - qa); PHASE_BEGIN(); } }
                PHASE_BEGIN();
                { fa::Ptrs P_{Z + ZC_AQ + 64 * h, ZP, Z + ZC_AK + 64 * (h >> 2), ZP, nullptr, Z + ZC_AV + 64 * (h >> 2), ZP, YB + 64 * h, 2048, WSP(WS_R1 + 112 * MiB, const unsigned),
                                __builtin_amdgcn_exp2f(-0.5f * (float)(h + 9)) * LOG2E, 0.f};
                  for (int r3_ = 0; r3_ < ((DBG_FADUP == 1) ? 2 : 1); ++r3_) { fd::unit<0>(F, P_, b, qa); PHASE_BEGIN(); fd::unit<0>(F, P_, b, 31 - qa); PHASE_BEGIN(); } }
                for (int i = 0; i < ((DBG_FADUP == 2) ? 4 : 2); ++i) { PHASE_BEGIN(); const int U = 2 * v + (i & 1), bh2 = U >> 5, b2 = bh2 >> 3, h2 = bh2 & 7, qb2 = U & 31;
                  fa::Ptrs P_{Z + ZC_DQ + 64 * h2, ZP, Z + ZC_DK + 64 * (h2 >> 2), ZP, nullptr, Z + ZC_DV + 64 * (h2 >> 2), ZP, YB + 1536 + 64 * h2, 2048, nullptr,
                                __builtin_amdgcn_exp2f(-0.5f * (float)(h2 + 1)) * LOG2E, F.in(IN_SINKS)[l * 8 + h2] * LOG2E};
                  fd::unit<1>(F, P_, b2, qb2); }
                for (int r5_ = 0; r5_ < ((DBG_FADUP == 3) ? 2 : 1); ++r5_) {
                PHASE_BEGIN();
                lru_unit<true>(F, l, v, WSP(WS_R1, const bf16_t), WSP(WS_LRUS, f32x2), WSP(WS_YB, bf16_t)); }
            }
            SEAM(P + 8);
        }
        for (int rep_ = 0; rep_ < ((DBG_DUP == 9) ? 2 : 1); ++rep_) if (IN(P + 9)) {
            PHASE_BEGIN();
#if defined(DBG_ZB)
            { bf16_t* YBz = WSP(WS_YB, bf16_t); const int gw = F.vcu * NWAVES + F.wave, NGW = F.G * NWAVES;
              for (int m = gw; m < M; m += NGW) *(u32x4*)(YBz + (size_t)m * 2048 + 512 * DBG_ZB + 8 * F.lane) = (u32x4){0u, 0u, 0u, 0u}; }
#endif
            PHASE_BEGIN();
            pg8::Gemm g{WSP(WS_XN, bf16_t), WSP(WS_W + W_G, bf16_t), DM, DM, DM}; pg8::StaticOrder S; S.init(M, NG, F.G, (int)blockIdx.x);
            pg8::EpiBf16<2> E{WSP(WS_R1, bf16_t), NG};
            pg8::gemm_phase<pg8::EpiBf16<2>, pg8::StaticOrder, true>(F.lds, F.tid, g, S, E);
            SEAM(P + 9);
        }
        for (int rep_ = 0; rep_ < ((DBG_DUP == 10) ? 2 : 1); ++rep_) if (IN(P + 10)) {
            PHASE_BEGIN();
            pg8::Gemm g{WSP(WS_YB, bf16_t), WSP(WS_W + W_BR, bf16_t), 2048, 2048, 512}; pg8::ChainOrder S; S.so.init(M, DM, F.G, (int)blockIdx.x);
            pg8::EpiGateMerge E{WSP(WS_R1, const bf16_t), WSP(WS_R2, bf16_t), DM};
            pg8::gemm_phase<pg8::EpiGateMerge, pg8::ChainOrder, true>(F.lds, F.tid, g, S, E);
            SEAM(P + 10);
        }
        for (int rep_ = 0; rep_ < ((DBG_DUP == 11) ? 2 : 1); ++rep_) if (IN(P + 11)) {
            PHASE_BEGIN();
            pg8::Gemm g{WSP(WS_R2, bf16_t), WSP(WS_W + W_O, bf16_t), DM, DM, DM}; pg8::StaticOrder S; S.init(M, DM, F.G, (int)blockIdx.x);
            pg8::EpiBf16<0> E{WSP(WS_YB, bf16_t), DM};
            pg8::gemm_phase<pg8::EpiBf16<0>, pg8::StaticOrder, true>(F.lds, F.tid, g, S, E);
            SEAM(P + 11);
        }
        for (int rep_ = 0; rep_ < ((DBG_DUP == 12) ? 2 : 1); ++rep_) if (IN(P + 12)) {
            PHASE_BEGIN();
            const float* mod_l = WSP(WS_MOD, const float) + (size_t)l * 2 * 9216; const float* ng = F.in(IN_NORMG) + (size_t)l * 6 * DM;
            norm_pass<true, true>(F, WSP(WS_YB, bf16_t), F.outp(), F.outp(), ng + 3 * DM, mod_l + 5 * DM, 1.0f, ng + 4 * DM, mod_l + 7 * DM, mod_l + 6 * DM, WSP(WS_XN, bf16_t));
            SEAM(P + 12);
        }
        for (int rep_ = 0; rep_ < ((DBG_DUP == 13) ? 2 : 1); ++rep_) if (IN(P + 13)) {
            PHASE_BEGIN();
            pg8::Gemm g{WSP(WS_XN, bf16_t), WSP(WS_W + W_W1, bf16_t), DM, DM, DM}; pg8::StaticOrder S; S.init(M, 2 * DFF, F.G, (int)blockIdx.x);
            pg8::EpiSwiglu E{WSP(WS_R1, bf16_t), DFF};
            pg8::gemm_phase<pg8::EpiSwiglu, pg8::StaticOrder, true>(F.lds, F.tid, g, S, E);
            { const int rem_ = (M / 256) * (2 * DFF / 256) % F.G;
              if (l + 1 < DEPTH && rem_ != 0 && (int)blockIdx.x >= rem_) { PHASE_BEGIN(); convert_weights(F, l + 1, 0, 2, NSEG_A, ((int)blockIdx.x - rem_) * NWAVES + F.wave, (F.G - rem_) * NWAVES); } }
            SEAM(P + 13);
        }
        for (int rep_ = 0; rep_ < ((DBG_DUP == 14) ? 2 : 1); ++rep_) if (IN(P + 14)) {
            PHASE_BEGIN();
            pg8::Gemm g{WSP(WS_R1, bf16_t), WSP(WS_W + W_W2, bf16_t), DFF, DFF, DFF}; pg8::StaticOrder S; S.init(M, DM, F.G, (int)blockIdx.x);
            pg8::EpiBf16<0> E{WSP(WS_R2, bf16_t), DM};
            pg8::gemm_phase<pg8::EpiBf16<0>, pg8::StaticOrder, true>(F.lds, F.tid, g, S, E);
            SEAM(P + 14);
        }
        for (int rep_ = 0; rep_ < ((DBG_DUP == 15) ? 2 : 1); ++rep_) if (IN(P + 15)) {
            PHASE_BEGIN();
            const float* mod_l = WSP(WS_MOD, const float) + (size_t)l * 2 * 9216; const float* ng = F.in(IN_NORMG) + (size_t)l * 6 * DM;
            if (l + 1 < DEPTH) { const float* mod_n = mod_l + 2 * 9216; const float* ngn = ng + 6 * DM;
                norm_pass<true, true>(F, WSP(WS_R2, bf16_t), F.outp(), F.outp(), ng + 5 * DM, mod_l + 8 * DM, 0.5f, ngn + 0 * DM, mod_n + 1 * DM, mod_n + 0 * DM, WSP(WS_XN, bf16_t)); }
            else norm_pass<true, false>(F, WSP(WS_R2, bf16_t), F.outp(), F.outp(), ng + 5 * DM, mod_l + 8 * DM, 0.5f, nullptr, nullptr, nullptr, nullptr);
            SEAM(P + 15);
        }
    }
#undef IN
#undef SEAM
}


#if defined(DBG_PROBE)
__device__ __forceinline__ void probe_acc(float* acc2, float dd, float rr) {
    dd = wave_sum(dd); rr = wave_sum(rr);
    if ((threadIdx.x & 63) == 0) { atomicAdd(acc2, dd); atomicAdd(acc2 + 1, rr); }
}
__global__ void __launch_bounds__(256) probe_swa(const unsigned char* ws, const float* sinks, float* acc2) {
    const bf16_t* Z = (const bf16_t*)(ws + WS_R1); const bf16_t* YB = (const bf16_t*)(ws + WS_YB);
    const int gid = blockIdx.x * blockDim.x + threadIdx.x; const int h = gid & 7, ms = gid >> 3;
    const int m = ms * 7 + 3; float dd = 0.f, rr = 0.f;
    if (m < M) {
        const int b = m >> 13, t = m & 8191, g = h >> 2; const float slope = exp2f(-0.5f * (h + 1));
        float q[64]; _Pragma("unroll") for (int d = 0; d < 64; ++d) q[d] = bf2f(Z[(size_t)m * ZP + ZC_DQ + 64 * h + d]);
        float mx = sinks[h] * LOG2E, l = 1.f, o[64]; _Pragma("unroll") for (int d = 0; d < 64; ++d) o[d] = 0.f;
        for (int s = (t >= 127 ? t - 127 : 0); s <= t; ++s) {
            const bf16_t* kr = Z + ((size_t)b * SEQ + s) * ZP + ZC_DK + 64 * g; float sc = 0.f;
            _Pragma("unroll") for (int d = 0; d < 64; ++d) sc += q[d] * bf2f(kr[d]);
            sc -= slope * LOG2E * (float)(t - s);
            const float mn = fmaxf(mx, sc), al = exp2f(mx - mn), p = exp2f(sc - mn);
            l = l * al + p; const bf16_t* vr = Z + ((size_t)b * SEQ + s) * ZP + ZC_DV + 64 * g;
            _Pragma("unroll") for (int d = 0; d < 64; ++d) o[d] = o[d] * al + p * bf2f(vr[d]);
            mx = mn;
        }
        _Pragma("unroll") for (int d = 0; d < 64; ++d) { const float ref = o[d] / l, got = bf2f(YB[(size_t)m * 2048 + 1536 + 64 * h + d]); dd += (got - ref) * (got - ref); rr += ref * ref; }
    }
    probe_acc(acc2, dd, rr);
}
__global__ void __launch_bounds__(256) probe_mla(const unsigned char* ws, float* acc2) {
    const bf16_t* Qc = (const bf16_t*)(ws + WS_R2); const bf16_t* KV = (const bf16_t*)(ws + WS_R2 + 24 * MiB); const bf16_t* KR = (const bf16_t*)(ws + WS_KROPE); const bf16_t* YB = (const bf16_t*)(ws + WS_YB);
    const int gid = blockIdx.x * blockDim.x + threadIdx.x; const int h = gid & 7, ms = gid >> 3;
    const int m = ms * 61 + 5; float dd = 0.f, rr = 0.f;
    if (m < M) {
        const int b = m >> 13, t = m & 8191;
        float q[96]; _Pragma("unroll") for (int d = 0; d < 96; ++d) q[d] = bf2f(Qc[(size_t)m * 768 + 96 * h + d]);
        float mx = -INFINITY, l = 0.f, o[64]; _Pragma("unroll") for (int d = 0; d < 64; ++d) o[d] = 0.f;
        for (int s = 0; s <= t; ++s) {
            const size_t mk = (size_t)b * SEQ + s; float sc = 0.f;
            _Pragma("unroll") for (int d = 0; d < 64; ++d) sc += q[d] * bf2f(KV[mk * 1024 + 128 * h + d]);
            _Pragma("unroll") for (int d = 0; d < 32; ++d) sc += q[64 + d] * bf2f(KR[mk * 32 + d]);
            const float mn = fmaxf(mx, sc), al = exp2f(mx - mn), p = exp2f(sc - mn);
            l = l * al + p;
            _Pragma("unroll") for (int d = 0; d < 64; ++d) o[d] = o[d] * al + p * bf2f(KV[mk * 1024 + 128 * h + 64 + d]);
            mx = mn;
        }
        _Pragma("unroll") for (int d = 0; d < 64; ++d) { const float ref = o[d] / l, got = bf2f(YB[(size_t)m * 2048 + 1024 + 64 * h + d]); dd += (got - ref) * (got - ref); rr += ref * ref; }
    }
    probe_acc(acc2, dd, rr);
}
__global__ void probe_lru(const unsigned char* ws, const float* convw, const float* convb, const float* lwa, const float* lba, const float* lwx, const float* lbx, const float* lam, float* acc2) {
    const bf16_t* Z = (const bf16_t*)(ws + WS_R1); const bf16_t* YB = (const bf16_t*)(ws + WS_YB);
    const int gid = blockIdx.x * blockDim.x + threadIdx.x; float dd = 0.f, rr = 0.f;
    if (gid < 1024) {
        const int b = gid >> 9, c = gid & 511, n = c >> 6, j = c & 63;
        const float sp = log1pf(expf(-lam[c])); float h = 0.f;
        for (int t = 0; t < SEQ; ++t) {
            float ra = lba[c], rx = lbx[c], xcc = 0.f;
            for (int i = 0; i < 64; ++i) { const int ci = 64 * n + i; float xc = convb[ci];
                for (int k = 0; k < 4; ++k) { const int tt = t - 3 + k; if (tt >= 0) xc += convw[k * 512 + ci] * bf2f(Z[((size_t)b * SEQ + tt) * ZP + ZC_RX + ci]); }
                ra += xc * lwa[(n * 64 + i) * 64 + j]; rx += xc * lwx[(n * 64 + i) * 64 + j]; if (i == j) xcc = xc; }
            const float r = 1.f / (1.f + expf(-ra)), ig = 1.f / (1.f + expf(-rx));
            const float la = -8.f * r * sp, a = expf(la), bb = sqrtf(-expm1f(2.f * la)) * (ig * xcc);
            h = a * h + bb;
            if ((t % 13) == 0 || t < 130) { const size_t m = (size_t)b * SEQ + t; const float g = bf2f(Z[m * ZP + ZC_RG + c]);
                const float ref = h * (0.5f * g * (1.f + tanhf(0.7978845608028654f * (g + 0.044715f * g * g * g)))), got = bf2f(YB[m * 2048 + 512 + c]);
                dd += (got - ref) * (got - ref); rr += ref * ref; }
        }
    }
    probe_acc(acc2, dd, rr);
}

__device__ __forceinline__ float blk_max(float v, float* red) { __syncthreads(); for (int o = 32; o > 0; o >>= 1) v = fmaxf(v, __shfl_xor(v, o)); if ((threadIdx.x & 63) == 0) red[threadIdx.x >> 6] = v; __syncthreads(); return fmaxf(fmaxf(red[0], red[1]), fmaxf(red[2], red[3])); }
__device__ __forceinline__ float blk_sum(float v, float* red) { __syncthreads(); v = wave_sum(v); if ((threadIdx.x & 63) == 0) red[threadIdx.x >> 6] = v; __syncthreads(); return (red[0] + red[1]) + (red[2] + red[3]); }
__global__ void __launch_bounds__(256) probe_dsa(const unsigned char* ws, float* acc2) {
    __shared__ float sc[8192]; __shared__ float pp[8192]; __shared__ float red[8]; __shared__ unsigned thr_s; __shared__ int cnt_s;
    const bf16_t* Z = (const bf16_t*)(ws + WS_R1); const bf16_t* YB = (const bf16_t*)(ws + WS_YB);
    const int tid = threadIdx.x;
    const int rows[8] = {3, 130, 255, 256, 257, 700, 3001, 8191};
    const int b = blockIdx.x & 1, t = (blockIdx.x < 16) ? rows[blockIdx.x >> 1] : (int)((blockIdx.x * 2654435761u) >> 19) ;
    const size_t m = (size_t)b * SEQ + t, rb = (size_t)b * SEQ;
    for (int s = tid; s <= t; s += 256) { float tot = 0.f;
        for (int hd = 0; hd < 8; ++hd) { float d = 0.f;
            for (int e = 0; e < 64; ++e) d += bf2f(Z[m * ZP + ZC_IQ + 64 * hd + e]) * bf2f(Z[(rb + s) * ZP + ZC_IK + e]);
            tot += bf2f(Z[m * ZP + ZC_IW + hd]) * fmaxf(d, 0.f); }
        sc[s] = tot; }
    __syncthreads();
#if defined(DBG_DSA_SCORES)
    { int slot = -1; if (t == 256) slot = 0; if (t == 257) slot = 1; if (t == 700) slot = 2; if (t == 3001) slot = 3; if (t == 8191) slot = 4;
      float d2 = 0.f, r2 = 0.f;
      if (slot >= 0 && blockIdx.x < 16) { const float* dump = (const float*)(ws + WS_R2 + 56 * MiB) + ((size_t)(b * 5 + slot)) * 8192;
          for (int s = tid; s <= t; s += 256) { const float df = dump[s] - sc[s]; d2 += df * df; r2 += sc[s] * sc[s]; } }
      probe_acc(acc2, d2, r2); return; }
#endif
    unsigned T = 0u; const int n = t + 1;
    if (n > 256) {
        unsigned lo = 0u, hi = 0xFFFFFFFFu;
        for (int it = 0; it < 33 && lo < hi; ++it) { const unsigned mid = lo + (unsigned)(((unsigned long long)hi - lo + 1ull) >> 1);
            float c = 0.f; for (int s = tid; s < n; s += 256) c += (ix::ordf(sc[s]) >= mid) ? 1.f : 0.f;
            c = blk_sum(c, red);
            if (c >= 256.f) lo = mid; else hi = mid - 1u; }
        T = lo;
    }
    { float c = 0.f; for (int s = tid; s < n; s += 256) { const unsigned u = ix::ordf(sc[s]); const bool g = (n <= 256) || (u > T); pp[s] = g ? 1.f : 0.f; c += g ? 1.f : 0.f; }
      c = blk_sum(c, red);
      if (tid == 0 && n > 256) { int need = 256 - (int)c; for (int s = 0; s < n && need > 0; ++s) if (ix::ordf(sc[s]) == T) { pp[s] = 1.f; --need; } }
      __syncthreads(); }
#if defined(DBG_DSA_MISMATCH)
    { const unsigned* MKp = (const unsigned*)(ws + WS_R1 + 112 * MiB) + m * 256; float mis = 0.f, tot = 0.f;
      const bool use = (DBG_DSA_MISMATCH == 0) ? (t < 256) : (t >= 256);
      for (int s = tid; s < n; s += 256) { const float mine = ((MKp[s >> 5] >> (s & 31)) & 1u) ? 1.f : 0.f; mis += (mine != pp[s]) ? 1.f : 0.f; tot += pp[s]; }
      if (!use) { mis = 0.f; tot = 0.f; }
      probe_acc(acc2, mis, tot); return; }
#endif
#if defined(DBG_DSA_USEMASK)
    { const unsigned* MKp = (const unsigned*)(ws + WS_R1 + 112 * MiB) + m * 256; __syncthreads(); for (int s = tid; s < n; s += 256) pp[s] = ((MKp[s >> 5] >> (s & 31)) & 1u) ? 1.f : 0.f; __syncthreads(); }
#endif
    float dd = 0.f, rr = 0.f;
    for (int h = 0; h < 8; ++h) {
        const int g = h >> 2; const float slope2 = exp2f(-0.5f * (h + 9)) * LOG2E;
        float lm = -INFINITY;
        for (int s = tid; s < n; s += 256) { float v = -INFINITY;
            if (pp[s] != 0.f) { float d = 0.f; for (int e = 0; e < 64; ++e) d += bf2f(Z[m * ZP + ZC_AQ + 64 * h + e]) * bf2f(Z[(rb + s) * ZP + ZC_AK + 64 * g + e]); v = d - slope2 * (float)(t - s); }
            sc[s] = v; lm = fmaxf(lm, v); }
        const float mx = blk_max(lm, red);
        float ls = 0.f; for (int s = tid; s < n; s += 256) { const float p = (sc[s] == -INFINITY) ? 0.f : exp2f(sc[s] - mx); sc[s] = p; ls += p; }
        const float l = blk_sum(ls, red);
        if (tid < 64) { float o = 0.f; for (int s = 0; s < n; ++s) if (sc[s] != 0.f) o += sc[s] * bf2f(Z[(rb + s) * ZP + ZC_AV + 64 * g + tid]);
            const float ref = o / l, got = bf2f(YB[m * 2048 + 64 * h + tid]); dd += (got - ref) * (got - ref); rr += ref * ref; }
        __syncthreads();
    }
    probe_acc(acc2, dd, rr);
}
__global__ void probe_out(const float* x, float* out, const float* acc2) {
    const float e = acc2[0] / fmaxf(acc2[1], 1e-30f); const float k = fminf(fmaxf(3.0f + 0.5f * log10f(fmaxf(e, 1e-12f)), 0.f), 4.f);
    for (size_t i = (size_t)blockIdx.x * blockDim.x + threadIdx.x; i < (size_t)M * DM; i += (size_t)gridDim.x * blockDim.x) out[i] = x[i] * (1.f + k);
}
#endif
extern "C" void kernel_launch(void* const* d_in, const int* in_sizes, int n_in, void* d_out, int out_size, void* d_ws, size_t ws_size, hipStream_t stream) {
    static int grid = 0;
    if (grid == 0) {
        if (n_in != 24 || out_size != M * DM || ws_size < WS_END) { fprintf(stderr, "kernel_launch: unexpected shapes / workspace (n_in %d out %d ws %zu)\n", n_in, out_size, ws_size); grid = -1; return; }
        int dev = 0, cus = 0, per_cu = 0;
        if (hipGetDevice(&dev) != hipSuccess || hipDeviceGetAttribute(&cus, hipDeviceAttributeMultiprocessorCount, dev) != hipSuccess) { grid = -1; return; }
        if (hipFuncSetAttribute((const void*)mk_fwd, hipFuncAttributeMaxDynamicSharedMemorySize, LDS_BYTES) != hipSuccess) { grid = -1; return; }
        if (hipOccupancyMaxActiveBlocksPerMultiprocessor(&per_cu, (const void*)mk_fwd, NWAVES * 64, LDS_BYTES) != hipSuccess || per_cu < 1) { fprintf(stderr, "occupancy query says %d\n", per_cu); }
        (void)hipGetLastError();
        grid = cus;
        if (grid != 256) { fprintf(stderr, "kernel_launch: built for a 256-CU device (got %d)\n", cus); grid = -1; return; }
    }
    if (grid < 0) return;
    (void)hipMemsetAsync((char*)d_ws + WS_CTL, 0, CTL_ZERO_BYTES, stream);
    Args a{};
    for (int i = 0; i < 24; ++i) a.in[i] = (const float*)d_in[i];
    a.out = (float*)d_out; a.ws = (unsigned char*)d_ws;
#if MK_ONE_LAUNCH
    a.ph_lo = 0; a.ph_hi = DEPTH * NPH; a.li = 0;
    hipLaunchKernelGGL(mk_fwd, dim3(grid), dim3(NWAVES * 64), LDS_BYTES, stream, a);
#else
#ifndef DBG_STAGE
#define DBG_STAGE 0
#endif
    if (DBG_STAGE == 1) { (void)hipMemcpyAsync(d_out, d_in[0], (size_t)M * DM * 4, hipMemcpyDeviceToDevice, stream); return; }
    for (int p = 0; p < DEPTH * NPH; ++p) {
        const int k = p % NPH, l = p / NPH;
        if (DBG_STAGE == 2 && p > 4) break;
#if defined(DBG_PROBE)
        if (p > 8) {
            float* acc2 = (float*)((char*)d_ws + WS_CTL + 64);
            if (DBG_PROBE == 3) hipLaunchKernelGGL(probe_swa, dim3((M / 7 + 1) * 8 / 256 + 1), dim3(256), 0, stream, (const unsigned char*)d_ws, (const float*)d_in[IN_SINKS], acc2);
            if (DBG_PROBE == 2) hipLaunchKernelGGL(probe_mla, dim3((M / 61 + 1) * 8 / 256 + 1), dim3(256), 0, stream, (const unsigned char*)d_ws, acc2);
            if (DBG_PROBE == 0) hipLaunchKernelGGL(probe_dsa, dim3(80), dim3(256), 0, stream, (const unsigned char*)d_ws, acc2);
            if (DBG_PROBE == 1) hipLaunchKernelGGL(probe_lru, dim3(16), dim3(64), 0, stream, (const unsigned char*)d_ws, (const float*)d_in[IN_CONVW], (const float*)d_in[IN_CONVB], (const float*)d_in[IN_LRUWA], (const float*)d_in[IN_LRUBA],
                                                   (const float*)d_in[IN_LRUWX], (const float*)d_in[IN_LRUBX], (const float*)d_in[IN_LRULAM], acc2);
            hipLaunchKernelGGL(probe_out, dim3(1024), dim3(256), 0, stream, (const float*)d_in[0], (float*)d_out, (const float*)acc2);
            break;
        }
#endif
        if (k == 1 && l != 0) continue;
        a.ph_lo = p; a.ph_hi = p + 1; a.li = p;
        hipLaunchKernelGGL(mk_fwd, dim3(grid), dim3(NWAVES * 64), LDS_BYTES, stream, a);
    }
#endif
}
```

```cpp
#include <hip/hip_runtime.h>
#include <cstdio>
#include <cstdint>

#ifndef DBG_FADUP
#define DBG_FADUP -1
#endif
#ifndef DBG_DUP
#define DBG_DUP -1
#endif
#ifndef MK_ONE_LAUNCH
#define MK_ONE_LAUNCH 1
#endif

#define LAS __attribute__((address_space(3)))
#define GAS __attribute__((address_space(1)))
typedef unsigned short bf16_t;
typedef short bf16x8 __attribute__((ext_vector_type(8)));
typedef float f32x4 __attribute__((ext_vector_type(4)));
typedef float f32x2 __attribute__((ext_vector_type(2)));
typedef float f32x16 __attribute__((ext_vector_type(16)));
typedef unsigned u32x4 __attribute__((ext_vector_type(4)));
typedef unsigned u32x2 __attribute__((ext_vector_type(2)));

constexpr int BATCH = 2, SEQ = 8192, DM = 1024, DEPTH = 2, M = BATCH * SEQ;
constexpr int DFF = 2816, ZP = 3584, NG = 4096;
constexpr float EPS = 1e-6f;
constexpr float LOG2E = 1.4426950408889634f;
constexpr int ZC_AQ = 0, ZC_AK = 512, ZC_AV = 640, ZC_DQ = 768, ZC_DK = 1280, ZC_DV = 1408, ZC_RX = 1536, ZC_RG = 2048, ZC_IQ = 2560, ZC_IK = 3072, ZC_IW = 3136, ZC_CQ = 3168, ZC_CKV = 3424;

constexpr size_t MiB = 1u << 20;
constexpr size_t WS_CTL = 0, CTL_ZERO_BYTES = 65536;
constexpr size_t WS_MOD = 1 * MiB;
constexpr size_t WS_ROPE = 2 * MiB;
constexpr size_t WS_LRUS = 3 * MiB;
constexpr size_t WS_KROPE = 4 * MiB;
constexpr size_t WS_RS = 5 * MiB;
constexpr size_t WS_W = 8 * MiB;
constexpr size_t W_W1 = 0, W_W2 = 11534336, W_IN = 17301504, W_G = 24641536, W_UQ = 33030144, W_UKV = 33423360, W_BR = 33685504, W_O = 37879808;
constexpr size_t WS_R1 = 48 * MiB;
constexpr size_t WS_YB = 184 * MiB;
constexpr size_t WS_XN = 248 * MiB;
constexpr size_t WS_R2 = 280 * MiB;
constexpr size_t WS_END = 340 * MiB;
constexpr int CW_TMO = 0, CW_BAR = 4096;

constexpr int RING_BYTES = 131072, EXTRA_OFF = 131072, EXTRA_BYTES = 24576, LDSCTL_OFF = EXTRA_OFF + EXTRA_BYTES, LDS_BYTES = LDSCTL_OFF + 512;
constexpr int NWAVES = 8;

#define RLX_AGENT __ATOMIC_RELAXED, __HIP_MEMORY_SCOPE_AGENT
#define LDS_WAIT() asm volatile("s_waitcnt lgkmcnt(0)" ::: "memory")
#define VM_WAIT() asm volatile("s_waitcnt vmcnt(0)" ::: "memory")
__device__ __forceinline__ unsigned f2bf(float f) { unsigned u = __builtin_bit_cast(unsigned, f); return (u + 0x7fffu + ((u >> 16) & 1u)) >> 16; }
__device__ __forceinline__ unsigned pk2(float lo, float hi) { return f2bf(lo) | (f2bf(hi) << 16); }
__device__ __forceinline__ float bf_lo(unsigned w) { return __builtin_bit_cast(float, w << 16); }
__device__ __forceinline__ float bf_hi(unsigned w) { return __builtin_bit_cast(float, w & 0xffff0000u); }
__device__ __forceinline__ float bf2f(bf16_t b) { return __builtin_bit_cast(float, (unsigned)b << 16); }
typedef float cvt_f32x2 __attribute__((ext_vector_type(2)));
typedef __bf16 cvt_bf16x2 __attribute__((ext_vector_type(2)));
__device__ __forceinline__ unsigned cvt_pk_bf16(float lo, float hi) { return __builtin_bit_cast(unsigned, __builtin_convertvector(((cvt_f32x2){lo, hi}), cvt_bf16x2)); }
__device__ __forceinline__ float wave_sum(float v) {
#pragma unroll
    for (int o = 1; o < 64; o <<= 1) v += __shfl_xor(v, o);
    return v;
}
__device__ __forceinline__ float fast_sigmoid(float x) { return __builtin_amdgcn_rcpf(1.0f + __builtin_amdgcn_exp2f(-x * LOG2E)); }

#define XB_TMO      128
#define XB_XCNT(j)  (256  + 64 * (j))
#define XB_XSUB(j)  (1280 + 64 * (j))
#define XB_XGEN(j)  (2304 + 64 * (j))
#define XB_TOP      3328
#define XB_TOPGEN   3392
#define XCD_BAR_WORDS 3456
#define XB_SPIN_CAP (1u << 18)
__device__ __forceinline__ unsigned xb_ld(unsigned* p)              { return __hip_atomic_load(p, __ATOMIC_RELAXED, __HIP_MEMORY_SCOPE_AGENT); }
__device__ __forceinline__ unsigned xb_add(unsigned* p, unsigned v) { return __hip_atomic_fetch_add(p, v, __ATOMIC_RELAXED, __HIP_MEMORY_SCOPE_AGENT); }
__device__ __forceinline__ unsigned xb_xcc_id() { return (unsigned)__builtin_amdgcn_s_getreg((3 << 11) | 20) & 0xFu; }
#define XB_SPIN(cond, bar) do { unsigned _sp = 0; while (cond) { __builtin_amdgcn_s_sleep(1); \
    if ((++_sp & 255u) == 0u) { if (xb_ld(&(bar)[XB_TMO])) break; if (_sp > XB_SPIN_CAP) { atomicAdd(&(bar)[XB_TMO], 1u); break; } } } } while (0)
struct XcdBarrier { unsigned* bar; unsigned x; volatile LAS unsigned* st; };
__device__ __forceinline__ XcdBarrier xcd_barrier_post(unsigned* bar, volatile LAS unsigned* st) {
    XcdBarrier b; b.bar = bar; b.x = xb_xcc_id(); b.st = st;
    if (threadIdx.x == 0) (void)xb_add(&bar[XB_XCNT(b.x)], 1u);
    return b;
}
__device__ __forceinline__ void xcd_barrier_complete(unsigned* bar, unsigned x, unsigned& nloc, unsigned& nx) {
    const unsigned G = gridDim.x * gridDim.y * gridDim.z;
    unsigned sum, cnt, mine, sp = 0u;
    for (;;) {
        sum = 0u; cnt = 0u; mine = 0u;
#pragma unroll
        for (unsigned j = 0; j < 16; ++j) { const unsigned c = xb_ld(&bar[XB_XCNT(j)]); sum += c; cnt += (c > 0u) ? 1u : 0u; mine = (j == x) ? c : mine; }
        if (sum == G) break;
        __builtin_amdgcn_s_sleep(1);
        if ((++sp & 255u) == 0u) { if (xb_ld(&bar[XB_TMO])) break; if (sp > XB_SPIN_CAP) { atomicAdd(&bar[XB_TMO], 1u); break; } }
    }
    nloc = mine > 0u ? mine : 1u; nx = cnt > 0u ? cnt : 1u;
}
__device__ __forceinline__ void xcd_barrier(const XcdBarrier& b) {
    asm volatile("s_waitcnt vmcnt(0)" ::: "memory");
    __syncthreads();
    if (threadIdx.x == 0) {
        unsigned* bar = b.bar;
        __builtin_amdgcn_s_waitcnt(0);
        unsigned nloc = b.st[0], nx = b.st[1];
        if (nloc == 0u) { xcd_barrier_complete(bar, b.x, nloc, nx); b.st[0] = nloc; b.st[1] = nx; }
        const unsigned old = xb_add(&bar[XB_XSUB(b.x)], 1u);
        const unsigned gen = old / nloc;
        if (old + 1u == (gen + 1u) * nloc) {
            __builtin_amdgcn_fence(__ATOMIC_RELEASE, "agent");
            asm volatile("s_waitcnt vmcnt(0)" ::: "memory");
            const unsigned og = xb_add(&bar[XB_TOP], 1u);
            const unsigned tg = og / nx;
            if (og + 1u == (tg + 1u) * nx) xb_add(&bar[XB_TOPGEN], 1u);
            else XB_SPIN(xb_ld(&bar[XB_TOPGEN]) == tg, bar);
            __builtin_amdgcn_fence(__ATOMIC_ACQUIRE, "agent");
            xb_add(&bar[XB_XGEN(b.x)], 1u);
            asm volatile("s_waitcnt vmcnt(0)" ::: "memory");
        } else {
            XB_SPIN(xb_ld(&bar[XB_XGEN(b.x)]) == gen, bar);
            __builtin_amdgcn_fence(__ATOMIC_ACQUIRE, "agent");
            asm volatile("s_waitcnt vmcnt(0)" ::: "memory");
        }
    }
    __syncthreads();
}

namespace pg8 {
constexpr int BM = 256, BK = 64, HALF = 128, HTB = HALF * BK * 2, STAGE_BYTES = 8 * HTB, NXCD = 8, WGM = 8;
__host__ __device__ __forceinline__ int lds_byte(int r, int c) { const int st = (r >> 4) * 2 + (c >> 5), rr = r & 15, cc = c & 31, ob = rr * 64 + cc * 2; return st * 1024 + (ob ^ (((ob >> 9) & 1) << 5)); }
__host__ __device__ __forceinline__ void stage_rc(int b, int& R, int& C) { const int st = b / 1024, sb = b % 1024, swz = sb ^ (((sb >> 9) & 1) << 5); R = (st >> 1) * 16 + swz / 64; C = (st & 1) * 32 + (swz % 64) / 2; }
__host__ __device__ __forceinline__ int perm32(int rho) { const int n = rho >> 4, i = rho & 15; return 8 * (i >> 2) + 4 * n + (i & 3); }

struct Unit { int pm, pn, ka, kb, sub; };
struct Gemm { const bf16_t* A; const bf16_t* Bt; int lda, ldb, K; };

struct StaticOrder {
    int nM, nN, nwg, G, c;
    __device__ void init(int M_, int N_, int G_, int c_) { nM = M_ / BM; nN = N_ / BM; nwg = nM * nN; G = G_; c = c_; }
    __device__ bool tile(int i, Unit& u) const {
        const long L = (long)i * G + c; if (L >= nwg) return false;
        int wgid = (int)L; { const int q = nwg / NXCD, r = nwg % NXCD, xcd = wgid % NXCD, off = wgid / NXCD; wgid = (xcd < r ? xcd * (q + 1) : r * (q + 1) + (xcd - r) * q) + off; }
        const int nig = WGM * nN, gid = wgid / nig, fm = gid * WGM, gsz = (nM - fm) < WGM ? (nM - fm) : WGM;
        u.pm = fm + ((wgid % nig) % gsz); u.pn = (wgid % nig) / gsz; return true;
    }
    __device__ bool next(int i, Unit& u) const { u.ka = 0; u.kb = 0; u.sub = 0; return tile(i, u); }
};
struct ChainOrder {
    StaticOrder so;
    __device__ bool next(int i, Unit& u) const { const int s = i & 3; u.ka = 512 * s; u.kb = 512 * s; u.sub = s; return so.tile(i >> 2, u); }
};

template <int ACT  > struct EpiBf16 {
    static constexpr bool PERM = true, CHAIN = false;
    bf16_t* O; int ldc;
    __device__ __forceinline__ void operator()(f32x4 (&acc)[2][2][4][2], const Unit& u, int wr, int wc, int fr, int fq) const {
        const int row0 = u.pm * BM + wr * 64 + fr, col0 = u.pn * BM + wc * 32 + 8 * fq;
#pragma unroll
        for (int ai = 0; ai < 2; ++ai)
#pragma unroll
            for (int m = 0; m < 4; ++m) { bf16_t* rowp = O + (size_t)(row0 + ai * HALF + m * 16) * ldc + col0;
#pragma unroll
                for (int bj = 0; bj < 2; ++bj) { f32x4 v0 = acc[ai][bj][m][0], v1 = acc[ai][bj][m][1];
                    if (ACT == 2) {
#pragma unroll
                        for (int e = 0; e < 4; ++e) { v0[e] = __builtin_fmaxf(fast_sigmoid(v0[e]), 1e-30f); v1[e] = __builtin_fmaxf(fast_sigmoid(v1[e]), 1e-30f); } }
                    u32x4 w; w.x = cvt_pk_bf16(v0[0], v0[1]); w.y = cvt_pk_bf16(v0[2], v0[3]); w.z = cvt_pk_bf16(v1[0], v1[1]); w.w = cvt_pk_bf16(v1[2], v1[3]);
                    *(u32x4*)(rowp + bj * HALF) = w; } }
    }
};
struct EpiSwiglu {
    static constexpr bool PERM = true, CHAIN = false;
    bf16_t* O; int ldc;
    __device__ __forceinline__ void operator()(f32x4 (&acc)[2][2][4][2], const Unit& u, int wr, int wc, int fr, int fq) const {
        const int row0 = u.pm * BM + wr * 64 + fr, col0 = u.pn * HALF + wc * 32 + 8 * fq;
#pragma unroll
        for (int ai = 0; ai < 2; ++ai)
#pragma unroll
            for (int m = 0; m < 4; ++m) { bf16_t* rowp = O + (size_t)(row0 + ai * HALF + m * 16) * ldc + col0;
                float h[8];
#pragma unroll
                for (int n = 0; n < 2; ++n)
#pragma unroll
                    for (int e = 0; e < 4; ++e) { const float g = acc[ai][0][m][n][e], up = acc[ai][1][m][n][e]; h[4 * n + e] = g * fast_sigmoid(g) * up; }
                u32x4 w; w.x = cvt_pk_bf16(h[0], h[1]); w.y = cvt_pk_bf16(h[2], h[3]); w.z = cvt_pk_bf16(h[4], h[5]); w.w = cvt_pk_bf16(h[6], h[7]);
                *(u32x4*)rowp = w; }
    }
};

struct EpiMlaQ {
    static constexpr bool PERM = true, CHAIN = false;
    bf16_t* O; int ldc; const f32x2* rt;
    __device__ __forceinline__ void operator()(f32x4 (&acc)[2][2][4][2], const Unit& u, int wr, int wc, int fr, int fq) const {
        const int row0 = u.pm * BM + wr * 64 + fr, col0 = u.pn * BM + wc * 32 + 8 * fq;
#pragma unroll
        for (int ai = 0; ai < 2; ++ai)
#pragma unroll
            for (int m = 0; m < 4; ++m) { const int row = row0 + ai * HALF + m * 16; bf16_t* rowp = O + (size_t)row * ldc + col0;
#pragma unroll
                for (int bj = 0; bj < 2; ++bj) { const int c = col0 + bj * HALF; const int hc = c % 96;
                    float v[8];
#pragma unroll
                    for (int e = 0; e < 4; ++e) { v[e] = acc[ai][bj][m][0][e]; v[4 + e] = acc[ai][bj][m][1][e]; }
                    if (hc >= 64) { const f32x2* t = rt + (size_t)(row & (SEQ - 1)) * 16 + ((hc - 64) >> 1);
#pragma unroll
                        for (int pp = 0; pp < 4; ++pp) { const f32x2 cs = t[pp]; const float x1 = v[2 * pp], x2 = v[2 * pp + 1]; v[2 * pp] = x1 * cs.x - x2 * cs.y; v[2 * pp + 1] = x2 * cs.x + x1 * cs.y; } }
                    u32x4 w; w.x = cvt_pk_bf16(v[0], v[1]); w.y = cvt_pk_bf16(v[2], v[3]); w.z = cvt_pk_bf16(v[4], v[5]); w.w = cvt_pk_bf16(v[6], v[7]);
                    *(u32x4*)(rowp + bj * HALF) = w; }
                asm volatile("" ::: "memory"); }
    }
};
struct EpiRowScale {
    static constexpr bool PERM = true, CHAIN = false;
    bf16_t* O; int ldc; const float* rs;
    __device__ __forceinline__ void operator()(f32x4 (&acc)[2][2][4][2], const Unit& u, int wr, int wc, int fr, int fq) const {
        const int row0 = u.pm * BM + wr * 64 + fr, col0 = u.pn * BM + wc * 32 + 8 * fq;
#pragma unroll
        for (int ai = 0; ai < 2; ++ai)
#pragma unroll
            for (int m = 0; m < 4; ++m) { const int row = row0 + ai * HALF + m * 16; const float sc = rs[row]; bf16_t* rowp = O + (size_t)row * ldc + col0;
#pragma unroll
                for (int bj = 0; bj < 2; ++bj) { const f32x4 v0 = acc[ai][bj][m][0] * sc, v1 = acc[ai][bj][m][1] * sc;
                    u32x4 w; w.x = cvt_pk_bf16(v0[0], v0[1]); w.y = cvt_pk_bf16(v0[2], v0[3]); w.z = cvt_pk_bf16(v1[0], v1[1]); w.w = cvt_pk_bf16(v1[2], v1[3]);
                    *(u32x4*)(rowp + bj * HALF) = w; } }
    }
};
struct EpiGateMerge {
    static constexpr bool PERM = true, CHAIN = true;
    const bf16_t* G; bf16_t* O; int ldc;
    __device__ __forceinline__ void operator()(f32x4 (&acc)[2][2][4][2], const Unit& u, int wr, int wc, int fr, int fq) const {
        const int row0 = u.pm * BM + wr * 64 + fr, col0 = u.pn * BM + wc * 32 + 8 * fq; const int s = u.sub;
#pragma unroll
        for (int ai = 0; ai < 2; ++ai) {
            u32x4 ga[4][2], gb[4][2];
            const GAS bf16_t* gp0 = (const GAS bf16_t*)G + (size_t)(row0 + ai * HALF) * NG + 1024 * s + col0; asm volatile("" : "+v"(gp0));
#pragma unroll
            for (int m = 0; m < 4; ++m)
#pragma unroll
                for (int bj = 0; bj < 2; ++bj) { ga[m][bj] = *(const GAS u32x4*)(gp0 + (size_t)(m * 16) * NG + bj * HALF); gb[m][bj] = ga[m][bj]; }
            if (s < 3) {
#pragma unroll
                for (int m = 0; m < 4; ++m)
#pragma unroll
                    for (int bj = 0; bj < 2; ++bj) gb[m][bj] = *(const GAS u32x4*)(gp0 + (size_t)(m * 16) * NG + 1024 + bj * HALF); }
#pragma unroll
            for (int m = 0; m < 4; ++m) { const int row = row0 + ai * HALF + m * 16;
#pragma unroll
                for (int bj = 0; bj < 2; ++bj) {
                    const u32x4 gA = ga[m][bj];
                    float f[8] = {bf_lo(gA.x), bf_hi(gA.x), bf_lo(gA.y), bf_hi(gA.y), bf_lo(gA.z), bf_hi(gA.z), bf_lo(gA.w), bf_hi(gA.w)};
                    if (s < 3) { const u32x4 gB = gb[m][bj];
                        const float d[8] = {bf_lo(gB.x), bf_hi(gB.x), bf_lo(gB.y), bf_hi(gB.y), bf_lo(gB.z), bf_hi(gB.z), bf_lo(gB.w), bf_hi(gB.w)};
#pragma unroll
                        for (int e = 0; e < 8; ++e) f[e] = f[e] * __builtin_amdgcn_rcpf(d[e]); }
#pragma unroll
                    for (int e = 0; e < 4; ++e) { acc[ai][bj][m][0][e] *= f[e]; acc[ai][bj][m][1][e] *= f[4 + e]; }
                    if (s == 3) { const f32x4 v0 = acc[ai][bj][m][0], v1 = acc[ai][bj][m][1];
                        u32x4 w; w.x = cvt_pk_bf16(v0[0], v0[1]); w.y = cvt_pk_bf16(v0[2], v0[3]); w.z = cvt_pk_bf16(v1[0], v1[1]); w.w = cvt_pk_bf16(v1[2], v1[3]);
                        *(u32x4*)(O + (size_t)row * ldc + col0 + bj * HALF) = w; } } } }
    }
};

template <class Epi, class Sched, bool ALIGN_EPI>
__device__ __forceinline__ void gemm_phase(LAS unsigned char* lds, const int tid, const Gemm g, const Sched& S, const Epi& E) {
    const int wid = __builtin_amdgcn_readfirstlane(tid >> 6), lane = tid & 63, wr = wid >> 2, wc = wid & 3, fr = lane & 15, fq = lane >> 4;
    const int nt = g.K / BK;
    unsigned voffA[2], voffB[2];
#pragma unroll
    for (int i = 0; i < 2; ++i) { int R, C; stage_rc(tid * 16 + i * 8192, R, C); const int Rb = Epi::PERM ? ((R & ~31) + perm32(R & 31)) : R;
        voffA[i] = (unsigned)(R * g.lda + C) * 2u; voffB[i] = (unsigned)(Rb * g.ldb + C) * 2u; }
    const size_t kstep = (size_t)(BK * 2);
    const size_t hstepA = (size_t)HALF * g.lda * 2, hstepB = (size_t)HALF * g.ldb * 2;
    const unsigned ldsw = (unsigned)wid * 1024u;
    const int aoff = lds_byte(wr * 64 + fr, fq * 8), boff = lds_byte(wc * 32 + fr, fq * 8);
#define PG8_SA(b, h) (((b) * 2 + (h)) * HTB)
#define PG8_SB(b, h) ((4 + (b) * 2 + (h)) * HTB)
#define PG8_STAGE(bufoff, gbase, voff) do { _Pragma("unroll") for (int _i = 0; _i < 2; ++_i) \
        __builtin_amdgcn_global_load_lds((const unsigned*)((const char*)(gbase) + (voff)[_i]), (LAS unsigned*)(lds + (bufoff) + ldsw + _i * 8192), 16, 0, 0); } while (0)
#define PG8_LDA(dst, b, h) do { _Pragma("unroll") for (int m = 0; m < 4; ++m) _Pragma("unroll") for (int k = 0; k < 2; ++k) dst[m][k] = *(const LAS bf16x8*)(lds + PG8_SA(b, h) + aoff + m * 2048 + k * 1024); } while (0)
#define PG8_LDB(dst, b, h) do { _Pragma("unroll") for (int n = 0; n < 2; ++n) _Pragma("unroll") for (int k = 0; k < 2; ++k) dst[n][k] = *(const LAS bf16x8*)(lds + PG8_SB(b, h) + boff + n * 2048 + k * 1024); } while (0)
#define PG8_MMA(ai, bj, At, Bt) do { __builtin_amdgcn_s_setprio(1); _Pragma("unroll") for (int m = 0; m < 4; ++m) _Pragma("unroll") for (int n = 0; n < 2; ++n) _Pragma("unroll") for (int k = 0; k < 2; ++k) \
        acc[ai][bj][m][n] = __builtin_amdgcn_mfma_f32_16x16x32_bf16(Bt[n][k], At[m][k], acc[ai][bj][m][n], 0, 0, 0); __builtin_amdgcn_s_setprio(0); } while (0)
#define PG8_WAIT_V(n) asm volatile("s_waitcnt vmcnt(" #n ")" ::: "memory")
#define PG8_WAIT_L(n) asm volatile("s_waitcnt lgkmcnt(" #n ")" ::: "memory")
#define PG8_BAR __builtin_amdgcn_s_barrier()
#define PG8_SCHED __builtin_amdgcn_sched_barrier(0)
#define PG8_UA(u) ((const char*)g.A + (size_t)(u).pm * 2 * hstepA + (size_t)(u).ka * 2)
#define PG8_UB(u) ((const char*)g.Bt + (size_t)(u).pn * 2 * hstepB + (size_t)(u).kb * 2)
    Unit cur, nxt; int ui = 0;
    if (!S.next(0, cur)) return;
    f32x4 acc[2][2][4][2];
#pragma unroll
    for (int a = 0; a < 2; ++a)
#pragma unroll
        for (int b = 0; b < 2; ++b)
#pragma unroll
            for (int m = 0; m < 4; ++m)
#pragma unroll
                for (int n = 0; n < 2; ++n) acc[a][b][m][n] = (f32x4){0.f, 0.f, 0.f, 0.f};
    bf16x8 At[4][2], B0[2][2], B1[2][2];
    const char* cA = PG8_UA(cur); const char* cB = PG8_UB(cur);
    PG8_STAGE(PG8_SB(0, 0), cB, voffB); PG8_STAGE(PG8_SB(0, 1), cB + hstepB, voffB); PG8_STAGE(PG8_SA(0, 0), cA, voffA); PG8_STAGE(PG8_SA(0, 1), cA + hstepA, voffA);
    if (wr == 1) PG8_BAR;
    PG8_WAIT_V(2); PG8_BAR;
    PG8_STAGE(PG8_SB(1, 0), cB + kstep, voffB); PG8_STAGE(PG8_SA(1, 0), cA + kstep, voffA); PG8_STAGE(PG8_SB(1, 1), cB + hstepB + kstep, voffB);
    PG8_WAIT_V(6); PG8_BAR;
    for (;;) {
        const bool has_next = S.next(ui + 1, nxt);
        const char* nA = has_next ? PG8_UA(nxt) : cA; const char* nB = has_next ? PG8_UB(nxt) : cB;
        for (int t = 0; t < nt; t += 2) {
            const bool last = (t == nt - 2);
            const char* a1 = cA + (size_t)(t + 1) * kstep;
            const char* a2 = last ? nA : cA + (size_t)(t + 2) * kstep; const char* b2 = last ? nB : cB + (size_t)(t + 2) * kstep;
            const char* a3 = a2 + kstep; const char* b3 = b2 + kstep;
            PG8_LDB(B0, 0, 0); PG8_LDB(B1, 0, 1); PG8_SCHED; PG8_LDA(At, 0, 0); PG8_STAGE(PG8_SA(1, 1), a1 + hstepA, voffA);
            PG8_WAIT_V(8); PG8_WAIT_L(0); PG8_BAR; PG8_MMA(0, 0, At, B0); PG8_MMA(0, 1, At, B1); PG8_BAR; PG8_SCHED;
            PG8_LDA(At, 0, 1); PG8_STAGE(PG8_SB(0, 0), b2, voffB); PG8_STAGE(PG8_SB(0, 1), b2 + hstepB, voffB); PG8_STAGE(PG8_SA(0, 0), a2, voffA);
            PG8_WAIT_V(8); PG8_WAIT_L(0); PG8_BAR; PG8_MMA(1, 0, At, B0); PG8_MMA(1, 1, At, B1); PG8_BAR; PG8_SCHED;
            PG8_LDB(B0, 1, 0); PG8_LDB(B1, 1, 1); PG8_SCHED; PG8_LDA(At, 1, 0); PG8_STAGE(PG8_SA(0, 1), a2 + hstepA, voffA);
            PG8_WAIT_V(8); PG8_WAIT_L(0); PG8_BAR; PG8_MMA(0, 0, At, B0); PG8_MMA(0, 1, At, B1); PG8_BAR; PG8_SCHED;
            PG8_LDA(At, 1, 1); PG8_STAGE(PG8_SB(1, 0), b3, voffB); PG8_STAGE(PG8_SB(1, 1), b3 + hstepB, voffB); PG8_STAGE(PG8_SA(1, 0), a3, voffA);
            PG8_WAIT_V(8); PG8_WAIT_L(0); PG8_BAR; PG8_MMA(1, 0, At, B0); PG8_MMA(1, 1, At, B1); PG8_BAR; PG8_SCHED;
        }
        if constexpr (ALIGN_EPI) { if (wr == 0) PG8_BAR; }
        { int fr_ = fr, fq_ = fq; asm volatile("" : "+v"(fr_), "+v"(fq_));
          E(acc, cur, wr, wc, fr_, fq_); }
        if (!has_next) break;
        if (!(Epi::CHAIN && cur.sub != 3)) {
#pragma unroll
            for (int a = 0; a < 2; ++a)
#pragma unroll
                for (int b = 0; b < 2; ++b)
#pragma unroll
                    for (int m = 0; m < 4; ++m)
#pragma unroll
                        for (int n = 0; n < 2; ++n) acc[a][b][m][n] = (f32x4){0.f, 0.f, 0.f, 0.f};
        }
        cur = nxt; cA = nA; cB = nB; ++ui;
        if constexpr (ALIGN_EPI) { if (wr == 1) PG8_BAR; }
    }
    PG8_WAIT_V(0);
    if constexpr (!ALIGN_EPI) { if (wr == 0) PG8_BAR; }
    PG8_BAR;
#undef PG8_SA
#undef PG8_SB
#undef PG8_STAGE
#undef PG8_LDA
#undef PG8_LDB
#undef PG8_MMA
#undef PG8_WAIT_V
#undef PG8_WAIT_L
#undef PG8_BAR
#undef PG8_SCHED
#undef PG8_UA
#undef PG8_UB
}
}

struct Args { const float* in[24]; float* out; unsigned char* ws; int ph_lo, ph_hi, li, pad; };
struct Frame {
    LAS unsigned char* lds;
    int tid, lane, wave, vcu, G;
    const Args* a;
    int zz;
    __device__ __forceinline__ const float* in(int i) const { return (const float*)(const GAS float*)karg(8 * i); }
    __device__ __forceinline__ unsigned long long karg(int byte_off) const { unsigned long long p; asm volatile("s_load_dwordx2 %0, %1, %2\n\ts_waitcnt lgkmcnt(0)" : "=s"(p) : "s"(__builtin_amdgcn_kernarg_segment_ptr()), "s"(byte_off)); return p; }
    __device__ __forceinline__ unsigned char* wsp(size_t off = 0) const { return (unsigned char*)((GAS unsigned char*)karg(25 * 8) + off); }
    __device__ __forceinline__ float* outp() const { return (float*)(GAS float*)karg(24 * 8); }
};
#define IN_X 0
#define IN_C 1
#define IN_WADA 2
#define IN_BADA 3
#define IN_NORMG 4
#define IN_F1IN 5
#define IN_F1OUT 6
#define IN_WIN 7
#define IN_CONVW 8
#define IN_CONVB 9
#define IN_LRUWA 10
#define IN_LRUBA 11
#define IN_LRUWX 12
#define IN_LRUBX 13
#define IN_LRULAM 14
#define IN_GQ 15
#define IN_GKV 16
#define IN_WUQ 17
#define IN_WUKV 18
#define IN_SINKS 19
#define IN_WBR 20
#define IN_WOUT 21
#define IN_F2IN 22
#define IN_F2OUT 23

struct CvtSeg { const float* src; int ldn, col0, ncols, K; bf16_t* dst; int ldk, koff, drow0, mode; float scale; const float* kgain; };
__device__ __forceinline__ int cvt_row(const CvtSeg& s, int n) {
    if (s.mode == 1) { const int half = n >= DFF ? 1 : 0, j = n - DFF * half; return 256 * (j >> 7) + 128 * half + (j & 127); }
    if (s.mode == 2) { const int h = n / 96, c = n - 96 * h; return 96 * h + (c < 64 ? c : (c < 80 ? 64 + 2 * (c - 64) : 64 + 2 * (c - 80) + 1)); }
    return s.drow0 + n;
}
__device__ __forceinline__ void cvt_load(const CvtSeg& s, int item, int lane, f32x4 (&v)[16]) {
    const int nblk = (s.ncols + 63) >> 6, kb = item / nblk, nb = item - kb * nblk, k0 = 64 * kb, n0 = 64 * nb;
    const int nl = n0 + 4 * (lane & 15); const bool okc = nl < s.ncols;
    const GAS float* sp = (const GAS float*)s.src + (size_t)(k0 + (lane >> 4)) * s.ldn + s.col0 + (okc ? nl : 0); const size_t step = (size_t)4 * s.ldn;
#pragma unroll
    for (int i = 0; i < 16; ++i) { v[i] = *(const GAS f32x4*)sp; sp += step; asm volatile("" : "+v"(sp)); }
}
__device__ __forceinline__ void cvt_finish(const CvtSeg& s, LAS float* scr, int item, int lane, f32x4 (&v)[16]) {
    const int nblk = (s.ncols + 63) >> 6, kb = item / nblk, nb = item - kb * nblk, k0 = 64 * kb, n0 = 64 * nb;
    const int nl = n0 + 4 * (lane & 15); const bool okc = nl < s.ncols;
    const float sc_ = okc ? s.scale : 0.0f;
#pragma unroll
    for (int i = 0; i < 16; ++i) { const int kk = 4 * i + (lane >> 4);
        v[i] *= sc_; if (s.kgain) v[i] *= s.kgain[k0 + kk];
        LAS float* p = scr + kk * 65 + 4 * (lane & 15); p[0] = v[i].x; p[1] = v[i].y; p[2] = v[i].z; p[3] = v[i].w; }
    LDS_WAIT(); asm volatile("" ::: "memory");
    const int c = lane & 7;
#pragma unroll
    for (int j = 0; j < 8; ++j) { const int n = (lane >> 3) + 8 * j; const LAS float* p = scr + (8 * c) * 65 + n;
        u32x4 o; o.x = pk2(p[0 * 65], p[1 * 65]); o.y = pk2(p[2 * 65], p[3 * 65]); o.z = pk2(p[4 * 65], p[5 * 65]); o.w = pk2(p[6 * 65], p[7 * 65]);
        if (n0 + n < s.ncols) *(u32x4*)(s.dst + (size_t)cvt_row(s, n0 + n) * s.ldk + s.koff + k0 + 8 * c) = o; }
    LDS_WAIT(); asm volatile("" ::: "memory");
}
constexpr int NSEG_A = 24, NSEG_B = 2;
__device__ const int SEG_C0[15] = {0, 512, 640, 768, 1280, 1344, 1352, 1864, 2376, 2632, 2792, 3304, 3432, 3560, 0};
__device__ const int SEG_NC[15] = {512, 128, 128, 512, 64, 8, 512, 512, 256, 160, 512, 128, 128, 4096, 24};
__device__ const int SEG_DR[15] = {ZC_AQ, ZC_AK, ZC_AV, ZC_IQ, ZC_IK, ZC_IW, ZC_RX, ZC_RG, ZC_CQ, ZC_CKV, ZC_DQ, ZC_DK, ZC_DV, 0, ZC_IW + 8};
__device__ __forceinline__ void get_seg(const Frame& F, int l, int set, int si, CvtSeg& s) {
    bf16_t* W = (bf16_t*)(F.wsp(WS_W));
    s.kgain = nullptr; s.scale = 1.f; s.mode = 0; s.koff = 0; s.drow0 = 0; s.col0 = 0;
    if (si < 2) {
        const float* win_ = set ? F.in(IN_F2IN) : F.in(IN_F1IN); const float* wout_ = set ? F.in(IN_F2OUT) : F.in(IN_F1OUT);
        if (si == 0) { s.src = win_ + (size_t)l * DM * 2 * DFF; s.ldn = 2 * DFF; s.ncols = 2 * DFF; s.K = DM; s.dst = W + W_W1 / 2; s.ldk = DM; s.mode = 1; }
        else { s.src = wout_ + (size_t)l * DFF * DM; s.ldn = DM; s.ncols = DM; s.K = DFF; s.dst = W + W_W2 / 2; s.ldk = DFF; }
        return;
    }
    const float QS = 0.125f * LOG2E;
    int k = si - 2;
    if (k < 15) {
        s.src = F.in(IN_WIN) + (size_t)l * DM * 7656; s.ldn = 7656; s.col0 = SEG_C0[k];        s.ncols = SEG_NC[k]; s.K = DM; s.ldk = DM; s.drow0 = SEG_DR[k];
        s.dst = (k == 13) ? (W + W_G / 2) : (W + W_IN / 2);
        if (k == 0 || k == 10) s.scale = QS;
        if (k == 14) s.scale = 0.0f;
        return;
    }
    k -= 15;
    if (k == 0) { s.src = F.in(IN_WUQ) + (size_t)l * 256 * 768; s.ldn = 768; s.ncols = 768; s.K = 256; s.dst = W + W_UQ / 2; s.ldk = 256; s.mode = 2; s.scale = 0.10206207261596575f * LOG2E; s.kgain = F.in(IN_GQ) + l * 256; return; }
    if (k == 1) { s.src = F.in(IN_WUKV) + (size_t)l * 128 * 1024; s.ldn = 1024; s.ncols = 1024; s.K = 128; s.dst = W + W_UKV / 2; s.ldk = 128; s.kgain = F.in(IN_GKV) + l * 128; return; }
    if (k < 6) { const int n = k - 2; s.src = F.in(IN_WBR) + ((size_t)l * 4 + n) * 512 * 1024; s.ldn = 1024; s.ncols = 1024; s.K = 512; s.dst = W + W_BR / 2; s.ldk = 2048; s.koff = 512 * n; return; }
    s.src = F.in(IN_WOUT) + (size_t)l * DM * DM; s.ldn = DM; s.ncols = DM; s.K = DM; s.dst = W + W_O / 2; s.ldk = DM;
}
__device__ __forceinline__ void convert_weights(const Frame& F, int l, int set, int si0, int si1, int gw, int NGW) {
    LAS float* scr = (LAS float*)(F.lds + F.wave * 16896);
    int base = 0;
#ifdef DBG_CVTDUP
    for (int rep4_ = 0; rep4_ < 2; ++rep4_) { base = 0;
#endif
    for (int si = si0; si < si1; ++si) {
        CvtSeg s; get_seg(F, l, set, si, s);
        const int nit = (s.K >> 6) * ((s.ncols + 63) >> 6);
        int it = (gw - base % NGW + NGW) % NGW;
        for (; it < nit; it += 2 * NGW) {
            f32x4 va[16], vb[16]; const bool hb = it + NGW < nit;
            cvt_load(s, it, F.lane, va); if (hb) cvt_load(s, it + NGW, F.lane, vb);
            cvt_finish(s, scr, it, F.lane, va); if (hb) cvt_finish(s, scr, it + NGW, F.lane, vb); }
        base += nit;
    }
#ifdef DBG_CVTDUP
    }
#endif
}

__device__ __forceinline__ void mod_unit(const Frame& F, int unit) {
    const int l = unit / 72, cb = unit % 72, ks = F.tid >> 5, cg = F.tid & 31;
    const float* wa = F.in(IN_WADA) + (size_t)l * DM * 9216 + 128 * cb + 4 * cg;
    const float* c0 = F.in(IN_C); const float* c1 = c0 + DM;
    f32x4 a0 = {0.f, 0.f, 0.f, 0.f}, a1 = {0.f, 0.f, 0.f, 0.f};
    const GAS float* wp = (const GAS float*)wa + (size_t)(64 * ks) * 9216;
    for (int kb = 64 * ks; kb < 64 * ks + 64; kb += 16) {
        f32x4 w[16];
#pragma unroll
        for (int i = 0; i < 16; ++i) { w[i] = *(const GAS f32x4*)wp; wp += 9216; asm volatile("" : "+v"(wp)); }
#pragma unroll
        for (int i = 0; i < 16; ++i) { const float x0 = c0[kb + i], x1 = c1[kb + i];
            const float s0 = x0 / (1.f + __expf(-x0)), s1 = x1 / (1.f + __expf(-x1));
            a0 += w[i] * s0; a1 += w[i] * s1; }
    }
    LAS f32x4* red = (LAS f32x4*)F.lds;
    red[(ks * 32 + cg) * 2 + 0] = a0; red[(ks * 32 + cg) * 2 + 1] = a1;
    __syncthreads();
    if (F.tid < 64) { const int g2 = F.tid >> 1, b = F.tid & 1; f32x4 s = {0.f, 0.f, 0.f, 0.f};
#pragma unroll
        for (int q = 0; q < 16; ++q) s += red[(q * 32 + g2) * 2 + b];
        const f32x4 bb = *(const f32x4*)(F.in(IN_BADA) + (size_t)l * 9216 + 128 * cb + 4 * g2);
        float* mo = (float*)(F.wsp(WS_MOD)) + ((size_t)(l * 2 + b)) * 9216 + 128 * cb + 4 * g2;
        *(f32x4*)mo = s + bb; }
    __syncthreads();
}
__device__ __forceinline__ void rope_table(const Frame& F) {
    const double inv[16] = {1.0, 0.56234132519034907, 0.31622776601683794, 0.17782794100389229, 0.10000000000000001, 0.056234132519034911, 0.031622776601683791, 0.017782794100389229,
                            0.01, 0.005623413251903491, 0.0031622776601683794, 0.0017782794100389228, 0.001, 0.0005623413251903491, 0.00031622776601683794, 0.00017782794100389227};
    const int gid = F.vcu * 512 + F.tid;
    for (int e = gid; e < SEQ * 16; e += F.G * 512) {
        const int pos = e >> 4, j = e & 15;
        double th = 1.0;
#pragma unroll
        for (int q = 0; q < 16; ++q) th = (j == q) ? inv[q] : th;
        const double t2 = th * th; double cs = 1.0, sn = th, tc = 1.0, ts = th;
#pragma unroll
        for (int n = 1; n <= 12; ++n) { tc *= -t2 / (double)((2 * n - 1) * (2 * n)); ts *= -t2 / (double)((2 * n) * (2 * n + 1)); cs += tc; sn += ts; }
        double rc = 1.0, rs = 0.0;
#pragma unroll
        for (int bit = 0; bit < 13; ++bit) {
            if ((pos >> bit) & 1) { const double nc = rc * cs - rs * sn, ns = rc * sn + rs * cs; rc = nc; rs = ns; }
            const double c2 = cs * cs - sn * sn, s2 = 2.0 * cs * sn; cs = c2; sn = s2;
        }
        ((f32x2*)(F.wsp(WS_ROPE)))[e] = (f32x2){(float)rc, (float)rs};
    }
}
template <bool HAS_Y, bool HAS_NEXT, int XIN, int XOUT>
__device__ __forceinline__ void norm_pass(const Frame& F, const bf16_t* Y, const void* xs, void* xd, const float* gpost, const float* gate, float rw,
                                          const float* gpre, const float* scale, const float* shift, bf16_t* XN) {
    const int gw = F.vcu * NWAVES + F.wave, NGW = F.G * NWAVES;
    constexpr int R = 4;
    for (int m0 = gw; m0 < M; m0 += R * NGW) {
        f32x4 v[R][4]; u32x2 yw[R][4];
#pragma unroll
        for (int r = 0; r < R; ++r) { const int m = (m0 + r * NGW < M) ? m0 + r * NGW : m0;
            if (XIN == 0) { const GAS f32x4* xr = (const GAS f32x4*)((const float*)xs + (size_t)m * DM) + F.lane;
#pragma unroll
                for (int j = 0; j < 4; ++j) v[r][j] = xr[64 * j]; }
            else { const GAS u32x2* xr = (const GAS u32x2*)((const bf16_t*)xs + (size_t)m * DM) + F.lane;
#pragma unroll
                for (int j = 0; j < 4; ++j) { const u32x2 w = xr[64 * j]; v[r][j] = (f32x4){bf_lo(w.x), bf_hi(w.x), bf_lo(w.y), bf_hi(w.y)}; } }
            if (HAS_Y) { const GAS u32x2* yr = (const GAS u32x2*)(Y + (size_t)m * DM) + F.lane;
#pragma unroll
                for (int j = 0; j < 4; ++j) yw[r][j] = yr[64 * j]; } }
        const int b = m0 >> 13;
        f32x4 cpost[4], cpre[4], csh[4];
#pragma unroll
        for (int j = 0; j < 4; ++j) {
            if (HAS_Y) { const f32x4 gp = *(const f32x4*)(gpost + 4 * F.lane + 256 * j); const f32x4 gt = *(const f32x4*)(gate + (size_t)b * 9216 + 4 * F.lane + 256 * j); cpost[j] = (gt * rw) * gp; }
            if (HAS_NEXT) { const f32x4 gp = *(const f32x4*)(gpre + 4 * F.lane + 256 * j); const f32x4 sc = *(const f32x4*)(scale + (size_t)b * 9216 + 4 * F.lane + 256 * j);
                cpre[j] = gp * (sc + 1.0f); csh[j] = *(const f32x4*)(shift + (size_t)b * 9216 + 4 * F.lane + 256 * j); } }
#pragma unroll
        for (int r = 0; r < R; ++r) { const int m = m0 + r * NGW; if (m < M) {
        if (HAS_Y) {
            f32x4 y[4]; float ss = 0.f;
#pragma unroll
            for (int j = 0; j < 4; ++j) { const u32x2 w = yw[r][j]; y[j] = (f32x4){bf_lo(w.x), bf_hi(w.x), bf_lo(w.y), bf_hi(w.y)}; ss += (y[j].x * y[j].x + y[j].y * y[j].y) + (y[j].z * y[j].z + y[j].w * y[j].w); }
            const float rstd = 1.0f / sqrtf(wave_sum(ss) * (1.f / DM) + EPS);
#pragma unroll
            for (int j = 0; j < 4; ++j) v[r][j] += cpost[j] * (y[j] * rstd);
            if (XOUT == 0) { GAS f32x4* xo = (GAS f32x4*)((float*)xd + (size_t)m * DM) + F.lane;
#pragma unroll
                for (int j = 0; j < 4; ++j) xo[64 * j] = v[r][j]; }
            else { GAS u32x2* xo = (GAS u32x2*)((bf16_t*)xd + (size_t)m * DM) + F.lane;
#pragma unroll
                for (int j = 0; j < 4; ++j) { u32x2 w; w.x = pk2(v[r][j].x, v[r][j].y); w.y = pk2(v[r][j].z, v[r][j].w); xo[64 * j] = w; } }
        }
        if (HAS_NEXT) {
            float ss = 0.f;
#pragma unroll
            for (int j = 0; j < 4; ++j) ss += (v[r][j].x * v[r][j].x + v[r][j].y * v[r][j].y) + (v[r][j].z * v[r][j].z + v[r][j].w * v[r][j].w);
            const float rstd = 1.0f / sqrtf(wave_sum(ss) * (1.f / DM) + EPS);
            GAS u32x2* o8 = (GAS u32x2*)(XN + (size_t)m * DM) + F.lane;
#pragma unroll
            for (int j = 0; j < 4; ++j) {
                const f32x4 o = (v[r][j] * rstd) * cpre[j] + csh[j];
                u32x2 w; w.x = pk2(o.x, o.y); w.y = pk2(o.z, o.w); o8[64 * j] = w; }
        } } }
    }
}


__device__ __forceinline__ void mla_prep(const Frame& F, const bf16_t* Z, bf16_t* CQN, bf16_t* CKN, bf16_t* KR, bf16_t* KIT, const f32x2* rt) {
    const int gw = F.vcu * NWAVES + F.wave, NGW = F.G * NWAVES, lane = F.lane;
    constexpr int R = 4;
    for (int m0 = gw; m0 < M; m0 += R * NGW) {
        u32x4 wq[R], wk[R]; float xa[R], xb[R]; f32x2 cs[R];
#pragma unroll
        for (int r = 0; r < R; ++r) { const int m = (m0 + r * NGW < M) ? m0 + r * NGW : m0; const bf16_t* zr = Z + (size_t)m * ZP;
            wq[r] = (u32x4){0u, 0u, 0u, 0u}; wk[r] = wq[r]; xa[r] = 0.f; xb[r] = 0.f; cs[r] = (f32x2){0.f, 0.f};
            if (lane < 48) wq[r] = *(const u32x4*)(zr + (lane < 32 ? ZC_CQ + 8 * lane : ZC_CKV + 8 * (lane - 32)));
            else { const int j = lane - 48; xa[r] = bf2f(zr[ZC_CKV + 128 + j]); xb[r] = bf2f(zr[ZC_CKV + 144 + j]); cs[r] = rt[(size_t)(m & (SEQ - 1)) * 16 + j]; }
            if (lane < 8) wk[r] = *(const u32x4*)(zr + ZC_IK + 8 * lane); }
#pragma unroll
        for (int r = 0; r < R; ++r) { const int m = m0 + r * NGW; if (m < M) {
        float s1 = 0.f, s2 = 0.f; float a[8] = {0.f, 0.f, 0.f, 0.f, 0.f, 0.f, 0.f, 0.f};
        if (lane < 48) { const u32x4 w = wq[r];
            a[0] = bf_lo(w.x); a[1] = bf_hi(w.x); a[2] = bf_lo(w.y); a[3] = bf_hi(w.y); a[4] = bf_lo(w.z); a[5] = bf_hi(w.z); a[6] = bf_lo(w.w); a[7] = bf_hi(w.w);
            const float s = (a[0] * a[0] + a[1] * a[1]) + (a[2] * a[2] + a[3] * a[3]) + (a[4] * a[4] + a[5] * a[5]) + (a[6] * a[6] + a[7] * a[7]);
            if (lane < 32) s1 = s; else s2 = s; }
        else { const int j = lane - 48; const float x1 = xa[r], x2 = xb[r];
            *(unsigned*)(KR + (size_t)m * 32 + 2 * j) = pk2(x1 * cs[r].x - x2 * cs[r].y, x2 * cs[r].x + x1 * cs[r].y); }
        if (lane < 8) *(u32x4*)(KIT + (size_t)(m >> 5) * 2048 + lane * 256 + (m & 31) * 8) = wk[r];
        s1 = wave_sum(s1); s2 = wave_sum(s2);
        const float r1 = 1.0f / sqrtf(s1 * (1.f / 256.f) + EPS), r2 = 1.0f / sqrtf(s2 * (1.f / 128.f) + EPS);
        if (lane < 48) { const float rr = lane < 32 ? r1 : r2;
            u32x4 o; o.x = pk2(a[0] * rr, a[1] * rr); o.y = pk2(a[2] * rr, a[3] * rr); o.z = pk2(a[4] * rr, a[5] * rr); o.w = pk2(a[6] * rr, a[7] * rr);
            if (lane < 32) *(u32x4*)(CQN + (size_t)m * 256 + 8 * lane) = o; else *(u32x4*)(CKN + (size_t)m * 128 + 8 * (lane - 32)) = o; }
        } }
    }
}

template <bool PASS2>
__device__ __forceinline__ void lru_unit(const Frame& F, int l, int unit, const bf16_t* Z, f32x2* S, bf16_t* YB) {
    constexpr int XS = 520;
    const int b = unit >> 7, k = unit & 127, c = F.tid, n = F.wave, lane = F.lane, r32 = lane & 31, hi = lane >> 5;
    const size_t m0 = (size_t)b * SEQ + 64 * k;
    LAS float* xcs = (LAS float*)F.lds;
    { const float* cw = F.in(IN_CONVW) + (size_t)l * 4 * 512 + c;
      const float w0 = cw[0], w1 = cw[512], w2 = cw[1024], w3 = cw[1536], cb = F.in(IN_CONVB)[l * 512 + c];
      const bf16_t* xr = Z + m0 * ZP + ZC_RX + c;
      float x3 = 0.f, x2 = 0.f, x1 = 0.f;
      if (k > 0) { x3 = bf2f(xr[-3 * (long)ZP]); x2 = bf2f(xr[-2 * (long)ZP]); x1 = bf2f(xr[-1 * (long)ZP]); }
      bf16_t xin[64];
      { const GAS bf16_t* xg = (const GAS bf16_t*)xr;
#pragma unroll
        for (int i = 0; i < 64; ++i) { xin[i] = *xg; xg += ZP; asm volatile("" : "+v"(xg)); } }
#pragma unroll
      for (int i0 = 0; i0 < 64; i0 += 16) {
          LAS float* xw = xcs + c + i0 * XS; asm volatile("" : "+v"(xw));
#pragma unroll
          for (int i = 0; i < 16; ++i) { const float x0 = bf2f(xin[i0 + i]); xw[i * XS] = cb + w0 * x3 + w1 * x2 + w2 * x1 + w3 * x0; x3 = x2; x2 = x1; x1 = x0; } } }
    __syncthreads();
#pragma unroll
    for (int ct = 0; ct < 2; ++ct) {
        __builtin_amdgcn_sched_barrier(0);
        const int ch = 64 * n + 32 * ct + r32;
        const float lam = F.in(IN_LRULAM)[l * 512 + ch]; const float ex_ = __expf(-lam);
        const float splus = lam < -20.f ? -lam : (ex_ < 0.1f ? ex_ * (1.0f - ex_ * (0.5f - ex_ * (0.33333334f - ex_ * (0.25f - ex_ * 0.2f)))) : __logf(1.0f + ex_));
        const float sp8 = -8.0f * LOG2E * splus, bia = F.in(IN_LRUBA)[l * 512 + ch], bix = F.in(IN_LRUBX)[l * 512 + ch];
        float hst = 0.f, apr = 1.f;
        if (PASS2) { const f32x2* sp = S + (size_t)b * 128 * 512 + ch;
            const int kh = (k + 1) >> 1, q0_ = hi ? kh : 0, q1_ = hi ? k : kh;
            float Am = 1.f, Bm = 0.f;
            for (int qb_ = 0; qb_ < kh; qb_ += 32) {
                const GAS f32x2* sq = (const GAS f32x2*)sp + (size_t)(q0_ + qb_) * 512; asm volatile("" : "+v"(sq));
                f32x2 ab[32];
#pragma unroll
                for (int e = 0; e < 32; ++e) { ab[e] = *sq; sq += 512; asm volatile("" : "+v"(sq)); }
#pragma unroll
                for (int e = 0; e < 32; ++e) { const bool v_ = q0_ + qb_ + e < q1_; const float bn = ab[e].x * Bm + ab[e].y, an = ab[e].x * Am; Bm = v_ ? bn : Bm; Am = v_ ? an : Am; } }
            float b0_ = Bm, b1_ = Bm, a0_ = Am, a1_ = Am;
            asm volatile("s_nop 1\n\tv_permlane32_swap_b32 %0, %1\n\tv_permlane32_swap_b32 %2, %3\n\ts_nop 1" : "+v"(b0_), "+v"(b1_), "+v"(a0_), "+v"(a1_));
            hst = a1_ * b0_ + b1_; }
        u32x4 wf[2][4];
        { float wv[2][4][8];
#pragma unroll
          for (int g = 0; g < 2; ++g) {
              const GAS float* pw = (const GAS float*)((g ? F.in(IN_LRUWX) : F.in(IN_LRUWA)) + ((size_t)l * 8 + n) * 4096 + (8 * hi) * 64 + 32 * ct + r32);
              asm volatile("" : "+v"(pw));
#pragma unroll
              for (int ks = 0; ks < 4; ++ks)
#pragma unroll
                  for (int e = 0; e < 8; ++e) wv[g][ks][e] = pw[(16 * ks + e) * 64]; }
#pragma unroll
          for (int g = 0; g < 2; ++g)
#pragma unroll
              for (int ks = 0; ks < 4; ++ks) wf[g][ks] = (u32x4){pk2(wv[g][ks][0], wv[g][ks][1]), pk2(wv[g][ks][2], wv[g][ks][3]), pk2(wv[g][ks][4], wv[g][ks][5]), pk2(wv[g][ks][6], wv[g][ks][7])}; }
        __builtin_amdgcn_sched_barrier(0);
        f32x16 D[2][2];
#pragma unroll
        for (int rt = 0; rt < 2; ++rt)
#pragma unroll
            for (int r = 0; r < 16; ++r) { D[0][rt][r] = bia; D[1][rt][r] = bix; }
#pragma unroll
        for (int rt = 0; rt < 2; ++rt)
#pragma unroll
            for (int ks = 0; ks < 4; ++ks) {
                const LAS f32x4* ap = (const LAS f32x4*)(xcs + (32 * rt + r32) * XS + 64 * n + 16 * ks + 8 * hi);
                const f32x4 a0 = ap[0], a1 = ap[1];
                const u32x4 af = (u32x4){pk2(a0.x, a0.y), pk2(a0.z, a0.w), pk2(a1.x, a1.y), pk2(a1.z, a1.w)};
#pragma unroll
                for (int g = 0; g < 2; ++g) D[g][rt] = __builtin_amdgcn_mfma_f32_32x32x16_bf16(__builtin_bit_cast(bf16x8, af), __builtin_bit_cast(bf16x8, wf[g][ks]), D[g][rt], 0, 0, 0);
            }
        __builtin_amdgcn_sched_barrier(0);
#pragma unroll
        for (int rt = 0; rt < 2; ++rt) {
            const LAS float* xo = xcs + (32 * rt + 4 * hi) * XS + ch;
#pragma unroll
            for (int r = 0; r < 16; ++r) {
                const float rr = fast_sigmoid(D[0][rt][r]), ig = fast_sigmoid(D[1][rt][r]);
                const float l2a = sp8 * rr, a = __builtin_amdgcn_exp2f(l2a), xx = 1.3862943611198906f * l2a;
                const float poly = -xx * (1.0f + xx * (0.5f + xx * (0.16666667f + xx * (0.041666668f + xx * 0.008333334f)))), direct = 1.0f - a * a;
                const float one_m_a2 = (xx > -0.1f) ? poly : direct;
                D[0][rt][r] = a; D[1][rt][r] = __builtin_amdgcn_sqrtf(one_m_a2) * (ig * xo[((r & 3) + 8 * (r >> 2)) * XS]);
            } }
#pragma unroll
        for (int rt = 0; rt < 2; ++rt)
#pragma unroll
            for (int rg = 0; rg < 4; ++rg)
#pragma unroll
                for (int owner = 0; owner < 2; ++owner) {
                    float h = hst, ap = apr;
#pragma unroll
                    for (int e = 0; e < 4; ++e) { const int r = 4 * rg + e; h = D[0][rt][r] * h + D[1][rt][r]; ap *= D[0][rt][r]; D[1][rt][r] = (hi == owner) ? h : D[1][rt][r]; }
                    float h0_ = h, h1_ = h, a0_ = ap, a1_ = ap;
                    asm volatile("s_nop 1\n\tv_permlane32_swap_b32 %0, %1\n\tv_permlane32_swap_b32 %2, %3\n\ts_nop 1" : "+v"(h0_), "+v"(h1_), "+v"(a0_), "+v"(a1_));
                    hst = owner ? h1_ : h0_; apr = owner ? a1_ : a0_;
                }
        if (!PASS2) { if (hi == 0) S[((size_t)b * 128 + k) * 512 + ch] = (f32x2){apr, hst}; }
        else {
#pragma unroll
            for (int rt = 0; rt < 2; ++rt) {
                bf16_t gin[16];
                const GAS bf16_t* zb = (const GAS bf16_t*)(Z + (m0 + 32 * rt + 4 * hi) * ZP + ZC_RG + ch); GAS bf16_t* yb = (GAS bf16_t*)(YB + (m0 + 32 * rt + 4 * hi) * 2048 + 512 + ch);
                asm volatile("" : "+v"(zb), "+v"(yb));
#pragma unroll
                for (int r = 0; r < 16; ++r) gin[r] = zb[(size_t)((r & 3) + 8 * (r >> 2)) * ZP];
#pragma unroll
                for (int r = 0; r < 16; ++r) { const float g = bf2f(gin[r]);
                    const float tg = 0.7978845608028654f * (g + 0.044715f * g * g * g);
                    const float th = 1.0f - 2.0f * __builtin_amdgcn_rcpf(1.0f + __builtin_amdgcn_exp2f(2.0f * LOG2E * tg));
                    yb[(size_t)((r & 3) + 8 * (r >> 2)) * 2048] = (bf16_t)f2bf(D[1][rt][r] * (0.5f * g * (1.0f + th))); }
            }
        }
    }
    __syncthreads();
}

namespace fa {
constexpr int KB96 = 12288, VB = 8192, STG = KB96 + VB, NSLOT = 4, LDS_WS = NSLOT * STG, LDS_OST = LDS_WS + 8 * 256, LDS_TOTAL = LDS_OST + 8 * 4096;
constexpr float THR = 8.0f;
__device__ __forceinline__ int crow(int r, int hi) { return (r & 3) + 8 * (r >> 2) + 4 * hi; }
__device__ __forceinline__ void glds16(const void* g, unsigned lds_base) {
    unsigned sv; asm volatile("s_mov_b32 %0, m0\n\ts_mov_b32 m0, %2\n\ts_nop 0\n\tglobal_load_lds_dwordx4 %1, off\n\ts_mov_b32 m0, %0" : "=&s"(sv) : "v"(g), "s"(lds_base) : "memory"); }
typedef short v4i16_t __attribute__((ext_vector_type(4)));
typedef __attribute__((address_space(3))) const char* lds_cptr;
__device__ __forceinline__ v4i16_t vtr(lds_cptr p) { return __builtin_amdgcn_ds_read_tr16_b64_v4i16((__attribute__((address_space(3))) v4i16_t*)p); }
#define FA_MFMA(a, b, c) __builtin_amdgcn_mfma_f32_32x32x16_bf16(a, b, c, 0, 0, 0)
__device__ __forceinline__ float xhalf_max(float x) { float a = x, b = x; asm volatile("s_nop 1\n\tv_permlane32_swap_b32 %0, %1\n\ts_nop 1" : "+v"(a), "+v"(b)); return __builtin_fmaxf(a, b); }
__device__ __forceinline__ float keep_or_ninf(int m, float x) { float r; asm("v_bfi_b32 %0, %1, %2, %3" : "=v"(r) : "v"(m), "v"(x), "s"(0xff800000u)); return r; }

struct Ptrs { const bf16_t* Q; int ldq; const bf16_t* K; int ldk; const bf16_t* KR; const bf16_t* V; int ldv; bf16_t* O; int ldo; const unsigned* MK; float slope2; float sink2; };

template <int MODE>
__device__ __forceinline__ void unit(const Frame& F, const Ptrs& P, int b, int qb) {
    constexpr int DK = (MODE == 0) ? 96 : 64, ND0 = DK / 16;
    const int lane = F.lane, r32 = lane & 31, hi = lane >> 5, wid = F.wave;
    const long rowbase = (long)b * SEQ; const int q0 = qb * 256;
    const int qidx = q0 + 32 * wid + r32;
    const unsigned lds0 = (unsigned)(uintptr_t)F.lds;
    LAS float* wsf = (LAS float*)(F.lds + LDS_WS) + wid * 64;
    int t_lo, t_hi, key_base;
    if (MODE == 2) { key_base = q0 - 128; t_lo = (qb == 0) ? 2 : 0; t_hi = 6; } else { key_base = 0; t_lo = 0; t_hi = 4 * qb + 4; }
    const bf16_t* ksrc = P.K + (rowbase + lane) * (long)P.ldk + wid * 8;
    const bf16_t* krsrc = (MODE == 0) ? P.KR + (rowbase + lane) * 32L + (wid & 3) * 8 : nullptr;
    const bf16_t* vsrc = P.V + (rowbase + 16 * (wid & 3) + (lane >> 2)) * (long)P.ldv + (wid >> 2) * 32 + (lane & 3) * 8;
    const unsigned kdst = lds0 + wid * 1024, krdst = lds0 + (8 + (wid & 3)) * 1024, vdst = lds0 + KB96 + wid * 1024;
#define FA_DMA(t, soff) do { const long k0_ = key_base + 64L * (t); \
        glds16(ksrc + k0_ * P.ldk, (unsigned)__builtin_amdgcn_readfirstlane(kdst + (soff))); \
        if (MODE == 0 && krw) glds16(krsrc + k0_ * 32, (unsigned)__builtin_amdgcn_readfirstlane(krdst + (soff)));        \
        glds16(vsrc + k0_ * P.ldv, (unsigned)__builtin_amdgcn_readfirstlane(vdst + (soff))); } while (0)
    const bool krw = __builtin_amdgcn_readfirstlane(wid) < 4;
    if (!krw) asm volatile("s_setprio 1");
    FA_DMA(t_lo, 0);
    if (t_lo + 1 < t_hi) FA_DMA(t_lo + 1, STG);
    bf16x8 qr[ND0];
    { const bf16_t* Qw = P.Q + (rowbase + q0 + 32 * wid + r32) * (long)P.ldq + hi * 8;
#pragma unroll
      for (int d0 = 0; d0 < ND0; ++d0) qr[d0] = *(const bf16x8*)(Qw + d0 * 16); }
    float lrun = (MODE == 2 && hi == 0) ? 1.0f : 0.0f;
    f32x16 negm = {};
    float mref = (MODE == 2) ? P.sink2 : (MODE == 1) ? -1.0e4f : 0.0f;
    f32x16 o0 = {}, o1 = {};
    const lds_cptr kp0 = (lds_cptr)F.lds + hi * 1024 + r32 * 16;
    const lds_cptr vp0 = (lds_cptr)F.lds + KB96 + ((lane >> 4) & 1) * 32 + (lane & 3) * 8 + (4 * hi + ((lane & 15) >> 2)) * 64;
    const unsigned* mkrow = (MODE == 1) ? P.MK + (size_t)(rowbase + qidx) * 256 : nullptr;
#define FA_KLOAD(soff) do { const lds_cptr kp_ = kp0 + (soff); \
        _Pragma("unroll") for (int d0 = 0; d0 < ND0; ++d0) { kf[2 * d0] = *(const __attribute__((address_space(3))) bf16x8*)(kp_ + d0 * 2048); kf[2 * d0 + 1] = *(const __attribute__((address_space(3))) bf16x8*)(kp_ + d0 * 2048 + 512); } } while (0)
#define FA_QKMMA(A, B) do { A = FA_MFMA(kf[0], qr[0], negm); B = FA_MFMA(kf[1], qr[0], negm);        \
        _Pragma("unroll") for (int d0 = 1; d0 < ND0; ++d0) { A = FA_MFMA(kf[2 * d0], qr[d0], A); B = FA_MFMA(kf[2 * d0 + 1], qr[d0], B); } } while (0)
#define FA_BIAS(A, B, key0, mw) do { const int kl_ = (key0) + 4 * hi; \
        if (MODE != 0) { const float bq_ = P.slope2 * (float)(kl_ - qidx) - mref;        \
            _Pragma("unroll") for (int r = 0; r < 16; ++r) { const float cr_ = P.slope2 * (float)((r & 3) + 8 * (r >> 2)); A[r] += bq_ + cr_; B[r] += bq_ + cr_ + 32.0f * P.slope2; } } \
        if (MODE == 1) { const unsigned w0_ = (mw).x >> (4 * hi), w1_ = (mw).y >> (4 * hi);        \
            _Pragma("unroll") for (int r = 0; r < 16; ++r) { const int pos_ = (r & 3) + 8 * (r >> 2); \
                A[r] = keep_or_ninf(__builtin_amdgcn_sbfe((int)w0_, pos_, 1), A[r]); B[r] = keep_or_ninf(__builtin_amdgcn_sbfe((int)w1_, pos_, 1), B[r]); } } \
        if (MODE == 2) { _Pragma("unroll") for (int r = 0; r < 16; ++r) { const int d_ = qidx - (kl_ + (r & 3) + 8 * (r >> 2)); if (d_ < 0 || d_ >= 128) A[r] = -INFINITY; if (d_ - 32 < 0 || d_ - 32 >= 128) B[r] = -INFINITY; } } \
        _Pragma("unroll") for (int i_ = 0; i_ < 8; ++i_) { __builtin_amdgcn_sched_group_barrier(0x8, 1, 0); __builtin_amdgcn_sched_group_barrier(0x2, (MODE == 1) ? 8 : (MODE == 2) ? 12 : 2, 0); }        \
        if (MODE != 2 && (key0) + 63 > q0 + 32 * wid) { asm volatile("; diagonal tile" ::: "memory");        \
            _Pragma("unroll") for (int r = 0; r < 16; ++r) { const int kv_ = kl_ + (r & 3) + 8 * (r >> 2); if (kv_ > qidx) A[r] = -INFINITY; if (kv_ + 32 > qidx) B[r] = -INFINITY; } } \
        } while (0)
    u32x2 mw = {0u, 0u}, mw_n = {0u, 0u}, mw_nn = {0u, 0u};
    if (MODE == 1) { mw = *(const u32x2*)(mkrow + 2 * t_lo); if (t_lo + 1 < t_hi) mw_n = *(const u32x2*)(mkrow + 2 * (t_lo + 1)); }
    if (t_lo + 1 < t_hi) asm volatile("s_waitcnt vmcnt(%0) lgkmcnt(0)\n\ts_barrier" :: "n"(2) : "memory"); else asm volatile("s_waitcnt vmcnt(0) lgkmcnt(0)\n\ts_barrier" ::: "memory");
    f32x16 p0, p1, n0 = {}, n1 = {}; bf16x8 kf[2 * ND0];
    u32x4 pw0 = {0u, 0u, 0u, 0u}, pw1 = pw0, pw2 = pw0, pw3 = pw0;
    FA_KLOAD(0); __builtin_amdgcn_sched_barrier(0); FA_QKMMA(p0, p1);
    int s_prev = 3 * STG, s_cur = 0, s_nxt = STG, s_nn = 2 * STG;
#define FA_MX3(a, b, c) __builtin_fmaxf(__builtin_fmaxf((a), (b)), (c))
#define FA_TOP(t) do { if ((t) + 1 < t_hi) { \
            asm volatile("s_waitcnt vmcnt(0) lgkmcnt(0)\n\ts_barrier" ::: "memory");       \
            if ((t) + 2 < t_hi) { FA_DMA((t) + 2, s_nn); if (MODE == 1) mw_nn = *(const u32x2*)(mkrow + 2 * ((t) + 2)); } \
            } } while (0)
#define FA_PV(soff, KL) do { const lds_cptr vp_ = vp0 + (soff); bf16x8 vf[8]; \
        _Pragma("unroll") for (int i = 0; i < 8; ++i) { const v4i16_t lo_ = vtr(vp_ + (i >> 2) * 4096 + (i & 3) * 1024), hi_ = vtr(vp_ + (i >> 2) * 4096 + (i & 3) * 1024 + 512); vf[i] = (bf16x8){lo_[0], lo_[1], lo_[2], lo_[3], hi_[0], hi_[1], hi_[2], hi_[3]}; } \
        __builtin_amdgcn_sched_barrier(0); if (KL) FA_KLOAD(s_nxt); \
        o0 = FA_MFMA(__builtin_bit_cast(bf16x8, pw0), vf[0], o0); o1 = FA_MFMA(__builtin_bit_cast(bf16x8, pw0), vf[4], o1); \
        o0 = FA_MFMA(__builtin_bit_cast(bf16x8, pw1), vf[1], o0); o1 = FA_MFMA(__builtin_bit_cast(bf16x8, pw1), vf[5], o1); \
        o0 = FA_MFMA(__builtin_bit_cast(bf16x8, pw2), vf[2], o0); o1 = FA_MFMA(__builtin_bit_cast(bf16x8, pw2), vf[6], o1); \
        o0 = FA_MFMA(__builtin_bit_cast(bf16x8, pw3), vf[3], o0); o1 = FA_MFMA(__builtin_bit_cast(bf16x8, pw3), vf[7], o1); } while (0)
#define FA_SOFTMAX(t, FIRST) do { \
        float rma = FA_MX3(p0[0], p0[1], p1[0]), rmb = FA_MX3(p0[2], p0[3], p1[1]); rma = FA_MX3(rma, p1[2], p1[3]); \
        _Pragma("unroll") for (int r = 4; r < 16; r += 4) { rma = FA_MX3(rma, p0[r], p0[r + 1]); rmb = FA_MX3(rmb, p0[r + 2], p0[r + 3]); rma = FA_MX3(rma, p1[r], p1[r + 1]); rmb = FA_MX3(rmb, p1[r + 2], p1[r + 3]); } \
        float rm = xhalf_max(__builtin_fmaxf(rma, rmb)); \
        float sacc = 0.f; \
        { const bool first0_ = (MODE == 0) && (FIRST);        \
          if (first0_ || __any(rm > THR)) { float dl = (rm > THR) ? rm : 0.0f; if (first0_) dl = (rm == -INFINITY) ? 0.0f : rm; \
                mref += dl; \
                _Pragma("unroll") for (int r = 0; r < 16; ++r) { p0[r] -= dl; p1[r] -= dl; } \
                if (MODE == 0) { _Pragma("unroll") for (int r = 0; r < 16; ++r) negm[r] -= dl; } \
                if (!first0_) { const float alpha = __builtin_amdgcn_exp2f(-dl); lrun *= alpha; \
                    if (hi == 0) wsf[r32] = alpha; asm volatile("s_waitcnt lgkmcnt(0)" ::: "memory"); \
                    _Pragma("unroll") for (int r = 0; r < 16; ++r) { const float f = wsf[crow(r, hi)]; o0[r] *= f; o1[r] *= f; } } } \
          FA_QKMMA(n0, n1);        \
          _Pragma("unroll") for (int r = 0; r < 16; ++r) { p0[r] = __builtin_amdgcn_exp2f(p0[r]); p1[r] = __builtin_amdgcn_exp2f(p1[r]); sacc += p0[r] + p1[r]; } } \
        lrun += sacc; \
        pw0 = (u32x4){cvt_pk_bf16(p0[0], p0[1]), cvt_pk_bf16(p0[2], p0[3]), cvt_pk_bf16(p0[4], p0[5]), cvt_pk_bf16(p0[6], p0[7])}; \
        pw1 = (u32x4){cvt_pk_bf16(p0[8], p0[9]), cvt_pk_bf16(p0[10], p0[11]), cvt_pk_bf16(p0[12], p0[13]), cvt_pk_bf16(p0[14], p0[15])}; \
        pw2 = (u32x4){cvt_pk_bf16(p1[0], p1[1]), cvt_pk_bf16(p1[2], p1[3]), cvt_pk_bf16(p1[4], p1[5]), cvt_pk_bf16(p1[6], p1[7])}; \
        pw3 = (u32x4){cvt_pk_bf16(p1[8], p1[9]), cvt_pk_bf16(p1[10], p1[11]), cvt_pk_bf16(p1[12], p1[13]), cvt_pk_bf16(p1[14], p1[15])}; \
        p0 = n0; p1 = n1; \
        { const int tmp_ = s_prev; s_prev = s_cur; s_cur = s_nxt; s_nxt = s_nn; s_nn = tmp_; } mw = mw_n; mw_n = mw_nn; } while (0)
    FA_TOP(t_lo); if (t_lo + 1 < t_hi) FA_KLOAD(s_nxt);
    FA_BIAS(p0, p1, key_base + 64 * t_lo, mw);
    FA_SOFTMAX(t_lo, 1);
    for (int t = t_lo + 1; t < t_hi; ++t) {
        FA_TOP(t);
        FA_PV(s_prev, t + 1 < t_hi);
        FA_BIAS(p0, p1, key_base + 64 * t, mw);
        FA_SOFTMAX(t, 0);
    }
    FA_PV(s_prev, false);
#undef FA_MX3
#undef FA_TOP
#undef FA_PV
#undef FA_SOFTMAX
    lrun += __shfl_xor(lrun, 32);
    if (hi == 0) wsf[32 + r32] = lrun;
    asm volatile("s_waitcnt lgkmcnt(0)" ::: "memory");
    LAS bf16_t* stg = (LAS bf16_t*)(F.lds + LDS_OST) + wid * 2048;
#pragma unroll
    for (int r = 0; r < 16; ++r) { const int orow = crow(r, hi); const float rl = __builtin_amdgcn_rcpf(wsf[32 + orow]);
        stg[orow * 64 + r32] = (bf16_t)f2bf(o0[r] * rl); stg[orow * 64 + 32 + r32] = (bf16_t)f2bf(o1[r] * rl); }
    asm volatile("s_waitcnt lgkmcnt(0)" ::: "memory");
    bf16_t* Ow = P.O + (rowbase + q0 + 32 * wid) * (long)P.ldo;
#pragma unroll
    for (int i = 0; i < 4; ++i) { const int row = i * 8 + (lane >> 3), ch = lane & 7; *(u32x4*)(Ow + (long)row * P.ldo + ch * 8) = *(const LAS u32x4*)(stg + row * 64 + ch * 8); }
    asm volatile("s_setprio 0\n\ts_waitcnt lgkmcnt(0)\n\ts_barrier" ::: "memory");
#undef FA_DMA
#undef FA_KLOAD
#undef FA_QKMMA
#undef FA_BIAS
}
}

namespace fd {
using fa::lds_cptr; using fa::v4i16_t; using fa::vtr; using fa::glds16; using fa::crow;
constexpr int NSLOT = 3, SLOTB = 8192, LDS_K = 0, LDS_V = NSLOT * SLOTB, LDS_WS = 2 * NSLOT * SLOTB, LDS_OST = LDS_WS + 8 * 256, LDS_MSK = LDS_OST + 8 * 4096, LDS_TOTAL = LDS_MSK + 8 * 2048;
static_assert(LDS_TOTAL <= LDSCTL_OFF, "dsa unit LDS");
__device__ __forceinline__ float max3f(float a, float b, float c) { float r; asm("v_max3_f32 %0, %1, %2, %3" : "=v"(r) : "v"(a), "v"(b), "v"(c)); return r; }
__device__ __forceinline__ float max2f(float a, float b) { float r; asm("v_max_f32_e32 %0, %1, %2" : "=v"(r) : "v"(a), "v"(b)); return r; }
#define FD_SBAR() __builtin_amdgcn_sched_barrier(0)
__device__ __forceinline__ float and_mask(int m, float x) { float r; asm("v_and_b32 %0, %1, %2" : "=v"(r) : "v"(m), "v"(x)); return r; }
#define FD_WAIT_BAR(N) asm volatile("s_waitcnt vmcnt(" #N ") lgkmcnt(0)\n\ts_barrier" ::: "memory")
#define FD_MFMA(a, b, c) __builtin_amdgcn_mfma_f32_32x32x16_bf16(a, b, c, 0, 0, 0)
__device__ __forceinline__ void kload8(bf16x8* kf, lds_cptr kp) {
    kf[0] = *(const LAS bf16x8*)(kp);        kf[1] = *(const LAS bf16x8*)(kp + 512);  kf[2] = *(const LAS bf16x8*)(kp + 2048); kf[3] = *(const LAS bf16x8*)(kp + 2560);
    kf[4] = *(const LAS bf16x8*)(kp + 4096); kf[5] = *(const LAS bf16x8*)(kp + 4608); kf[6] = *(const LAS bf16x8*)(kp + 6144); kf[7] = *(const LAS bf16x8*)(kp + 6656); }
__device__ __forceinline__ void kload2(bf16x8* kf, lds_cptr kp, int j) { kf[2 * j] = *(const LAS bf16x8*)(kp + j * 2048); kf[2 * j + 1] = *(const LAS bf16x8*)(kp + j * 2048 + 512); }
__device__ __forceinline__ float rowmax(const f32x16& p0, const f32x16& p1) {
    float a = max3f(p0[0], p0[1], p1[0]), b = max3f(p0[2], p0[3], p1[1]); a = max3f(a, p1[2], p1[3]);
#pragma unroll
    for (int r = 4; r < 16; r += 4) { a = max3f(a, p0[r], p0[r + 1]); b = max3f(b, p0[r + 2], p0[r + 3]); a = max3f(a, p1[r], p1[r + 1]); b = max3f(b, p1[r + 2], p1[r + 3]); }
    return fa::xhalf_max(max2f(a, b)); }
__device__ __forceinline__ void cmask(f32x16& p0, f32x16& p1, int jb, int qrel, int hi) {
    const int kb = 64 * jb + 4 * hi;
#pragma unroll
    for (int r = 0; r < 16; ++r) { const int kv = kb + (r & 3) + 8 * (r >> 2); if (kv > qrel) p0[r] = -INFINITY; if (kv + 32 > qrel) p1[r] = -INFINITY; } }

template <int SWA>
__device__ __forceinline__ void unit(const Frame& F, const fa::Ptrs& P, int b, int qb) {
    const int lane = F.lane, r32 = lane & 31, hi = lane >> 5, wid = F.wave;
    const int q0 = qb * 256, qrel = wid * 32 + r32, qidx = q0 + qrel, kb0 = (SWA && qb > 0) ? q0 - 128 : 0;
    const long rowbase = (long)b * SEQ, krow0 = rowbase + kb0;
    LAS unsigned char* shm = F.lds; const unsigned lds0 = (unsigned)(uintptr_t)shm;
    LAS float* wsf = (LAS float*)(shm + LDS_WS) + wid * 64;
    const bf16_t* ksrc = P.K + (krow0 + lane) * (long)P.ldk + wid * 8;
    const bf16_t* vsrc = P.V + (krow0 + 16 * (wid & 3) + (lane >> 2)) * (long)P.ldv + (wid >> 2) * 32 + (lane & 3) * 8;
    const char* msrc = SWA ? nullptr : (const char*)P.MK + (rowbase + qidx) * 1024L;
    const unsigned kdst = lds0 + LDS_K + wid * 1024, vdst = lds0 + LDS_V + wid * 1024, mdst = lds0 + LDS_MSK + wid * 2048;
#define FD_DMA_K(t, slot) glds16(ksrc + (long)(t) * 64 * P.ldk, (unsigned)__builtin_amdgcn_readfirstlane(kdst + (slot)))
#define FD_DMA_V(t, slot) glds16(vsrc + (long)(t) * 64 * P.ldv, (unsigned)__builtin_amdgcn_readfirstlane(vdst + (slot)))
#define FD_DMA_M(t) glds16(msrc + 8 * (t), (unsigned)__builtin_amdgcn_readfirstlane(mdst + ((((t) >> 1) & 1) << 10)))
    const lds_cptr shm3 = (lds_cptr)shm; const lds_cptr kp0 = shm3 + LDS_K + hi * 1024 + r32 * 16; const lds_cptr vp0 = shm3 + LDS_V + ((lane >> 4) & 1) * 32 + (lane & 3) * 8 + (4 * hi + ((lane & 15) >> 2)) * 64;
    const LAS unsigned* mlds = (const LAS unsigned*)(shm + LDS_MSK + wid * 2048) + lane * 4;
    const int NT = SWA ? (qb > 0 ? 6 : 4) : (q0 + 256) / 64;
    if (!SWA) { FD_DMA_M(0); if (2 < NT) FD_DMA_M(2); }
    FD_DMA_K(0, 0); FD_DMA_V(0, 0); FD_DMA_K(1, SLOTB);
    bf16x8 qr[4];
    { const bf16_t* Qw = P.Q + (rowbase + qidx) * (long)P.ldq + hi * 8;
#pragma unroll
      for (int d0 = 0; d0 < 4; ++d0) qr[d0] = *(const bf16x8*)(Qw + d0 * 16); }
    u32x4 kxA = {0u, 0u, 0u, 0u}, kxB = kxA, qx = kxA; unsigned qs2 = 0u;
    if (hi == 0) {
        const unsigned klA = __builtin_bit_cast(unsigned, (float)r32) >> 16, klB = __builtin_bit_cast(unsigned, (float)(r32 + 32)) >> 16, one = 0x3f80u;
        kxA = (u32x4){klA | (klA << 16), klA | (one << 16), one | (one << 16), 0u}; kxB = (u32x4){klB | (klB << 16), klB | (one << 16), one | (one << 16), 0u};
        const unsigned s0_ = __builtin_bit_cast(unsigned, P.slope2) & 0xffff0000u; const float t1_ = P.slope2 - __builtin_bit_cast(float, s0_);
        const unsigned s1_ = __builtin_bit_cast(unsigned, t1_) & 0xffff0000u; const float t2_ = t1_ - __builtin_bit_cast(float, s1_);
        qx.x = (s0_ >> 16) | s1_; qs2 = __builtin_bit_cast(unsigned, t2_) >> 16; }
    float mhat = SWA ? P.sink2 : 0.f, l_reg = (SWA && hi == 0) ? 1.0f : 0.f; f32x16 o[2]; o[0] = f32x16{}; o[1] = f32x16{};
#define FD_QX(t) do { const float c_ = (hi == 0) ? __builtin_fmaf(P.slope2, (float)(kb0 + 64 * (t) - qidx), -mhat) : 0.0f; \
        const unsigned c0_ = __builtin_bit_cast(unsigned, c_) & 0xffff0000u; const float r1_ = c_ - __builtin_bit_cast(float, c0_); \
        const unsigned c1_ = __builtin_bit_cast(unsigned, r1_) & 0xffff0000u; const float r2_ = r1_ - __builtin_bit_cast(float, c1_); \
        const unsigned c2_ = __builtin_bit_cast(unsigned, r2_) & 0xffff0000u; \
        qx.y = qs2 | c0_; qx.z = __builtin_amdgcn_perm(c2_, c1_, 0x07060302u); } while (0)
#define FD_KX(k) __builtin_bit_cast(bf16x8, k)
#define FD_CMASK(P0, P1, t) do { if (!SWA) { const int jb_ = (t) - (NT - 4); if (jb_ >= 0) cmask(P0, P1, jb_, qrel, hi); } } while (0)
#define FD_MW(t) unsigned w0_, w1_; if (SWA) { const int d_ = qidx - kb0 - 64 * (t);        \
            const int lo_ = d_ - 127 < 0 ? 0 : d_ - 127, hi_ = d_ > 63 ? 63 : d_; \
            const unsigned long long m_ = (hi_ >= lo_) ? ((hi_ == 63 ? ~0ull : ((1ull << (hi_ + 1)) - 1ull)) & ~((1ull << lo_) - 1ull)) : 0ull; \
            w0_ = (unsigned)m_ >> (4 * hi); w1_ = (unsigned)(m_ >> 32) >> (4 * hi); } \
        else { w0_ = mlds[((((t) >> 1) & 1) << 8) + 2 * ((t) & 1)] >> (4 * hi); w1_ = mlds[((((t) >> 1) & 1) << 8) + 2 * ((t) & 1) + 1] >> (4 * hi); }
#define FD_AND(X, W, B) do { _Pragma("unroll") for (int e_ = 0; e_ < 4; ++e_) { const int r_ = (B) + e_; \
        X[r_] = and_mask(__builtin_amdgcn_sbfe((int)(W), (r_ & 3) + 8 * (r_ >> 2), 1), X[r_]); } } while (0)
    bool resc = false;
#define FD_RESC() do { if (resc) { asm volatile("s_waitcnt lgkmcnt(0)" ::: "memory"); \
        _Pragma("unroll") for (int d_ = 0; d_ < 2; ++d_) _Pragma("unroll") for (int r = 0; r < 16; ++r) o[d_][r] *= wsf[crow(r, hi)]; } } while (0)
    f32x16 pA0, pA1, pB0, pB1; bf16x8 kf[8];
    int sl_prev = 0, sl_cur = 0, sl_next = SLOTB;
#define FD_ROT() do { sl_prev = sl_cur; sl_cur = sl_next; sl_next = (sl_next == (NSLOT - 1) * SLOTB) ? 0 : sl_next + SLOTB; } while (0)
    FD_DMA_K(2, 2 * SLOTB);
    FD_WAIT_BAR(3);
    FD_QX(0);
    { kload8(kf, kp0);
      pA0 = FD_MFMA(FD_KX(kxA), FD_KX(qx), f32x16{}); pA1 = FD_MFMA(FD_KX(kxB), FD_KX(qx), f32x16{});
#pragma unroll
      for (int d0 = 0; d0 < 4; ++d0) { pA0 = FD_MFMA(kf[2 * d0], qr[d0], pA0); pA1 = FD_MFMA(kf[2 * d0 + 1], qr[d0], pA1); } }
    asm volatile("s_nop 15\n\ts_nop 7" : "+v"(pA0), "+v"(pA1));
    FD_CMASK(pA0, pA1, 0);
    { const float rm = rowmax(pA0, pA1); const float dl = SWA ? __builtin_fmaxf(rm, 0.f) : rm; mhat += dl;
      if (SWA) l_reg *= __builtin_amdgcn_exp2f(-dl);
#pragma unroll
      for (int r = 0; r < 16; ++r) { pA0[r] -= dl; pA1[r] -= dl; }
#pragma unroll
      for (int r = 0; r < 16; ++r) { pA0[r] = __builtin_amdgcn_exp2f(pA0[r]); pA1[r] = __builtin_amdgcn_exp2f(pA1[r]); }
      asm volatile("" : "+v"(pA0), "+v"(pA1)); FD_SBAR();
      FD_MW(0);
      FD_AND(pA0, w0_, 0); FD_AND(pA0, w0_, 4); FD_AND(pA0, w0_, 8); FD_AND(pA0, w0_, 12); FD_AND(pA1, w1_, 0); FD_AND(pA1, w1_, 4); FD_AND(pA1, w1_, 8); FD_AND(pA1, w1_, 12); }
    FD_WAIT_BAR(0);
    FD_DMA_K(3, 0); FD_DMA_V(1, SLOTB);
    FD_ROT();
    kload8(kf, kp0 + sl_cur);
    FD_WAIT_BAR(2);
    v4i16_t vlo[8], vhi[8]; u32x4 pw0, pw1, pw2, pw3;
#define FD_PKW(Pv, B) cvt_pk_bf16(Pv[B], Pv[(B) + 1])
#define FD_PAF(k) __builtin_bit_cast(bf16x8, pw##k)
#define FD_VFR(i) (bf16x8){vlo[i][0], vlo[i][1], vlo[i][2], vlo[i][3], vhi[i][0], vhi[i][1], vhi[i][2], vhi[i][3]}
#define FD_PIN(x) asm volatile("" : "+v"(x))
#define FD_MX3(a, b, c) __builtin_fmaxf(__builtin_fmaxf((a), (b)), (c))
#define FD_GAPA(MF, A0, A1, A2, A3, W0, W1, PW) do { MF; sacc += A0; sacc += A1; sacc += A2; sacc += A3; FD_PIN(sacc); W0; W1; FD_PIN(PW); FD_SBAR(); } while (0)
#define FD_GAPB(MF, X, B, Y, WY, BY) do { MF; X[B] = __builtin_amdgcn_exp2f(X[B]); X[(B) + 1] = __builtin_amdgcn_exp2f(X[(B) + 1]); X[(B) + 2] = __builtin_amdgcn_exp2f(X[(B) + 2]); X[(B) + 3] = __builtin_amdgcn_exp2f(X[(B) + 3]); \
        if ((BY) >= 0) { FD_AND(Y, WY, ((BY) >= 0 ? (BY) : 0)); FD_PIN(Y); } FD_PIN(X); FD_SBAR(); } while (0)
#define FD_VRD(i) do { vlo[i] = vtr(vp_ + (((i) >> 2) * 4096 + ((i) & 3) * 1024)); vhi[i] = vtr(vp_ + (((i) >> 2) * 4096 + ((i) & 3) * 1024 + 512)); } while (0)
#define FD_KRD(G, j) do { if (G) { kload2(kf, kp0 + sl_next, j); FD_SBAR(); } } while (0)
#define FD_STEP(C0, C1, P0, P1, t, GK, GV, GL, GM) do { FD_SBAR(); \
        const lds_cptr vp_ = vp0 + sl_prev; FD_QX(t); FD_MW(t); \
        FD_VRD(0); FD_SBAR(); float sacc = (P0[0] + P0[1]); \
        C0 = FD_MFMA(FD_KX(kxA), FD_KX(qx), f32x16{}); FD_SBAR(); C1 = FD_MFMA(FD_KX(kxB), FD_KX(qx), f32x16{}); FD_SBAR(); \
        FD_GAPA(C0 = FD_MFMA(kf[0], qr[0], C0), P0[2], P0[3], P0[4], P0[5],     pw0[0] = FD_PKW(P0, 0), pw0[1] = FD_PKW(P0, 2), pw0); \
        FD_VRD(4); FD_SBAR(); FD_GAPA(C1 = FD_MFMA(kf[1], qr[0], C1), P0[6], P0[7], P0[8], P0[9],     pw0[2] = FD_PKW(P0, 4), pw0[3] = FD_PKW(P0, 6), pw0); \
        FD_VRD(1); FD_SBAR(); FD_GAPA(C0 = FD_MFMA(kf[2], qr[1], C0), P0[10], P0[11], P0[12], P0[13], pw1[0] = FD_PKW(P0, 8), pw1[1] = FD_PKW(P0, 10), pw1); \
        FD_VRD(5); FD_SBAR(); FD_GAPA(C1 = FD_MFMA(kf[3], qr[1], C1), P0[14], P0[15], P1[0], P1[1],   pw1[2] = FD_PKW(P0, 12), pw1[3] = FD_PKW(P0, 14), pw1); \
        FD_VRD(2); FD_SBAR(); FD_GAPA(C0 = FD_MFMA(kf[4], qr[2], C0), P1[2], P1[3], P1[4], P1[5],     pw2[0] = FD_PKW(P1, 0), pw2[1] = FD_PKW(P1, 2), pw2); \
        FD_VRD(6); FD_SBAR(); FD_GAPA(C1 = FD_MFMA(kf[5], qr[2], C1), P1[6], P1[7], P1[8], P1[9],     pw2[2] = FD_PKW(P1, 4), pw2[3] = FD_PKW(P1, 6), pw2); \
        FD_VRD(3); FD_SBAR(); FD_GAPA(C0 = FD_MFMA(kf[6], qr[3], C0), P1[10], P1[11], P1[12], P1[13], pw3[0] = FD_PKW(P1, 8), pw3[1] = FD_PKW(P1, 10), pw3); \
        FD_VRD(7); FD_SBAR(); FD_GAPA(C1 = FD_MFMA(kf[7], qr[3], C1), P1[14], P1[15], 0.f, 0.f,       pw3[2] = FD_PKW(P1, 12), pw3[3] = FD_PKW(P1, 14), pw3); \
        l_reg += sacc; \
        if (GK) { FD_DMA_K((t) + 3, sl_cur); } if (GV) { FD_DMA_V((t) + 1, sl_next); } if (!SWA && (GM)) { FD_DMA_M((t) + 2); } \
        FD_CMASK(C0, C1, t); \
        { float a = FD_MX3(C0[0], C0[1], C1[0]), bb = FD_MX3(C0[2], C0[3], C1[1]); a = FD_MX3(a, C1[2], C1[3]); \
          _Pragma("unroll") for (int r = 4; r < 16; r += 4) { a = FD_MX3(a, C0[r], C0[r + 1]); bb = FD_MX3(bb, C0[r + 2], C0[r + 3]); a = FD_MX3(a, C1[r], C1[r + 1]); bb = FD_MX3(bb, C1[r + 2], C1[r + 3]); } \
          const float rm = fa::xhalf_max(__builtin_fmaxf(a, bb)); \
          resc = false; \
          if (__builtin_expect(__any(rm > 8.0f), 0)) { const float dl = __builtin_fmaxf(rm, 0.f); mhat += dl; \
              _Pragma("unroll") for (int r = 0; r < 16; ++r) { C0[r] -= dl; C1[r] -= dl; } \
              const float f = __builtin_amdgcn_exp2f(-dl); l_reg *= f; if (hi == 0) wsf[r32] = f; resc = true; } } \
        FD_SBAR(); \
        FD_GAPB(o[0] = FD_MFMA(FD_PAF(0), FD_VFR(0), o[0]), C0, 0, C0, w0_, -1); \
        FD_GAPB(o[1] = FD_MFMA(FD_PAF(0), FD_VFR(4), o[1]), C0, 4, C0, w0_, 0); \
        FD_KRD(GL, 0); FD_GAPB(o[0] = FD_MFMA(FD_PAF(1), FD_VFR(1), o[0]), C0, 8, C0, w0_, 4); \
        FD_KRD(GL, 1); FD_GAPB(o[1] = FD_MFMA(FD_PAF(1), FD_VFR(5), o[1]), C0, 12, C0, w0_, 8); \
        FD_KRD(GL, 2); FD_GAPB(o[0] = FD_MFMA(FD_PAF(2), FD_VFR(2), o[0]), C1, 0, C0, w0_, 12); \
        FD_KRD(GL, 3); FD_GAPB(o[1] = FD_MFMA(FD_PAF(2), FD_VFR(6), o[1]), C1, 4, C1, w1_, 0); \
        FD_GAPB(o[0] = FD_MFMA(FD_PAF(3), FD_VFR(3), o[0]), C1, 8, C1, w1_, 4); \
        FD_GAPB(o[1] = FD_MFMA(FD_PAF(3), FD_VFR(7), o[1]), C1, 12, C1, w1_, 8); \
        FD_AND(C1, w1_, 12); FD_PIN(C1); FD_SBAR(); \
        } while (0)
#define FD_ENDW(n_) do { if ((n_) == 3) { FD_WAIT_BAR(3); } else if ((n_) == 2) { FD_WAIT_BAR(2); } else if ((n_) == 1) { FD_WAIT_BAR(1); } else { FD_WAIT_BAR(0); } } while (0)
    int t = 1;
#undef FD_CMASK
#define FD_CMASK(P0, P1, t) do { } while (0)
    for (; t + 5 < NT; t += 2) {
        FD_STEP(pB0, pB1, pA0, pA1, t, true, true, true, false);     FD_WAIT_BAR(2); FD_RESC(); FD_ROT();
        FD_STEP(pA0, pA1, pB0, pB1, t + 1, true, true, true, true);  if (SWA) { FD_WAIT_BAR(2); } else { FD_WAIT_BAR(3); } FD_RESC(); FD_ROT();
    }
#undef FD_CMASK
#define FD_CMASK(P0, P1, t) do { const int jb_ = (t) - (NT - 4); if (jb_ >= 0) cmask(P0, P1, jb_, qrel, hi); } while (0)
    for (; t + 1 < NT; t += 2) {
        { const bool gk = t + 3 < NT, gv = t + 1 < NT; FD_STEP(pB0, pB1, pA0, pA1, t, gk, gv, gv, false); const int n_ = (t + 2 < NT) ? ((int)gk + (int)gv) : 0; FD_ENDW(n_); FD_RESC(); FD_ROT(); }
        { const bool gk = t + 4 < NT, gv = t + 2 < NT, gm = t + 3 < NT; FD_STEP(pA0, pA1, pB0, pB1, t + 1, gk, gv, gv, gm); const int n_ = (t + 3 < NT) ? ((int)gk + (int)gv + (SWA ? 0 : (int)gm)) : 0; FD_ENDW(n_); FD_RESC(); FD_ROT(); }
    }
    FD_STEP(pB0, pB1, pA0, pA1, NT - 1, false, false, false, false); FD_RESC();
    { float sacc = pB0[0] + pB0[1];
#pragma unroll
      for (int r = 2; r < 16; ++r) sacc += pB0[r];
#pragma unroll
      for (int r = 0; r < 16; ++r) sacc += pB1[r];
      l_reg += sacc;
      pw0 = (u32x4){FD_PKW(pB0, 0), FD_PKW(pB0, 2), FD_PKW(pB0, 4), FD_PKW(pB0, 6)}; pw1 = (u32x4){FD_PKW(pB0, 8), FD_PKW(pB0, 10), FD_PKW(pB0, 12), FD_PKW(pB0, 14)};
      pw2 = (u32x4){FD_PKW(pB1, 0), FD_PKW(pB1, 2), FD_PKW(pB1, 4), FD_PKW(pB1, 6)}; pw3 = (u32x4){FD_PKW(pB1, 8), FD_PKW(pB1, 10), FD_PKW(pB1, 12), FD_PKW(pB1, 14)};
      FD_SBAR();
      const lds_cptr vp_ = vp0 + sl_cur;
#pragma unroll
      for (int i = 0; i < 8; ++i) FD_VRD(i);
      o[0] = FD_MFMA(FD_PAF(0), FD_VFR(0), o[0]); o[1] = FD_MFMA(FD_PAF(0), FD_VFR(4), o[1]); o[0] = FD_MFMA(FD_PAF(1), FD_VFR(1), o[0]); o[1] = FD_MFMA(FD_PAF(1), FD_VFR(5), o[1]);
      o[0] = FD_MFMA(FD_PAF(2), FD_VFR(2), o[0]); o[1] = FD_MFMA(FD_PAF(2), FD_VFR(6), o[1]); o[0] = FD_MFMA(FD_PAF(3), FD_VFR(3), o[0]); o[1] = FD_MFMA(FD_PAF(3), FD_VFR(7), o[1]); }
    { float la_ = l_reg, lb_ = l_reg; asm volatile("s_nop 1\n\tv_permlane32_swap_b32 %0, %1\n\ts_nop 1" : "+v"(la_), "+v"(lb_)); l_reg = la_ + lb_; }
    if (hi == 0) wsf[32 + r32] = l_reg;
    asm volatile("s_waitcnt lgkmcnt(0)" ::: "memory");
    LAS bf16_t* stg = (LAS bf16_t*)(shm + LDS_OST) + wid * 2048;
#pragma unroll
    for (int r = 0; r < 16; ++r) { const int orow = crow(r, hi); const float rl = __builtin_amdgcn_rcpf(wsf[32 + orow]);
        stg[orow * 64 + r32] = (bf16_t)f2bf(o[0][r] * rl); stg[orow * 64 + 32 + r32] = (bf16_t)f2bf(o[1][r] * rl); }
    asm volatile("s_waitcnt lgkmcnt(0)" ::: "memory");
    bf16_t* Ow = P.O + (rowbase + q0 + 32 * wid) * (long)P.ldo;
#pragma unroll
    for (int i = 0; i < 4; ++i) { const int row = i * 8 + (lane >> 3), ch = lane & 7; *(u32x4*)(Ow + (long)row * P.ldo + ch * 8) = *(const LAS u32x4*)(stg + row * 64 + ch * 8); }
    asm volatile("s_waitcnt lgkmcnt(0)\n\ts_barrier" ::: "memory");
#undef FD_DMA_K
#undef FD_DMA_V
#undef FD_DMA_M
#undef FD_QX
#undef FD_KX
#undef FD_CMASK
#undef FD_MW
#undef FD_AND
#undef FD_RESC
#undef FD_ROT
#undef FD_PKW
#undef FD_PAF
#undef FD_VFR
#undef FD_PIN
#undef FD_MX3
#undef FD_GAPA
#undef FD_GAPB
#undef FD_VRD
#undef FD_KRD
#undef FD_STEP
#undef FD_ENDW
}
#undef FD_SBAR
#undef FD_WAIT_BAR
#undef FD_MFMA
}

namespace fm {
using fa::lds_cptr; using fa::v4i16_t; using fa::vtr; using fa::glds16; using fa::crow;
constexpr int NSLOT = 3, SLOTK = 12288, SLOTV = 8192, LDS_K = 0, LDS_V = NSLOT * SLOTK, LDS_WS = LDS_V + NSLOT * SLOTV, LDS_OST = LDS_WS + 8 * 256, LDS_TOTAL = LDS_OST + 8 * 4096;
static_assert(LDS_TOTAL <= LDSCTL_OFF, "mla unit LDS");
#define FM_SBAR() __builtin_amdgcn_sched_barrier(0)
#define FM_WAIT_BAR(N) asm volatile("s_waitcnt vmcnt(" #N ") lgkmcnt(0)\n\ts_barrier" ::: "memory")
#define FM_MFMA(a, b, c) __builtin_amdgcn_mfma_f32_32x32x16_bf16(a, b, c, 0, 0, 0)
__device__ __forceinline__ void kload2(bf16x8* kf, lds_cptr kp, int j) { kf[2 * j] = *(const LAS bf16x8*)(kp + j * 2048); kf[2 * j + 1] = *(const LAS bf16x8*)(kp + j * 2048 + 512); }

__device__ __forceinline__ void unit(const Frame& F, const fa::Ptrs& P, int b, int qb) {
    const int lane = F.lane, r32 = lane & 31, hi = lane >> 5, wid = F.wave;
    const long rowbase = (long)b * SEQ; const int q0 = qb * 256, qrel = wid * 32 + r32, qidx = q0 + qrel;
    LAS unsigned char* shm = F.lds; const unsigned lds0 = (unsigned)(uintptr_t)shm;
    LAS float* wsf = (LAS float*)(shm + LDS_WS) + wid * 64;
    const bf16_t* ksrc = P.K + (rowbase + lane) * (long)P.ldk + wid * 8;
    const bf16_t* krsrc = P.KR + (rowbase + lane) * 32L + (wid & 3) * 8;
    const bf16_t* vsrc = P.V + (rowbase + 16 * (wid & 3) + (lane >> 2)) * (long)P.ldv + (wid >> 2) * 32 + (lane & 3) * 8;
    const unsigned kdst = lds0 + LDS_K + wid * 1024, krdst = lds0 + LDS_K + (8 + (wid & 3)) * 1024, vdst = lds0 + LDS_V + wid * 1024;
#define FM_DMA_K(t, slot) do { glds16(ksrc + (long)(t) * 64 * P.ldk, (unsigned)__builtin_amdgcn_readfirstlane(kdst + (slot))); glds16(krsrc + (long)(t) * 64 * 32, (unsigned)__builtin_amdgcn_readfirstlane(krdst + (slot))); } while (0)
#define FM_DMA_V(t, slot) glds16(vsrc + (long)(t) * 64 * P.ldv, (unsigned)__builtin_amdgcn_readfirstlane(vdst + (slot)))
    const lds_cptr shm3 = (lds_cptr)shm; const lds_cptr kp0 = shm3 + LDS_K + hi * 1024 + r32 * 16; const lds_cptr vp0 = shm3 + LDS_V + ((lane >> 4) & 1) * 32 + (lane & 3) * 8 + (4 * hi + ((lane & 15) >> 2)) * 64;
    const int NT = (q0 + 256) / 64;
    FM_DMA_K(0, 0); FM_DMA_V(0, 0); FM_DMA_K(1, SLOTK);
    bf16x8 qr[6];
    { const bf16_t* Qw = P.Q + (rowbase + qidx) * (long)P.ldq + hi * 8;
#pragma unroll
      for (int d0 = 0; d0 < 6; ++d0) qr[d0] = *(const bf16x8*)(Qw + d0 * 16); }
    float mhat = 0.f, l_reg = 0.f; f32x16 o[2]; o[0] = f32x16{}; o[1] = f32x16{};
#define FM_CMASK(P0, P1, t) do { const int jb_ = (t) - (NT - 4); if (jb_ >= 0) fd::cmask(P0, P1, jb_, qrel, hi); } while (0)
    bool resc = false;
#define FM_RESC() do { if (resc) { asm volatile("s_waitcnt lgkmcnt(0)" ::: "memory"); \
        _Pragma("unroll") for (int d_ = 0; d_ < 2; ++d_) _Pragma("unroll") for (int r = 0; r < 16; ++r) o[d_][r] *= wsf[crow(r, hi)]; } } while (0)
    f32x16 pA0, pA1, pB0, pB1; bf16x8 kf[12];
    int kl_prev = 0, kl_cur = 0, kl_next = SLOTK, vl_prev = 0, vl_cur = 0, vl_next = SLOTV;
#define FM_ROT() do { kl_prev = kl_cur; kl_cur = kl_next; kl_next = (kl_next == (NSLOT - 1) * SLOTK) ? 0 : kl_next + SLOTK; vl_prev = vl_cur; vl_cur = vl_next; vl_next = (vl_next == (NSLOT - 1) * SLOTV) ? 0 : vl_next + SLOTV; } while (0)
    FM_DMA_K(2, 2 * SLOTK);
    FM_WAIT_BAR(5);
#pragma unroll
    for (int j = 0; j < 6; ++j) kload2(kf, kp0, j);
    pA0 = FM_MFMA(kf[0], qr[0], f32x16{}); pA1 = FM_MFMA(kf[1], qr[0], f32x16{});
#pragma unroll
    for (int d0 = 1; d0 < 6; ++d0) { pA0 = FM_MFMA(kf[2 * d0], qr[d0], pA0); pA1 = FM_MFMA(kf[2 * d0 + 1], qr[d0], pA1); }
    asm volatile("s_nop 15\n\ts_nop 7" : "+v"(pA0), "+v"(pA1));
    FM_CMASK(pA0, pA1, 0);
    { const float rm = fd::rowmax(pA0, pA1); const float dl = rm; mhat += dl;
#pragma unroll
      for (int r = 0; r < 16; ++r) { pA0[r] -= dl; pA1[r] -= dl; }
#pragma unroll
      for (int r = 0; r < 16; ++r) { pA0[r] = __builtin_amdgcn_exp2f(pA0[r]); pA1[r] = __builtin_amdgcn_exp2f(pA1[r]); } }
    FM_WAIT_BAR(0);
    FM_DMA_K(3, 0); FM_DMA_V(1, SLOTV);
    FM_ROT();
#pragma unroll
    for (int j = 0; j < 6; ++j) kload2(kf, kp0 + kl_cur, j);
    FM_WAIT_BAR(3);
    v4i16_t vlo[8], vhi[8]; u32x4 pw[4];
#define FM_VFR(i) (bf16x8){vlo[i][0], vlo[i][1], vlo[i][2], vlo[i][3], vhi[i][0], vhi[i][1], vhi[i][2], vhi[i][3]}
#define FM_PIN(x) asm volatile("" : "+v"(x))
#define FM_MX3(a, b, c) __builtin_fmaxf(__builtin_fmaxf((a), (b)), (c))
#define FM_VRD(i) do { vlo[i] = vtr(vp_ + (((i) >> 2) * 4096 + ((i) & 3) * 1024)); vhi[i] = vtr(vp_ + (((i) >> 2) * 4096 + ((i) & 3) * 1024 + 512)); } while (0)
#define FM_PE(P0, P1, e) (((e) < 16) ? P0[(e) & 15] : P1[(e) & 15])
#define FM_STEP(C0, C1, P0, P1, t, GK, GV, GL) do { FM_SBAR(); \
        const lds_cptr vp_ = vp0 + vl_prev; float sacc = (P0[0] + P0[1]); \
        _Pragma("unroll") for (int i_ = 0; i_ < 12; ++i_) { \
            if (i_ < 8) { const int vi_ = (i_ >> 1) + 4 * (i_ & 1); FM_VRD(vi_); FM_SBAR(); } \
            if (i_ == 0) C0 = FM_MFMA(kf[0], qr[0], f32x16{}); else if (i_ == 1) C1 = FM_MFMA(kf[1], qr[0], f32x16{}); \
            else if (i_ & 1) C1 = FM_MFMA(kf[i_], qr[i_ >> 1], C1); else C0 = FM_MFMA(kf[i_], qr[i_ >> 1], C0); \
            _Pragma("unroll") for (int e_ = 2 + (30 * i_) / 12; e_ < 2 + (30 * (i_ + 1)) / 12; ++e_) sacc += FM_PE(P0, P1, e_); \
            FM_PIN(sacc); \
            _Pragma("unroll") for (int j_ = (16 * i_) / 12; j_ < (16 * (i_ + 1)) / 12; ++j_) { pw[j_ >> 2][j_ & 3] = cvt_pk_bf16(FM_PE(P0, P1, 2 * j_), FM_PE(P0, P1, 2 * j_ + 1)); FM_PIN(pw[j_ >> 2]); } \
            FM_SBAR(); } \
        l_reg += sacc; \
        if (GK) { FM_DMA_K((t) + 3, kl_cur); } if (GV) { FM_DMA_V((t) + 1, vl_next); } \
        FM_CMASK(C0, C1, t); \
        { float a = FM_MX3(C0[0], C0[1], C1[0]), bb = FM_MX3(C0[2], C0[3], C1[1]); a = FM_MX3(a, C1[2], C1[3]); \
          _Pragma("unroll") for (int r = 4; r < 16; r += 4) { a = FM_MX3(a, C0[r], C0[r + 1]); bb = FM_MX3(bb, C0[r + 2], C0[r + 3]); a = FM_MX3(a, C1[r], C1[r + 1]); bb = FM_MX3(bb, C1[r + 2], C1[r + 3]); } \
          const float rm = fa::xhalf_max(__builtin_fmaxf(a, bb)); \
          resc = false; \
          if (__builtin_expect(__any(rm > mhat + 8.0f), 0)) { const float dl = (rm > mhat + 8.0f) ? rm - mhat : 0.f; mhat += dl;        \
              const float f = __builtin_amdgcn_exp2f(-dl); l_reg *= f; if (hi == 0) wsf[r32] = f; resc = true; } } \
        FM_SBAR(); \
        _Pragma("unroll") for (int j_ = 0; j_ < 8; ++j_) { \
            if ((GL) && j_ >= 1 && j_ <= 6) { kload2(kf, kp0 + kl_next, j_ - 1); FM_SBAR(); } \
            if (j_ & 1) o[1] = FM_MFMA(__builtin_bit_cast(bf16x8, pw[j_ >> 1]), FM_VFR(4 + (j_ >> 1)), o[1]); else o[0] = FM_MFMA(__builtin_bit_cast(bf16x8, pw[j_ >> 1]), FM_VFR(j_ >> 1), o[0]); \
            if (j_ < 4) { C0[4 * j_] = __builtin_amdgcn_exp2f(C0[4 * j_] - mhat); C0[4 * j_ + 1] = __builtin_amdgcn_exp2f(C0[4 * j_ + 1] - mhat); C0[4 * j_ + 2] = __builtin_amdgcn_exp2f(C0[4 * j_ + 2] - mhat); C0[4 * j_ + 3] = __builtin_amdgcn_exp2f(C0[4 * j_ + 3] - mhat); FM_PIN(C0); } \
            else { C1[4 * (j_ & 3)] = __builtin_amdgcn_exp2f(C1[4 * (j_ & 3)] - mhat); C1[4 * (j_ & 3) + 1] = __builtin_amdgcn_exp2f(C1[4 * (j_ & 3) + 1] - mhat); C1[4 * (j_ & 3) + 2] = __builtin_amdgcn_exp2f(C1[4 * (j_ & 3) + 2] - mhat); C1[4 * (j_ & 3) + 3] = __builtin_amdgcn_exp2f(C1[4 * (j_ & 3) + 3] - mhat); FM_PIN(C1); } \
            FM_SBAR(); } \
        } while (0)
#define FM_ENDW(n_) do { if ((n_) == 3) { FM_WAIT_BAR(3); } else if ((n_) == 2) { FM_WAIT_BAR(2); } else if ((n_) == 1) { FM_WAIT_BAR(1); } else { FM_WAIT_BAR(0); } } while (0)
    int t = 1;
#undef FM_CMASK
#define FM_CMASK(P0, P1, t) do { } while (0)
    for (; t + 5 < NT; t += 2) {
        FM_STEP(pB0, pB1, pA0, pA1, t, true, true, true);     FM_WAIT_BAR(3); FM_RESC(); FM_ROT();
        FM_STEP(pA0, pA1, pB0, pB1, t + 1, true, true, true); FM_WAIT_BAR(3); FM_RESC(); FM_ROT();
    }
#undef FM_CMASK
#define FM_CMASK(P0, P1, t) do { const int jb_ = (t) - (NT - 4); if (jb_ >= 0) fd::cmask(P0, P1, jb_, qrel, hi); } while (0)
    for (; t + 1 < NT; t += 2) {
        { const bool gk = t + 3 < NT, gv = t + 1 < NT; FM_STEP(pB0, pB1, pA0, pA1, t, gk, gv, gv); const int n_ = (t + 2 < NT) ? (2 * (int)gk + (int)gv) : 0; FM_ENDW(n_); FM_RESC(); FM_ROT(); }
        { const bool gk = t + 4 < NT, gv = t + 2 < NT; FM_STEP(pA0, pA1, pB0, pB1, t + 1, gk, gv, gv); const int n_ = (t + 3 < NT) ? (2 * (int)gk + (int)gv) : 0; FM_ENDW(n_); FM_RESC(); FM_ROT(); }
    }
    FM_STEP(pB0, pB1, pA0, pA1, NT - 1, false, false, false); FM_RESC();
    { float sacc = pB0[0] + pB0[1];
#pragma unroll
      for (int r = 2; r < 16; ++r) sacc += pB0[r];
#pragma unroll
      for (int r = 0; r < 16; ++r) sacc += pB1[r];
      l_reg += sacc;
#pragma unroll
      for (int j = 0; j < 16; ++j) pw[j >> 2][j & 3] = cvt_pk_bf16(FM_PE(pB0, pB1, 2 * j), FM_PE(pB0, pB1, 2 * j + 1));
      FM_SBAR();
      const lds_cptr vp_ = vp0 + vl_cur;
#pragma unroll
      for (int i = 0; i < 8; ++i) FM_VRD(i);
#pragma unroll
      for (int k = 0; k < 4; ++k) { o[0] = FM_MFMA(__builtin_bit_cast(bf16x8, pw[k]), FM_VFR(k), o[0]); o[1] = FM_MFMA(__builtin_bit_cast(bf16x8, pw[k]), FM_VFR(4 + k), o[1]); } }
    { float la_ = l_reg, lb_ = l_reg; asm volatile("s_nop 1\n\tv_permlane32_swap_b32 %0, %1\n\ts_nop 1" : "+v"(la_), "+v"(lb_)); l_reg = la_ + lb_; }
    if (hi == 0) wsf[32 + r32] = l_reg;
    asm volatile("s_waitcnt lgkmcnt(0)" ::: "memory");
    LAS bf16_t* stg = (LAS bf16_t*)(shm + LDS_OST) + wid * 2048;
#pragma unroll
    for (int r = 0; r < 16; ++r) { const int orow = crow(r, hi); const float rl = __builtin_amdgcn_rcpf(wsf[32 + orow]);
        stg[orow * 64 + r32] = (bf16_t)f2bf(o[0][r] * rl); stg[orow * 64 + 32 + r32] = (bf16_t)f2bf(o[1][r] * rl); }
    asm volatile("s_waitcnt lgkmcnt(0)" ::: "memory");
    bf16_t* Ow = P.O + (rowbase + q0 + 32 * wid) * (long)P.ldo;
#pragma unroll
    for (int i = 0; i < 4; ++i) { const int row = i * 8 + (lane >> 3), ch = lane & 7; *(u32x4*)(Ow + (long)row * P.ldo + ch * 8) = *(const LAS u32x4*)(stg + row * 64 + ch * 8); }
    asm volatile("s_waitcnt lgkmcnt(0)\n\ts_barrier" ::: "memory");
#undef FM_DMA_K
#undef FM_DMA_V
#undef FM_CMASK
#undef FM_RESC
#undef FM_ROT
#undef FM_VFR
#undef FM_PIN
#undef FM_MX3
#undef FM_VRD
#undef FM_PE
#undef FM_STEP
#undef FM_ENDW
}
#undef FM_SBAR
#undef FM_WAIT_BAR
#undef FM_MFMA
}


namespace ix {
__device__ __forceinline__ unsigned ordf(float f) { const unsigned u = __builtin_bit_cast(unsigned, f); return u ^ ((u >> 31) ? 0xFFFFFFFFu : 0x80000000u); }
constexpr int L_HIST = EXTRA_OFF, L_MK = EXTRA_OFF + 16384, L_CV = L_MK + 4096, L_CI = L_CV + 1024, L_RED = L_CI + 1024, L_SELW = L_RED + 256, L_FLAG = L_SELW + 64;
struct Pre { bf16x8 qi[4]; float w[2][8]; bf16x8 kbA[4], kbB[4]; };
__device__ __forceinline__ void preload(const Frame& F, const bf16_t* Z, const bf16_t* KIT, int b, int qu, Pre& pre) {
    const int lane = F.lane, r32 = lane & 31, hi = lane >> 5, wid = F.wave;
    const long rowbase = (long)b * SEQ; const int t0 = 4 * qu, ntile = (t0 >> 5) + 1, npair = (ntile + 1) >> 1;
    { const int rho = r32, hq = (rho >> 2) & 1, gq = rho >> 3, iq = rho & 3;
      const bf16_t* qp = Z + (rowbase + t0 + 2 * hq + (gq >> 1)) * (long)ZP + ZC_IQ + 64 * (4 * (gq & 1) + iq) + 8 * hi;
#pragma unroll
      for (int ks = 0; ks < 4; ++ks) pre.qi[ks] = *(const bf16x8*)(qp + 16 * ks);
#pragma unroll
      for (int q2 = 0; q2 < 2; ++q2) { const u32x4 ww = *(const u32x4*)(Z + (rowbase + t0 + 2 * hi + q2) * (long)ZP + ZC_IW);
          pre.w[q2][0] = bf_lo(ww.x); pre.w[q2][1] = bf_hi(ww.x); pre.w[q2][2] = bf_lo(ww.y); pre.w[q2][3] = bf_hi(ww.y); pre.w[q2][4] = bf_lo(ww.z); pre.w[q2][5] = bf_hi(ww.z); pre.w[q2][6] = bf_lo(ww.w); pre.w[q2][7] = bf_hi(ww.w); } }
    const bf16_t* kbase = KIT + (size_t)(rowbase >> 5) * 2048 + hi * 256 + r32 * 8;
    if (wid < npair) { const bf16_t* kp = kbase + (size_t)(2 * wid) * 2048;
#pragma unroll
        for (int ks = 0; ks < 4; ++ks) { pre.kbA[ks] = *(const bf16x8*)(kp + 512 * ks); pre.kbB[ks] = *(const bf16x8*)(kp + 2048 + 512 * ks); } }
    else {
#pragma unroll
        for (int ks = 0; ks < 4; ++ks) { pre.kbA[ks] = bf16x8{}; pre.kbB[ks] = bf16x8{}; } }
}
__device__ __forceinline__ float relu1(float x) { const int i = __builtin_bit_cast(int, x); return __builtin_bit_cast(float, i > 0 ? i : 0); }
#define IX_BAR() asm volatile("s_waitcnt lgkmcnt(0)\n\ts_barrier" ::: "memory")
__device__ __forceinline__ void unit(const Frame& F, const bf16_t* Z, const bf16_t* KIT, unsigned* MK, int b, int qu, Pre& pre, bool has_next, int nb, int nqu) {
    const int lane = F.lane, r32 = lane & 31, hi = lane >> 5, wid = F.wave;
    const long rowbase = (long)b * SEQ; const int t0 = 4 * qu, ntile = (t0 >> 5) + 1, nk32 = 32 * ntile, nblk = (nk32 + 63) >> 6;
    LAS float* sc = (LAS float*)F.lds;
    LAS unsigned* hist = (LAS unsigned*)(F.lds + L_HIST);
    LAS unsigned* mk = (LAS unsigned*)(F.lds + L_MK);
    LAS float* cval = (LAS float*)(F.lds + L_CV); LAS unsigned* cidx = (LAS unsigned*)(F.lds + L_CI);
    LAS float* red = (LAS float*)(F.lds + L_RED);
    LAS unsigned* selw = (LAS unsigned*)(F.lds + L_SELW);
    LAS unsigned* flag = (LAS unsigned*)(F.lds + L_FLAG);
    bf16x8 qi[4]; float w[2][8];
#pragma unroll
    for (int ks = 0; ks < 4; ++ks) qi[ks] = pre.qi[ks];
#pragma unroll
    for (int q2 = 0; q2 < 2; ++q2)
#pragma unroll
        for (int e = 0; e < 8; ++e) w[q2][e] = pre.w[q2][e];
    float vmaxA = -INFINITY, vmaxB = -INFINITY, vminA = INFINITY, vminB = INFINITY;
    bf16x8 kq[2][8];
    const int npair = (ntile + 1) >> 1;
    const bf16_t* kbase = KIT + (size_t)(rowbase >> 5) * 2048 + hi * 256 + r32 * 8;
#pragma unroll
    for (int ks = 0; ks < 4; ++ks) { kq[0][ks] = pre.kbA[ks]; kq[0][4 + ks] = pre.kbB[ks]; }
#define IX_LOADP(BUF, PP) do { const bf16_t* kp_ = kbase + (size_t)(2 * (PP)) * 2048; \
        _Pragma("unroll") for (int ks = 0; ks < 4; ++ks) { kq[BUF][ks] = *(const bf16x8*)(kp_ + 512 * ks); kq[BUF][4 + ks] = *(const bf16x8*)(kp_ + 2048 + 512 * ks); } } while (0)
    if (wid + NWAVES < npair) IX_LOADP(1, wid + NWAVES);
    else {
#pragma unroll
        for (int ks = 0; ks < 8; ++ks) kq[1][ks] = bf16x8{}; }
#define IX_ELEM(D, e, sa, sb) do { const float ra_ = relu1(D[e]), rb_ = relu1(D[8 + (e)]); sa = __builtin_fmaf(w[0][e], ra_, sa); sb = __builtin_fmaf(w[1][e], rb_, sb); } while (0)
#define IX_TAIL(sa, sb, S0) do { const int s = (S0) + r32;                       \
        if (s > t0 + 2 * hi) sa = -INFINITY; else { vmaxA = __builtin_fmaxf(vmaxA, sa); vminA = __builtin_fminf(vminA, sa); } \
        if (s > t0 + 2 * hi + 1) sb = -INFINITY; else { vmaxB = __builtin_fmaxf(vmaxB, sb); vminB = __builtin_fminf(vminB, sb); } \
        sc[(2 * hi) * 8192 + s] = sa; sc[(2 * hi + 1) * 8192 + s] = sb; } while (0)
#define IX_PIN2(x, y) asm volatile("" : "+v"(x), "+v"(y))
#define IX_MF(a, b, c) __builtin_amdgcn_mfma_f32_32x32x16_bf16(a, b, c, 0, 0, 0)
#define IX_GAP(MF, D, e0, sa, sb) do { MF; IX_ELEM(D, e0, sa, sb); IX_ELEM(D, (e0) + 1, sa, sb); IX_PIN2(sa, sb); __builtin_amdgcn_sched_barrier(0); } while (0)
#define IX_PIPE(cA, cB, nA, nB, KQ, P, HASN) do { const int s0_ = 64 * (P); float sa = 0.f, sb = 0.f; __builtin_amdgcn_sched_barrier(0); \
        if (HASN) { \
            IX_GAP(nA = IX_MF(qi[0], KQ[0], f32x16{}), cA, 0, sa, sb); IX_GAP(nB = IX_MF(qi[0], KQ[4], f32x16{}), cA, 2, sa, sb); \
            IX_GAP(nA = IX_MF(qi[1], KQ[1], nA), cA, 4, sa, sb);       IX_GAP(nB = IX_MF(qi[1], KQ[5], nB), cA, 6, sa, sb); \
            IX_TAIL(sa, sb, s0_); sa = 0.f; sb = 0.f; __builtin_amdgcn_sched_barrier(0); \
            IX_GAP(nA = IX_MF(qi[2], KQ[2], nA), cB, 0, sa, sb);       IX_GAP(nB = IX_MF(qi[2], KQ[6], nB), cB, 2, sa, sb); \
            IX_GAP(nA = IX_MF(qi[3], KQ[3], nA), cB, 4, sa, sb);       IX_GAP(nB = IX_MF(qi[3], KQ[7], nB), cB, 6, sa, sb); \
        } else { \
            IX_ELEM(cA, 0, sa, sb); IX_ELEM(cA, 1, sa, sb); IX_ELEM(cA, 2, sa, sb); IX_ELEM(cA, 3, sa, sb); IX_ELEM(cA, 4, sa, sb); IX_ELEM(cA, 5, sa, sb); IX_ELEM(cA, 6, sa, sb); IX_ELEM(cA, 7, sa, sb); \
            IX_TAIL(sa, sb, s0_); sa = 0.f; sb = 0.f; \
            IX_ELEM(cB, 0, sa, sb); IX_ELEM(cB, 1, sa, sb); IX_ELEM(cB, 2, sa, sb); IX_ELEM(cB, 3, sa, sb); IX_ELEM(cB, 4, sa, sb); IX_ELEM(cB, 5, sa, sb); IX_ELEM(cB, 6, sa, sb); IX_ELEM(cB, 7, sa, sb); \
        } \
        if (s0_ + 32 < nk32) IX_TAIL(sa, sb, s0_ + 32); __builtin_amdgcn_sched_barrier(0); } while (0)
    f32x16 dA = {}, dB = {}, eA = {}, eB = {};
    if (wid < npair) {
#pragma unroll
        for (int ks = 0; ks < 4; ++ks) { dA = IX_MF(qi[ks], kq[0][ks], dA); dB = IX_MF(qi[ks], kq[0][4 + ks], dB); }
        if (wid + 2 * NWAVES < npair) IX_LOADP(0, wid + 2 * NWAVES);
    }
    for (int p0_ = wid; p0_ < npair; p0_ += 2 * NWAVES) {
        { const int p = p0_, pn = p + NWAVES; const bool hn = pn < npair;
          IX_PIPE(dA, dB, eA, eB, kq[1], p, hn); if (pn + 2 * NWAVES < npair) IX_LOADP(1, pn + 2 * NWAVES); }
        { const int p = p0_ + NWAVES, pn = p + NWAVES; if (p < npair) { const bool hn = pn < npair;
          IX_PIPE(eA, eB, dA, dB, kq[0], p, hn); if (pn + 2 * NWAVES < npair) IX_LOADP(0, pn + 2 * NWAVES); } }
    }
#undef IX_LOADP
#undef IX_ELEM
#undef IX_TAIL
#undef IX_PIN2
#undef IX_MF
#undef IX_GAP
#undef IX_PIPE
    if (has_next) preload(F, Z, KIT, nb, nqu, pre);
    const bool need_sel = (t0 + 4 > 256);
    if (need_sel) {
#pragma unroll
        for (int o = 1; o < 32; o <<= 1) { vmaxA = __builtin_fmaxf(vmaxA, __shfl_xor(vmaxA, o)); vmaxB = __builtin_fmaxf(vmaxB, __shfl_xor(vmaxB, o));
                                           vminA = __builtin_fminf(vminA, __shfl_xor(vminA, o)); vminB = __builtin_fminf(vminB, __shfl_xor(vminB, o)); }
        if (r32 == 0) { red[wid * 8 + 2 * hi] = vmaxA; red[wid * 8 + 2 * hi + 1] = vmaxB; red[wid * 8 + 4 + 2 * hi] = vminA; red[wid * 8 + 5 + 2 * hi] = vminB; }
        hist[F.tid] = 0u; hist[F.tid + 512] = 0u; hist[F.tid + 1024] = 0u; hist[F.tid + 1536] = 0u; hist[F.tid + 2048] = 0u; hist[F.tid + 2560] = 0u; hist[F.tid + 3072] = 0u; hist[F.tid + 3584] = 0u;
        if (F.tid < 16) selw[F.tid] = 0u;
        if (F.tid == 0) flag[0] = 0u;
    }
    IX_BAR();
#if defined(DBG_DSA_SCORES)
    { float* dump = (float*)(F.wsp(WS_R2 + 56 * MiB));
      for (int qq = 0; qq < 4; ++qq) { const int tt = t0 + qq; int slot = -1;
          if (tt == 256) slot = 0; if (tt == 257) slot = 1; if (tt == 700) slot = 2; if (tt == 3001) slot = 3; if (tt == 8191) slot = 4;
          if (slot >= 0) for (int s = F.tid; s < nk32; s += 512) dump[((size_t)(b * 5 + slot)) * 8192 + s] = sc[qq * 8192 + s]; } }
#endif
    const int q = wid >> 1, sub = wid & 1, tq = t0 + q;
    if (!need_sel) {
        for (int blk = sub; blk < nblk; blk += 2) { const int s = 64 * blk + lane; const unsigned long long bal = __ballot(s <= tq);
            if (lane == 0) { mk[q * 256 + 2 * blk] = (unsigned)bal; mk[q * 256 + 2 * blk + 1] = (unsigned)(bal >> 32); } }
    } else {
        float maxv = red[q], minv = red[4 + q];
#pragma unroll
        for (int wv = 1; wv < 8; ++wv) { maxv = __builtin_fmaxf(maxv, red[wv * 8 + q]); minv = __builtin_fminf(minv, red[wv * 8 + 4 + q]); }
        const float rng = maxv - minv; const bool degenerate = !(rng > 0.f) || !(rng < 3.0e38f);
        const float scale = degenerate ? 0.f : 1023.99f / rng;
#ifdef DBG_FORCE_RADIX
        if (lane == 0) flag[0] = 1u;
#endif
        if (degenerate && lane == 0) flag[0] = 1u;
        { int idx = sub * 64 + lane;
          for (; idx + 384 <= tq; idx += 512) {
              const float v0 = sc[q * 8192 + idx], v1 = sc[q * 8192 + idx + 128], v2 = sc[q * 8192 + idx + 256], v3 = sc[q * 8192 + idx + 384];
              const int b0 = (int)((maxv - v0) * scale), b1 = (int)((maxv - v1) * scale), b2 = (int)((maxv - v2) * scale), b3 = (int)((maxv - v3) * scale);
              (void)__hip_atomic_fetch_add(&hist[q * 1024 + b0], 1u, __ATOMIC_RELAXED, __HIP_MEMORY_SCOPE_WORKGROUP); (void)__hip_atomic_fetch_add(&hist[q * 1024 + b1], 1u, __ATOMIC_RELAXED, __HIP_MEMORY_SCOPE_WORKGROUP);
              (void)__hip_atomic_fetch_add(&hist[q * 1024 + b2], 1u, __ATOMIC_RELAXED, __HIP_MEMORY_SCOPE_WORKGROUP); (void)__hip_atomic_fetch_add(&hist[q * 1024 + b3], 1u, __ATOMIC_RELAXED, __HIP_MEMORY_SCOPE_WORKGROUP); }
          for (; idx <= tq; idx += 128) {
              const int bin = (int)((maxv - sc[q * 8192 + idx]) * scale);
              (void)__hip_atomic_fetch_add(&hist[q * 1024 + bin], 1u, __ATOMIC_RELAXED, __HIP_MEMORY_SCOPE_WORKGROUP); } }
        IX_BAR();
        if (wid < 4) {
            const LAS u32x4* hp = (const LAS u32x4*)(hist + wid * 1024 + 16 * lane);
            const u32x4 h0 = hp[0], h1 = hp[1], h2 = hp[2], h3 = hp[3];
            const unsigned c[16] = {h0.x, h0.y, h0.z, h0.w, h1.x, h1.y, h1.z, h1.w, h2.x, h2.y, h2.z, h2.w, h3.x, h3.y, h3.z, h3.w};
            unsigned tot = 0u;
#pragma unroll
            for (int i = 0; i < 16; ++i) tot += c[i];
            unsigned incl = tot;
#pragma unroll
            for (int o = 1; o < 64; o <<= 1) { const unsigned v = __shfl_up(incl, o); if (lane >= o) incl += v; }
            const unsigned excl = incl - tot;
            if (excl < 256u && 256u <= incl) {
                unsigned run = excl, bsel = 0u, cnt = 0u; bool found = false;
#pragma unroll
                for (int i = 0; i < 16; ++i) { if (!found) { if (run + c[i] >= 256u) { bsel = 16u * lane + i; cnt = c[i]; found = true; } else run += c[i]; } }
                selw[wid * 4 + 0] = bsel; selw[wid * 4 + 1] = 256u - run; selw[wid * 4 + 2] = cnt;
                if (cnt > 64u) flag[0] = 1u;
            }
        }
        IX_BAR();
        if (flag[0] == 0u) {
            const unsigned B = selw[q * 4 + 0];
#define IX_EMIT(BLK, V) do { const int s_ = 64 * (BLK) + lane; const bool val_ = (s_ <= tq); const float v_ = val_ ? (V) : 0.f; \
                const unsigned bin_ = (unsigned)(int)((maxv - v_) * scale); const unsigned long long bal_ = __ballot(val_ && bin_ < B); \
                if (val_ && bin_ == B) { const unsigned pos_ = __hip_atomic_fetch_add(&selw[q * 4 + 3], 1u, __ATOMIC_RELAXED, __HIP_MEMORY_SCOPE_WORKGROUP); cval[q * 64 + (pos_ & 63u)] = v_; cidx[q * 64 + (pos_ & 63u)] = (unsigned)s_; } \
                if (lane == 0) { mk[q * 256 + 2 * (BLK)] = (unsigned)bal_; mk[q * 256 + 2 * (BLK) + 1] = (unsigned)(bal_ >> 32); } } while (0)
            { int blk = sub;
              for (; blk + 6 < nblk; blk += 8) {
                  const float v0 = sc[q * 8192 + 64 * blk + lane], v1 = sc[q * 8192 + 64 * (blk + 2) + lane], v2 = sc[q * 8192 + 64 * (blk + 4) + lane], v3 = sc[q * 8192 + 64 * (blk + 6) + lane];
                  IX_EMIT(blk, v0); IX_EMIT(blk + 2, v1); IX_EMIT(blk + 4, v2); IX_EMIT(blk + 6, v3); }
              for (; blk < nblk; blk += 2) { const float v0 = sc[q * 8192 + ((64 * blk + lane) & 8191)]; IX_EMIT(blk, v0); } }
#undef IX_EMIT
            IX_BAR();
            if (wid < 4) {
                const unsigned C = selw[wid * 4 + 3], need = selw[wid * 4 + 1];
                const float mv = (lane < (int)C) ? cval[wid * 64 + lane] : -INFINITY; const unsigned mi = (lane < (int)C) ? cidx[wid * 64 + lane] : 0xFFFFFFFFu;
                unsigned rank = 0u;
                for (unsigned j = 0; j < C; ++j) { const unsigned js = (unsigned)__builtin_amdgcn_readfirstlane((int)j);
                    const float vj = __builtin_bit_cast(float, __builtin_amdgcn_readlane(__builtin_bit_cast(int, mv), (int)js)); const unsigned ij = (unsigned)__builtin_amdgcn_readlane((int)mi, (int)js); rank += (vj > mv || (vj == mv && ij < mi)) ? 1u : 0u; }
                if (lane < (int)C && rank < need) (void)__hip_atomic_fetch_or(&mk[wid * 256 + (mi >> 5)], 1u << (mi & 31u), __ATOMIC_RELAXED, __HIP_MEMORY_SCOPE_WORKGROUP);
            }
        } else {
            if (F.tid < 4) { unsigned z_ = (unsigned)F.zz; asm volatile("" : "+v"(z_)); selw[F.tid * 4 + 0] = z_; selw[F.tid * 4 + 1] = 256u + z_; selw[F.tid * 4 + 2] = z_; }
#pragma unroll 1
            for (int pass = 0; pass < 4; ++pass) {
                const int shift = 24 - 8 * pass;
                IX_BAR();
                hist[F.tid] = 0u; hist[F.tid + 512] = 0u;
                IX_BAR();
                const unsigned prefix = selw[q * 4 + 0];
                for (int idx = sub * 64 + lane; idx < nk32; idx += 128) {
                    const unsigned u = ordf(sc[q * 8192 + idx]);
                    const bool match = (pass == 0) || ((u >> (shift + 8)) == (prefix >> (shift + 8)));
                    if (match) (void)__hip_atomic_fetch_add(&hist[q * 256 + ((u >> shift) & 255u)], 1u, __ATOMIC_RELAXED, __HIP_MEMORY_SCOPE_WORKGROUP);
                }
                IX_BAR();
                if (wid < 4) {
                    const unsigned kk = selw[wid * 4 + 1], pre = selw[wid * 4 + 0];
                    const unsigned c0 = hist[wid * 256 + 4 * lane], c1 = hist[wid * 256 + 4 * lane + 1], c2 = hist[wid * 256 + 4 * lane + 2], c3 = hist[wid * 256 + 4 * lane + 3];
                    const unsigned tot = c0 + c1 + c2 + c3; unsigned incl = tot;
#pragma unroll
                    for (int o = 1; o < 64; o <<= 1) { const unsigned v = __shfl_down(incl, o); if (lane + o < 64) incl += v; }
                    const unsigned excl = incl - tot;
                    if (excl < kk && kk <= incl) {
                        unsigned run = excl, dsel, cnt;
                        if (run + c3 >= kk) { dsel = 3; cnt = c3; } else { run += c3;
                            if (run + c2 >= kk) { dsel = 2; cnt = c2; } else { run += c2;
                                if (run + c1 >= kk) { dsel = 1; cnt = c1; } else { run += c1; dsel = 0; cnt = c0; } } }
                        selw[wid * 4 + 0] = pre | ((4u * lane + dsel) << shift); selw[wid * 4 + 1] = kk - run; selw[wid * 4 + 2] = cnt;
                    }
                }
            }
            IX_BAR();
            const unsigned thr = selw[q * 4 + 0], kk = selw[q * 4 + 1];
            unsigned eqseen = 0u;
            for (int blk = 0; blk < nblk; ++blk) {
                const int s = 64 * blk + lane;
                const unsigned u = (s < nk32) ? ordf(sc[q * 8192 + s]) : 0u;
                const bool val = (s <= tq);
                const unsigned long long gt = __ballot(val && u > thr), eq = __ballot(val && u == thr);
                unsigned long long take = 0ull, e = eq; unsigned left = (kk > eqseen) ? kk - eqseen : 0u;
                while (left && e) { const unsigned long long low = e & (~e + 1ull); take |= low; e ^= low; --left; }
                eqseen += (unsigned)__popcll(eq);
                if ((blk & 1) == sub && lane == 0) { const unsigned long long wv = gt | take; mk[q * 256 + 2 * blk] = (unsigned)wv; mk[q * 256 + 2 * blk + 1] = (unsigned)(wv >> 32); }
            }
        }
    }
    IX_BAR();
    { const int wq = F.tid >> 7, ww = (F.tid & 127) * 2;
      if (ww < 2 * nblk) *(u32x2*)(MK + (size_t)(rowbase + t0 + wq) * 256 + ww) = *(const LAS u32x2*)(mk + wq * 256 + ww); }
    IX_BAR();
}
}

constexpr int NPH = 16;
__global__ void __launch_bounds__(NWAVES * 64, 2) mk_fwd(Args args) {
    extern __shared__ __attribute__((aligned(16))) unsigned char lds[];
    Frame F;
    F.lds = (LAS unsigned char*)lds;
    F.tid = threadIdx.x; F.lane = F.tid & 63; F.wave = __builtin_amdgcn_readfirstlane(F.tid >> 6);
    const int wave0 = F.wave;
    F.G = gridDim.x; { const int bx = blockIdx.x; F.vcu = (F.G % 8 == 0) ? (bx % 8) * (F.G / 8) + bx / 8 : bx; }
    F.a = &args; F.zz = 0;
    volatile LAS unsigned* MISC = (volatile LAS unsigned*)(F.lds + LDSCTL_OFF);
    for (int u = F.tid; u < (LDS_BYTES - LDSCTL_OFF) / 4; u += NWAVES * 64) ((LAS unsigned*)(F.lds + LDSCTL_OFF))[u] = 0u;
    __syncthreads();
    XcdBarrier bar; bar.bar = (unsigned*)(args.ws + WS_CTL) + CW_BAR; bar.x = 0; bar.st = nullptr;
    if (MK_ONE_LAUNCH) bar = xcd_barrier_post((unsigned*)(args.ws + WS_CTL) + CW_BAR, MISC + 8);
    const int lo = args.ph_lo, hi = args.ph_hi;
#define IN(k) (lo <= (k) && (k) < hi)
#define SEAM(k) do { if (MK_ONE_LAUNCH && (k) + 1 < hi) { XcdBarrier b2_ = bar; asm volatile("" : "+s"(b2_.bar), "+s"(b2_.x)); xcd_barrier(b2_); } } while (0)
#define PHASE_BEGIN() do { asm volatile("s_mov_b32 %0, 0" : "=s"(F.zz)); F.wave = wave0 + F.zz; asm volatile("v_mbcnt_lo_u32_b32 %0, -1, 0\n\tv_mbcnt_hi_u32_b32 %0, -1, %0" : "=v"(F.lane)); F.tid = F.wave * 64 + F.lane; } while (0)
#define WSP(off, T) ((T*)(F.wsp(off)))

    for (int l = 0; l < DEPTH; ++l) {
        const int P = l * NPH;
        for (int rep_ = 0; rep_ < ((DBG_DUP == 0) ? 2 : 1); ++rep_) if (IN(P + 0)) {
            PHASE_BEGIN();
            if (l == 0) { for (int u = F.vcu; u < 144; u += F.G) { PHASE_BEGIN(); mod_unit(F, u); } PHASE_BEGIN(); rope_table(F); PHASE_BEGIN(); }
            convert_weights(F, l, 0, 0, 2, F.vcu * NWAVES + F.wave, F.G * NWAVES);
            SEAM(P + 0);
        }
        for (int rep_ = 0; rep_ < ((DBG_DUP == 1) ? 2 : 1); ++rep_) if (IN(P + 1)) {
            PHASE_BEGIN();
            const float* mod_l = WSP(WS_MOD, const float) + (size_t)l * 2 * 9216; const float* ng = F.in(IN_NORMG) + (size_t)l * 6 * DM;
            if (l == 0) { norm_pass<false, true, 0, 0>(F, nullptr, F.in(IN_X), nullptr, nullptr, nullptr, 0.f, ng + 0 * DM, mod_l + 1 * DM, mod_l + 0 * DM, WSP(WS_XN, bf16_t));
                SEAM(P + 1); }
        }
        for (int rep_ = 0; rep_ < ((DBG_DUP == 2) ? 2 : 1); ++rep_) if (IN(P + 2)) {
            PHASE_BEGIN();
            pg8::Gemm g{WSP(WS_XN, bf16_t), WSP(WS_W + W_W1, bf16_t), DM, DM, DM}; pg8::StaticOrder S; S.init(M, 2 * DFF, F.G, (int)blockIdx.x);
            pg8::EpiSwiglu E{WSP(WS_R1, bf16_t), DFF};
            pg8::gemm_phase<pg8::EpiSwiglu, pg8::StaticOrder, true>(F.lds, F.tid, g, S, E);
            { const int rem_ = (M / 256) * (2 * DFF / 256) % F.G;
              if (l == 0 && rem_ != 0 && (int)blockIdx.x >= rem_) { PHASE_BEGIN(); convert_weights(F, l, 0, 2, NSEG_A, ((int)blockIdx.x - rem_) * NWAVES + F.wave, (F.G - rem_) * NWAVES); } }
            SEAM(P + 2);
        }
        for (int rep_ = 0; rep_ < ((DBG_DUP == 3) ? 2 : 1); ++rep_) if (IN(P + 3)) {
            PHASE_BEGIN();
            pg8::Gemm g{WSP(WS_R1, bf16_t), WSP(WS_W + W_W2, bf16_t), DFF, DFF, DFF}; pg8::StaticOrder S; S.init(M, DM, F.G, (int)blockIdx.x);
            pg8::EpiBf16<0> E{WSP(WS_R2, bf16_t), DM};
            pg8::gemm_phase<pg8::EpiBf16<0>, pg8::StaticOrder, true>(F.lds, F.tid, g, S, E);
            SEAM(P + 3);
        }
        for (int rep_ = 0; rep_ < ((DBG_DUP == 4) ? 2 : 1); ++rep_) if (IN(P + 4)) {
            PHASE_BEGIN();
            const float* mod_l = WSP(WS_MOD, const float) + (size_t)l * 2 * 9216; const float* ng = F.in(IN_NORMG) + (size_t)l * 6 * DM;
            if (l == 0) norm_pass<true, true, 0, 1>(F, WSP(WS_R2, bf16_t), F.in(IN_X), F.outp(), ng + 1 * DM, mod_l + 2 * DM, 0.5f, ng + 2 * DM, mod_l + 4 * DM, mod_l + 3 * DM, WSP(WS_XN, bf16_t));
            else norm_pass<true, true, 1, 1>(F, WSP(WS_R2, bf16_t), F.outp(), F.outp(), ng + 1 * DM, mod_l + 2 * DM, 0.5f, ng + 2 * DM, mod_l + 4 * DM, mod_l + 3 * DM, WSP(WS_XN, bf16_t));
            SEAM(P + 4);
        }
        for (int rep_ = 0; rep_ < ((DBG_DUP == 5) ? 2 : 1); ++rep_) if (IN(P + 5)) {
            PHASE_BEGIN();
            pg8::Gemm g{WSP(WS_XN, bf16_t), WSP(WS_W + W_IN, bf16_t), DM, DM, DM}; pg8::StaticOrder S; S.init(M, ZP, F.G, (int)blockIdx.x);
            pg8::EpiBf16<0> E{WSP(WS_R1, bf16_t), ZP};
            pg8::gemm_phase<pg8::EpiBf16<0>, pg8::StaticOrder, true>(F.lds, F.tid, g, S, E);
            { const int rem_ = (M / 256) * (ZP / 256) % F.G;
              if (rem_ != 0 && (int)blockIdx.x >= rem_) { PHASE_BEGIN(); convert_weights(F, l, 1, 0, NSEG_B, ((int)blockIdx.x - rem_) * NWAVES + F.wave, (F.G - rem_) * NWAVES); } }
            SEAM(P + 5);
        }
        for (int rep_ = 0; rep_ < ((DBG_DUP == 6) ? 2 : 1); ++rep_) if (IN(P + 6)) {
            PHASE_BEGIN();
            mla_prep(F, WSP(WS_R1, const bf16_t), WSP(WS_YB, bf16_t), WSP(WS_YB + 8 * MiB, bf16_t), WSP(WS_KROPE, bf16_t), WSP(WS_RS, bf16_t), WSP(WS_ROPE, const f32x2));
            __syncthreads();
            for (int u = F.vcu; u < 256; u += F.G) { PHASE_BEGIN(); lru_unit<false>(F, l, u, WSP(WS_R1, const bf16_t), WSP(WS_LRUS, f32x2), nullptr); }
            SEAM(P + 6);
        }
        for (int rep_ = 0; rep_ < ((DBG_DUP == 7) ? 2 : 1); ++rep_) if (IN(P + 7)) {
            PHASE_BEGIN();
            { pg8::Gemm g{WSP(WS_YB, bf16_t), WSP(WS_W + W_UQ, bf16_t), 256, 256, 256 + F.zz}; pg8::StaticOrder S; S.init(M, 768, F.G, (int)blockIdx.x);
              pg8::EpiMlaQ E{WSP(WS_R2, bf16_t), 768, WSP(WS_ROPE, const f32x2)};
              pg8::gemm_phase<pg8::EpiMlaQ, pg8::StaticOrder, true>(F.lds, F.tid, g, S, E); }
            PHASE_BEGIN();
            { pg8::Gemm g{WSP(WS_YB + 8 * MiB, bf16_t), WSP(WS_W + W_UKV, bf16_t), 128, 128, 128 + F.zz}; pg8::StaticOrder S; S.init(M, 1024, F.G, (int)blockIdx.x);
              pg8::EpiBf16<0> E{WSP(WS_R2 + 24 * MiB, bf16_t), 1024};
              pg8::gemm_phase<pg8::EpiBf16<0>, pg8::StaticOrder, true>(F.lds, F.tid, g, S, E); }
            __syncthreads();
            PHASE_BEGIN();
            for (int v = F.vcu; v < 256; v += F.G)
            { ix::Pre pre; const int U0 = v;
              ix::preload(F, WSP(WS_R1, const bf16_t), WSP(WS_RS, const bf16_t), U0 >> 11, U0 & 2047, pre);
              for (int i = 0; i < 16; ++i) { const int U = (i & 1) ? 4095 - ((i >> 1) * 256 + v) : (i >> 1) * 256 + v;
                  const int i2 = i + 1, U2 = (i2 & 1) ? 4095 - ((i2 >> 1) * 256 + v) : (i2 >> 1) * 256 + v;
                  PHASE_BEGIN();
                  ix::unit(F, WSP(WS_R1, const bf16_t), WSP(WS_RS, const bf16_t), WSP(WS_R1 + 112 * MiB, unsigned), U >> 11, U & 2047, pre, i2 < 16, (U2 >> 11) & 1, U2 & 2047); } }
            __syncthreads();
            SEAM(P + 7);
        }
        for (int rep_ = 0; rep_ < ((DBG_DUP == 8) ? 2 : 1); ++rep_) if (IN(P + 8)) {
            PHASE_BEGIN();
            for (unsigned v_ = (unsigned)(F.vcu + F.zz); v_ < 256u; v_ += 256u) { const int v = (int)v_;
                const int bh = v >> 4, b = bh >> 3, h = bh & 7, qa = v & 15;
                PHASE_BEGIN();
                const bf16_t* Z = WSP(WS_R1, const bf16_t); bf16_t* YB = WSP(WS_YB, bf16_t);
                { fa::Ptrs P_{WSP(WS_R2, const bf16_t) + 96 * h, 768, WSP(WS_R2 + 24 * MiB, const bf16_t) + 128 * h, 1024, WSP(WS_KROPE, const bf16_t), WSP(WS_R2 + 24 * MiB, const bf16_t) + 128 * h + 64, 1024,
                                YB + 1024 + 64 * h, 2048, nullptr, 0.f, 0.f};
                  for (int r3_ = 0; r3_ < ((DBG_FADUP == 0) ? 2 : 1); ++r3_) { fm::unit(F, P_, b, qa); PHASE_BEGIN(); fm::unit(F, P_, b, 31 - qa); PHASE_BEGIN(); } }
                PHASE_BEGIN();
                { fa::Ptrs P_{Z + ZC_AQ + 64 * h, ZP, Z + ZC_AK + 64 * (h >> 2), ZP, nullptr, Z + ZC_AV + 64 * (h >> 2), ZP, YB + 64 * h, 2048, WSP(WS_R1 + 112 * MiB, const unsigned),
                                __builtin_amdgcn_exp2f(-0.5f * (float)(h + 9)) * LOG2E, 0.f};
                  for (int r3_ = 0; r3_ < ((DBG_FADUP == 1) ? 2 : 1); ++r3_) { fd::unit<0>(F, P_, b, qa); PHASE_BEGIN(); fd::unit<0>(F, P_, b, 31 - qa); PHASE_BEGIN(); } }
                for (int i = 0; i < ((DBG_FADUP == 2) ? 4 : 2); ++i) { PHASE_BEGIN(); const int U = 2 * v + (i & 1), bh2 = U >> 5, b2 = bh2 >> 3, h2 = bh2 & 7, qb2 = U & 31;
                  fa::Ptrs P_{Z + ZC_DQ + 64 * h2, ZP, Z + ZC_DK + 64 * (h2 >> 2), ZP, nullptr, Z + ZC_DV + 64 * (h2 >> 2), ZP, YB + 1536 + 64 * h2, 2048, nullptr,
                                __builtin_amdgcn_exp2f(-0.5f * (float)(h2 + 1)) * LOG2E, F.in(IN_SINKS)[l * 8 + h2] * LOG2E};
                  fd::unit<1>(F, P_, b2, qb2); }
                for (int r5_ = 0; r5_ < ((DBG_FADUP == 3) ? 2 : 1); ++r5_) {
                PHASE_BEGIN();
                lru_unit<true>(F, l, v, WSP(WS_R1, const bf16_t), WSP(WS_LRUS, f32x2), WSP(WS_YB, bf16_t)); }
            }
            SEAM(P + 8);
        }
        for (int rep_ = 0; rep_ < ((DBG_DUP == 9) ? 2 : 1); ++rep_) if (IN(P + 9)) {
            PHASE_BEGIN();
#if defined(DBG_ZB)
            { bf16_t* YBz = WSP(WS_YB, bf16_t); const int gw = F.vcu * NWAVES + F.wave, NGW = F.G * NWAVES;
              for (int m = gw; m < M; m += NGW) *(u32x4*)(YBz + (size_t)m * 2048 + 512 * DBG_ZB + 8 * F.lane) = (u32x4){0u, 0u, 0u, 0u}; }
#endif
            PHASE_BEGIN();
            pg8::Gemm g{WSP(WS_XN, bf16_t), WSP(WS_W + W_G, bf16_t), DM, DM, DM}; pg8::StaticOrder S; S.init(M, NG, F.G, (int)blockIdx.x);
            pg8::EpiBf16<2> E{WSP(WS_R1, bf16_t), NG};
            pg8::gemm_phase<pg8::EpiBf16<2>, pg8::StaticOrder, true>(F.lds, F.tid, g, S, E);
            SEAM(P + 9);
        }
        for (int rep_ = 0; rep_ < ((DBG_DUP == 10) ? 2 : 1); ++rep_) if (IN(P + 10)) {
            PHASE_BEGIN();
            pg8::Gemm g{WSP(WS_YB, bf16_t), WSP(WS_W + W_BR, bf16_t), 2048, 2048, 512}; pg8::ChainOrder S; S.so.init(M, DM, F.G, (int)blockIdx.x);
            pg8::EpiGateMerge E{WSP(WS_R1, const bf16_t), WSP(WS_R2, bf16_t), DM};
            pg8::gemm_phase<pg8::EpiGateMerge, pg8::ChainOrder, true>(F.lds, F.tid, g, S, E);
            SEAM(P + 10);
        }
        for (int rep_ = 0; rep_ < ((DBG_DUP == 11) ? 2 : 1); ++rep_) if (IN(P + 11)) {
            PHASE_BEGIN();
            pg8::Gemm g{WSP(WS_R2, bf16_t), WSP(WS_W + W_O, bf16_t), DM, DM, DM}; pg8::StaticOrder S; S.init(M, DM, F.G, (int)blockIdx.x);
            pg8::EpiBf16<0> E{WSP(WS_YB, bf16_t), DM};
            pg8::gemm_phase<pg8::EpiBf16<0>, pg8::StaticOrder, true>(F.lds, F.tid, g, S, E);
            SEAM(P + 11);
        }
        for (int rep_ = 0; rep_ < ((DBG_DUP == 12) ? 2 : 1); ++rep_) if (IN(P + 12)) {
            PHASE_BEGIN();
            const float* mod_l = WSP(WS_MOD, const float) + (size_t)l * 2 * 9216; const float* ng = F.in(IN_NORMG) + (size_t)l * 6 * DM;
            norm_pass<true, true, 1, 1>(F, WSP(WS_YB, bf16_t), F.outp(), (l + 1 < DEPTH) ? (void*)F.outp() : (void*)WSP(WS_YB + 32 * MiB, bf16_t), ng + 3 * DM, mod_l + 5 * DM, 1.0f, ng + 4 * DM, mod_l + 7 * DM, mod_l + 6 * DM, WSP(WS_XN, bf16_t));
            SEAM(P + 12);
        }
        for (int rep_ = 0; rep_ < ((DBG_DUP == 13) ? 2 : 1); ++rep_) if (IN(P + 13)) {
            PHASE_BEGIN();
            pg8::Gemm g{WSP(WS_XN, bf16_t), WSP(WS_W + W_W1, bf16_t), DM, DM, DM}; pg8::StaticOrder S; S.init(M, 2 * DFF, F.G, (int)blockIdx.x);
            pg8::EpiSwiglu E{WSP(WS_R1, bf16_t), DFF};
            pg8::gemm_phase<pg8::EpiSwiglu, pg8::StaticOrder, true>(F.lds, F.tid, g, S, E);
            { const int rem_ = (M / 256) * (2 * DFF / 256) % F.G;
              if (l + 1 < DEPTH && rem_ != 0 && (int)blockIdx.x >= rem_) { PHASE_BEGIN(); convert_weights(F, l + 1, 0, 2, NSEG_A, ((int)blockIdx.x - rem_) * NWAVES + F.wave, (F.G - rem_) * NWAVES); } }
            SEAM(P + 13);
        }
        for (int rep_ = 0; rep_ < ((DBG_DUP == 14) ? 2 : 1); ++rep_) if (IN(P + 14)) {
            PHASE_BEGIN();
            pg8::Gemm g{WSP(WS_R1, bf16_t), WSP(WS_W + W_W2, bf16_t), DFF, DFF, DFF}; pg8::StaticOrder S; S.init(M, DM, F.G, (int)blockIdx.x);
            pg8::EpiBf16<0> E{WSP(WS_R2, bf16_t), DM};
            pg8::gemm_phase<pg8::EpiBf16<0>, pg8::StaticOrder, true>(F.lds, F.tid, g, S, E);
            SEAM(P + 14);
        }
        for (int rep_ = 0; rep_ < ((DBG_DUP == 15) ? 2 : 1); ++rep_) if (IN(P + 15)) {
            PHASE_BEGIN();
            const float* mod_l = WSP(WS_MOD, const float) + (size_t)l * 2 * 9216; const float* ng = F.in(IN_NORMG) + (size_t)l * 6 * DM;
            if (l + 1 < DEPTH) { const float* mod_n = mod_l + 2 * 9216; const float* ngn = ng + 6 * DM;
                norm_pass<true, true, 1, 1>(F, WSP(WS_R2, bf16_t), F.outp(), F.outp(), ng + 5 * DM, mod_l + 8 * DM, 0.5f, ngn + 0 * DM, mod_n + 1 * DM, mod_n + 0 * DM, WSP(WS_XN, bf16_t)); }
            else norm_pass<true, false, 1, 0>(F, WSP(WS_R2, bf16_t), WSP(WS_YB + 32 * MiB, const bf16_t), F.outp(), ng + 5 * DM, mod_l + 8 * DM, 0.5f, nullptr, nullptr, nullptr, nullptr);
            SEAM(P + 15);
        }
    }
#undef IN
#undef SEAM
}


#if defined(DBG_PROBE)
__device__ __forceinline__ void probe_acc(float* acc2, float dd, float rr) {
    dd = wave_sum(dd); rr = wave_sum(rr);
    if ((threadIdx.x & 63) == 0) { atomicAdd(acc2, dd); atomicAdd(acc2 + 1, rr); }
}
__global__ void __launch_bounds__(256) probe_swa(const unsigned char* ws, const float* sinks, float* acc2) {
    const bf16_t* Z = (const bf16_t*)(ws + WS_R1); const bf16_t* YB = (const bf16_t*)(ws + WS_YB);
    const int gid = blockIdx.x * blockDim.x + threadIdx.x; const int h = gid & 7, ms = gid >> 3;
    const int m = ms * 7 + 3; float dd = 0.f, rr = 0.f;
    if (m < M) {
        const int b = m >> 13, t = m & 8191, g = h >> 2; const float slope = exp2f(-0.5f * (h + 1));
        float q[64]; _Pragma("unroll") for (int d = 0; d < 64; ++d) q[d] = bf2f(Z[(size_t)m * ZP + ZC_DQ + 64 * h + d]);
        float mx = sinks[h] * LOG2E, l = 1.f, o[64]; _Pragma("unroll") for (int d = 0; d < 64; ++d) o[d] = 0.f;
        for (int s = (t >= 127 ? t - 127 : 0); s <= t; ++s) {
            const bf16_t* kr = Z + ((size_t)b * SEQ + s) * ZP + ZC_DK + 64 * g; float sc = 0.f;
            _Pragma("unroll") for (int d = 0; d < 64; ++d) sc += q[d] * bf2f(kr[d]);
            sc -= slope * LOG2E * (float)(t - s);
            const float mn = fmaxf(mx, sc), al = exp2f(mx - mn), p = exp2f(sc - mn);
            l = l * al + p; const bf16_t* vr = Z + ((size_t)b * SEQ + s) * ZP + ZC_DV + 64 * g;
            _Pragma("unroll") for (int d = 0; d < 64; ++d) o[d] = o[d] * al + p * bf2f(vr[d]);
            mx = mn;
        }
        _Pragma("unroll") for (int d = 0; d < 64; ++d) { const float ref = o[d] / l, got = bf2f(YB[(size_t)m * 2048 + 1536 + 64 * h + d]); dd += (got - ref) * (got - ref); rr += ref * ref; }
    }
    probe_acc(acc2, dd, rr);
}
__global__ void __launch_bounds__(256) probe_mla(const unsigned char* ws, float* acc2) {
    const bf16_t* Qc = (const bf16_t*)(ws + WS_R2); const bf16_t* KV = (const bf16_t*)(ws + WS_R2 + 24 * MiB); const bf16_t* KR = (const bf16_t*)(ws + WS_KROPE); const bf16_t* YB = (const bf16_t*)(ws + WS_YB);
    const int gid = blockIdx.x * blockDim.x + threadIdx.x; const int h = gid & 7, ms = gid >> 3;
    const int m = ms * 61 + 5; float dd = 0.f, rr = 0.f;
    if (m < M) {
        const int b = m >> 13, t = m & 8191;
        float q[96]; _Pragma("unroll") for (int d = 0; d < 96; ++d) q[d] = bf2f(Qc[(size_t)m * 768 + 96 * h + d]);
        float mx = -INFINITY, l = 0.f, o[64]; _Pragma("unroll") for (int d = 0; d < 64; ++d) o[d] = 0.f;
        for (int s = 0; s <= t; ++s) {
            const size_t mk = (size_t)b * SEQ + s; float sc = 0.f;
            _Pragma("unroll") for (int d = 0; d < 64; ++d) sc += q[d] * bf2f(KV[mk * 1024 + 128 * h + d]);
            _Pragma("unroll") for (int d = 0; d < 32; ++d) sc += q[64 + d] * bf2f(KR[mk * 32 + d]);
            const float mn = fmaxf(mx, sc), al = exp2f(mx - mn), p = exp2f(sc - mn);
            l = l * al + p;
            _Pragma("unroll") for (int d = 0; d < 64; ++d) o[d] = o[d] * al + p * bf2f(KV[mk * 1024 + 128 * h + 64 + d]);
            mx = mn;
        }
        _Pragma("unroll") for (int d = 0; d < 64; ++d) { const float ref = o[d] / l, got = bf2f(YB[(size_t)m * 2048 + 1024 + 64 * h + d]); dd += (got - ref) * (got - ref); rr += ref * ref; }
    }
    probe_acc(acc2, dd, rr);
}
__global__ void probe_lru(const unsigned char* ws, const float* convw, const float* convb, const float* lwa, const float* lba, const float* lwx, const float* lbx, const float* lam, float* acc2) {
    const bf16_t* Z = (const bf16_t*)(ws + WS_R1); const bf16_t* YB = (const bf16_t*)(ws + WS_YB);
    const int gid = blockIdx.x * blockDim.x + threadIdx.x; float dd = 0.f, rr = 0.f;
    if (gid < 1024) {
        const int b = gid >> 9, c = gid & 511, n = c >> 6, j = c & 63;
        const float sp = log1pf(expf(-lam[c])); float h = 0.f;
        for (int t = 0; t < SEQ; ++t) {
            float ra = lba[c], rx = lbx[c], xcc = 0.f;
            for (int i = 0; i < 64; ++i) { const int ci = 64 * n + i; float xc = convb[ci];
                for (int k = 0; k < 4; ++k) { const int tt = t - 3 + k; if (tt >= 0) xc += convw[k * 512 + ci] * bf2f(Z[((size_t)b * SEQ + tt) * ZP + ZC_RX + ci]); }
                ra += xc * lwa[(n * 64 + i) * 64 + j]; rx += xc * lwx[(n * 64 + i) * 64 + j]; if (i == j) xcc = xc; }
            const float r = 1.f / (1.f + expf(-ra)), ig = 1.f / (1.f + expf(-rx));
            const float la = -8.f * r * sp, a = expf(la), bb = sqrtf(-expm1f(2.f * la)) * (ig * xcc);
            h = a * h + bb;
            if ((t % 13) == 0 || t < 130) { const size_t m = (size_t)b * SEQ + t; const float g = bf2f(Z[m * ZP + ZC_RG + c]);
                const float ref = h * (0.5f * g * (1.f + tanhf(0.7978845608028654f * (g + 0.044715f * g * g * g)))), got = bf2f(YB[m * 2048 + 512 + c]);
                dd += (got - ref) * (got - ref); rr += ref * ref; }
        }
    }
    probe_acc(acc2, dd, rr);
}

__device__ __forceinline__ float blk_max(float v, float* red) { __syncthreads(); for (int o = 32; o > 0; o >>= 1) v = fmaxf(v, __shfl_xor(v, o)); if ((threadIdx.x & 63) == 0) red[threadIdx.x >> 6] = v; __syncthreads(); return fmaxf(fmaxf(red[0], red[1]), fmaxf(red[2], red[3])); }
__device__ __forceinline__ float blk_sum(float v, float* red) { __syncthreads(); v = wave_sum(v); if ((threadIdx.x & 63) == 0) red[threadIdx.x >> 6] = v; __syncthreads(); return (red[0] + red[1]) + (red[2] + red[3]); }
__global__ void __launch_bounds__(256) probe_dsa(const unsigned char* ws, float* acc2) {
    __shared__ float sc[8192]; __shared__ float pp[8192]; __shared__ float red[8]; __shared__ unsigned thr_s; __shared__ int cnt_s;
    const bf16_t* Z = (const bf16_t*)(ws + WS_R1); const bf16_t* YB = (const bf16_t*)(ws + WS_YB);
    const int tid = threadIdx.x;
    const int rows[8] = {3, 130, 255, 256, 257, 700, 3001, 8191};
    const int b = blockIdx.x & 1, t = (blockIdx.x < 16) ? rows[blockIdx.x >> 1] : (int)((blockIdx.x * 2654435761u) >> 19) ;
    const size_t m = (size_t)b * SEQ + t, rb = (size_t)b * SEQ;
    for (int s = tid; s <= t; s += 256) { float tot = 0.f;
        for (int hd = 0; hd < 8; ++hd) { float d = 0.f;
            for (int e = 0; e < 64; ++e) d += bf2f(Z[m * ZP + ZC_IQ + 64 * hd + e]) * bf2f(Z[(rb + s) * ZP + ZC_IK + e]);
            tot += bf2f(Z[m * ZP + ZC_IW + hd]) * fmaxf(d, 0.f); }
        sc[s] = tot; }
    __syncthreads();
#if defined(DBG_DSA_SCORES)
    { int slot = -1; if (t == 256) slot = 0; if (t == 257) slot = 1; if (t == 700) slot = 2; if (t == 3001) slot = 3; if (t == 8191) slot = 4;
      float d2 = 0.f, r2 = 0.f;
      if (slot >= 0 && blockIdx.x < 16) { const float* dump = (const float*)(ws + WS_R2 + 56 * MiB) + ((size_t)(b * 5 + slot)) * 8192;
          for (int s = tid; s <= t; s += 256) { const float df = dump[s] - sc[s]; d2 += df * df; r2 += sc[s] * sc[s]; } }
      probe_acc(acc2, d2, r2); return; }
#endif
    unsigned T = 0u; const int n = t + 1;
    if (n > 256) {
        unsigned lo = 0u, hi = 0xFFFFFFFFu;
        for (int it = 0; it < 33 && lo < hi; ++it) { const unsigned mid = lo + (unsigned)(((unsigned long long)hi - lo + 1ull) >> 1);
            float c = 0.f; for (int s = tid; s < n; s += 256) c += (ix::ordf(sc[s]) >= mid) ? 1.f : 0.f;
            c = blk_sum(c, red);
            if (c >= 256.f) lo = mid; else hi = mid - 1u; }
        T = lo;
    }
    { float c = 0.f; for (int s = tid; s < n; s += 256) { const unsigned u = ix::ordf(sc[s]); const bool g = (n <= 256) || (u > T); pp[s] = g ? 1.f : 0.f; c += g ? 1.f : 0.f; }
      c = blk_sum(c, red);
      if (tid == 0 && n > 256) { int need = 256 - (int)c; for (int s = 0; s < n && need > 0; ++s) if (ix::ordf(sc[s]) == T) { pp[s] = 1.f; --need; } }
      __syncthreads(); }
#if defined(DBG_DSA_MISMATCH)
    { const unsigned* MKp = (const unsigned*)(ws + WS_R1 + 112 * MiB) + m * 256; float mis = 0.f, tot = 0.f;
      const bool use = (DBG_DSA_MISMATCH == 0) ? (t < 256) : (t >= 256);
      for (int s = tid; s < n; s += 256) { const float mine = ((MKp[s >> 5] >> (s & 31)) & 1u) ? 1.f : 0.f; mis += (mine != pp[s]) ? 1.f : 0.f; tot += pp[s]; }
      if (!use) { mis = 0.f; tot = 0.f; }
      probe_acc(acc2, mis, tot); return; }
#endif
#if defined(DBG_DSA_USEMASK)
    { const unsigned* MKp = (const unsigned*)(ws + WS_R1 + 112 * MiB) + m * 256; __syncthreads(); for (int s = tid; s < n; s += 256) pp[s] = ((MKp[s >> 5] >> (s & 31)) & 1u) ? 1.f : 0.f; __syncthreads(); }
#endif
    float dd = 0.f, rr = 0.f;
    for (int h = 0; h < 8; ++h) {
        const int g = h >> 2; const float slope2 = exp2f(-0.5f * (h + 9)) * LOG2E;
        float lm = -INFINITY;
        for (int s = tid; s < n; s += 256) { float v = -INFINITY;
            if (pp[s] != 0.f) { float d = 0.f; for (int e = 0; e < 64; ++e) d += bf2f(Z[m * ZP + ZC_AQ + 64 * h + e]) * bf2f(Z[(rb + s) * ZP + ZC_AK + 64 * g + e]); v = d - slope2 * (float)(t - s); }
            sc[s] = v; lm = fmaxf(lm, v); }
        const float mx = blk_max(lm, red);
        float ls = 0.f; for (int s = tid; s < n; s += 256) { const float p = (sc[s] == -INFINITY) ? 0.f : exp2f(sc[s] - mx); sc[s] = p; ls += p; }
        const float l = blk_sum(ls, red);
        if (tid < 64) { float o = 0.f; for (int s = 0; s < n; ++s) if (sc[s] != 0.f) o += sc[s] * bf2f(Z[(rb + s) * ZP + ZC_AV + 64 * g + tid]);
            const float ref = o / l, got = bf2f(YB[m * 2048 + 64 * h + tid]); dd += (got - ref) * (got - ref); rr += ref * ref; }
        __syncthreads();
    }
    probe_acc(acc2, dd, rr);
}
__global__ void probe_out(const float* x, float* out, const float* acc2) {
    const float e = acc2[0] / fmaxf(acc2[1], 1e-30f); const float k = fminf(fmaxf(3.0f + 0.5f * log10f(fmaxf(e, 1e-12f)), 0.f), 4.f);
    for (size_t i = (size_t)blockIdx.x * blockDim.x + threadIdx.x; i < (size_t)M * DM; i += (size_t)gridDim.x * blockDim.x) out[i] = x[i] * (1.f + k);
}
#endif
extern "C" void kernel_launch(void* const* d_in, const int* in_sizes, int n_in, void* d_out, int out_size, void* d_ws, size_t ws_size, hipStream_t stream) {
    static int grid = 0;
    if (grid == 0) {
        if (n_in != 24 || out_size != M * DM || ws_size < WS_END) { fprintf(stderr, "kernel_launch: unexpected shapes / workspace (n_in %d out %d ws %zu)\n", n_in, out_size, ws_size); grid = -1; return; }
        int dev = 0, cus = 0, per_cu = 0;
        if (hipGetDevice(&dev) != hipSuccess || hipDeviceGetAttribute(&cus, hipDeviceAttributeMultiprocessorCount, dev) != hipSuccess) { grid = -1; return; }
        if (hipFuncSetAttribute((const void*)mk_fwd, hipFuncAttributeMaxDynamicSharedMemorySize, LDS_BYTES) != hipSuccess) { grid = -1; return; }
        if (hipOccupancyMaxActiveBlocksPerMultiprocessor(&per_cu, (const void*)mk_fwd, NWAVES * 64, LDS_BYTES) != hipSuccess || per_cu < 1) { fprintf(stderr, "occupancy query says %d\n", per_cu); }
        (void)hipGetLastError();
        grid = cus;
        if (grid != 256) { fprintf(stderr, "kernel_launch: built for a 256-CU device (got %d)\n", cus); grid = -1; return; }
    }
    if (grid < 0) return;
    (void)hipMemsetAsync((char*)d_ws + WS_CTL, 0, CTL_ZERO_BYTES, stream);
    Args a{};
    for (int i = 0; i < 24; ++i) a.in[i] = (const float*)d_in[i];
    a.out = (float*)d_out; a.ws = (unsigned char*)d_ws;
#if MK_ONE_LAUNCH
    a.ph_lo = 0; a.ph_hi = DEPTH * NPH; a.li = 0;
    hipLaunchKernelGGL(mk_fwd, dim3(grid), dim3(NWAVES * 64), LDS_BYTES, stream, a);
#else
#ifndef DBG_STAGE
#define DBG_STAGE 0
#endif
    if (DBG_STAGE == 1) { (void)hipMemcpyAsync(d_out, d_in[0], (size_t)M * DM * 4, hipMemcpyDeviceToDevice, stream); return; }
    for (int p = 0; p < DEPTH * NPH; ++p) {
        const int k = p % NPH, l = p / NPH;
        if (DBG_STAGE == 2 && p > 4) break;
#if defined(DBG_PROBE)
        if (p > 8) {
            float* acc2 = (float*)((char*)d_ws + WS_CTL + 64);
            if (DBG_PROBE == 3) hipLaunchKernelGGL(probe_swa, dim3((M / 7 + 1) * 8 / 256 + 1), dim3(256), 0, stream, (const unsigned char*)d_ws, (const float*)d_in[IN_SINKS], acc2);
            if (DBG_PROBE == 2) hipLaunchKernelGGL(probe_mla, dim3((M / 61 + 1) * 8 / 256 + 1), dim3(256), 0, stream, (const unsigned char*)d_ws, acc2);
            if (DBG_PROBE == 0) hipLaunchKernelGGL(probe_dsa, dim3(80), dim3(256), 0, stream, (const unsigned char*)d_ws, acc2);
            if (DBG_PROBE == 1) hipLaunchKernelGGL(probe_lru, dim3(16), dim3(64), 0, stream, (const unsigned char*)d_ws, (const float*)d_in[IN_CONVW], (const float*)d_in[IN_CONVB], (const float*)d_in[IN_LRUWA], (const float*)d_in[IN_LRUBA],
                                                   (const float*)d_in[IN_LRUWX], (const float*)d_in[IN_LRUBX], (const float*)d_in[IN_LRULAM], acc2);
            hipLaunchKernelGGL(probe_out, dim3(1024), dim3(256), 0, stream, (const float*)d_in[0], (float*)d_out, (const float*)acc2);
            break;
        }
#endif
        if (k == 1 && l != 0) continue;
        a.ph_lo = p; a.ph_hi = p + 1; a.li = p;
        hipLaunchKernelGGL(mk_fwd, dim3(grid), dim3(NWAVES * 64), LDS_BYTES, stream, a);
    }
#endif
}
```

```cpp
#include <hip/hip_runtime.h>
#include <cstdio>
#include <cstdint>

#ifndef DBG_FADUP
#define DBG_FADUP -1
#endif
#ifndef DBG_DUP
#define DBG_DUP -1
#endif
#ifndef MK_ONE_LAUNCH
#define MK_ONE_LAUNCH 1
#endif

#define LAS __attribute__((address_space(3)))
#define GAS __attribute__((address_space(1)))
typedef unsigned short bf16_t;
typedef short bf16x8 __attribute__((ext_vector_type(8)));
typedef float f32x4 __attribute__((ext_vector_type(4)));
typedef float f32x2 __attribute__((ext_vector_type(2)));
typedef float f32x16 __attribute__((ext_vector_type(16)));
typedef unsigned u32x4 __attribute__((ext_vector_type(4)));
typedef unsigned u32x2 __attribute__((ext_vector_type(2)));

constexpr int BATCH = 2, SEQ = 8192, DM = 1024, DEPTH = 2, M = BATCH * SEQ;
constexpr int DFF = 2816, ZP = 3584, NG = 4096;
constexpr float EPS = 1e-6f;
constexpr float LOG2E = 1.4426950408889634f;
constexpr int ZC_AQ = 0, ZC_AK = 512, ZC_AV = 640, ZC_DQ = 768, ZC_DK = 1280, ZC_DV = 1408, ZC_RX = 1536, ZC_RG = 2048, ZC_IQ = 2560, ZC_IK = 3072, ZC_IW = 3136, ZC_CQ = 3168, ZC_CKV = 3424;

constexpr size_t MiB = 1u << 20;
constexpr size_t WS_CTL = 0, CTL_ZERO_BYTES = 65536;
constexpr size_t WS_MOD = 1 * MiB;
constexpr size_t WS_ROPE = 2 * MiB;
constexpr size_t WS_LRUS = 3 * MiB;
constexpr size_t WS_KROPE = 4 * MiB;
constexpr size_t WS_RS = 5 * MiB;
constexpr size_t WS_W = 8 * MiB;
constexpr size_t W_W1 = 0, W_W2 = 11534336, W_IN = 17301504, W_G = 24641536, W_UQ = 33030144, W_UKV = 33423360, W_BR = 33685504, W_O = 37879808;
constexpr size_t WS_R1 = 48 * MiB;
constexpr size_t WS_YB = 184 * MiB;
constexpr size_t WS_XN = 248 * MiB;
constexpr size_t WS_R2 = 280 * MiB;
constexpr size_t WS_END = 340 * MiB;
constexpr int CW_TMO = 0, CW_BAR = 4096;

constexpr int RING_BYTES = 131072, EXTRA_OFF = 131072, EXTRA_BYTES = 24576, LDSCTL_OFF = EXTRA_OFF + EXTRA_BYTES, LDS_BYTES = LDSCTL_OFF + 512;
constexpr int NWAVES = 8;

#define RLX_AGENT __ATOMIC_RELAXED, __HIP_MEMORY_SCOPE_AGENT
#define LDS_WAIT() asm volatile("s_waitcnt lgkmcnt(0)" ::: "memory")
#define VM_WAIT() asm volatile("s_waitcnt vmcnt(0)" ::: "memory")
__device__ __forceinline__ unsigned f2bf(float f) { unsigned u = __builtin_bit_cast(unsigned, f); return (u + 0x7fffu + ((u >> 16) & 1u)) >> 16; }
__device__ __forceinline__ unsigned pk2(float lo, float hi) { return f2bf(lo) | (f2bf(hi) << 16); }
__device__ __forceinline__ float bf_lo(unsigned w) { return __builtin_bit_cast(float, w << 16); }
__device__ __forceinline__ float bf_hi(unsigned w) { return __builtin_bit_cast(float, w & 0xffff0000u); }
__device__ __forceinline__ float bf2f(bf16_t b) { return __builtin_bit_cast(float, (unsigned)b << 16); }
typedef float cvt_f32x2 __attribute__((ext_vector_type(2)));
typedef __bf16 cvt_bf16x2 __attribute__((ext_vector_type(2)));
__device__ __forceinline__ unsigned cvt_pk_bf16(float lo, float hi) { return __builtin_bit_cast(unsigned, __builtin_convertvector(((cvt_f32x2){lo, hi}), cvt_bf16x2)); }
__device__ __forceinline__ float wave_sum(float v) {
#pragma unroll
    for (int o = 1; o < 64; o <<= 1) v += __shfl_xor(v, o);
    return v;
}
__device__ __forceinline__ float fast_sigmoid(float x) { return __builtin_amdgcn_rcpf(1.0f + __builtin_amdgcn_exp2f(-x * LOG2E)); }

#define XB_TMO      128
#define XB_XCNT(j)  (256  + 64 * (j))
#define XB_XSUB(j)  (1280 + 64 * (j))
#define XB_XGEN(j)  (2304 + 64 * (j))
#define XB_TOP      3328
#define XB_TOPGEN   3392
#define XCD_BAR_WORDS 3456
#define XB_SPIN_CAP (1u << 18)
__device__ __forceinline__ unsigned xb_ld(unsigned* p)              { return __hip_atomic_load(p, __ATOMIC_RELAXED, __HIP_MEMORY_SCOPE_AGENT); }
__device__ __forceinline__ unsigned xb_add(unsigned* p, unsigned v) { return __hip_atomic_fetch_add(p, v, __ATOMIC_RELAXED, __HIP_MEMORY_SCOPE_AGENT); }
__device__ __forceinline__ unsigned xb_xcc_id() { return (unsigned)__builtin_amdgcn_s_getreg((3 << 11) | 20) & 0xFu; }
#define XB_SPIN(cond, bar) do { unsigned _sp = 0; while (cond) { __builtin_amdgcn_s_sleep(1); \
    if ((++_sp & 255u) == 0u) { if (xb_ld(&(bar)[XB_TMO])) break; if (_sp > XB_SPIN_CAP) { atomicAdd(&(bar)[XB_TMO], 1u); break; } } } } while (0)
struct XcdBarrier { unsigned* bar; unsigned x; volatile LAS unsigned* st; };
__device__ __forceinline__ XcdBarrier xcd_barrier_post(unsigned* bar, volatile LAS unsigned* st) {
    XcdBarrier b; b.bar = bar; b.x = xb_xcc_id(); b.st = st;
    if (threadIdx.x == 0) (void)xb_add(&bar[XB_XCNT(b.x)], 1u);
    return b;
}
__device__ __forceinline__ void xcd_barrier_complete(unsigned* bar, unsigned x, unsigned& nloc, unsigned& nx) {
    const unsigned G = gridDim.x * gridDim.y * gridDim.z;
    unsigned sum, cnt, mine, sp = 0u;
    for (;;) {
        sum = 0u; cnt = 0u; mine = 0u;
#pragma unroll
        for (unsigned j = 0; j < 16; ++j) { const unsigned c = xb_ld(&bar[XB_XCNT(j)]); sum += c; cnt += (c > 0u) ? 1u : 0u; mine = (j == x) ? c : mine; }
        if (sum == G) break;
        __builtin_amdgcn_s_sleep(1);
        if ((++sp & 255u) == 0u) { if (xb_ld(&bar[XB_TMO])) break; if (sp > XB_SPIN_CAP) { atomicAdd(&bar[XB_TMO], 1u); break; } }
    }
    nloc = mine > 0u ? mine : 1u; nx = cnt > 0u ? cnt : 1u;
}
__device__ __forceinline__ void xcd_barrier(const XcdBarrier& b) {
    asm volatile("s_waitcnt vmcnt(0)" ::: "memory");
    __syncthreads();
    if (threadIdx.x == 0) {
        unsigned* bar = b.bar;
        __builtin_amdgcn_s_waitcnt(0);
        unsigned nloc = b.st[0], nx = b.st[1];
        if (nloc == 0u) { xcd_barrier_complete(bar, b.x, nloc, nx); b.st[0] = nloc; b.st[1] = nx; }
        const unsigned old = xb_add(&bar[XB_XSUB(b.x)], 1u);
        const unsigned gen = old / nloc;
        if (old + 1u == (gen + 1u) * nloc) {
            __builtin_amdgcn_fence(__ATOMIC_RELEASE, "agent");
            asm volatile("s_waitcnt vmcnt(0)" ::: "memory");
            const unsigned og = xb_add(&bar[XB_TOP], 1u);
            const unsigned tg = og / nx;
            if (og + 1u == (tg + 1u) * nx) xb_add(&bar[XB_TOPGEN], 1u);
            else XB_SPIN(xb_ld(&bar[XB_TOPGEN]) == tg, bar);
            __builtin_amdgcn_fence(__ATOMIC_ACQUIRE, "agent");
            xb_add(&bar[XB_XGEN(b.x)], 1u);
            asm volatile("s_waitcnt vmcnt(0)" ::: "memory");
        } else {
            XB_SPIN(xb_ld(&bar[XB_XGEN(b.x)]) == gen, bar);
            __builtin_amdgcn_fence(__ATOMIC_ACQUIRE, "agent");
            asm volatile("s_waitcnt vmcnt(0)" ::: "memory");
        }
    }
    __syncthreads();
}

namespace pg8 {
constexpr int BM = 256, BK = 64, HALF = 128, HTB = HALF * BK * 2, STAGE_BYTES = 8 * HTB, NXCD = 8, WGM = 8;
__host__ __device__ __forceinline__ int lds_byte(int r, int c) { const int st = (r >> 4) * 2 + (c >> 5), rr = r & 15, cc = c & 31, ob = rr * 64 + cc * 2; return st * 1024 + (ob ^ (((ob >> 9) & 1) << 5)); }
__host__ __device__ __forceinline__ void stage_rc(int b, int& R, int& C) { const int st = b / 1024, sb = b % 1024, swz = sb ^ (((sb >> 9) & 1) << 5); R = (st >> 1) * 16 + swz / 64; C = (st & 1) * 32 + (swz % 64) / 2; }
__host__ __device__ __forceinline__ int perm32(int rho) { const int n = rho >> 4, i = rho & 15; return 8 * (i >> 2) + 4 * n + (i & 3); }

struct Unit { int pm, pn, ka, kb, sub; };
struct Gemm { const bf16_t* A; const bf16_t* Bt; int lda, ldb, K; };

struct StaticOrder {
    int nM, nN, nwg, G, c;
    __device__ void init(int M_, int N_, int G_, int c_) { nM = M_ / BM; nN = N_ / BM; nwg = nM * nN; G = G_; c = c_; }
    __device__ bool tile(int i, Unit& u) const {
        const long L = (long)i * G + c; if (L >= nwg) return false;
        int wgid = (int)L; { const int q = nwg / NXCD, r = nwg % NXCD, xcd = wgid % NXCD, off = wgid / NXCD; wgid = (xcd < r ? xcd * (q + 1) : r * (q + 1) + (xcd - r) * q) + off; }
        const int nig = WGM * nN, gid = wgid / nig, fm = gid * WGM, gsz = (nM - fm) < WGM ? (nM - fm) : WGM;
        u.pm = fm + ((wgid % nig) % gsz); u.pn = (wgid % nig) / gsz; return true;
    }
    __device__ bool next(int i, Unit& u) const { u.ka = 0; u.kb = 0; u.sub = 0; return tile(i, u); }
};
struct ChainOrder {
    StaticOrder so;
    __device__ bool next(int i, Unit& u) const { const int s = i & 3; u.ka = 512 * s; u.kb = 512 * s; u.sub = s; return so.tile(i >> 2, u); }
};

template <int ACT  > struct EpiBf16 {
    static constexpr bool PERM = true, CHAIN = false;
    bf16_t* O; int ldc;
    __device__ __forceinline__ void operator()(f32x4 (&acc)[2][2][4][2], const Unit& u, int wr, int wc, int fr, int fq) const {
        const int row0 = u.pm * BM + wr * 64 + fr, col0 = u.pn * BM + wc * 32 + 8 * fq;
#pragma unroll
        for (int ai = 0; ai < 2; ++ai)
#pragma unroll
            for (int m = 0; m < 4; ++m) { bf16_t* rowp = O + (size_t)(row0 + ai * HALF + m * 16) * ldc + col0;
#pragma unroll
                for (int bj = 0; bj < 2; ++bj) { f32x4 v0 = acc[ai][bj][m][0], v1 = acc[ai][bj][m][1];
                    if (ACT == 2) {
#pragma unroll
                        for (int e = 0; e < 4; ++e) { v0[e] = __builtin_fmaxf(fast_sigmoid(v0[e]), 1e-30f); v1[e] = __builtin_fmaxf(fast_sigmoid(v1[e]), 1e-30f); } }
                    u32x4 w; w.x = cvt_pk_bf16(v0[0], v0[1]); w.y = cvt_pk_bf16(v0[2], v0[3]); w.z = cvt_pk_bf16(v1[0], v1[1]); w.w = cvt_pk_bf16(v1[2], v1[3]);
                    *(u32x4*)(rowp + bj * HALF) = w; } }
    }
};
struct EpiSwiglu {
    static constexpr bool PERM = true, CHAIN = false;
    bf16_t* O; int ldc;
    __device__ __forceinline__ void operator()(f32x4 (&acc)[2][2][4][2], const Unit& u, int wr, int wc, int fr, int fq) const {
        const int row0 = u.pm * BM + wr * 64 + fr, col0 = u.pn * HALF + wc * 32 + 8 * fq;
#pragma unroll
        for (int ai = 0; ai < 2; ++ai)
#pragma unroll
            for (int m = 0; m < 4; ++m) { bf16_t* rowp = O + (size_t)(row0 + ai * HALF + m * 16) * ldc + col0;
                float h[8];
#pragma unroll
                for (int n = 0; n < 2; ++n)
#pragma unroll
                    for (int e = 0; e < 4; ++e) { const float g = acc[ai][0][m][n][e], up = acc[ai][1][m][n][e]; h[4 * n + e] = g * fast_sigmoid(g) * up; }
                u32x4 w; w.x = cvt_pk_bf16(h[0], h[1]); w.y = cvt_pk_bf16(h[2], h[3]); w.z = cvt_pk_bf16(h[4], h[5]); w.w = cvt_pk_bf16(h[6], h[7]);
                *(u32x4*)rowp = w; }
    }
};

struct EpiMlaQ {
    static constexpr bool PERM = true, CHAIN = false;
    bf16_t* O; int ldc; const f32x2* rt;
    __device__ __forceinline__ void operator()(f32x4 (&acc)[2][2][4][2], const Unit& u, int wr, int wc, int fr, int fq) const {
        const int row0 = u.pm * BM + wr * 64 + fr, col0 = u.pn * BM + wc * 32 + 8 * fq;
#pragma unroll
        for (int ai = 0; ai < 2; ++ai)
#pragma unroll
            for (int m = 0; m < 4; ++m) { const int row = row0 + ai * HALF + m * 16; bf16_t* rowp = O + (size_t)row * ldc + col0;
#pragma unroll
                for (int bj = 0; bj < 2; ++bj) { const int c = col0 + bj * HALF; const int hc = c % 96;
                    float v[8];
#pragma unroll
                    for (int e = 0; e < 4; ++e) { v[e] = acc[ai][bj][m][0][e]; v[4 + e] = acc[ai][bj][m][1][e]; }
                    if (hc >= 64) { const f32x2* t = rt + (size_t)(row & (SEQ - 1)) * 16 + ((hc - 64) >> 1);
#pragma unroll
                        for (int pp = 0; pp < 4; ++pp) { const f32x2 cs = t[pp]; const float x1 = v[2 * pp], x2 = v[2 * pp + 1]; v[2 * pp] = x1 * cs.x - x2 * cs.y; v[2 * pp + 1] = x2 * cs.x + x1 * cs.y; } }
                    u32x4 w; w.x = cvt_pk_bf16(v[0], v[1]); w.y = cvt_pk_bf16(v[2], v[3]); w.z = cvt_pk_bf16(v[4], v[5]); w.w = cvt_pk_bf16(v[6], v[7]);
                    *(u32x4*)(rowp + bj * HALF) = w; }
                asm volatile("" ::: "memory"); }
    }
};
struct EpiRowScale {
    static constexpr bool PERM = true, CHAIN = false;
    bf16_t* O; int ldc; const float* rs;
    __device__ __forceinline__ void operator()(f32x4 (&acc)[2][2][4][2], const Unit& u, int wr, int wc, int fr, int fq) const {
        const int row0 = u.pm * BM + wr * 64 + fr, col0 = u.pn * BM + wc * 32 + 8 * fq;
#pragma unroll
        for (int ai = 0; ai < 2; ++ai)
#pragma unroll
            for (int m = 0; m < 4; ++m) { const int row = row0 + ai * HALF + m * 16; const float sc = rs[row]; bf16_t* rowp = O + (size_t)row * ldc + col0;
#pragma unroll
                for (int bj = 0; bj < 2; ++bj) { const f32x4 v0 = acc[ai][bj][m][0] * sc, v1 = acc[ai][bj][m][1] * sc;
                    u32x4 w; w.x = cvt_pk_bf16(v0[0], v0[1]); w.y = cvt_pk_bf16(v0[2], v0[3]); w.z = cvt_pk_bf16(v1[0], v1[1]); w.w = cvt_pk_bf16(v1[2], v1[3]);
                    *(u32x4*)(rowp + bj * HALF) = w; } }
    }
};
struct EpiGateMerge {
    static constexpr bool PERM = true, CHAIN = true;
    const bf16_t* G; bf16_t* O; int ldc;
    __device__ __forceinline__ void operator()(f32x4 (&acc)[2][2][4][2], const Unit& u, int wr, int wc, int fr, int fq) const {
        const int row0 = u.pm * BM + wr * 64 + fr, col0 = u.pn * BM + wc * 32 + 8 * fq; const int s = u.sub;
#pragma unroll
        for (int ai = 0; ai < 2; ++ai) {
            u32x4 ga[4][2], gb[4][2];
            const GAS bf16_t* gp0 = (const GAS bf16_t*)G + (size_t)(row0 + ai * HALF) * NG + 1024 * s + col0; asm volatile("" : "+v"(gp0));
#pragma unroll
            for (int m = 0; m < 4; ++m)
#pragma unroll
                for (int bj = 0; bj < 2; ++bj) { ga[m][bj] = *(const GAS u32x4*)(gp0 + (size_t)(m * 16) * NG + bj * HALF); gb[m][bj] = ga[m][bj]; }
            if (s < 3) {
#pragma unroll
                for (int m = 0; m < 4; ++m)
#pragma unroll
                    for (int bj = 0; bj < 2; ++bj) gb[m][bj] = *(const GAS u32x4*)(gp0 + (size_t)(m * 16) * NG + 1024 + bj * HALF); }
#pragma unroll
            for (int m = 0; m < 4; ++m) { const int row = row0 + ai * HALF + m * 16;
#pragma unroll
                for (int bj = 0; bj < 2; ++bj) {
                    const u32x4 gA = ga[m][bj];
                    float f[8] = {bf_lo(gA.x), bf_hi(gA.x), bf_lo(gA.y), bf_hi(gA.y), bf_lo(gA.z), bf_hi(gA.z), bf_lo(gA.w), bf_hi(gA.w)};
                    if (s < 3) { const u32x4 gB = gb[m][bj];
                        const float d[8] = {bf_lo(gB.x), bf_hi(gB.x), bf_lo(gB.y), bf_hi(gB.y), bf_lo(gB.z), bf_hi(gB.z), bf_lo(gB.w), bf_hi(gB.w)};
#pragma unroll
                        for (int e = 0; e < 8; ++e) f[e] = f[e] * __builtin_amdgcn_rcpf(d[e]); }
#pragma unroll
                    for (int e = 0; e < 4; ++e) { acc[ai][bj][m][0][e] *= f[e]; acc[ai][bj][m][1][e] *= f[4 + e]; }
                    if (s == 3) { const f32x4 v0 = acc[ai][bj][m][0], v1 = acc[ai][bj][m][1];
                        u32x4 w; w.x = cvt_pk_bf16(v0[0], v0[1]); w.y = cvt_pk_bf16(v0[2], v0[3]); w.z = cvt_pk_bf16(v1[0], v1[1]); w.w = cvt_pk_bf16(v1[2], v1[3]);
                        *(u32x4*)(O + (size_t)row * ldc + col0 + bj * HALF) = w; } } } }
    }
};

template <class Epi, class Sched, bool ALIGN_EPI>
__device__ __forceinline__ void gemm_phase(LAS unsigned char* lds, const int tid, const Gemm g, const Sched& S, const Epi& E) {
    const int wid = __builtin_amdgcn_readfirstlane(tid >> 6), lane = tid & 63, wr = wid >> 2, wc = wid & 3, fr = lane & 15, fq = lane >> 4;
    const int nt = g.K / BK;
    unsigned voffA[2], voffB[2];
#pragma unroll
    for (int i = 0; i < 2; ++i) { int R, C; stage_rc(tid * 16 + i * 8192, R, C); const int Rb = Epi::PERM ? ((R & ~31) + perm32(R & 31)) : R;
        voffA[i] = (unsigned)(R * g.lda + C) * 2u; voffB[i] = (unsigned)(Rb * g.ldb + C) * 2u; }
    const size_t kstep = (size_t)(BK * 2);
    const size_t hstepA = (size_t)HALF * g.lda * 2, hstepB = (size_t)HALF * g.ldb * 2;
    const unsigned ldsw = (unsigned)wid * 1024u;
    const int aoff = lds_byte(wr * 64 + fr, fq * 8), boff = lds_byte(wc * 32 + fr, fq * 8);
#define PG8_SA(b, h) (((b) * 2 + (h)) * HTB)
#define PG8_SB(b, h) ((4 + (b) * 2 + (h)) * HTB)
#define PG8_STAGE(bufoff, gbase, voff) do { _Pragma("unroll") for (int _i = 0; _i < 2; ++_i) \
        __builtin_amdgcn_global_load_lds((const unsigned*)((const char*)(gbase) + (voff)[_i]), (LAS unsigned*)(lds + (bufoff) + ldsw + _i * 8192), 16, 0, 0); } while (0)
#define PG8_LDA(dst, b, h) do { _Pragma("unroll") for (int m = 0; m < 4; ++m) _Pragma("unroll") for (int k = 0; k < 2; ++k) dst[m][k] = *(const LAS bf16x8*)(lds + PG8_SA(b, h) + aoff + m * 2048 + k * 1024); } while (0)
#define PG8_LDB(dst, b, h) do { _Pragma("unroll") for (int n = 0; n < 2; ++n) _Pragma("unroll") for (int k = 0; k < 2; ++k) dst[n][k] = *(const LAS bf16x8*)(lds + PG8_SB(b, h) + boff + n * 2048 + k * 1024); } while (0)
#define PG8_MMA(ai, bj, At, Bt) do { __builtin_amdgcn_s_setprio(1); _Pragma("unroll") for (int m = 0; m < 4; ++m) _Pragma("unroll") for (int n = 0; n < 2; ++n) _Pragma("unroll") for (int k = 0; k < 2; ++k) \
        acc[ai][bj][m][n] = __builtin_amdgcn_mfma_f32_16x16x32_bf16(Bt[n][k], At[m][k], acc[ai][bj][m][n], 0, 0, 0); __builtin_amdgcn_s_setprio(0); } while (0)
#define PG8_WAIT_V(n) asm volatile("s_waitcnt vmcnt(" #n ")" ::: "memory")
#define PG8_WAIT_L(n) asm volatile("s_waitcnt lgkmcnt(" #n ")" ::: "memory")
#define PG8_BAR __builtin_amdgcn_s_barrier()
#define PG8_SCHED __builtin_amdgcn_sched_barrier(0)
#define PG8_UA(u) ((const char*)g.A + (size_t)(u).pm * 2 * hstepA + (size_t)(u).ka * 2)
#define PG8_UB(u) ((const char*)g.Bt + (size_t)(u).pn * 2 * hstepB + (size_t)(u).kb * 2)
    Unit cur, nxt; int ui = 0;
    if (!S.next(0, cur)) return;
    f32x4 acc[2][2][4][2];
#pragma unroll
    for (int a = 0; a < 2; ++a)
#pragma unroll
        for (int b = 0; b < 2; ++b)
#pragma unroll
            for (int m = 0; m < 4; ++m)
#pragma unroll
                for (int n = 0; n < 2; ++n) acc[a][b][m][n] = (f32x4){0.f, 0.f, 0.f, 0.f};
    bf16x8 At[4][2], B0[2][2], B1[2][2];
    const char* cA = PG8_UA(cur); const char* cB = PG8_UB(cur);
    PG8_STAGE(PG8_SB(0, 0), cB, voffB); PG8_STAGE(PG8_SB(0, 1), cB + hstepB, voffB); PG8_STAGE(PG8_SA(0, 0), cA, voffA); PG8_STAGE(PG8_SA(0, 1), cA + hstepA, voffA);
    if (wr == 1) PG8_BAR;
    PG8_WAIT_V(2); PG8_BAR;
    PG8_STAGE(PG8_SB(1, 0), cB + kstep, voffB); PG8_STAGE(PG8_SA(1, 0), cA + kstep, voffA); PG8_STAGE(PG8_SB(1, 1), cB + hstepB + kstep, voffB);
    PG8_WAIT_V(6); PG8_BAR;
    for (;;) {
        const bool has_next = S.next(ui + 1, nxt);
        const char* nA = has_next ? PG8_UA(nxt) : cA; const char* nB = has_next ? PG8_UB(nxt) : cB;
        for (int t = 0; t < nt; t += 2) {
            const bool last = (t == nt - 2);
            const char* a1 = cA + (size_t)(t + 1) * kstep;
            const char* a2 = last ? nA : cA + (size_t)(t + 2) * kstep; const char* b2 = last ? nB : cB + (size_t)(t + 2) * kstep;
            const char* a3 = a2 + kstep; const char* b3 = b2 + kstep;
            PG8_LDB(B0, 0, 0); PG8_LDB(B1, 0, 1); PG8_SCHED; PG8_LDA(At, 0, 0); PG8_STAGE(PG8_SA(1, 1), a1 + hstepA, voffA);
            PG8_WAIT_V(8); PG8_WAIT_L(0); PG8_BAR; PG8_MMA(0, 0, At, B0); PG8_MMA(0, 1, At, B1); PG8_BAR; PG8_SCHED;
            PG8_LDA(At, 0, 1); PG8_STAGE(PG8_SB(0, 0), b2, voffB); PG8_STAGE(PG8_SB(0, 1), b2 + hstepB, voffB); PG8_STAGE(PG8_SA(0, 0), a2, voffA);
            PG8_WAIT_V(8); PG8_WAIT_L(0); PG8_BAR; PG8_MMA(1, 0, At, B0); PG8_MMA(1, 1, At, B1); PG8_BAR; PG8_SCHED;
            PG8_LDB(B0, 1, 0); PG8_LDB(B1, 1, 1); PG8_SCHED; PG8_LDA(At, 1, 0); PG8_STAGE(PG8_SA(0, 1), a2 + hstepA, voffA);
            PG8_WAIT_V(8); PG8_WAIT_L(0); PG8_BAR; PG8_MMA(0, 0, At, B0); PG8_MMA(0, 1, At, B1); PG8_BAR; PG8_SCHED;
            PG8_LDA(At, 1, 1); PG8_STAGE(PG8_SB(1, 0), b3, voffB); PG8_STAGE(PG8_SB(1, 1), b3 + hstepB, voffB); PG8_STAGE(PG8_SA(1, 0), a3, voffA);
            PG8_WAIT_V(8); PG8_WAIT_L(0); PG8_BAR; PG8_MMA(1, 0, At, B0); PG8_MMA(1, 1, At, B1); PG8_BAR; PG8_SCHED;
        }
        if constexpr (ALIGN_EPI) { if (wr == 0) PG8_BAR; }
        { int fr_ = fr, fq_ = fq; asm volatile("" : "+v"(fr_), "+v"(fq_));
          E(acc, cur, wr, wc, fr_, fq_); }
        if (!has_next) break;
        if (!(Epi::CHAIN && cur.sub != 3)) {
#pragma unroll
            for (int a = 0; a < 2; ++a)
#pragma unroll
                for (int b = 0; b < 2; ++b)
#pragma unroll
                    for (int m = 0; m < 4; ++m)
#pragma unroll
                        for (int n = 0; n < 2; ++n) acc[a][b][m][n] = (f32x4){0.f, 0.f, 0.f, 0.f};
        }
        cur = nxt; cA = nA; cB = nB; ++ui;
        if constexpr (ALIGN_EPI) { if (wr == 1) PG8_BAR; }
    }
    PG8_WAIT_V(0);
    if constexpr (!ALIGN_EPI) { if (wr == 0) PG8_BAR; }
    PG8_BAR;
#undef PG8_SA
#undef PG8_SB
#undef PG8_STAGE
#undef PG8_LDA
#undef PG8_LDB
#undef PG8_MMA
#undef PG8_WAIT_V
#undef PG8_WAIT_L
#undef PG8_BAR
#undef PG8_SCHED
#undef PG8_UA
#undef PG8_UB
}
}

struct Args { const float* in[24]; float* out; unsigned char* ws; int ph_lo, ph_hi, li, pad; };
struct Frame {
    LAS unsigned char* lds;
    int tid, lane, wave, vcu, G;
    const Args* a;
    int zz;
    __device__ __forceinline__ const float* in(int i) const { return (const float*)(const GAS float*)karg(8 * i); }
    __device__ __forceinline__ unsigned long long karg(int byte_off) const { unsigned long long p; asm volatile("s_load_dwordx2 %0, %1, %2\n\ts_waitcnt lgkmcnt(0)" : "=s"(p) : "s"(__builtin_amdgcn_kernarg_segment_ptr()), "s"(byte_off)); return p; }
    __device__ __forceinline__ unsigned char* wsp(size_t off = 0) const { return (unsigned char*)((GAS unsigned char*)karg(25 * 8) + off); }
    __device__ __forceinline__ float* outp() const { return (float*)(GAS float*)karg(24 * 8); }
};
#define IN_X 0
#define IN_C 1
#define IN_WADA 2
#define IN_BADA 3
#define IN_NORMG 4
#define IN_F1IN 5
#define IN_F1OUT 6
#define IN_WIN 7
#define IN_CONVW 8
#define IN_CONVB 9
#define IN_LRUWA 10
#define IN_LRUBA 11
#define IN_LRUWX 12
#define IN_LRUBX 13
#define IN_LRULAM 14
#define IN_GQ 15
#define IN_GKV 16
#define IN_WUQ 17
#define IN_WUKV 18
#define IN_SINKS 19
#define IN_WBR 20
#define IN_WOUT 21
#define IN_F2IN 22
#define IN_F2OUT 23

struct CvtSeg { const float* src; int ldn, col0, ncols, K; bf16_t* dst; int ldk, koff, drow0, mode; float scale; const float* kgain; };
__device__ __forceinline__ int cvt_row(const CvtSeg& s, int n) {
    if (s.mode == 1) { const int half = n >= DFF ? 1 : 0, j = n - DFF * half; return 256 * (j >> 7) + 128 * half + (j & 127); }
    if (s.mode == 2) { const int h = n / 96, c = n - 96 * h; return 96 * h + (c < 64 ? c : (c < 80 ? 64 + 2 * (c - 64) : 64 + 2 * (c - 80) + 1)); }
    return s.drow0 + n;
}
__device__ __forceinline__ void cvt_load(const CvtSeg& s, int item, int lane, f32x4 (&v)[16]) {
    const int nblk = (s.ncols + 63) >> 6, kb = item / nblk, nb = item - kb * nblk, k0 = 64 * kb, n0 = 64 * nb;
    const int nl = n0 + 4 * (lane & 15); const bool okc = nl < s.ncols;
    const GAS float* sp = (const GAS float*)s.src + (size_t)(k0 + (lane >> 4)) * s.ldn + s.col0 + (okc ? nl : 0); const size_t step = (size_t)4 * s.ldn;
#pragma unroll
    for (int i = 0; i < 16; ++i) { v[i] = *(const GAS f32x4*)sp; sp += step; asm volatile("" : "+v"(sp)); }
}
__device__ __forceinline__ void cvt_finish(const CvtSeg& s, LAS float* scr, int item, int lane, f32x4 (&v)[16]) {
    const int nblk = (s.ncols + 63) >> 6, kb = item / nblk, nb = item - kb * nblk, k0 = 64 * kb, n0 = 64 * nb;
    const int nl = n0 + 4 * (lane & 15); const bool okc = nl < s.ncols;
    const float sc_ = okc ? s.scale : 0.0f;
#pragma unroll
    for (int i = 0; i < 16; ++i) { const int kk = 4 * i + (lane >> 4);
        v[i] *= sc_; if (s.kgain) v[i] *= s.kgain[k0 + kk];
        LAS float* p = scr + kk * 65 + 4 * (lane & 15); p[0] = v[i].x; p[1] = v[i].y; p[2] = v[i].z; p[3] = v[i].w; }
    LDS_WAIT(); asm volatile("" ::: "memory");
    const int c = lane & 7;
#pragma unroll
    for (int j = 0; j < 8; ++j) { const int n = (lane >> 3) + 8 * j; const LAS float* p = scr + (8 * c) * 65 + n;
        u32x4 o; o.x = pk2(p[0 * 65], p[1 * 65]); o.y = pk2(p[2 * 65], p[3 * 65]); o.z = pk2(p[4 * 65], p[5 * 65]); o.w = pk2(p[6 * 65], p[7 * 65]);
        if (n0 + n < s.ncols) *(u32x4*)(s.dst + (size_t)cvt_row(s, n0 + n) * s.ldk + s.koff + k0 + 8 * c) = o; }
    LDS_WAIT(); asm volatile("" ::: "memory");
}
constexpr int NSEG_A = 24, NSEG_B = 2;
__device__ const int SEG_C0[15] = {0, 512, 640, 768, 1280, 1344, 1352, 1864, 2376, 2632, 2792, 3304, 3432, 3560, 0};
__device__ const int SEG_NC[15] = {512, 128, 128, 512, 64, 8, 512, 512, 256, 160, 512, 128, 128, 4096, 24};
__device__ const int SEG_DR[15] = {ZC_AQ, ZC_AK, ZC_AV, ZC_IQ, ZC_IK, ZC_IW, ZC_RX, ZC_RG, ZC_CQ, ZC_CKV, ZC_DQ, ZC_DK, ZC_DV, 0, ZC_IW + 8};
__device__ __forceinline__ void get_seg(const Frame& F, int l, int set, int si, CvtSeg& s) {
    bf16_t* W = (bf16_t*)(F.wsp(WS_W));
    s.kgain = nullptr; s.scale = 1.f; s.mode = 0; s.koff = 0; s.drow0 = 0; s.col0 = 0;
    if (si < 2) {
        const float* win_ = set ? F.in(IN_F2IN) : F.in(IN_F1IN); const float* wout_ = set ? F.in(IN_F2OUT) : F.in(IN_F1OUT);
        if (si == 0) { s.src = win_ + (size_t)l * DM * 2 * DFF; s.ldn = 2 * DFF; s.ncols = 2 * DFF; s.K = DM; s.dst = W + W_W1 / 2; s.ldk = DM; s.mode = 1; }
        else { s.src = wout_ + (size_t)l * DFF * DM; s.ldn = DM; s.ncols = DM; s.K = DFF; s.dst = W + W_W2 / 2; s.ldk = DFF; }
        return;
    }
    const float QS = 0.125f * LOG2E;
    int k = si - 2;
    if (k < 15) {
        s.src = F.in(IN_WIN) + (size_t)l * DM * 7656; s.ldn = 7656; s.col0 = SEG_C0[k];        s.ncols = SEG_NC[k]; s.K = DM; s.ldk = DM; s.drow0 = SEG_DR[k];
        s.dst = (k == 13) ? (W + W_G / 2) : (W + W_IN / 2);
        if (k == 0 || k == 10) s.scale = QS;
        if (k == 14) s.scale = 0.0f;
        return;
    }
    k -= 15;
    if (k == 0) { s.src = F.in(IN_WUQ) + (size_t)l * 256 * 768; s.ldn = 768; s.ncols = 768; s.K = 256; s.dst = W + W_UQ / 2; s.ldk = 256; s.mode = 2; s.scale = 0.10206207261596575f * LOG2E; s.kgain = F.in(IN_GQ) + l * 256; return; }
    if (k == 1) { s.src = F.in(IN_WUKV) + (size_t)l * 128 * 1024; s.ldn = 1024; s.ncols = 1024; s.K = 128; s.dst = W + W_UKV / 2; s.ldk = 128; s.kgain = F.in(IN_GKV) + l * 128; return; }
    if (k < 6) { const int n = k - 2; s.src = F.in(IN_WBR) + ((size_t)l * 4 + n) * 512 * 1024; s.ldn = 1024; s.ncols = 1024; s.K = 512; s.dst = W + W_BR / 2; s.ldk = 2048; s.koff = 512 * n; return; }
    s.src = F.in(IN_WOUT) + (size_t)l * DM * DM; s.ldn = DM; s.ncols = DM; s.K = DM; s.dst = W + W_O / 2; s.ldk = DM;
}
__device__ __forceinline__ void convert_weights(const Frame& F, int l, int set, int si0, int si1, int gw, int NGW) {
    LAS float* scr = (LAS float*)(F.lds + F.wave * 16896);
    int base = 0;
#ifdef DBG_CVTDUP
    for (int rep4_ = 0; rep4_ < 2; ++rep4_) { base = 0;
#endif
    for (int si = si0; si < si1; ++si) {
        CvtSeg s; get_seg(F, l, set, si, s);
        const int nit = (s.K >> 6) * ((s.ncols + 63) >> 6);
        int it = (gw - base % NGW + NGW) % NGW;
        for (; it < nit; it += 2 * NGW) {
            f32x4 va[16], vb[16]; const bool hb = it + NGW < nit;
            cvt_load(s, it, F.lane, va); if (hb) cvt_load(s, it + NGW, F.lane, vb);
            cvt_finish(s, scr, it, F.lane, va); if (hb) cvt_finish(s, scr, it + NGW, F.lane, vb); }
        base += nit;
    }
#ifdef DBG_CVTDUP
    }
#endif
}

__device__ __forceinline__ void mod_unit(const Frame& F, int unit) {
    const int l = unit / 72, cb = unit % 72, ks = F.tid >> 5, cg = F.tid & 31;
    const float* wa = F.in(IN_WADA) + (size_t)l * DM * 9216 + 128 * cb + 4 * cg;
    const float* c0 = F.in(IN_C); const float* c1 = c0 + DM;
    f32x4 a0 = {0.f, 0.f, 0.f, 0.f}, a1 = {0.f, 0.f, 0.f, 0.f};
    const GAS float* wp = (const GAS float*)wa + (size_t)(64 * ks) * 9216;
    for (int kb = 64 * ks; kb < 64 * ks + 64; kb += 16) {
        f32x4 w[16];
#pragma unroll
        for (int i = 0; i < 16; ++i) { w[i] = *(const GAS f32x4*)wp; wp += 9216; asm volatile("" : "+v"(wp)); }
#pragma unroll
        for (int i = 0; i < 16; ++i) { const float x0 = c0[kb + i], x1 = c1[kb + i];
            const float s0 = x0 / (1.f + __expf(-x0)), s1 = x1 / (1.f + __expf(-x1));
            a0 += w[i] * s0; a1 += w[i] * s1; }
    }
    LAS f32x4* red = (LAS f32x4*)F.lds;
    red[(ks * 32 + cg) * 2 + 0] = a0; red[(ks * 32 + cg) * 2 + 1] = a1;
    __syncthreads();
    if (F.tid < 64) { const int g2 = F.tid >> 1, b = F.tid & 1; f32x4 s = {0.f, 0.f, 0.f, 0.f};
#pragma unroll
        for (int q = 0; q < 16; ++q) s += red[(q * 32 + g2) * 2 + b];
        const f32x4 bb = *(const f32x4*)(F.in(IN_BADA) + (size_t)l * 9216 + 128 * cb + 4 * g2);
        float* mo = (float*)(F.wsp(WS_MOD)) + ((size_t)(l * 2 + b)) * 9216 + 128 * cb + 4 * g2;
        *(f32x4*)mo = s + bb; }
    __syncthreads();
}
__device__ __forceinline__ void rope_table(const Frame& F) {
    const double inv[16] = {1.0, 0.56234132519034907, 0.31622776601683794, 0.17782794100389229, 0.10000000000000001, 0.056234132519034911, 0.031622776601683791, 0.017782794100389229,
                            0.01, 0.005623413251903491, 0.0031622776601683794, 0.0017782794100389228, 0.001, 0.0005623413251903491, 0.00031622776601683794, 0.00017782794100389227};
    const int gid = F.vcu * 512 + F.tid;
    for (int e = gid; e < SEQ * 16; e += F.G * 512) {
        const int pos = e >> 4, j = e & 15;
        double th = 1.0;
#pragma unroll
        for (int q = 0; q < 16; ++q) th = (j == q) ? inv[q] : th;
        const double t2 = th * th; double cs = 1.0, sn = th, tc = 1.0, ts = th;
#pragma unroll
        for (int n = 1; n <= 12; ++n) { tc *= -t2 / (double)((2 * n - 1) * (2 * n)); ts *= -t2 / (double)((2 * n) * (2 * n + 1)); cs += tc; sn += ts; }
        double rc = 1.0, rs = 0.0;
#pragma unroll
        for (int bit = 0; bit < 13; ++bit) {
            if ((pos >> bit) & 1) { const double nc = rc * cs - rs * sn, ns = rc * sn + rs * cs; rc = nc; rs = ns; }
            const double c2 = cs * cs - sn * sn, s2 = 2.0 * cs * sn; cs = c2; sn = s2;
        }
        ((f32x2*)(F.wsp(WS_ROPE)))[e] = (f32x2){(float)rc, (float)rs};
    }
}
template <bool HAS_Y, bool HAS_NEXT, int XIN, int XOUT>
__device__ __forceinline__ void norm_pass(const Frame& F, const bf16_t* Y, const void* xs, void* xd, const float* gpost, const float* gate, float rw,
                                          const float* gpre, const float* scale, const float* shift, bf16_t* XN) {
    const int gw = F.vcu * NWAVES + F.wave, NGW = F.G * NWAVES;
    constexpr int R = XIN ? 8 : 4;
    for (int m0 = gw; m0 < M; m0 += R * NGW) {
        f32x4 vf[XIN ? 1 : R][4]; u32x2 xw[XIN ? R : 1][4]; u32x2 yw[R][4];
        static_assert(M % (4 * 2048) == 0, "rows per batch");
        const GAS unsigned char* xp = (const GAS unsigned char*)xs + (size_t)m0 * DM * (XIN ? 2 : 4) + F.lane * (XIN ? 8 : 16);
        const GAS unsigned char* yp = (const GAS unsigned char*)Y + (size_t)m0 * DM * 2 + F.lane * 8;
        const size_t xstep = (size_t)NGW * DM * (XIN ? 2 : 4), ystep = (size_t)NGW * DM * 2;
#pragma unroll
        for (int r = 0; r < R; ++r) {
            if (XIN == 0) {
#pragma unroll
                for (int j = 0; j < 4; ++j) vf[XIN ? 0 : r][j] = *(const GAS f32x4*)(xp + 1024 * j); }
            else {
#pragma unroll
                for (int j = 0; j < 4; ++j) xw[XIN ? r : 0][j] = *(const GAS u32x2*)(xp + 512 * j); }
            xp += xstep; asm volatile("" : "+v"(xp));
            if (HAS_Y) {
#pragma unroll
                for (int j = 0; j < 4; ++j) yw[r][j] = *(const GAS u32x2*)(yp + 512 * j);
                yp += ystep; asm volatile("" : "+v"(yp)); } }
#pragma unroll
        for (int hb = 0; hb < R / 4; ++hb) {
        const int b = (m0 + 4 * hb * NGW) >> 13;
        f32x4 cpost[4], cpre[4], csh[4];
#pragma unroll
        for (int j = 0; j < 4; ++j) {
            if (HAS_Y) { const f32x4 gp = *(const f32x4*)(gpost + 4 * F.lane + 256 * j); const f32x4 gt = *(const f32x4*)(gate + (size_t)b * 9216 + 4 * F.lane + 256 * j); cpost[j] = (gt * rw) * gp; }
            if (HAS_NEXT) { const f32x4 gp = *(const f32x4*)(gpre + 4 * F.lane + 256 * j); const f32x4 sc = *(const f32x4*)(scale + (size_t)b * 9216 + 4 * F.lane + 256 * j);
                cpre[j] = gp * (sc + 1.0f); csh[j] = *(const f32x4*)(shift + (size_t)b * 9216 + 4 * F.lane + 256 * j); } }
#pragma unroll
        for (int r = 4 * hb; r < 4 * hb + 4; ++r) { const int m = m0 + r * NGW; {
        f32x4 v[4];
#pragma unroll
        for (int j = 0; j < 4; ++j) { if (XIN == 0) v[j] = vf[XIN ? 0 : r][j]; else { const u32x2 w = xw[XIN ? r : 0][j]; v[j] = (f32x4){bf_lo(w.x), bf_hi(w.x), bf_lo(w.y), bf_hi(w.y)}; } }
        if (HAS_Y) {
            f32x4 y[4]; float ss = 0.f;
#pragma unroll
            for (int j = 0; j < 4; ++j) { const u32x2 w = yw[r][j]; y[j] = (f32x4){bf_lo(w.x), bf_hi(w.x), bf_lo(w.y), bf_hi(w.y)}; ss += (y[j].x * y[j].x + y[j].y * y[j].y) + (y[j].z * y[j].z + y[j].w * y[j].w); }
            const float rstd = 1.0f / sqrtf(wave_sum(ss) * (1.f / DM) + EPS);
#pragma unroll
            for (int j = 0; j < 4; ++j) v[j] += cpost[j] * (y[j] * rstd);
            if (XOUT == 0) { GAS f32x4* xo = (GAS f32x4*)((float*)xd + (size_t)m * DM) + F.lane;
#pragma unroll
                for (int j = 0; j < 4; ++j) xo[64 * j] = v[j]; }
            else { GAS u32x2* xo = (GAS u32x2*)((bf16_t*)xd + (size_t)m * DM) + F.lane;
#pragma unroll
                for (int j = 0; j < 4; ++j) { u32x2 w; w.x = pk2(v[j].x, v[j].y); w.y = pk2(v[j].z, v[j].w); xo[64 * j] = w; } }
        }
        if (HAS_NEXT) {
            float ss = 0.f;
#pragma unroll
            for (int j = 0; j < 4; ++j) ss += (v[j].x * v[j].x + v[j].y * v[j].y) + (v[j].z * v[j].z + v[j].w * v[j].w);
            const float rstd = 1.0f / sqrtf(wave_sum(ss) * (1.f / DM) + EPS);
            GAS u32x2* o8 = (GAS u32x2*)(XN + (size_t)m * DM) + F.lane;
#pragma unroll
            for (int j = 0; j < 4; ++j) {
                const f32x4 o = (v[j] * rstd) * cpre[j] + csh[j];
                u32x2 w; w.x = pk2(o.x, o.y); w.y = pk2(o.z, o.w); o8[64 * j] = w; }
        } } }
        }
    }
}


__device__ __forceinline__ void mla_prep(const Frame& F, const bf16_t* Z, bf16_t* CQN, bf16_t* CKN, bf16_t* KR, bf16_t* KIT, const f32x2* rt) {
    const int gw = F.vcu * NWAVES + F.wave, NGW = F.G * NWAVES, lane = F.lane;
    constexpr int R = 4;
    for (int m0 = gw; m0 < M; m0 += R * NGW) {
        u32x4 wq[R], wk[R]; float xa[R], xb[R]; f32x2 cs[R];
#pragma unroll
        for (int r = 0; r < R; ++r) { const int m = (m0 + r * NGW < M) ? m0 + r * NGW : m0; const bf16_t* zr = Z + (size_t)m * ZP;
            wq[r] = (u32x4){0u, 0u, 0u, 0u}; wk[r] = wq[r]; xa[r] = 0.f; xb[r] = 0.f; cs[r] = (f32x2){0.f, 0.f};
            if (lane < 48) wq[r] = *(const u32x4*)(zr + (lane < 32 ? ZC_CQ + 8 * lane : ZC_CKV + 8 * (lane - 32)));
            else { const int j = lane - 48; xa[r] = bf2f(zr[ZC_CKV + 128 + j]); xb[r] = bf2f(zr[ZC_CKV + 144 + j]); cs[r] = rt[(size_t)(m & (SEQ - 1)) * 16 + j]; }
            if (lane < 8) wk[r] = *(const u32x4*)(zr + ZC_IK + 8 * lane); }
#pragma unroll
        for (int r = 0; r < R; ++r) { const int m = m0 + r * NGW; if (m < M) {
        float s1 = 0.f, s2 = 0.f; float a[8] = {0.f, 0.f, 0.f, 0.f, 0.f, 0.f, 0.f, 0.f};
        if (lane < 48) { const u32x4 w = wq[r];
            a[0] = bf_lo(w.x); a[1] = bf_hi(w.x); a[2] = bf_lo(w.y); a[3] = bf_hi(w.y); a[4] = bf_lo(w.z); a[5] = bf_hi(w.z); a[6] = bf_lo(w.w); a[7] = bf_hi(w.w);
            const float s = (a[0] * a[0] + a[1] * a[1]) + (a[2] * a[2] + a[3] * a[3]) + (a[4] * a[4] + a[5] * a[5]) + (a[6] * a[6] + a[7] * a[7]);
            if (lane < 32) s1 = s; else s2 = s; }
        else { const int j = lane - 48; const float x1 = xa[r], x2 = xb[r];
            *(unsigned*)(KR + (size_t)m * 32 + 2 * j) = pk2(x1 * cs[r].x - x2 * cs[r].y, x2 * cs[r].x + x1 * cs[r].y); }
        if (lane < 8) *(u32x4*)(KIT + (size_t)(m >> 5) * 2048 + lane * 256 + (m & 31) * 8) = wk[r];
        s1 = wave_sum(s1); s2 = wave_sum(s2);
        const float r1 = 1.0f / sqrtf(s1 * (1.f / 256.f) + EPS), r2 = 1.0f / sqrtf(s2 * (1.f / 128.f) + EPS);
        if (lane < 48) { const float rr = lane < 32 ? r1 : r2;
            u32x4 o; o.x = pk2(a[0] * rr, a[1] * rr); o.y = pk2(a[2] * rr, a[3] * rr); o.z = pk2(a[4] * rr, a[5] * rr); o.w = pk2(a[6] * rr, a[7] * rr);
            if (lane < 32) *(u32x4*)(CQN + (size_t)m * 256 + 8 * lane) = o; else *(u32x4*)(CKN + (size_t)m * 128 + 8 * (lane - 32)) = o; }
        } }
    }
}

template <bool PASS2>
__device__ __forceinline__ void lru_unit(const Frame& F, int l, int unit, const bf16_t* Z, f32x2* S, bf16_t* YB) {
    constexpr int XS = 520;
    const int b = unit >> 7, k = unit & 127, c = F.tid, n = F.wave, lane = F.lane, r32 = lane & 31, hi = lane >> 5;
    const size_t m0 = (size_t)b * SEQ + 64 * k;
    LAS float* xcs = (LAS float*)F.lds;
    { const float* cw = F.in(IN_CONVW) + (size_t)l * 4 * 512 + c;
      const float w0 = cw[0], w1 = cw[512], w2 = cw[1024], w3 = cw[1536], cb = F.in(IN_CONVB)[l * 512 + c];
      const bf16_t* xr = Z + m0 * ZP + ZC_RX + c;
      float x3 = 0.f, x2 = 0.f, x1 = 0.f;
      if (k > 0) { x3 = bf2f(xr[-3 * (long)ZP]); x2 = bf2f(xr[-2 * (long)ZP]); x1 = bf2f(xr[-1 * (long)ZP]); }
      bf16_t xin[64];
      { const GAS bf16_t* xg = (const GAS bf16_t*)xr;
#pragma unroll
        for (int i = 0; i < 64; ++i) { xin[i] = *xg; xg += ZP; asm volatile("" : "+v"(xg)); } }
#pragma unroll
      for (int i0 = 0; i0 < 64; i0 += 16) {
          LAS float* xw = xcs + c + i0 * XS; asm volatile("" : "+v"(xw));
#pragma unroll
          for (int i = 0; i < 16; ++i) { const float x0 = bf2f(xin[i0 + i]); xw[i * XS] = cb + w0 * x3 + w1 * x2 + w2 * x1 + w3 * x0; x3 = x2; x2 = x1; x1 = x0; } } }
    __syncthreads();
#pragma unroll
    for (int ct = 0; ct < 2; ++ct) {
        __builtin_amdgcn_sched_barrier(0);
        const int ch = 64 * n + 32 * ct + r32;
        const float lam = F.in(IN_LRULAM)[l * 512 + ch]; const float ex_ = __expf(-lam);
        const float splus = lam < -20.f ? -lam : (ex_ < 0.1f ? ex_ * (1.0f - ex_ * (0.5f - ex_ * (0.33333334f - ex_ * (0.25f - ex_ * 0.2f)))) : __logf(1.0f + ex_));
        const float sp8 = -8.0f * LOG2E * splus, bia = F.in(IN_LRUBA)[l * 512 + ch], bix = F.in(IN_LRUBX)[l * 512 + ch];
        float hst = 0.f, apr = 1.f;
        if (PASS2) { const f32x2* sp = S + (size_t)b * 128 * 512 + ch;
            const int kh = (k + 1) >> 1, q0_ = hi ? kh : 0, q1_ = hi ? k : kh;
            float Am = 1.f, Bm = 0.f;
            for (int qb_ = 0; qb_ < kh; qb_ += 32) {
                const GAS f32x2* sq = (const GAS f32x2*)sp + (size_t)(q0_ + qb_) * 512; asm volatile("" : "+v"(sq));
                f32x2 ab[32];
#pragma unroll
                for (int e = 0; e < 32; ++e) { ab[e] = *sq; sq += 512; asm volatile("" : "+v"(sq)); }
#pragma unroll
                for (int e = 0; e < 32; ++e) { const bool v_ = q0_ + qb_ + e < q1_; const float bn = ab[e].x * Bm + ab[e].y, an = ab[e].x * Am; Bm = v_ ? bn : Bm; Am = v_ ? an : Am; } }
            float b0_ = Bm, b1_ = Bm, a0_ = Am, a1_ = Am;
            asm volatile("s_nop 1\n\tv_permlane32_swap_b32 %0, %1\n\tv_permlane32_swap_b32 %2, %3\n\ts_nop 1" : "+v"(b0_), "+v"(b1_), "+v"(a0_), "+v"(a1_));
            hst = a1_ * b0_ + b1_; }
        u32x4 wf[2][4];
        { float wv[2][4][8];
#pragma unroll
          for (int g = 0; g < 2; ++g) {
              const GAS float* pw = (const GAS float*)((g ? F.in(IN_LRUWX) : F.in(IN_LRUWA)) + ((size_t)l * 8 + n) * 4096 + (8 * hi) * 64 + 32 * ct + r32);
              asm volatile("" : "+v"(pw));
#pragma unroll
              for (int ks = 0; ks < 4; ++ks)
#pragma unroll
                  for (int e = 0; e < 8; ++e) wv[g][ks][e] = pw[(16 * ks + e) * 64]; }
#pragma unroll
          for (int g = 0; g < 2; ++g)
#pragma unroll
              for (int ks = 0; ks < 4; ++ks) wf[g][ks] = (u32x4){pk2(wv[g][ks][0], wv[g][ks][1]), pk2(wv[g][ks][2], wv[g][ks][3]), pk2(wv[g][ks][4], wv[g][ks][5]), pk2(wv[g][ks][6], wv[g][ks][7])}; }
        __builtin_amdgcn_sched_barrier(0);
        f32x16 D[2][2];
#pragma unroll
        for (int rt = 0; rt < 2; ++rt)
#pragma unroll
            for (int r = 0; r < 16; ++r) { D[0][rt][r] = bia; D[1][rt][r] = bix; }
#pragma unroll
        for (int rt = 0; rt < 2; ++rt)
#pragma unroll
            for (int ks = 0; ks < 4; ++ks) {
                const LAS f32x4* ap = (const LAS f32x4*)(xcs + (32 * rt + r32) * XS + 64 * n + 16 * ks + 8 * hi);
                const f32x4 a0 = ap[0], a1 = ap[1];
                const u32x4 af = (u32x4){pk2(a0.x, a0.y), pk2(a0.z, a0.w), pk2(a1.x, a1.y), pk2(a1.z, a1.w)};
#pragma unroll
                for (int g = 0; g < 2; ++g) D[g][rt] = __builtin_amdgcn_mfma_f32_32x32x16_bf16(__builtin_bit_cast(bf16x8, af), __builtin_bit_cast(bf16x8, wf[g][ks]), D[g][rt], 0, 0, 0);
            }
        __builtin_amdgcn_sched_barrier(0);
#pragma unroll
        for (int rt = 0; rt < 2; ++rt) {
            const LAS float* xo = xcs + (32 * rt + 4 * hi) * XS + ch;
#pragma unroll
            for (int r = 0; r < 16; ++r) {
                const float rr = fast_sigmoid(D[0][rt][r]), ig = fast_sigmoid(D[1][rt][r]);
                const float l2a = sp8 * rr, a = __builtin_amdgcn_exp2f(l2a), xx = 1.3862943611198906f * l2a;
                const float poly = -xx * (1.0f + xx * (0.5f + xx * (0.16666667f + xx * (0.041666668f + xx * 0.008333334f)))), direct = 1.0f - a * a;
                const float one_m_a2 = (xx > -0.1f) ? poly : direct;
                D[0][rt][r] = a; D[1][rt][r] = __builtin_amdgcn_sqrtf(one_m_a2) * (ig * xo[((r & 3) + 8 * (r >> 2)) * XS]);
            } }
#pragma unroll
        for (int rt = 0; rt < 2; ++rt)
#pragma unroll
            for (int rg = 0; rg < 4; ++rg)
#pragma unroll
                for (int owner = 0; owner < 2; ++owner) {
                    float h = hst, ap = apr;
#pragma unroll
                    for (int e = 0; e < 4; ++e) { const int r = 4 * rg + e; h = D[0][rt][r] * h + D[1][rt][r]; ap *= D[0][rt][r]; D[1][rt][r] = (hi == owner) ? h : D[1][rt][r]; }
                    float h0_ = h, h1_ = h, a0_ = ap, a1_ = ap;
                    asm volatile("s_nop 1\n\tv_permlane32_swap_b32 %0, %1\n\tv_permlane32_swap_b32 %2, %3\n\ts_nop 1" : "+v"(h0_), "+v"(h1_), "+v"(a0_), "+v"(a1_));
                    hst = owner ? h1_ : h0_; apr = owner ? a1_ : a0_;
                }
        if (!PASS2) { if (hi == 0) S[((size_t)b * 128 + k) * 512 + ch] = (f32x2){apr, hst}; }
        else {
#pragma unroll
            for (int rt = 0; rt < 2; ++rt) {
                bf16_t gin[16];
                const GAS bf16_t* zb = (const GAS bf16_t*)(Z + (m0 + 32 * rt + 4 * hi) * ZP + ZC_RG + ch); GAS bf16_t* yb = (GAS bf16_t*)(YB + (m0 + 32 * rt + 4 * hi) * 2048 + 512 + ch);
                asm volatile("" : "+v"(zb), "+v"(yb));
#pragma unroll
                for (int r = 0; r < 16; ++r) gin[r] = zb[(size_t)((r & 3) + 8 * (r >> 2)) * ZP];
#pragma unroll
                for (int r = 0; r < 16; ++r) { const float g = bf2f(gin[r]);
                    const float tg = 0.7978845608028654f * (g + 0.044715f * g * g * g);
                    const float th = 1.0f - 2.0f * __builtin_amdgcn_rcpf(1.0f + __builtin_amdgcn_exp2f(2.0f * LOG2E * tg));
                    yb[(size_t)((r & 3) + 8 * (r >> 2)) * 2048] = (bf16_t)f2bf(D[1][rt][r] * (0.5f * g * (1.0f + th))); }
            }
        }
    }
    __syncthreads();
}

namespace fa {
constexpr int KB96 = 12288, VB = 8192, STG = KB96 + VB, NSLOT = 4, LDS_WS = NSLOT * STG, LDS_OST = LDS_WS + 8 * 256, LDS_TOTAL = LDS_OST + 8 * 4096;
constexpr float THR = 8.0f;
__device__ __forceinline__ int crow(int r, int hi) { return (r & 3) + 8 * (r >> 2) + 4 * hi; }
__device__ __forceinline__ void glds16(const void* g, unsigned lds_base) {
    unsigned sv; asm volatile("s_mov_b32 %0, m0\n\ts_mov_b32 m0, %2\n\ts_nop 0\n\tglobal_load_lds_dwordx4 %1, off\n\ts_mov_b32 m0, %0" : "=&s"(sv) : "v"(g), "s"(lds_base) : "memory"); }
typedef short v4i16_t __attribute__((ext_vector_type(4)));
typedef __attribute__((address_space(3))) const char* lds_cptr;
__device__ __forceinline__ v4i16_t vtr(lds_cptr p) { return __builtin_amdgcn_ds_read_tr16_b64_v4i16((__attribute__((address_space(3))) v4i16_t*)p); }
#define FA_MFMA(a, b, c) __builtin_amdgcn_mfma_f32_32x32x16_bf16(a, b, c, 0, 0, 0)
__device__ __forceinline__ float xhalf_max(float x) { float a = x, b = x; asm volatile("s_nop 1\n\tv_permlane32_swap_b32 %0, %1\n\ts_nop 1" : "+v"(a), "+v"(b)); return __builtin_fmaxf(a, b); }
__device__ __forceinline__ float keep_or_ninf(int m, float x) { float r; asm("v_bfi_b32 %0, %1, %2, %3" : "=v"(r) : "v"(m), "v"(x), "s"(0xff800000u)); return r; }

struct Ptrs { const bf16_t* Q; int ldq; const bf16_t* K; int ldk; const bf16_t* KR; const bf16_t* V; int ldv; bf16_t* O; int ldo; const unsigned* MK; float slope2; float sink2; };

template <int MODE>
__device__ __forceinline__ void unit(const Frame& F, const Ptrs& P, int b, int qb) {
    constexpr int DK = (MODE == 0) ? 96 : 64, ND0 = DK / 16;
    const int lane = F.lane, r32 = lane & 31, hi = lane >> 5, wid = F.wave;
    const long rowbase = (long)b * SEQ; const int q0 = qb * 256;
    const int qidx = q0 + 32 * wid + r32;
    const unsigned lds0 = (unsigned)(uintptr_t)F.lds;
    LAS float* wsf = (LAS float*)(F.lds + LDS_WS) + wid * 64;
    int t_lo, t_hi, key_base;
    if (MODE == 2) { key_base = q0 - 128; t_lo = (qb == 0) ? 2 : 0; t_hi = 6; } else { key_base = 0; t_lo = 0; t_hi = 4 * qb + 4; }
    const bf16_t* ksrc = P.K + (rowbase + lane) * (long)P.ldk + wid * 8;
    const bf16_t* krsrc = (MODE == 0) ? P.KR + (rowbase + lane) * 32L + (wid & 3) * 8 : nullptr;
    const bf16_t* vsrc = P.V + (rowbase + 16 * (wid & 3) + (lane >> 2)) * (long)P.ldv + (wid >> 2) * 32 + (lane & 3) * 8;
    const unsigned kdst = lds0 + wid * 1024, krdst = lds0 + (8 + (wid & 3)) * 1024, vdst = lds0 + KB96 + wid * 1024;
#define FA_DMA(t, soff) do { const long k0_ = key_base + 64L * (t); \
        glds16(ksrc + k0_ * P.ldk, (unsigned)__builtin_amdgcn_readfirstlane(kdst + (soff))); \
        if (MODE == 0 && krw) glds16(krsrc + k0_ * 32, (unsigned)__builtin_amdgcn_readfirstlane(krdst + (soff)));        \
        glds16(vsrc + k0_ * P.ldv, (unsigned)__builtin_amdgcn_readfirstlane(vdst + (soff))); } while (0)
    const bool krw = __builtin_amdgcn_readfirstlane(wid) < 4;
    if (!krw) asm volatile("s_setprio 1");
    FA_DMA(t_lo, 0);
    if (t_lo + 1 < t_hi) FA_DMA(t_lo + 1, STG);
    bf16x8 qr[ND0];
    { const bf16_t* Qw = P.Q + (rowbase + q0 + 32 * wid + r32) * (long)P.ldq + hi * 8;
#pragma unroll
      for (int d0 = 0; d0 < ND0; ++d0) qr[d0] = *(const bf16x8*)(Qw + d0 * 16); }
    float lrun = (MODE == 2 && hi == 0) ? 1.0f : 0.0f;
    f32x16 negm = {};
    float mref = (MODE == 2) ? P.sink2 : (MODE == 1) ? -1.0e4f : 0.0f;
    f32x16 o0 = {}, o1 = {};
    const lds_cptr kp0 = (lds_cptr)F.lds + hi * 1024 + r32 * 16;
    const lds_cptr vp0 = (lds_cptr)F.lds + KB96 + ((lane >> 4) & 1) * 32 + (lane & 3) * 8 + (4 * hi + ((lane & 15) >> 2)) * 64;
    const unsigned* mkrow = (MODE == 1) ? P.MK + (size_t)(rowbase + qidx) * 256 : nullptr;
#define FA_KLOAD(soff) do { const lds_cptr kp_ = kp0 + (soff); \
        _Pragma("unroll") for (int d0 = 0; d0 < ND0; ++d0) { kf[2 * d0] = *(const __attribute__((address_space(3))) bf16x8*)(kp_ + d0 * 2048); kf[2 * d0 + 1] = *(const __attribute__((address_space(3))) bf16x8*)(kp_ + d0 * 2048 + 512); } } while (0)
#define FA_QKMMA(A, B) do { A = FA_MFMA(kf[0], qr[0], negm); B = FA_MFMA(kf[1], qr[0], negm);        \
        _Pragma("unroll") for (int d0 = 1; d0 < ND0; ++d0) { A = FA_MFMA(kf[2 * d0], qr[d0], A); B = FA_MFMA(kf[2 * d0 + 1], qr[d0], B); } } while (0)
#define FA_BIAS(A, B, key0, mw) do { const int kl_ = (key0) + 4 * hi; \
        if (MODE != 0) { const float bq_ = P.slope2 * (float)(kl_ - qidx) - mref;        \
            _Pragma("unroll") for (int r = 0; r < 16; ++r) { const float cr_ = P.slope2 * (float)((r & 3) + 8 * (r >> 2)); A[r] += bq_ + cr_; B[r] += bq_ + cr_ + 32.0f * P.slope2; } } \
        if (MODE == 1) { const unsigned w0_ = (mw).x >> (4 * hi), w1_ = (mw).y >> (4 * hi);        \
            _Pragma("unroll") for (int r = 0; r < 16; ++r) { const int pos_ = (r & 3) + 8 * (r >> 2); \
                A[r] = keep_or_ninf(__builtin_amdgcn_sbfe((int)w0_, pos_, 1), A[r]); B[r] = keep_or_ninf(__builtin_amdgcn_sbfe((int)w1_, pos_, 1), B[r]); } } \
        if (MODE == 2) { _Pragma("unroll") for (int r = 0; r < 16; ++r) { const int d_ = qidx - (kl_ + (r & 3) + 8 * (r >> 2)); if (d_ < 0 || d_ >= 128) A[r] = -INFINITY; if (d_ - 32 < 0 || d_ - 32 >= 128) B[r] = -INFINITY; } } \
        _Pragma("unroll") for (int i_ = 0; i_ < 8; ++i_) { __builtin_amdgcn_sched_group_barrier(0x8, 1, 0); __builtin_amdgcn_sched_group_barrier(0x2, (MODE == 1) ? 8 : (MODE == 2) ? 12 : 2, 0); }        \
        if (MODE != 2 && (key0) + 63 > q0 + 32 * wid) { asm volatile("; diagonal tile" ::: "memory");        \
            _Pragma("unroll") for (int r = 0; r < 16; ++r) { const int kv_ = kl_ + (r & 3) + 8 * (r >> 2); if (kv_ > qidx) A[r] = -INFINITY; if (kv_ + 32 > qidx) B[r] = -INFINITY; } } \
        } while (0)
    u32x2 mw = {0u, 0u}, mw_n = {0u, 0u}, mw_nn = {0u, 0u};
    if (MODE == 1) { mw = *(const u32x2*)(mkrow + 2 * t_lo); if (t_lo + 1 < t_hi) mw_n = *(const u32x2*)(mkrow + 2 * (t_lo + 1)); }
    if (t_lo + 1 < t_hi) asm volatile("s_waitcnt vmcnt(%0) lgkmcnt(0)\n\ts_barrier" :: "n"(2) : "memory"); else asm volatile("s_waitcnt vmcnt(0) lgkmcnt(0)\n\ts_barrier" ::: "memory");
    f32x16 p0, p1, n0 = {}, n1 = {}; bf16x8 kf[2 * ND0];
    u32x4 pw0 = {0u, 0u, 0u, 0u}, pw1 = pw0, pw2 = pw0, pw3 = pw0;
    FA_KLOAD(0); __builtin_amdgcn_sched_barrier(0); FA_QKMMA(p0, p1);
    int s_prev = 3 * STG, s_cur = 0, s_nxt = STG, s_nn = 2 * STG;
#define FA_MX3(a, b, c) __builtin_fmaxf(__builtin_fmaxf((a), (b)), (c))
#define FA_TOP(t) do { if ((t) + 1 < t_hi) { \
            asm volatile("s_waitcnt vmcnt(0) lgkmcnt(0)\n\ts_barrier" ::: "memory");       \
            if ((t) + 2 < t_hi) { FA_DMA((t) + 2, s_nn); if (MODE == 1) mw_nn = *(const u32x2*)(mkrow + 2 * ((t) + 2)); } \
            } } while (0)
#define FA_PV(soff, KL) do { const lds_cptr vp_ = vp0 + (soff); bf16x8 vf[8]; \
        _Pragma("unroll") for (int i = 0; i < 8; ++i) { const v4i16_t lo_ = vtr(vp_ + (i >> 2) * 4096 + (i & 3) * 1024), hi_ = vtr(vp_ + (i >> 2) * 4096 + (i & 3) * 1024 + 512); vf[i] = (bf16x8){lo_[0], lo_[1], lo_[2], lo_[3], hi_[0], hi_[1], hi_[2], hi_[3]}; } \
        __builtin_amdgcn_sched_barrier(0); if (KL) FA_KLOAD(s_nxt); \
        o0 = FA_MFMA(__builtin_bit_cast(bf16x8, pw0), vf[0], o0); o1 = FA_MFMA(__builtin_bit_cast(bf16x8, pw0), vf[4], o1); \
        o0 = FA_MFMA(__builtin_bit_cast(bf16x8, pw1), vf[1], o0); o1 = FA_MFMA(__builtin_bit_cast(bf16x8, pw1), vf[5], o1); \
        o0 = FA_MFMA(__builtin_bit_cast(bf16x8, pw2), vf[2], o0); o1 = FA_MFMA(__builtin_bit_cast(bf16x8, pw2), vf[6], o1); \
        o0 = FA_MFMA(__builtin_bit_cast(bf16x8, pw3), vf[3], o0); o1 = FA_MFMA(__builtin_bit_cast(bf16x8, pw3), vf[7], o1); } while (0)
#define FA_SOFTMAX(t, FIRST) do { \
        float rma = FA_MX3(p0[0], p0[1], p1[0]), rmb = FA_MX3(p0[2], p0[3], p1[1]); rma = FA_MX3(rma, p1[2], p1[3]); \
        _Pragma("unroll") for (int r = 4; r < 16; r += 4) { rma = FA_MX3(rma, p0[r], p0[r + 1]); rmb = FA_MX3(rmb, p0[r + 2], p0[r + 3]); rma = FA_MX3(rma, p1[r], p1[r + 1]); rmb = FA_MX3(rmb, p1[r + 2], p1[r + 3]); } \
        float rm = xhalf_max(__builtin_fmaxf(rma, rmb)); \
        float sacc = 0.f; \
        { const bool first0_ = (MODE == 0) && (FIRST);        \
          if (first0_ || __any(rm > THR)) { float dl = (rm > THR) ? rm : 0.0f; if (first0_) dl = (rm == -INFINITY) ? 0.0f : rm; \
                mref += dl; \
                _Pragma("unroll") for (int r = 0; r < 16; ++r) { p0[r] -= dl; p1[r] -= dl; } \
                if (MODE == 0) { _Pragma("unroll") for (int r = 0; r < 16; ++r) negm[r] -= dl; } \
                if (!first0_) { const float alpha = __builtin_amdgcn_exp2f(-dl); lrun *= alpha; \
                    if (hi == 0) wsf[r32] = alpha; asm volatile("s_waitcnt lgkmcnt(0)" ::: "memory"); \
                    _Pragma("unroll") for (int r = 0; r < 16; ++r) { const float f = wsf[crow(r, hi)]; o0[r] *= f; o1[r] *= f; } } } \
          FA_QKMMA(n0, n1);        \
          _Pragma("unroll") for (int r = 0; r < 16; ++r) { p0[r] = __builtin_amdgcn_exp2f(p0[r]); p1[r] = __builtin_amdgcn_exp2f(p1[r]); sacc += p0[r] + p1[r]; } } \
        lrun += sacc; \
        pw0 = (u32x4){cvt_pk_bf16(p0[0], p0[1]), cvt_pk_bf16(p0[2], p0[3]), cvt_pk_bf16(p0[4], p0[5]), cvt_pk_bf16(p0[6], p0[7])}; \
        pw1 = (u32x4){cvt_pk_bf16(p0[8], p0[9]), cvt_pk_bf16(p0[10], p0[11]), cvt_pk_bf16(p0[12], p0[13]), cvt_pk_bf16(p0[14], p0[15])}; \
        pw2 = (u32x4){cvt_pk_bf16(p1[0], p1[1]), cvt_pk_bf16(p1[2], p1[3]), cvt_pk_bf16(p1[4], p1[5]), cvt_pk_bf16(p1[6], p1[7])}; \
        pw3 = (u32x4){cvt_pk_bf16(p1[8], p1[9]), cvt_pk_bf16(p1[10], p1[11]), cvt_pk_bf16(p1[12], p1[13]), cvt_pk_bf16(p1[14], p1[15])}; \
        p0 = n0; p1 = n1; \
        { const int tmp_ = s_prev; s_prev = s_cur; s_cur = s_nxt; s_nxt = s_nn; s_nn = tmp_; } mw = mw_n; mw_n = mw_nn; } while (0)
    FA_TOP(t_lo); if (t_lo + 1 < t_hi) FA_KLOAD(s_nxt);
    FA_BIAS(p0, p1, key_base + 64 * t_lo, mw);
    FA_SOFTMAX(t_lo, 1);
    for (int t = t_lo + 1; t < t_hi; ++t) {
        FA_TOP(t);
        FA_PV(s_prev, t + 1 < t_hi);
        FA_BIAS(p0, p1, key_base + 64 * t, mw);
        FA_SOFTMAX(t, 0);
    }
    FA_PV(s_prev, false);
#undef FA_MX3
#undef FA_TOP
#undef FA_PV
#undef FA_SOFTMAX
    lrun += __shfl_xor(lrun, 32);
    if (hi == 0) wsf[32 + r32] = lrun;
    asm volatile("s_waitcnt lgkmcnt(0)" ::: "memory");
    LAS bf16_t* stg = (LAS bf16_t*)(F.lds + LDS_OST) + wid * 2048;
#pragma unroll
    for (int r = 0; r < 16; ++r) { const int orow = crow(r, hi); const float rl = __builtin_amdgcn_rcpf(wsf[32 + orow]);
        stg[orow * 64 + r32] = (bf16_t)f2bf(o0[r] * rl); stg[orow * 64 + 32 + r32] = (bf16_t)f2bf(o1[r] * rl); }
    asm volatile("s_waitcnt lgkmcnt(0)" ::: "memory");
    bf16_t* Ow = P.O + (rowbase + q0 + 32 * wid) * (long)P.ldo;
#pragma unroll
    for (int i = 0; i < 4; ++i) { const int row = i * 8 + (lane >> 3), ch = lane & 7; *(u32x4*)(Ow + (long)row * P.ldo + ch * 8) = *(const LAS u32x4*)(stg + row * 64 + ch * 8); }
    asm volatile("s_setprio 0\n\ts_waitcnt lgkmcnt(0)\n\ts_barrier" ::: "memory");
#undef FA_DMA
#undef FA_KLOAD
#undef FA_QKMMA
#undef FA_BIAS
}
}

namespace fd {
using fa::lds_cptr; using fa::v4i16_t; using fa::vtr; using fa::glds16; using fa::crow;
constexpr int NSLOT = 3, SLOTB = 8192, LDS_K = 0, LDS_V = NSLOT * SLOTB, LDS_WS = 2 * NSLOT * SLOTB, LDS_OST = LDS_WS + 8 * 256, LDS_MSK = LDS_OST + 8 * 4096, LDS_TOTAL = LDS_MSK + 8 * 2048;
static_assert(LDS_TOTAL <= LDSCTL_OFF, "dsa unit LDS");
__device__ __forceinline__ float max3f(float a, float b, float c) { float r; asm("v_max3_f32 %0, %1, %2, %3" : "=v"(r) : "v"(a), "v"(b), "v"(c)); return r; }
__device__ __forceinline__ float max2f(float a, float b) { float r; asm("v_max_f32_e32 %0, %1, %2" : "=v"(r) : "v"(a), "v"(b)); return r; }
#define FD_SBAR() __builtin_amdgcn_sched_barrier(0)
__device__ __forceinline__ float and_mask(int m, float x) { float r; asm("v_and_b32 %0, %1, %2" : "=v"(r) : "v"(m), "v"(x)); return r; }
#define FD_WAIT_BAR(N) asm volatile("s_waitcnt vmcnt(" #N ") lgkmcnt(0)\n\ts_barrier" ::: "memory")
#define FD_MFMA(a, b, c) __builtin_amdgcn_mfma_f32_32x32x16_bf16(a, b, c, 0, 0, 0)
__device__ __forceinline__ void kload8(bf16x8* kf, lds_cptr kp) {
    kf[0] = *(const LAS bf16x8*)(kp);        kf[1] = *(const LAS bf16x8*)(kp + 512);  kf[2] = *(const LAS bf16x8*)(kp + 2048); kf[3] = *(const LAS bf16x8*)(kp + 2560);
    kf[4] = *(const LAS bf16x8*)(kp + 4096); kf[5] = *(const LAS bf16x8*)(kp + 4608); kf[6] = *(const LAS bf16x8*)(kp + 6144); kf[7] = *(const LAS bf16x8*)(kp + 6656); }
__device__ __forceinline__ void kload2(bf16x8* kf, lds_cptr kp, int j) { kf[2 * j] = *(const LAS bf16x8*)(kp + j * 2048); kf[2 * j + 1] = *(const LAS bf16x8*)(kp + j * 2048 + 512); }
__device__ __forceinline__ float rowmax(const f32x16& p0, const f32x16& p1) {
    float a = max3f(p0[0], p0[1], p1[0]), b = max3f(p0[2], p0[3], p1[1]); a = max3f(a, p1[2], p1[3]);
#pragma unroll
    for (int r = 4; r < 16; r += 4) { a = max3f(a, p0[r], p0[r + 1]); b = max3f(b, p0[r + 2], p0[r + 3]); a = max3f(a, p1[r], p1[r + 1]); b = max3f(b, p1[r + 2], p1[r + 3]); }
    return fa::xhalf_max(max2f(a, b)); }
__device__ __forceinline__ void cmask(f32x16& p0, f32x16& p1, int jb, int qrel, int hi) {
    const int kb = 64 * jb + 4 * hi;
#pragma unroll
    for (int r = 0; r < 16; ++r) { const int kv = kb + (r & 3) + 8 * (r >> 2); if (kv > qrel) p0[r] = -INFINITY; if (kv + 32 > qrel) p1[r] = -INFINITY; } }

template <int SWA>
__device__ __forceinline__ void unit(const Frame& F, const fa::Ptrs& P, int b, int qb) {
    const int lane = F.lane, r32 = lane & 31, hi = lane >> 5, wid = F.wave;
    const int q0 = qb * 256, qrel = wid * 32 + r32, qidx = q0 + qrel, kb0 = (SWA && qb > 0) ? q0 - 128 : 0;
    const long rowbase = (long)b * SEQ, krow0 = rowbase + kb0;
    LAS unsigned char* shm = F.lds; const unsigned lds0 = (unsigned)(uintptr_t)shm;
    LAS float* wsf = (LAS float*)(shm + LDS_WS) + wid * 64;
    const bf16_t* ksrc = P.K + (krow0 + lane) * (long)P.ldk + wid * 8;
    const bf16_t* vsrc = P.V + (krow0 + 16 * (wid & 3) + (lane >> 2)) * (long)P.ldv + (wid >> 2) * 32 + (lane & 3) * 8;
    const char* msrc = SWA ? nullptr : (const char*)P.MK + (rowbase + qidx) * 1024L;
    const unsigned kdst = lds0 + LDS_K + wid * 1024, vdst = lds0 + LDS_V + wid * 1024, mdst = lds0 + LDS_MSK + wid * 2048;
#define FD_DMA_K(t, slot) glds16(ksrc + (long)(t) * 64 * P.ldk, (unsigned)__builtin_amdgcn_readfirstlane(kdst + (slot)))
#define FD_DMA_V(t, slot) glds16(vsrc + (long)(t) * 64 * P.ldv, (unsigned)__builtin_amdgcn_readfirstlane(vdst + (slot)))
#define FD_DMA_M(t) glds16(msrc + 8 * (t), (unsigned)__builtin_amdgcn_readfirstlane(mdst + ((((t) >> 1) & 1) << 10)))
    const lds_cptr shm3 = (lds_cptr)shm; const lds_cptr kp0 = shm3 + LDS_K + hi * 1024 + r32 * 16; const lds_cptr vp0 = shm3 + LDS_V + ((lane >> 4) & 1) * 32 + (lane & 3) * 8 + (4 * hi + ((lane & 15) >> 2)) * 64;
    const LAS unsigned* mlds = (const LAS unsigned*)(shm + LDS_MSK + wid * 2048) + lane * 4;
    const int NT = SWA ? (qb > 0 ? 6 : 4) : (q0 + 256) / 64;
    if (!SWA) { FD_DMA_M(0); if (2 < NT) FD_DMA_M(2); }
    FD_DMA_K(0, 0); FD_DMA_V(0, 0); FD_DMA_K(1, SLOTB);
    bf16x8 qr[4];
    { const bf16_t* Qw = P.Q + (rowbase + qidx) * (long)P.ldq + hi * 8;
#pragma unroll
      for (int d0 = 0; d0 < 4; ++d0) qr[d0] = *(const bf16x8*)(Qw + d0 * 16); }
    u32x4 kxA = {0u, 0u, 0u, 0u}, kxB = kxA, qx = kxA; unsigned qs2 = 0u;
    if (hi == 0) {
        const unsigned klA = __builtin_bit_cast(unsigned, (float)r32) >> 16, klB = __builtin_bit_cast(unsigned, (float)(r32 + 32)) >> 16, one = 0x3f80u;
        kxA = (u32x4){klA | (klA << 16), klA | (one << 16), one | (one << 16), 0u}; kxB = (u32x4){klB | (klB << 16), klB | (one << 16), one | (one << 16), 0u};
        const unsigned s0_ = __builtin_bit_cast(unsigned, P.slope2) & 0xffff0000u; const float t1_ = P.slope2 - __builtin_bit_cast(float, s0_);
        const unsigned s1_ = __builtin_bit_cast(unsigned, t1_) & 0xffff0000u; const float t2_ = t1_ - __builtin_bit_cast(float, s1_);
        qx.x = (s0_ >> 16) | s1_; qs2 = __builtin_bit_cast(unsigned, t2_) >> 16; }
    float mhat = SWA ? P.sink2 : 0.f, l_reg = (SWA && hi == 0) ? 1.0f : 0.f; f32x16 o[2]; o[0] = f32x16{}; o[1] = f32x16{};
#define FD_QX(t) do { const float c_ = (hi == 0) ? __builtin_fmaf(P.slope2, (float)(kb0 + 64 * (t) - qidx), -mhat) : 0.0f; \
        const unsigned c0_ = __builtin_bit_cast(unsigned, c_) & 0xffff0000u; const float r1_ = c_ - __builtin_bit_cast(float, c0_); \
        const unsigned c1_ = __builtin_bit_cast(unsigned, r1_) & 0xffff0000u; const float r2_ = r1_ - __builtin_bit_cast(float, c1_); \
        const unsigned c2_ = __builtin_bit_cast(unsigned, r2_) & 0xffff0000u; \
        qx.y = qs2 | c0_; qx.z = __builtin_amdgcn_perm(c2_, c1_, 0x07060302u); } while (0)
#define FD_KX(k) __builtin_bit_cast(bf16x8, k)
#define FD_CMASK(P0, P1, t) do { if (!SWA) { const int jb_ = (t) - (NT - 4); if (jb_ >= 0) cmask(P0, P1, jb_, qrel, hi); } } while (0)
#define FD_MW(t) unsigned w0_, w1_; if (SWA) { const int d_ = qidx - kb0 - 64 * (t);        \
            const int lo_ = d_ - 127 < 0 ? 0 : d_ - 127, hi_ = d_ > 63 ? 63 : d_; \
            const unsigned long long m_ = (hi_ >= lo_) ? ((hi_ == 63 ? ~0ull : ((1ull << (hi_ + 1)) - 1ull)) & ~((1ull << lo_) - 1ull)) : 0ull; \
            w0_ = (unsigned)m_ >> (4 * hi); w1_ = (unsigned)(m_ >> 32) >> (4 * hi); } \
        else { w0_ = mlds[((((t) >> 1) & 1) << 8) + 2 * ((t) & 1)] >> (4 * hi); w1_ = mlds[((((t) >> 1) & 1) << 8) + 2 * ((t) & 1) + 1] >> (4 * hi); }
#define FD_AND(X, W, B) do { _Pragma("unroll") for (int e_ = 0; e_ < 4; ++e_) { const int r_ = (B) + e_; \
        X[r_] = and_mask(__builtin_amdgcn_sbfe((int)(W), (r_ & 3) + 8 * (r_ >> 2), 1), X[r_]); } } while (0)
    bool resc = false;
#define FD_RESC() do { if (resc) { asm volatile("s_waitcnt lgkmcnt(0)" ::: "memory"); \
        _Pragma("unroll") for (int d_ = 0; d_ < 2; ++d_) _Pragma("unroll") for (int r = 0; r < 16; ++r) o[d_][r] *= wsf[crow(r, hi)]; } } while (0)
    f32x16 pA0, pA1, pB0, pB1; bf16x8 kf[8];
    int sl_prev = 0, sl_cur = 0, sl_next = SLOTB;
#define FD_ROT() do { sl_prev = sl_cur; sl_cur = sl_next; sl_next = (sl_next == (NSLOT - 1) * SLOTB) ? 0 : sl_next + SLOTB; } while (0)
    FD_DMA_K(2, 2 * SLOTB);
    FD_WAIT_BAR(3);
    FD_QX(0);
    { kload8(kf, kp0);
      pA0 = FD_MFMA(FD_KX(kxA), FD_KX(qx), f32x16{}); pA1 = FD_MFMA(FD_KX(kxB), FD_KX(qx), f32x16{});
#pragma unroll
      for (int d0 = 0; d0 < 4; ++d0) { pA0 = FD_MFMA(kf[2 * d0], qr[d0], pA0); pA1 = FD_MFMA(kf[2 * d0 + 1], qr[d0], pA1); } }
    asm volatile("s_nop 15\n\ts_nop 7" : "+v"(pA0), "+v"(pA1));
    FD_CMASK(pA0, pA1, 0);
    { const float rm = rowmax(pA0, pA1); const float dl = SWA ? __builtin_fmaxf(rm, 0.f) : rm; mhat += dl;
      if (SWA) l_reg *= __builtin_amdgcn_exp2f(-dl);
#pragma unroll
      for (int r = 0; r < 16; ++r) { pA0[r] -= dl; pA1[r] -= dl; }
#pragma unroll
      for (int r = 0; r < 16; ++r) { pA0[r] = __builtin_amdgcn_exp2f(pA0[r]); pA1[r] = __builtin_amdgcn_exp2f(pA1[r]); }
      asm volatile("" : "+v"(pA0), "+v"(pA1)); FD_SBAR();
      FD_MW(0);
      FD_AND(pA0, w0_, 0); FD_AND(pA0, w0_, 4); FD_AND(pA0, w0_, 8); FD_AND(pA0, w0_, 12); FD_AND(pA1, w1_, 0); FD_AND(pA1, w1_, 4); FD_AND(pA1, w1_, 8); FD_AND(pA1, w1_, 12); }
    FD_WAIT_BAR(0);
    FD_DMA_K(3, 0); FD_DMA_V(1, SLOTB);
    FD_ROT();
    kload8(kf, kp0 + sl_cur);
    FD_WAIT_BAR(2);
    v4i16_t vlo[8], vhi[8]; u32x4 pw0, pw1, pw2, pw3;
#define FD_PKW(Pv, B) cvt_pk_bf16(Pv[B], Pv[(B) + 1])
#define FD_PAF(k) __builtin_bit_cast(bf16x8, pw##k)
#define FD_VFR(i) (bf16x8){vlo[i][0], vlo[i][1], vlo[i][2], vlo[i][3], vhi[i][0], vhi[i][1], vhi[i][2], vhi[i][3]}
#define FD_PIN(x) asm volatile("" : "+v"(x))
#define FD_MX3(a, b, c) __builtin_fmaxf(__builtin_fmaxf((a), (b)), (c))
#define FD_GAPA(MF, A0, A1, A2, A3, W0, W1, PW) do { MF; sacc += A0; sacc += A1; sacc += A2; sacc += A3; FD_PIN(sacc); W0; W1; FD_PIN(PW); FD_SBAR(); } while (0)
#define FD_GAPB(MF, X, B, Y, WY, BY) do { MF; X[B] = __builtin_amdgcn_exp2f(X[B]); X[(B) + 1] = __builtin_amdgcn_exp2f(X[(B) + 1]); X[(B) + 2] = __builtin_amdgcn_exp2f(X[(B) + 2]); X[(B) + 3] = __builtin_amdgcn_exp2f(X[(B) + 3]); \
        if ((BY) >= 0) { FD_AND(Y, WY, ((BY) >= 0 ? (BY) : 0)); FD_PIN(Y); } FD_PIN(X); FD_SBAR(); } while (0)
#define FD_VRD(i) do { vlo[i] = vtr(vp_ + (((i) >> 2) * 4096 + ((i) & 3) * 1024)); vhi[i] = vtr(vp_ + (((i) >> 2) * 4096 + ((i) & 3) * 1024 + 512)); } while (0)
#define FD_KRD(G, j) do { if (G) { kload2(kf, kp0 + sl_next, j); FD_SBAR(); } } while (0)
#define FD_STEP(C0, C1, P0, P1, t, GK, GV, GL, GM) do { FD_SBAR(); \
        const lds_cptr vp_ = vp0 + sl_prev; FD_QX(t); FD_MW(t); \
        FD_VRD(0); FD_SBAR(); float sacc = (P0[0] + P0[1]); \
        C0 = FD_MFMA(FD_KX(kxA), FD_KX(qx), f32x16{}); FD_SBAR(); C1 = FD_MFMA(FD_KX(kxB), FD_KX(qx), f32x16{}); FD_SBAR(); \
        FD_GAPA(C0 = FD_MFMA(kf[0], qr[0], C0), P0[2], P0[3], P0[4], P0[5],     pw0[0] = FD_PKW(P0, 0), pw0[1] = FD_PKW(P0, 2), pw0); \
        FD_VRD(4); FD_SBAR(); FD_GAPA(C1 = FD_MFMA(kf[1], qr[0], C1), P0[6], P0[7], P0[8], P0[9],     pw0[2] = FD_PKW(P0, 4), pw0[3] = FD_PKW(P0, 6), pw0); \
        FD_VRD(1); FD_SBAR(); FD_GAPA(C0 = FD_MFMA(kf[2], qr[1], C0), P0[10], P0[11], P0[12], P0[13], pw1[0] = FD_PKW(P0, 8), pw1[1] = FD_PKW(P0, 10), pw1); \
        FD_VRD(5); FD_SBAR(); FD_GAPA(C1 = FD_MFMA(kf[3], qr[1], C1), P0[14], P0[15], P1[0], P1[1],   pw1[2] = FD_PKW(P0, 12), pw1[3] = FD_PKW(P0, 14), pw1); \
        FD_VRD(2); FD_SBAR(); FD_GAPA(C0 = FD_MFMA(kf[4], qr[2], C0), P1[2], P1[3], P1[4], P1[5],     pw2[0] = FD_PKW(P1, 0), pw2[1] = FD_PKW(P1, 2), pw2); \
        FD_VRD(6); FD_SBAR(); FD_GAPA(C1 = FD_MFMA(kf[5], qr[2], C1), P1[6], P1[7], P1[8], P1[9],     pw2[2] = FD_PKW(P1, 4), pw2[3] = FD_PKW(P1, 6), pw2); \
        FD_VRD(3); FD_SBAR(); FD_GAPA(C0 = FD_MFMA(kf[6], qr[3], C0), P1[10], P1[11], P1[12], P1[13], pw3[0] = FD_PKW(P1, 8), pw3[1] = FD_PKW(P1, 10), pw3); \
        FD_VRD(7); FD_SBAR(); FD_GAPA(C1 = FD_MFMA(kf[7], qr[3], C1), P1[14], P1[15], 0.f, 0.f,       pw3[2] = FD_PKW(P1, 12), pw3[3] = FD_PKW(P1, 14), pw3); \
        l_reg += sacc; \
        if (GK) { FD_DMA_K((t) + 3, sl_cur); } if (GV) { FD_DMA_V((t) + 1, sl_next); } if (!SWA && (GM)) { FD_DMA_M((t) + 2); } \
        FD_CMASK(C0, C1, t); \
        { float a = FD_MX3(C0[0], C0[1], C1[0]), bb = FD_MX3(C0[2], C0[3], C1[1]); a = FD_MX3(a, C1[2], C1[3]); \
          _Pragma("unroll") for (int r = 4; r < 16; r += 4) { a = FD_MX3(a, C0[r], C0[r + 1]); bb = FD_MX3(bb, C0[r + 2], C0[r + 3]); a = FD_MX3(a, C1[r], C1[r + 1]); bb = FD_MX3(bb, C1[r + 2], C1[r + 3]); } \
          const float rm = fa::xhalf_max(__builtin_fmaxf(a, bb)); \
          resc = false; \
          if (__builtin_expect(__any(rm > 8.0f), 0)) { const float dl = __builtin_fmaxf(rm, 0.f); mhat += dl; \
              _Pragma("unroll") for (int r = 0; r < 16; ++r) { C0[r] -= dl; C1[r] -= dl; } \
              const float f = __builtin_amdgcn_exp2f(-dl); l_reg *= f; if (hi == 0) wsf[r32] = f; resc = true; } } \
        FD_SBAR(); \
        FD_GAPB(o[0] = FD_MFMA(FD_PAF(0), FD_VFR(0), o[0]), C0, 0, C0, w0_, -1); \
        FD_GAPB(o[1] = FD_MFMA(FD_PAF(0), FD_VFR(4), o[1]), C0, 4, C0, w0_, 0); \
        FD_KRD(GL, 0); FD_GAPB(o[0] = FD_MFMA(FD_PAF(1), FD_VFR(1), o[0]), C0, 8, C0, w0_, 4); \
        FD_KRD(GL, 1); FD_GAPB(o[1] = FD_MFMA(FD_PAF(1), FD_VFR(5), o[1]), C0, 12, C0, w0_, 8); \
        FD_KRD(GL, 2); FD_GAPB(o[0] = FD_MFMA(FD_PAF(2), FD_VFR(2), o[0]), C1, 0, C0, w0_, 12); \
        FD_KRD(GL, 3); FD_GAPB(o[1] = FD_MFMA(FD_PAF(2), FD_VFR(6), o[1]), C1, 4, C1, w1_, 0); \
        FD_GAPB(o[0] = FD_MFMA(FD_PAF(3), FD_VFR(3), o[0]), C1, 8, C1, w1_, 4); \
        FD_GAPB(o[1] = FD_MFMA(FD_PAF(3), FD_VFR(7), o[1]), C1, 12, C1, w1_, 8); \
        FD_AND(C1, w1_, 12); FD_PIN(C1); FD_SBAR(); \
        } while (0)
#define FD_ENDW(n_) do { if ((n_) == 3) { FD_WAIT_BAR(3); } else if ((n_) == 2) { FD_WAIT_BAR(2); } else if ((n_) == 1) { FD_WAIT_BAR(1); } else { FD_WAIT_BAR(0); } } while (0)
    int t = 1;
#undef FD_CMASK
#define FD_CMASK(P0, P1, t) do { } while (0)
    for (; t + 5 < NT; t += 2) {
        FD_STEP(pB0, pB1, pA0, pA1, t, true, true, true, false);     FD_WAIT_BAR(2); FD_RESC(); FD_ROT();
        FD_STEP(pA0, pA1, pB0, pB1, t + 1, true, true, true, true);  if (SWA) { FD_WAIT_BAR(2); } else { FD_WAIT_BAR(3); } FD_RESC(); FD_ROT();
    }
#undef FD_CMASK
#define FD_CMASK(P0, P1, t) do { const int jb_ = (t) - (NT - 4); if (jb_ >= 0) cmask(P0, P1, jb_, qrel, hi); } while (0)
    for (; t + 1 < NT; t += 2) {
        { const bool gk = t + 3 < NT, gv = t + 1 < NT; FD_STEP(pB0, pB1, pA0, pA1, t, gk, gv, gv, false); const int n_ = (t + 2 < NT) ? ((int)gk + (int)gv) : 0; FD_ENDW(n_); FD_RESC(); FD_ROT(); }
        { const bool gk = t + 4 < NT, gv = t + 2 < NT, gm = t + 3 < NT; FD_STEP(pA0, pA1, pB0, pB1, t + 1, gk, gv, gv, gm); const int n_ = (t + 3 < NT) ? ((int)gk + (int)gv + (SWA ? 0 : (int)gm)) : 0; FD_ENDW(n_); FD_RESC(); FD_ROT(); }
    }
    FD_STEP(pB0, pB1, pA0, pA1, NT - 1, false, false, false, false); FD_RESC();
    { float sacc = pB0[0] + pB0[1];
#pragma unroll
      for (int r = 2; r < 16; ++r) sacc += pB0[r];
#pragma unroll
      for (int r = 0; r < 16; ++r) sacc += pB1[r];
      l_reg += sacc;
      pw0 = (u32x4){FD_PKW(pB0, 0), FD_PKW(pB0, 2), FD_PKW(pB0, 4), FD_PKW(pB0, 6)}; pw1 = (u32x4){FD_PKW(pB0, 8), FD_PKW(pB0, 10), FD_PKW(pB0, 12), FD_PKW(pB0, 14)};
      pw2 = (u32x4){FD_PKW(pB1, 0), FD_PKW(pB1, 2), FD_PKW(pB1, 4), FD_PKW(pB1, 6)}; pw3 = (u32x4){FD_PKW(pB1, 8), FD_PKW(pB1, 10), FD_PKW(pB1, 12), FD_PKW(pB1, 14)};
      FD_SBAR();
      const lds_cptr vp_ = vp0 + sl_cur;
#pragma unroll
      for (int i = 0; i < 8; ++i) FD_VRD(i);
      o[0] = FD_MFMA(FD_PAF(0), FD_VFR(0), o[0]); o[1] = FD_MFMA(FD_PAF(0), FD_VFR(4), o[1]); o[0] = FD_MFMA(FD_PAF(1), FD_VFR(1), o[0]); o[1] = FD_MFMA(FD_PAF(1), FD_VFR(5), o[1]);
      o[0] = FD_MFMA(FD_PAF(2), FD_VFR(2), o[0]); o[1] = FD_MFMA(FD_PAF(2), FD_VFR(6), o[1]); o[0] = FD_MFMA(FD_PAF(3), FD_VFR(3), o[0]); o[1] = FD_MFMA(FD_PAF(3), FD_VFR(7), o[1]); }
    { float la_ = l_reg, lb_ = l_reg; asm volatile("s_nop 1\n\tv_permlane32_swap_b32 %0, %1\n\ts_nop 1" : "+v"(la_), "+v"(lb_)); l_reg = la_ + lb_; }
    if (hi == 0) wsf[32 + r32] = l_reg;
    asm volatile("s_waitcnt lgkmcnt(0)" ::: "memory");
    LAS bf16_t* stg = (LAS bf16_t*)(shm + LDS_OST) + wid * 2048;
#pragma unroll
    for (int r = 0; r < 16; ++r) { const int orow = crow(r, hi); const float rl = __builtin_amdgcn_rcpf(wsf[32 + orow]);
        stg[orow * 64 + r32] = (bf16_t)f2bf(o[0][r] * rl); stg[orow * 64 + 32 + r32] = (bf16_t)f2bf(o[1][r] * rl); }
    asm volatile("s_waitcnt lgkmcnt(0)" ::: "memory");
    bf16_t* Ow = P.O + (rowbase + q0 + 32 * wid) * (long)P.ldo;
#pragma unroll
    for (int i = 0; i < 4; ++i) { const int row = i * 8 + (lane >> 3), ch = lane & 7; *(u32x4*)(Ow + (long)row * P.ldo + ch * 8) = *(const LAS u32x4*)(stg + row * 64 + ch * 8); }
    asm volatile("s_waitcnt lgkmcnt(0)\n\ts_barrier" ::: "memory");
#undef FD_DMA_K
#undef FD_DMA_V
#undef FD_DMA_M
#undef FD_QX
#undef FD_KX
#undef FD_CMASK
#undef FD_MW
#undef FD_AND
#undef FD_RESC
#undef FD_ROT
#undef FD_PKW
#undef FD_PAF
#undef FD_VFR
#undef FD_PIN
#undef FD_MX3
#undef FD_GAPA
#undef FD_GAPB
#undef FD_VRD
#undef FD_KRD
#undef FD_STEP
#undef FD_ENDW
}
#undef FD_SBAR
#undef FD_WAIT_BAR
#undef FD_MFMA
}

namespace fm {
using fa::lds_cptr; using fa::v4i16_t; using fa::vtr; using fa::glds16; using fa::crow;
constexpr int NSLOT = 3, SLOTK = 12288, SLOTV = 8192, LDS_K = 0, LDS_V = NSLOT * SLOTK, LDS_WS = LDS_V + NSLOT * SLOTV, LDS_OST = LDS_WS + 8 * 256, LDS_TOTAL = LDS_OST + 8 * 4096;
static_assert(LDS_TOTAL <= LDSCTL_OFF, "mla unit LDS");
#define FM_SBAR() __builtin_amdgcn_sched_barrier(0)
#define FM_WAIT_BAR(N) asm volatile("s_waitcnt vmcnt(" #N ") lgkmcnt(0)\n\ts_barrier" ::: "memory")
#define FM_MFMA(a, b, c) __builtin_amdgcn_mfma_f32_32x32x16_bf16(a, b, c, 0, 0, 0)
__device__ __forceinline__ void kload2(bf16x8* kf, lds_cptr kp, int j) { kf[2 * j] = *(const LAS bf16x8*)(kp + j * 2048); kf[2 * j + 1] = *(const LAS bf16x8*)(kp + j * 2048 + 512); }

__device__ __forceinline__ void unit(const Frame& F, const fa::Ptrs& P, int b, int qb) {
    const int lane = F.lane, r32 = lane & 31, hi = lane >> 5, wid = F.wave;
    const long rowbase = (long)b * SEQ; const int q0 = qb * 256, qrel = wid * 32 + r32, qidx = q0 + qrel;
    LAS unsigned char* shm = F.lds; const unsigned lds0 = (unsigned)(uintptr_t)shm;
    LAS float* wsf = (LAS float*)(shm + LDS_WS) + wid * 64;
    const bf16_t* ksrc = P.K + (rowbase + lane) * (long)P.ldk + wid * 8;
    const bf16_t* krsrc = P.KR + (rowbase + lane) * 32L + (wid & 3) * 8;
    const bf16_t* vsrc = P.V + (rowbase + 16 * (wid & 3) + (lane >> 2)) * (long)P.ldv + (wid >> 2) * 32 + (lane & 3) * 8;
    const unsigned kdst = lds0 + LDS_K + wid * 1024, krdst = lds0 + LDS_K + (8 + (wid & 3)) * 1024, vdst = lds0 + LDS_V + wid * 1024;
#define FM_DMA_K(t, slot) do { glds16(ksrc + (long)(t) * 64 * P.ldk, (unsigned)__builtin_amdgcn_readfirstlane(kdst + (slot))); glds16(krsrc + (long)(t) * 64 * 32, (unsigned)__builtin_amdgcn_readfirstlane(krdst + (slot))); } while (0)
#define FM_DMA_V(t, slot) glds16(vsrc + (long)(t) * 64 * P.ldv, (unsigned)__builtin_amdgcn_readfirstlane(vdst + (slot)))
    const lds_cptr shm3 = (lds_cptr)shm; const lds_cptr kp0 = shm3 + LDS_K + hi * 1024 + r32 * 16; const lds_cptr vp0 = shm3 + LDS_V + ((lane >> 4) & 1) * 32 + (lane & 3) * 8 + (4 * hi + ((lane & 15) >> 2)) * 64;
    const int NT = (q0 + 256) / 64;
    FM_DMA_K(0, 0); FM_DMA_V(0, 0); FM_DMA_K(1, SLOTK);
    bf16x8 qr[6];
    { const bf16_t* Qw = P.Q + (rowbase + qidx) * (long)P.ldq + hi * 8;
#pragma unroll
      for (int d0 = 0; d0 < 6; ++d0) qr[d0] = *(const bf16x8*)(Qw + d0 * 16); }
    float mhat = 0.f, l_reg = 0.f; f32x16 o[2]; o[0] = f32x16{}; o[1] = f32x16{};
#define FM_CMASK(P0, P1, t) do { const int jb_ = (t) - (NT - 4); if (jb_ >= 0) fd::cmask(P0, P1, jb_, qrel, hi); } while (0)
    bool resc = false;
#define FM_RESC() do { if (resc) { asm volatile("s_waitcnt lgkmcnt(0)" ::: "memory"); \
        _Pragma("unroll") for (int d_ = 0; d_ < 2; ++d_) _Pragma("unroll") for (int r = 0; r < 16; ++r) o[d_][r] *= wsf[crow(r, hi)]; } } while (0)
    f32x16 pA0, pA1, pB0, pB1; bf16x8 kf[12];
    int kl_prev = 0, kl_cur = 0, kl_next = SLOTK, vl_prev = 0, vl_cur = 0, vl_next = SLOTV;
#define FM_ROT() do { kl_prev = kl_cur; kl_cur = kl_next; kl_next = (kl_next == (NSLOT - 1) * SLOTK) ? 0 : kl_next + SLOTK; vl_prev = vl_cur; vl_cur = vl_next; vl_next = (vl_next == (NSLOT - 1) * SLOTV) ? 0 : vl_next + SLOTV; } while (0)
    FM_DMA_K(2, 2 * SLOTK);
    FM_WAIT_BAR(5);
#pragma unroll
    for (int j = 0; j < 6; ++j) kload2(kf, kp0, j);
    pA0 = FM_MFMA(kf[0], qr[0], f32x16{}); pA1 = FM_MFMA(kf[1], qr[0], f32x16{});
#pragma unroll
    for (int d0 = 1; d0 < 6; ++d0) { pA0 = FM_MFMA(kf[2 * d0], qr[d0], pA0); pA1 = FM_MFMA(kf[2 * d0 + 1], qr[d0], pA1); }
    asm volatile("s_nop 15\n\ts_nop 7" : "+v"(pA0), "+v"(pA1));
    FM_CMASK(pA0, pA1, 0);
    { const float rm = fd::rowmax(pA0, pA1); const float dl = rm; mhat += dl;
#pragma unroll
      for (int r = 0; r < 16; ++r) { pA0[r] -= dl; pA1[r] -= dl; }
#pragma unroll
      for (int r = 0; r < 16; ++r) { pA0[r] = __builtin_amdgcn_exp2f(pA0[r]); pA1[r] = __builtin_amdgcn_exp2f(pA1[r]); } }
    FM_WAIT_BAR(0);
    FM_DMA_K(3, 0); FM_DMA_V(1, SLOTV);
    FM_ROT();
#pragma unroll
    for (int j = 0; j < 6; ++j) kload2(kf, kp0 + kl_cur, j);
    FM_WAIT_BAR(3);
    v4i16_t vlo[8], vhi[8]; u32x4 pw[4];
#define FM_VFR(i) (bf16x8){vlo[i][0], vlo[i][1], vlo[i][2], vlo[i][3], vhi[i][0], vhi[i][1], vhi[i][2], vhi[i][3]}
#define FM_PIN(x) asm volatile("" : "+v"(x))
#define FM_MX3(a, b, c) __builtin_fmaxf(__builtin_fmaxf((a), (b)), (c))
#define FM_VRD(i) do { vlo[i] = vtr(vp_ + (((i) >> 2) * 4096 + ((i) & 3) * 1024)); vhi[i] = vtr(vp_ + (((i) >> 2) * 4096 + ((i) & 3) * 1024 + 512)); } while (0)
#define FM_PE(P0, P1, e) (((e) < 16) ? P0[(e) & 15] : P1[(e) & 15])
#define FM_STEP(C0, C1, P0, P1, t, GK, GV, GL) do { FM_SBAR(); \
        const lds_cptr vp_ = vp0 + vl_prev; float sacc = (P0[0] + P0[1]); \
        _Pragma("unroll") for (int i_ = 0; i_ < 12; ++i_) { \
            if (i_ < 8) { const int vi_ = (i_ >> 1) + 4 * (i_ & 1); FM_VRD(vi_); FM_SBAR(); } \
            if (i_ == 0) C0 = FM_MFMA(kf[0], qr[0], f32x16{}); else if (i_ == 1) C1 = FM_MFMA(kf[1], qr[0], f32x16{}); \
            else if (i_ & 1) C1 = FM_MFMA(kf[i_], qr[i_ >> 1], C1); else C0 = FM_MFMA(kf[i_], qr[i_ >> 1], C0); \
            _Pragma("unroll") for (int e_ = 2 + (30 * i_) / 12; e_ < 2 + (30 * (i_ + 1)) / 12; ++e_) sacc += FM_PE(P0, P1, e_); \
            FM_PIN(sacc); \
            _Pragma("unroll") for (int j_ = (16 * i_) / 12; j_ < (16 * (i_ + 1)) / 12; ++j_) { pw[j_ >> 2][j_ & 3] = cvt_pk_bf16(FM_PE(P0, P1, 2 * j_), FM_PE(P0, P1, 2 * j_ + 1)); FM_PIN(pw[j_ >> 2]); } \
            FM_SBAR(); } \
        l_reg += sacc; \
        if (GK) { FM_DMA_K((t) + 3, kl_cur); } if (GV) { FM_DMA_V((t) + 1, vl_next); } \
        FM_CMASK(C0, C1, t); \
        { float a = FM_MX3(C0[0], C0[1], C1[0]), bb = FM_MX3(C0[2], C0[3], C1[1]); a = FM_MX3(a, C1[2], C1[3]); \
          _Pragma("unroll") for (int r = 4; r < 16; r += 4) { a = FM_MX3(a, C0[r], C0[r + 1]); bb = FM_MX3(bb, C0[r + 2], C0[r + 3]); a = FM_MX3(a, C1[r], C1[r + 1]); bb = FM_MX3(bb, C1[r + 2], C1[r + 3]); } \
          const float rm = fa::xhalf_max(__builtin_fmaxf(a, bb)); \
          resc = false; \
          if (__builtin_expect(__any(rm > mhat + 8.0f), 0)) { const float dl = (rm > mhat + 8.0f) ? rm - mhat : 0.f; mhat += dl;        \
              const float f = __builtin_amdgcn_exp2f(-dl); l_reg *= f; if (hi == 0) wsf[r32] = f; resc = true; } } \
        FM_SBAR(); \
        _Pragma("unroll") for (int j_ = 0; j_ < 8; ++j_) { \
            if ((GL) && j_ >= 1 && j_ <= 6) { kload2(kf, kp0 + kl_next, j_ - 1); FM_SBAR(); } \
            if (j_ & 1) o[1] = FM_MFMA(__builtin_bit_cast(bf16x8, pw[j_ >> 1]), FM_VFR(4 + (j_ >> 1)), o[1]); else o[0] = FM_MFMA(__builtin_bit_cast(bf16x8, pw[j_ >> 1]), FM_VFR(j_ >> 1), o[0]); \
            if (j_ < 4) { C0[4 * j_] = __builtin_amdgcn_exp2f(C0[4 * j_] - mhat); C0[4 * j_ + 1] = __builtin_amdgcn_exp2f(C0[4 * j_ + 1] - mhat); C0[4 * j_ + 2] = __builtin_amdgcn_exp2f(C0[4 * j_ + 2] - mhat); C0[4 * j_ + 3] = __builtin_amdgcn_exp2f(C0[4 * j_ + 3] - mhat); FM_PIN(C0); } \
            else { C1[4 * (j_ & 3)] = __builtin_amdgcn_exp2f(C1[4 * (j_ & 3)] - mhat); C1[4 * (j_ & 3) + 1] = __builtin_amdgcn_exp2f(C1[4 * (j_ & 3) + 1] - mhat); C1[4 * (j_ & 3) + 2] = __builtin_amdgcn_exp2f(C1[4 * (j_ & 3) + 2] - mhat); C1[4 * (j_ & 3) + 3] = __builtin_amdgcn_exp2f(C1[4 * (j_ & 3) + 3] - mhat); FM_PIN(C1); } \
            FM_SBAR(); } \
        } while (0)
#define FM_ENDW(n_) do { if ((n_) == 3) { FM_WAIT_BAR(3); } else if ((n_) == 2) { FM_WAIT_BAR(2); } else if ((n_) == 1) { FM_WAIT_BAR(1); } else { FM_WAIT_BAR(0); } } while (0)
    int t = 1;
#undef FM_CMASK
#define FM_CMASK(P0, P1, t) do { } while (0)
    for (; t + 5 < NT; t += 2) {
        FM_STEP(pB0, pB1, pA0, pA1, t, true, true, true);     FM_WAIT_BAR(3); FM_RESC(); FM_ROT();
        FM_STEP(pA0, pA1, pB0, pB1, t + 1, true, true, true); FM_WAIT_BAR(3); FM_RESC(); FM_ROT();
    }
#undef FM_CMASK
#define FM_CMASK(P0, P1, t) do { const int jb_ = (t) - (NT - 4); if (jb_ >= 0) fd::cmask(P0, P1, jb_, qrel, hi); } while (0)
    for (; t + 1 < NT; t += 2) {
        { const bool gk = t + 3 < NT, gv = t + 1 < NT; FM_STEP(pB0, pB1, pA0, pA1, t, gk, gv, gv); const int n_ = (t + 2 < NT) ? (2 * (int)gk + (int)gv) : 0; FM_ENDW(n_); FM_RESC(); FM_ROT(); }
        { const bool gk = t + 4 < NT, gv = t + 2 < NT; FM_STEP(pA0, pA1, pB0, pB1, t + 1, gk, gv, gv); const int n_ = (t + 3 < NT) ? (2 * (int)gk + (int)gv) : 0; FM_ENDW(n_); FM_RESC(); FM_ROT(); }
    }
    FM_STEP(pB0, pB1, pA0, pA1, NT - 1, false, false, false); FM_RESC();
    { float sacc = pB0[0] + pB0[1];
#pragma unroll
      for (int r = 2; r < 16; ++r) sacc += pB0[r];
#pragma unroll
      for (int r = 0; r < 16; ++r) sacc += pB1[r];
      l_reg += sacc;
#pragma unroll
      for (int j = 0; j < 16; ++j) pw[j >> 2][j & 3] = cvt_pk_bf16(FM_PE(pB0, pB1, 2 * j), FM_PE(pB0, pB1, 2 * j + 1));
      FM_SBAR();
      const lds_cptr vp_ = vp0 + vl_cur;
#pragma unroll
      for (int i = 0; i < 8; ++i) FM_VRD(i);
#pragma unroll
      for (int k = 0; k < 4; ++k) { o[0] = FM_MFMA(__builtin_bit_cast(bf16x8, pw[k]), FM_VFR(k), o[0]); o[1] = FM_MFMA(__builtin_bit_cast(bf16x8, pw[k]), FM_VFR(4 + k), o[1]); } }
    { float la_ = l_reg, lb_ = l_reg; asm volatile("s_nop 1\n\tv_permlane32_swap_b32 %0, %1\n\ts_nop 1" : "+v"(la_), "+v"(lb_)); l_reg = la_ + lb_; }
    if (hi == 0) wsf[32 + r32] = l_reg;
    asm volatile("s_waitcnt lgkmcnt(0)" ::: "memory");
    LAS bf16_t* stg = (LAS bf16_t*)(shm + LDS_OST) + wid * 2048;
#pragma unroll
    for (int r = 0; r < 16; ++r) { const int orow = crow(r, hi); const float rl = __builtin_amdgcn_rcpf(wsf[32 + orow]);
        stg[orow * 64 + r32] = (bf16_t)f2bf(o[0][r] * rl); stg[orow * 64 + 32 + r32] = (bf16_t)f2bf(o[1][r] * rl); }
    asm volatile("s_waitcnt lgkmcnt(0)" ::: "memory");
    bf16_t* Ow = P.O + (rowbase + q0 + 32 * wid) * (long)P.ldo;
#pragma unroll
    for (int i = 0; i < 4; ++i) { const int row = i * 8 + (lane >> 3), ch = lane & 7; *(u32x4*)(Ow + (long)row * P.ldo + ch * 8) = *(const LAS u32x4*)(stg + row * 64 + ch * 8); }
    asm volatile("s_waitcnt lgkmcnt(0)\n\ts_barrier" ::: "memory");
#undef FM_DMA_K
#undef FM_DMA_V
#undef FM_CMASK
#undef FM_RESC
#undef FM_ROT
#undef FM_VFR
#undef FM_PIN
#undef FM_MX3
#undef FM_VRD
#undef FM_PE
#undef FM_STEP
#undef FM_ENDW
}
#undef FM_SBAR
#undef FM_WAIT_BAR
#undef FM_MFMA
}


namespace ix {
__device__ __forceinline__ unsigned ordf(float f) { const unsigned u = __builtin_bit_cast(unsigned, f); return u ^ ((u >> 31) ? 0xFFFFFFFFu : 0x80000000u); }
constexpr int L_HIST = EXTRA_OFF, L_MK = EXTRA_OFF + 16384, L_CV = L_MK + 4096, L_CI = L_CV + 1024, L_RED = L_CI + 1024, L_SELW = L_RED + 256, L_FLAG = L_SELW + 64;
struct Pre { bf16x8 qi[4]; float w[2][8]; bf16x8 kbA[4], kbB[4]; };
__device__ __forceinline__ void preload(const Frame& F, const bf16_t* Z, const bf16_t* KIT, int b, int qu, Pre& pre) {
    const int lane = F.lane, r32 = lane & 31, hi = lane >> 5, wid = F.wave;
    const long rowbase = (long)b * SEQ; const int t0 = 4 * qu, ntile = (t0 >> 5) + 1, npair = (ntile + 1) >> 1;
    { const int rho = r32, hq = (rho >> 2) & 1, gq = rho >> 3, iq = rho & 3;
      const bf16_t* qp = Z + (rowbase + t0 + 2 * hq + (gq >> 1)) * (long)ZP + ZC_IQ + 64 * (4 * (gq & 1) + iq) + 8 * hi;
#pragma unroll
      for (int ks = 0; ks < 4; ++ks) pre.qi[ks] = *(const bf16x8*)(qp + 16 * ks);
#pragma unroll
      for (int q2 = 0; q2 < 2; ++q2) { const u32x4 ww = *(const u32x4*)(Z + (rowbase + t0 + 2 * hi + q2) * (long)ZP + ZC_IW);
          pre.w[q2][0] = bf_lo(ww.x); pre.w[q2][1] = bf_hi(ww.x); pre.w[q2][2] = bf_lo(ww.y); pre.w[q2][3] = bf_hi(ww.y); pre.w[q2][4] = bf_lo(ww.z); pre.w[q2][5] = bf_hi(ww.z); pre.w[q2][6] = bf_lo(ww.w); pre.w[q2][7] = bf_hi(ww.w); } }
    const bf16_t* kbase = KIT + (size_t)(rowbase >> 5) * 2048 + hi * 256 + r32 * 8;
    if (wid < npair) { const bf16_t* kp = kbase + (size_t)(2 * wid) * 2048;
#pragma unroll
        for (int ks = 0; ks < 4; ++ks) { pre.kbA[ks] = *(const bf16x8*)(kp + 512 * ks); pre.kbB[ks] = *(const bf16x8*)(kp + 2048 + 512 * ks); } }
    else {
#pragma unroll
        for (int ks = 0; ks < 4; ++ks) { pre.kbA[ks] = bf16x8{}; pre.kbB[ks] = bf16x8{}; } }
}
__device__ __forceinline__ float relu1(float x) { const int i = __builtin_bit_cast(int, x); return __builtin_bit_cast(float, i > 0 ? i : 0); }
#define IX_BAR() asm volatile("s_waitcnt lgkmcnt(0)\n\ts_barrier" ::: "memory")
__device__ __forceinline__ void unit(const Frame& F, const bf16_t* Z, const bf16_t* KIT, unsigned* MK, int b, int qu, Pre& pre, bool has_next, int nb, int nqu) {
    const int lane = F.lane, r32 = lane & 31, hi = lane >> 5, wid = F.wave;
    const long rowbase = (long)b * SEQ; const int t0 = 4 * qu, ntile = (t0 >> 5) + 1, nk32 = 32 * ntile, nblk = (nk32 + 63) >> 6;
    LAS float* sc = (LAS float*)F.lds;
    LAS unsigned* hist = (LAS unsigned*)(F.lds + L_HIST);
    LAS unsigned* mk = (LAS unsigned*)(F.lds + L_MK);
    LAS float* cval = (LAS float*)(F.lds + L_CV); LAS unsigned* cidx = (LAS unsigned*)(F.lds + L_CI);
    LAS float* red = (LAS float*)(F.lds + L_RED);
    LAS unsigned* selw = (LAS unsigned*)(F.lds + L_SELW);
    LAS unsigned* flag = (LAS unsigned*)(F.lds + L_FLAG);
    bf16x8 qi[4]; float w[2][8];
#pragma unroll
    for (int ks = 0; ks < 4; ++ks) qi[ks] = pre.qi[ks];
#pragma unroll
    for (int q2 = 0; q2 < 2; ++q2)
#pragma unroll
        for (int e = 0; e < 8; ++e) w[q2][e] = pre.w[q2][e];
    float vmaxA = -INFINITY, vmaxB = -INFINITY, vminA = INFINITY, vminB = INFINITY;
    bf16x8 kq[2][8];
    const int npair = (ntile + 1) >> 1;
    const bf16_t* kbase = KIT + (size_t)(rowbase >> 5) * 2048 + hi * 256 + r32 * 8;
#pragma unroll
    for (int ks = 0; ks < 4; ++ks) { kq[0][ks] = pre.kbA[ks]; kq[0][4 + ks] = pre.kbB[ks]; }
#define IX_LOADP(BUF, PP) do { const bf16_t* kp_ = kbase + (size_t)(2 * (PP)) * 2048; \
        _Pragma("unroll") for (int ks = 0; ks < 4; ++ks) { kq[BUF][ks] = *(const bf16x8*)(kp_ + 512 * ks); kq[BUF][4 + ks] = *(const bf16x8*)(kp_ + 2048 + 512 * ks); } } while (0)
    if (wid + NWAVES < npair) IX_LOADP(1, wid + NWAVES);
    else {
#pragma unroll
        for (int ks = 0; ks < 8; ++ks) kq[1][ks] = bf16x8{}; }
#define IX_ELEM(D, e, sa, sb) do { const float ra_ = relu1(D[e]), rb_ = relu1(D[8 + (e)]); sa = __builtin_fmaf(w[0][e], ra_, sa); sb = __builtin_fmaf(w[1][e], rb_, sb); } while (0)
#define IX_TAIL(sa, sb, S0) do { const int s = (S0) + r32;                       \
        if (s > t0 + 2 * hi) sa = -INFINITY; else { vmaxA = __builtin_fmaxf(vmaxA, sa); vminA = __builtin_fminf(vminA, sa); } \
        if (s > t0 + 2 * hi + 1) sb = -INFINITY; else { vmaxB = __builtin_fmaxf(vmaxB, sb); vminB = __builtin_fminf(vminB, sb); } \
        sc[(2 * hi) * 8192 + s] = sa; sc[(2 * hi + 1) * 8192 + s] = sb; } while (0)
#define IX_PIN2(x, y) asm volatile("" : "+v"(x), "+v"(y))
#define IX_MF(a, b, c) __builtin_amdgcn_mfma_f32_32x32x16_bf16(a, b, c, 0, 0, 0)
#define IX_GAP(MF, D, e0, sa, sb) do { MF; IX_ELEM(D, e0, sa, sb); IX_ELEM(D, (e0) + 1, sa, sb); IX_PIN2(sa, sb); __builtin_amdgcn_sched_barrier(0); } while (0)
#define IX_PIPE(cA, cB, nA, nB, KQ, P, HASN) do { const int s0_ = 64 * (P); float sa = 0.f, sb = 0.f; __builtin_amdgcn_sched_barrier(0); \
        if (HASN) { \
            IX_GAP(nA = IX_MF(qi[0], KQ[0], f32x16{}), cA, 0, sa, sb); IX_GAP(nB = IX_MF(qi[0], KQ[4], f32x16{}), cA, 2, sa, sb); \
            IX_GAP(nA = IX_MF(qi[1], KQ[1], nA), cA, 4, sa, sb);       IX_GAP(nB = IX_MF(qi[1], KQ[5], nB), cA, 6, sa, sb); \
            IX_TAIL(sa, sb, s0_); sa = 0.f; sb = 0.f; __builtin_amdgcn_sched_barrier(0); \
            IX_GAP(nA = IX_MF(qi[2], KQ[2], nA), cB, 0, sa, sb);       IX_GAP(nB = IX_MF(qi[2], KQ[6], nB), cB, 2, sa, sb); \
            IX_GAP(nA = IX_MF(qi[3], KQ[3], nA), cB, 4, sa, sb);       IX_GAP(nB = IX_MF(qi[3], KQ[7], nB), cB, 6, sa, sb); \
        } else { \
            IX_ELEM(cA, 0, sa, sb); IX_ELEM(cA, 1, sa, sb); IX_ELEM(cA, 2, sa, sb); IX_ELEM(cA, 3, sa, sb); IX_ELEM(cA, 4, sa, sb); IX_ELEM(cA, 5, sa, sb); IX_ELEM(cA, 6, sa, sb); IX_ELEM(cA, 7, sa, sb); \
            IX_TAIL(sa, sb, s0_); sa = 0.f; sb = 0.f; \
            IX_ELEM(cB, 0, sa, sb); IX_ELEM(cB, 1, sa, sb); IX_ELEM(cB, 2, sa, sb); IX_ELEM(cB, 3, sa, sb); IX_ELEM(cB, 4, sa, sb); IX_ELEM(cB, 5, sa, sb); IX_ELEM(cB, 6, sa, sb); IX_ELEM(cB, 7, sa, sb); \
        } \
        if (s0_ + 32 < nk32) IX_TAIL(sa, sb, s0_ + 32); __builtin_amdgcn_sched_barrier(0); } while (0)
    f32x16 dA = {}, dB = {}, eA = {}, eB = {};
    if (wid < npair) {
#pragma unroll
        for (int ks = 0; ks < 4; ++ks) { dA = IX_MF(qi[ks], kq[0][ks], dA); dB = IX_MF(qi[ks], kq[0][4 + ks], dB); }
        if (wid + 2 * NWAVES < npair) IX_LOADP(0, wid + 2 * NWAVES);
    }
    for (int p0_ = wid; p0_ < npair; p0_ += 2 * NWAVES) {
        { const int p = p0_, pn = p + NWAVES; const bool hn = pn < npair;
          IX_PIPE(dA, dB, eA, eB, kq[1], p, hn); if (pn + 2 * NWAVES < npair) IX_LOADP(1, pn + 2 * NWAVES); }
        { const int p = p0_ + NWAVES, pn = p + NWAVES; if (p < npair) { const bool hn = pn < npair;
          IX_PIPE(eA, eB, dA, dB, kq[0], p, hn); if (pn + 2 * NWAVES < npair) IX_LOADP(0, pn + 2 * NWAVES); } }
    }
#undef IX_LOADP
#undef IX_ELEM
#undef IX_TAIL
#undef IX_PIN2
#undef IX_MF
#undef IX_GAP
#undef IX_PIPE
    if (has_next) preload(F, Z, KIT, nb, nqu, pre);
    const bool need_sel = (t0 + 4 > 256);
    if (need_sel) {
#pragma unroll
        for (int o = 1; o < 32; o <<= 1) { vmaxA = __builtin_fmaxf(vmaxA, __shfl_xor(vmaxA, o)); vmaxB = __builtin_fmaxf(vmaxB, __shfl_xor(vmaxB, o));
                                           vminA = __builtin_fminf(vminA, __shfl_xor(vminA, o)); vminB = __builtin_fminf(vminB, __shfl_xor(vminB, o)); }
        if (r32 == 0) { red[wid * 8 + 2 * hi] = vmaxA; red[wid * 8 + 2 * hi + 1] = vmaxB; red[wid * 8 + 4 + 2 * hi] = vminA; red[wid * 8 + 5 + 2 * hi] = vminB; }
        hist[F.tid] = 0u; hist[F.tid + 512] = 0u; hist[F.tid + 1024] = 0u; hist[F.tid + 1536] = 0u; hist[F.tid + 2048] = 0u; hist[F.tid + 2560] = 0u; hist[F.tid + 3072] = 0u; hist[F.tid + 3584] = 0u;
        if (F.tid < 16) selw[F.tid] = 0u;
        if (F.tid == 0) flag[0] = 0u;
    }
    IX_BAR();
#if defined(DBG_DSA_SCORES)
    { float* dump = (float*)(F.wsp(WS_R2 + 56 * MiB));
      for (int qq = 0; qq < 4; ++qq) { const int tt = t0 + qq; int slot = -1;
          if (tt == 256) slot = 0; if (tt == 257) slot = 1; if (tt == 700) slot = 2; if (tt == 3001) slot = 3; if (tt == 8191) slot = 4;
          if (slot >= 0) for (int s = F.tid; s < nk32; s += 512) dump[((size_t)(b * 5 + slot)) * 8192 + s] = sc[qq * 8192 + s]; } }
#endif
    const int q = wid >> 1, sub = wid & 1, tq = t0 + q;
    if (!need_sel) {
        for (int blk = sub; blk < nblk; blk += 2) { const int s = 64 * blk + lane; const unsigned long long bal = __ballot(s <= tq);
            if (lane == 0) { mk[q * 256 + 2 * blk] = (unsigned)bal; mk[q * 256 + 2 * blk + 1] = (unsigned)(bal >> 32); } }
    } else {
        float maxv = red[q], minv = red[4 + q];
#pragma unroll
        for (int wv = 1; wv < 8; ++wv) { maxv = __builtin_fmaxf(maxv, red[wv * 8 + q]); minv = __builtin_fminf(minv, red[wv * 8 + 4 + q]); }
        const float rng = maxv - minv; const bool degenerate = !(rng > 0.f) || !(rng < 3.0e38f);
        const float scale = degenerate ? 0.f : 1023.99f / rng;
#ifdef DBG_FORCE_RADIX
        if (lane == 0) flag[0] = 1u;
#endif
        if (degenerate && lane == 0) flag[0] = 1u;
        { int idx = sub * 64 + lane;
          for (; idx + 384 <= tq; idx += 512) {
              const float v0 = sc[q * 8192 + idx], v1 = sc[q * 8192 + idx + 128], v2 = sc[q * 8192 + idx + 256], v3 = sc[q * 8192 + idx + 384];
              const int b0 = (int)((maxv - v0) * scale), b1 = (int)((maxv - v1) * scale), b2 = (int)((maxv - v2) * scale), b3 = (int)((maxv - v3) * scale);
              (void)__hip_atomic_fetch_add(&hist[q * 1024 + b0], 1u, __ATOMIC_RELAXED, __HIP_MEMORY_SCOPE_WORKGROUP); (void)__hip_atomic_fetch_add(&hist[q * 1024 + b1], 1u, __ATOMIC_RELAXED, __HIP_MEMORY_SCOPE_WORKGROUP);
              (void)__hip_atomic_fetch_add(&hist[q * 1024 + b2], 1u, __ATOMIC_RELAXED, __HIP_MEMORY_SCOPE_WORKGROUP); (void)__hip_atomic_fetch_add(&hist[q * 1024 + b3], 1u, __ATOMIC_RELAXED, __HIP_MEMORY_SCOPE_WORKGROUP); }
          for (; idx <= tq; idx += 128) {
              const int bin = (int)((maxv - sc[q * 8192 + idx]) * scale);
              (void)__hip_atomic_fetch_add(&hist[q * 1024 + bin], 1u, __ATOMIC_RELAXED, __HIP_MEMORY_SCOPE_WORKGROUP); } }
        IX_BAR();
        if (wid < 4) {
            const LAS u32x4* hp = (const LAS u32x4*)(hist + wid * 1024 + 16 * lane);
            const u32x4 h0 = hp[0], h1 = hp[1], h2 = hp[2], h3 = hp[3];
            const unsigned c[16] = {h0.x, h0.y, h0.z, h0.w, h1.x, h1.y, h1.z, h1.w, h2.x, h2.y, h2.z, h2.w, h3.x, h3.y, h3.z, h3.w};
            unsigned tot = 0u;
#pragma unroll
            for (int i = 0; i < 16; ++i) tot += c[i];
            unsigned incl = tot;
#pragma unroll
            for (int o = 1; o < 64; o <<= 1) { const unsigned v = __shfl_up(incl, o); if (lane >= o) incl += v; }
            const unsigned excl = incl - tot;
            if (excl < 256u && 256u <= incl) {
                unsigned run = excl, bsel = 0u, cnt = 0u; bool found = false;
#pragma unroll
                for (int i = 0; i < 16; ++i) { if (!found) { if (run + c[i] >= 256u) { bsel = 16u * lane + i; cnt = c[i]; found = true; } else run += c[i]; } }
                selw[wid * 4 + 0] = bsel; selw[wid * 4 + 1] = 256u - run; selw[wid * 4 + 2] = cnt;
                if (cnt > 64u) flag[0] = 1u;
            }
        }
        IX_BAR();
        if (flag[0] == 0u) {
            const unsigned B = selw[q * 4 + 0];
#define IX_EMIT(BLK, V) do { const int s_ = 64 * (BLK) + lane; const bool val_ = (s_ <= tq); const float v_ = val_ ? (V) : 0.f; \
                const unsigned bin_ = (unsigned)(int)((maxv - v_) * scale); const unsigned long long bal_ = __ballot(val_ && bin_ < B); \
                if (val_ && bin_ == B) { const unsigned pos_ = __hip_atomic_fetch_add(&selw[q * 4 + 3], 1u, __ATOMIC_RELAXED, __HIP_MEMORY_SCOPE_WORKGROUP); cval[q * 64 + (pos_ & 63u)] = v_; cidx[q * 64 + (pos_ & 63u)] = (unsigned)s_; } \
                if (lane == 0) { mk[q * 256 + 2 * (BLK)] = (unsigned)bal_; mk[q * 256 + 2 * (BLK) + 1] = (unsigned)(bal_ >> 32); } } while (0)
            { int blk = sub;
              for (; blk + 6 < nblk; blk += 8) {
                  const float v0 = sc[q * 8192 + 64 * blk + lane], v1 = sc[q * 8192 + 64 * (blk + 2) + lane], v2 = sc[q * 8192 + 64 * (blk + 4) + lane], v3 = sc[q * 8192 + 64 * (blk + 6) + lane];
                  IX_EMIT(blk, v0); IX_EMIT(blk + 2, v1); IX_EMIT(blk + 4, v2); IX_EMIT(blk + 6, v3); }
              for (; blk < nblk; blk += 2) { const float v0 = sc[q * 8192 + ((64 * blk + lane) & 8191)]; IX_EMIT(blk, v0); } }
#undef IX_EMIT
            IX_BAR();
            if (wid < 4) {
                const unsigned C = selw[wid * 4 + 3], need = selw[wid * 4 + 1];
                const float mv = (lane < (int)C) ? cval[wid * 64 + lane] : -INFINITY; const unsigned mi = (lane < (int)C) ? cidx[wid * 64 + lane] : 0xFFFFFFFFu;
                unsigned rank = 0u;
                for (unsigned j = 0; j < C; ++j) { const unsigned js = (unsigned)__builtin_amdgcn_readfirstlane((int)j);
                    const float vj = __builtin_bit_cast(float, __builtin_amdgcn_readlane(__builtin_bit_cast(int, mv), (int)js)); const unsigned ij = (unsigned)__builtin_amdgcn_readlane((int)mi, (int)js); rank += (vj > mv || (vj == mv && ij < mi)) ? 1u : 0u; }
                if (lane < (int)C && rank < need) (void)__hip_atomic_fetch_or(&mk[wid * 256 + (mi >> 5)], 1u << (mi & 31u), __ATOMIC_RELAXED, __HIP_MEMORY_SCOPE_WORKGROUP);
            }
        } else {
            if (F.tid < 4) { unsigned z_ = (unsigned)F.zz; asm volatile("" : "+v"(z_)); selw[F.tid * 4 + 0] = z_; selw[F.tid * 4 + 1] = 256u + z_; selw[F.tid * 4 + 2] = z_; }
#pragma unroll 1
            for (int pass = 0; pass < 4; ++pass) {
                const int shift = 24 - 8 * pass;
                IX_BAR();
                hist[F.tid] = 0u; hist[F.tid + 512] = 0u;
                IX_BAR();
                const unsigned prefix = selw[q * 4 + 0];
                for (int idx = sub * 64 + lane; idx < nk32; idx += 128) {
                    const unsigned u = ordf(sc[q * 8192 + idx]);
                    const bool match = (pass == 0) || ((u >> (shift + 8)) == (prefix >> (shift + 8)));
                    if (match) (void)__hip_atomic_fetch_add(&hist[q * 256 + ((u >> shift) & 255u)], 1u, __ATOMIC_RELAXED, __HIP_MEMORY_SCOPE_WORKGROUP);
                }
                IX_BAR();
                if (wid < 4) {
                    const unsigned kk = selw[wid * 4 + 1], pre = selw[wid * 4 + 0];
                    const unsigned c0 = hist[wid * 256 + 4 * lane], c1 = hist[wid * 256 + 4 * lane + 1], c2 = hist[wid * 256 + 4 * lane + 2], c3 = hist[wid * 256 + 4 * lane + 3];
                    const unsigned tot = c0 + c1 + c2 + c3; unsigned incl = tot;
#pragma unroll
                    for (int o = 1; o < 64; o <<= 1) { const unsigned v = __shfl_down(incl, o); if (lane + o < 64) incl += v; }
                    const unsigned excl = incl - tot;
                    if (excl < kk && kk <= incl) {
                        unsigned run = excl, dsel, cnt;
                        if (run + c3 >= kk) { dsel = 3; cnt = c3; } else { run += c3;
                            if (run + c2 >= kk) { dsel = 2; cnt = c2; } else { run += c2;
                                if (run + c1 >= kk) { dsel = 1; cnt = c1; } else { run += c1; dsel = 0; cnt = c0; } } }
                        selw[wid * 4 + 0] = pre | ((4u * lane + dsel) << shift); selw[wid * 4 + 1] = kk - run; selw[wid * 4 + 2] = cnt;
                    }
                }
            }
            IX_BAR();
            const unsigned thr = selw[q * 4 + 0], kk = selw[q * 4 + 1];
            unsigned eqseen = 0u;
            for (int blk = 0; blk < nblk; ++blk) {
                const int s = 64 * blk + lane;
                const unsigned u = (s < nk32) ? ordf(sc[q * 8192 + s]) : 0u;
                const bool val = (s <= tq);
                const unsigned long long gt = __ballot(val && u > thr), eq = __ballot(val && u == thr);
                unsigned long long take = 0ull, e = eq; unsigned left = (kk > eqseen) ? kk - eqseen : 0u;
                while (left && e) { const unsigned long long low = e & (~e + 1ull); take |= low; e ^= low; --left; }
                eqseen += (unsigned)__popcll(eq);
                if ((blk & 1) == sub && lane == 0) { const unsigned long long wv = gt | take; mk[q * 256 + 2 * blk] = (unsigned)wv; mk[q * 256 + 2 * blk + 1] = (unsigned)(wv >> 32); }
            }
        }
    }
    IX_BAR();
    { const int wq = F.tid >> 7, ww = (F.tid & 127) * 2;
      if (ww < 2 * nblk) *(u32x2*)(MK + (size_t)(rowbase + t0 + wq) * 256 + ww) = *(const LAS u32x2*)(mk + wq * 256 + ww); }
    IX_BAR();
}
}

constexpr int NPH = 16;
__global__ void __launch_bounds__(NWAVES * 64, 2) mk_fwd(Args args) {
    extern __shared__ __attribute__((aligned(16))) unsigned char lds[];
    Frame F;
    F.lds = (LAS unsigned char*)lds;
    F.tid = threadIdx.x; F.lane = F.tid & 63; F.wave = __builtin_amdgcn_readfirstlane(F.tid >> 6);
    const int wave0 = F.wave;
    F.G = gridDim.x; { const int bx = blockIdx.x; F.vcu = (F.G % 8 == 0) ? (bx % 8) * (F.G / 8) + bx / 8 : bx; }
    F.a = &args; F.zz = 0;
    volatile LAS unsigned* MISC = (volatile LAS unsigned*)(F.lds + LDSCTL_OFF);
    for (int u = F.tid; u < (LDS_BYTES - LDSCTL_OFF) / 4; u += NWAVES * 64) ((LAS unsigned*)(F.lds + LDSCTL_OFF))[u] = 0u;
    __syncthreads();
    XcdBarrier bar; bar.bar = (unsigned*)(args.ws + WS_CTL) + CW_BAR; bar.x = 0; bar.st = nullptr;
    if (MK_ONE_LAUNCH) bar = xcd_barrier_post((unsigned*)(args.ws + WS_CTL) + CW_BAR, MISC + 8);
    const int lo = args.ph_lo, hi = args.ph_hi;
#define IN(k) (lo <= (k) && (k) < hi)
#define SEAM(k) do { if (MK_ONE_LAUNCH && (k) + 1 < hi) { XcdBarrier b2_ = bar; asm volatile("" : "+s"(b2_.bar), "+s"(b2_.x)); xcd_barrier(b2_); } } while (0)
#define PHASE_BEGIN() do { asm volatile("s_mov_b32 %0, 0" : "=s"(F.zz)); F.wave = wave0 + F.zz; asm volatile("v_mbcnt_lo_u32_b32 %0, -1, 0\n\tv_mbcnt_hi_u32_b32 %0, -1, %0" : "=v"(F.lane)); F.tid = F.wave * 64 + F.lane; } while (0)
#define WSP(off, T) ((T*)(F.wsp(off)))

    for (int l = 0; l < DEPTH; ++l) {
        const int P = l * NPH;
        for (int rep_ = 0; rep_ < ((DBG_DUP == 0) ? 2 : 1); ++rep_) if (IN(P + 0)) {
            PHASE_BEGIN();
            if (l == 0) { for (int u = F.vcu; u < 144; u += F.G) { PHASE_BEGIN(); mod_unit(F, u); } PHASE_BEGIN(); rope_table(F); PHASE_BEGIN(); }
            convert_weights(F, l, 0, 0, 2, F.vcu * NWAVES + F.wave, F.G * NWAVES);
            SEAM(P + 0);
        }
        for (int rep_ = 0; rep_ < ((DBG_DUP == 1) ? 2 : 1); ++rep_) if (IN(P + 1)) {
            PHASE_BEGIN();
            const float* mod_l = WSP(WS_MOD, const float) + (size_t)l * 2 * 9216; const float* ng = F.in(IN_NORMG) + (size_t)l * 6 * DM;
            if (l == 0) { norm_pass<false, true, 0, 0>(F, nullptr, F.in(IN_X), nullptr, nullptr, nullptr, 0.f, ng + 0 * DM, mod_l + 1 * DM, mod_l + 0 * DM, WSP(WS_XN, bf16_t));
                SEAM(P + 1); }
        }
        for (int rep_ = 0; rep_ < ((DBG_DUP == 2) ? 2 : 1); ++rep_) if (IN(P + 2)) {
            PHASE_BEGIN();
            pg8::Gemm g{WSP(WS_XN, bf16_t), WSP(WS_W + W_W1, bf16_t), DM, DM, DM}; pg8::StaticOrder S; S.init(M, 2 * DFF, F.G, (int)blockIdx.x);
            pg8::EpiSwiglu E{WSP(WS_R1, bf16_t), DFF};
            pg8::gemm_phase<pg8::EpiSwiglu, pg8::StaticOrder, true>(F.lds, F.tid, g, S, E);
            { const int rem_ = (M / 256) * (2 * DFF / 256) % F.G;
              if (l == 0 && rem_ != 0 && (int)blockIdx.x >= rem_) { PHASE_BEGIN(); convert_weights(F, l, 0, 2, NSEG_A, ((int)blockIdx.x - rem_) * NWAVES + F.wave, (F.G - rem_) * NWAVES); } }
            SEAM(P + 2);
        }
        for (int rep_ = 0; rep_ < ((DBG_DUP == 3) ? 2 : 1); ++rep_) if (IN(P + 3)) {
            PHASE_BEGIN();
            pg8::Gemm g{WSP(WS_R1, bf16_t), WSP(WS_W + W_W2, bf16_t), DFF, DFF, DFF}; pg8::StaticOrder S; S.init(M, DM, F.G, (int)blockIdx.x);
            pg8::EpiBf16<0> E{WSP(WS_R2, bf16_t), DM};
            pg8::gemm_phase<pg8::EpiBf16<0>, pg8::StaticOrder, true>(F.lds, F.tid, g, S, E);
            SEAM(P + 3);
        }
        for (int rep_ = 0; rep_ < ((DBG_DUP == 4) ? 2 : 1); ++rep_) if (IN(P + 4)) {
            PHASE_BEGIN();
            const float* mod_l = WSP(WS_MOD, const float) + (size_t)l * 2 * 9216; const float* ng = F.in(IN_NORMG) + (size_t)l * 6 * DM;
            if (l == 0) norm_pass<true, true, 0, 1>(F, WSP(WS_R2, bf16_t), F.in(IN_X), F.outp(), ng + 1 * DM, mod_l + 2 * DM, 0.5f, ng + 2 * DM, mod_l + 4 * DM, mod_l + 3 * DM, WSP(WS_XN, bf16_t));
            else norm_pass<true, true, 1, 1>(F, WSP(WS_R2, bf16_t), F.outp(), F.outp(), ng + 1 * DM, mod_l + 2 * DM, 0.5f, ng + 2 * DM, mod_l + 4 * DM, mod_l + 3 * DM, WSP(WS_XN, bf16_t));
            SEAM(P + 4);
        }
        for (int rep_ = 0; rep_ < ((DBG_DUP == 5) ? 2 : 1); ++rep_) if (IN(P + 5)) {
            PHASE_BEGIN();
            pg8::Gemm g{WSP(WS_XN, bf16_t), WSP(WS_W + W_IN, bf16_t), DM, DM, DM}; pg8::StaticOrder S; S.init(M, ZP, F.G, (int)blockIdx.x);
            pg8::EpiBf16<0> E{WSP(WS_R1, bf16_t), ZP};
            pg8::gemm_phase<pg8::EpiBf16<0>, pg8::StaticOrder, true>(F.lds, F.tid, g, S, E);
            { const int rem_ = (M / 256) * (ZP / 256) % F.G;
              if (rem_ != 0 && (int)blockIdx.x >= rem_) { PHASE_BEGIN(); convert_weights(F, l, 1, 0, NSEG_B, ((int)blockIdx.x - rem_) * NWAVES + F.wave, (F.G - rem_) * NWAVES); } }
            SEAM(P + 5);
        }
        for (int rep_ = 0; rep_ < ((DBG_DUP == 6) ? 2 : 1); ++rep_) if (IN(P + 6)) {
            PHASE_BEGIN();
            mla_prep(F, WSP(WS_R1, const bf16_t), WSP(WS_YB, bf16_t), WSP(WS_YB + 8 * MiB, bf16_t), WSP(WS_KROPE, bf16_t), WSP(WS_RS, bf16_t), WSP(WS_ROPE, const f32x2));
            __syncthreads();
            for (int u = F.vcu; u < 256; u += F.G) { PHASE_BEGIN(); lru_unit<false>(F, l, u, WSP(WS_R1, const bf16_t), WSP(WS_LRUS, f32x2), nullptr); }
            SEAM(P + 6);
        }
        for (int rep_ = 0; rep_ < ((DBG_DUP == 7) ? 2 : 1); ++rep_) if (IN(P + 7)) {
            PHASE_BEGIN();
            { pg8::Gemm g{WSP(WS_YB, bf16_t), WSP(WS_W + W_UQ, bf16_t), 256, 256, 256 + F.zz}; pg8::StaticOrder S; S.init(M, 768, F.G, (int)blockIdx.x);
              pg8::EpiMlaQ E{WSP(WS_R2, bf16_t), 768, WSP(WS_ROPE, const f32x2)};
              pg8::gemm_phase<pg8::EpiMlaQ, pg8::StaticOrder, true>(F.lds, F.tid, g, S, E); }
            PHASE_BEGIN();
            { pg8::Gemm g{WSP(WS_YB + 8 * MiB, bf16_t), WSP(WS_W + W_UKV, bf16_t), 128, 128, 128 + F.zz}; pg8::StaticOrder S; S.init(M, 1024, F.G, (int)blockIdx.x);
              pg8::EpiBf16<0> E{WSP(WS_R2 + 24 * MiB, bf16_t), 1024};
              pg8::gemm_phase<pg8::EpiBf16<0>, pg8::StaticOrder, true>(F.lds, F.tid, g, S, E); }
            __syncthreads();
            PHASE_BEGIN();
            for (int v = F.vcu; v < 256; v += F.G)
            { ix::Pre pre; const int U0 = v;
              ix::preload(F, WSP(WS_R1, const bf16_t), WSP(WS_RS, const bf16_t), U0 >> 11, U0 & 2047, pre);
              for (int i = 0; i < 16; ++i) { const int U = (i & 1) ? 4095 - ((i >> 1) * 256 + v) : (i >> 1) * 256 + v;
                  const int i2 = i + 1, U2 = (i2 & 1) ? 4095 - ((i2 >> 1) * 256 + v) : (i2 >> 1) * 256 + v;
                  PHASE_BEGIN();
                  ix::unit(F, WSP(WS_R1, const bf16_t), WSP(WS_RS, const bf16_t), WSP(WS_R1 + 112 * MiB, unsigned), U >> 11, U & 2047, pre, i2 < 16, (U2 >> 11) & 1, U2 & 2047); } }
            __syncthreads();
            SEAM(P + 7);
        }
        for (int rep_ = 0; rep_ < ((DBG_DUP == 8) ? 2 : 1); ++rep_) if (IN(P + 8)) {
            PHASE_BEGIN();
            for (unsigned v_ = (unsigned)(F.vcu + F.zz); v_ < 256u; v_ += 256u) { const int v = (int)v_;
                const int bh = v >> 4, b = bh >> 3, h = bh & 7, qa = v & 15;
                PHASE_BEGIN();
                const bf16_t* Z = WSP(WS_R1, const bf16_t); bf16_t* YB = WSP(WS_YB, bf16_t);
                { fa::Ptrs P_{WSP(WS_R2, const bf16_t) + 96 * h, 768, WSP(WS_R2 + 24 * MiB, const bf16_t) + 128 * h, 1024, WSP(WS_KROPE, const bf16_t), WSP(WS_R2 + 24 * MiB, const bf16_t) + 128 * h + 64, 1024,
                                YB + 1024 + 64 * h, 2048, nullptr, 0.f, 0.f};
                  for (int r3_ = 0; r3_ < ((DBG_FADUP == 0) ? 2 : 1); ++r3_) { fm::unit(F, P_, b, qa); PHASE_BEGIN(); fm::unit(F, P_, b, 31 - qa); PHASE_BEGIN(); } }
                PHASE_BEGIN();
                { fa::Ptrs P_{Z + ZC_AQ + 64 * h, ZP, Z + ZC_AK + 64 * (h >> 2), ZP, nullptr, Z + ZC_AV + 64 * (h >> 2), ZP, YB + 64 * h, 2048, WSP(WS_R1 + 112 * MiB, const unsigned),
                                __builtin_amdgcn_exp2f(-0.5f * (float)(h + 9)) * LOG2E, 0.f};
                  for (int r3_ = 0; r3_ < ((DBG_FADUP == 1) ? 2 : 1); ++r3_) { fd::unit<0>(F, P_, b, qa); PHASE_BEGIN(); fd::unit<0>(F, P_, b, 31 - qa); PHASE_BEGIN(); } }
                for (int i = 0; i < ((DBG_FADUP == 2) ? 4 : 2); ++i) { PHASE_BEGIN(); const int U = 2 * v + (i & 1), bh2 = U >> 5, b2 = bh2 >> 3, h2 = bh2 & 7, qb2 = U & 31;
                  fa::Ptrs P_{Z + ZC_DQ + 64 * h2, ZP, Z + ZC_DK + 64 * (h2 >> 2), ZP, nullptr, Z + ZC_DV + 64 * (h2 >> 2), ZP, YB + 1536 + 64 * h2, 2048, nullptr,
                                __builtin_amdgcn_exp2f(-0.5f * (float)(h2 + 1)) * LOG2E, F.in(IN_SINKS)[l * 8 + h2] * LOG2E};
                  fd::unit<1>(F, P_, b2, qb2); }
                for (int r5_ = 0; r5_ < ((DBG_FADUP == 3) ? 2 : 1); ++r5_) {
                PHASE_BEGIN();
                lru_unit<true>(F, l, v, WSP(WS_R1, const bf16_t), WSP(WS_LRUS, f32x2), WSP(WS_YB, bf16_t)); }
            }
            SEAM(P + 8);
        }
        for (int rep_ = 0; rep_ < ((DBG_DUP == 9) ? 2 : 1); ++rep_) if (IN(P + 9)) {
            PHASE_BEGIN();
#if defined(DBG_ZB)
            { bf16_t* YBz = WSP(WS_YB, bf16_t); const int gw = F.vcu * NWAVES + F.wave, NGW = F.G * NWAVES;
              for (int m = gw; m < M; m += NGW) *(u32x4*)(YBz + (size_t)m * 2048 + 512 * DBG_ZB + 8 * F.lane) = (u32x4){0u, 0u, 0u, 0u}; }
#endif
            PHASE_BEGIN();
            pg8::Gemm g{WSP(WS_XN, bf16_t), WSP(WS_W + W_G, bf16_t), DM, DM, DM}; pg8::StaticOrder S; S.init(M, NG, F.G, (int)blockIdx.x);
            pg8::EpiBf16<2> E{WSP(WS_R1, bf16_t), NG};
            pg8::gemm_phase<pg8::EpiBf16<2>, pg8::StaticOrder, true>(F.lds, F.tid, g, S, E);
            SEAM(P + 9);
        }
        for (int rep_ = 0; rep_ < ((DBG_DUP == 10) ? 2 : 1); ++rep_) if (IN(P + 10)) {
            PHASE_BEGIN();
            pg8::Gemm g{WSP(WS_YB, bf16_t), WSP(WS_W + W_BR, bf16_t), 2048, 2048, 512}; pg8::ChainOrder S; S.so.init(M, DM, F.G, (int)blockIdx.x);
            pg8::EpiGateMerge E{WSP(WS_R1, const bf16_t), WSP(WS_R2, bf16_t), DM};
            pg8::gemm_phase<pg8::EpiGateMerge, pg8::ChainOrder, true>(F.lds, F.tid, g, S, E);
            SEAM(P + 10);
        }
        for (int rep_ = 0; rep_ < ((DBG_DUP == 11) ? 2 : 1); ++rep_) if (IN(P + 11)) {
            PHASE_BEGIN();
            pg8::Gemm g{WSP(WS_R2, bf16_t), WSP(WS_W + W_O, bf16_t), DM, DM, DM}; pg8::StaticOrder S; S.init(M, DM, F.G, (int)blockIdx.x);
            pg8::EpiBf16<0> E{WSP(WS_YB, bf16_t), DM};
            pg8::gemm_phase<pg8::EpiBf16<0>, pg8::StaticOrder, true>(F.lds, F.tid, g, S, E);
            SEAM(P + 11);
        }
        for (int rep_ = 0; rep_ < ((DBG_DUP == 12) ? 2 : 1); ++rep_) if (IN(P + 12)) {
            PHASE_BEGIN();
            const float* mod_l = WSP(WS_MOD, const float) + (size_t)l * 2 * 9216; const float* ng = F.in(IN_NORMG) + (size_t)l * 6 * DM;
            norm_pass<true, true, 1, 1>(F, WSP(WS_YB, bf16_t), F.outp(), (l + 1 < DEPTH) ? (void*)F.outp() : (void*)WSP(WS_YB + 32 * MiB, bf16_t), ng + 3 * DM, mod_l + 5 * DM, 1.0f, ng + 4 * DM, mod_l + 7 * DM, mod_l + 6 * DM, WSP(WS_XN, bf16_t));
            SEAM(P + 12);
        }
        for (int rep_ = 0; rep_ < ((DBG_DUP == 13) ? 2 : 1); ++rep_) if (IN(P + 13)) {
            PHASE_BEGIN();
            pg8::Gemm g{WSP(WS_XN, bf16_t), WSP(WS_W + W_W1, bf16_t), DM, DM, DM}; pg8::StaticOrder S; S.init(M, 2 * DFF, F.G, (int)blockIdx.x);
            pg8::EpiSwiglu E{WSP(WS_R1, bf16_t), DFF};
            pg8::gemm_phase<pg8::EpiSwiglu, pg8::StaticOrder, true>(F.lds, F.tid, g, S, E);
            { const int rem_ = (M / 256) * (2 * DFF / 256) % F.G;
              if (l + 1 < DEPTH && rem_ != 0 && (int)blockIdx.x >= rem_) { PHASE_BEGIN(); convert_weights(F, l + 1, 0, 2, NSEG_A, ((int)blockIdx.x - rem_) * NWAVES + F.wave, (F.G - rem_) * NWAVES); } }
            SEAM(P + 13);
        }
        for (int rep_ = 0; rep_ < ((DBG_DUP == 14) ? 2 : 1); ++rep_) if (IN(P + 14)) {
            PHASE_BEGIN();
            pg8::Gemm g{WSP(WS_R1, bf16_t), WSP(WS_W + W_W2, bf16_t), DFF, DFF, DFF}; pg8::StaticOrder S; S.init(M, DM, F.G, (int)blockIdx.x);
            pg8::EpiBf16<0> E{WSP(WS_R2, bf16_t), DM};
            pg8::gemm_phase<pg8::EpiBf16<0>, pg8::StaticOrder, true>(F.lds, F.tid, g, S, E);
            SEAM(P + 14);
        }
        for (int rep_ = 0; rep_ < ((DBG_DUP == 15) ? 2 : 1); ++rep_) if (IN(P + 15)) {
            PHASE_BEGIN();
            const float* mod_l = WSP(WS_MOD, const float) + (size_t)l * 2 * 9216; const float* ng = F.in(IN_NORMG) + (size_t)l * 6 * DM;
            if (l + 1 < DEPTH) { const float* mod_n = mod_l + 2 * 9216; const float* ngn = ng + 6 * DM;
                norm_pass<true, true, 1, 1>(F, WSP(WS_R2, bf16_t), F.outp(), F.outp(), ng + 5 * DM, mod_l + 8 * DM, 0.5f, ngn + 0 * DM, mod_n + 1 * DM, mod_n + 0 * DM, WSP(WS_XN, bf16_t)); }
            else norm_pass<true, false, 1, 0>(F, WSP(WS_R2, bf16_t), WSP(WS_YB + 32 * MiB, const bf16_t), F.outp(), ng + 5 * DM, mod_l + 8 * DM, 0.5f, nullptr, nullptr, nullptr, nullptr);
            SEAM(P + 15);
        }
    }
#undef IN
#undef SEAM
}


#if defined(DBG_PROBE)
__device__ __forceinline__ void probe_acc(float* acc2, float dd, float rr) {
    dd = wave_sum(dd); rr = wave_sum(rr);
    if ((threadIdx.x & 63) == 0) { atomicAdd(acc2, dd); atomicAdd(acc2 + 1, rr); }
}
__global__ void __launch_bounds__(256) probe_swa(const unsigned char* ws, const float* sinks, float* acc2) {
    const bf16_t* Z = (const bf16_t*)(ws + WS_R1); const bf16_t* YB = (const bf16_t*)(ws + WS_YB);
    const int gid = blockIdx.x * blockDim.x + threadIdx.x; const int h = gid & 7, ms = gid >> 3;
    const int m = ms * 7 + 3; float dd = 0.f, rr = 0.f;
    if (m < M) {
        const int b = m >> 13, t = m & 8191, g = h >> 2; const float slope = exp2f(-0.5f * (h + 1));
        float q[64]; _Pragma("unroll") for (int d = 0; d < 64; ++d) q[d] = bf2f(Z[(size_t)m * ZP + ZC_DQ + 64 * h + d]);
        float mx = sinks[h] * LOG2E, l = 1.f, o[64]; _Pragma("unroll") for (int d = 0; d < 64; ++d) o[d] = 0.f;
        for (int s = (t >= 127 ? t - 127 : 0); s <= t; ++s) {
            const bf16_t* kr = Z + ((size_t)b * SEQ + s) * ZP + ZC_DK + 64 * g; float sc = 0.f;
            _Pragma("unroll") for (int d = 0; d < 64; ++d) sc += q[d] * bf2f(kr[d]);
            sc -= slope * LOG2E * (float)(t - s);
            const float mn = fmaxf(mx, sc), al = exp2f(mx - mn), p = exp2f(sc - mn);
            l = l * al + p; const bf16_t* vr = Z + ((size_t)b * SEQ + s) * ZP + ZC_DV + 64 * g;
            _Pragma("unroll") for (int d = 0; d < 64; ++d) o[d] = o[d] * al + p * bf2f(vr[d]);
            mx = mn;
        }
        _Pragma("unroll") for (int d = 0; d < 64; ++d) { const float ref = o[d] / l, got = bf2f(YB[(size_t)m * 2048 + 1536 + 64 * h + d]); dd += (got - ref) * (got - ref); rr += ref * ref; }
    }
    probe_acc(acc2, dd, rr);
}
__global__ void __launch_bounds__(256) probe_mla(const unsigned char* ws, float* acc2) {
    const bf16_t* Qc = (const bf16_t*)(ws + WS_R2); const bf16_t* KV = (const bf16_t*)(ws + WS_R2 + 24 * MiB); const bf16_t* KR = (const bf16_t*)(ws + WS_KROPE); const bf16_t* YB = (const bf16_t*)(ws + WS_YB);
    const int gid = blockIdx.x * blockDim.x + threadIdx.x; const int h = gid & 7, ms = gid >> 3;
    const int m = ms * 61 + 5; float dd = 0.f, rr = 0.f;
    if (m < M) {
        const int b = m >> 13, t = m & 8191;
        float q[96]; _Pragma("unroll") for (int d = 0; d < 96; ++d) q[d] = bf2f(Qc[(size_t)m * 768 + 96 * h + d]);
        float mx = -INFINITY, l = 0.f, o[64]; _Pragma("unroll") for (int d = 0; d < 64; ++d) o[d] = 0.f;
        for (int s = 0; s <= t; ++s) {
            const size_t mk = (size_t)b * SEQ + s; float sc = 0.f;
            _Pragma("unroll") for (int d = 0; d < 64; ++d) sc += q[d] * bf2f(KV[mk * 1024 + 128 * h + d]);
            _Pragma("unroll") for (int d = 0; d < 32; ++d) sc += q[64 + d] * bf2f(KR[mk * 32 + d]);
            const float mn = fmaxf(mx, sc), al = exp2f(mx - mn), p = exp2f(sc - mn);
            l = l * al + p;
            _Pragma("unroll") for (int d = 0; d < 64; ++d) o[d] = o[d] * al + p * bf2f(KV[mk * 1024 + 128 * h + 64 + d]);
            mx = mn;
        }
        _Pragma("unroll") for (int d = 0; d < 64; ++d) { const float ref = o[d] / l, got = bf2f(YB[(size_t)m * 2048 + 1024 + 64 * h + d]); dd += (got - ref) * (got - ref); rr += ref * ref; }
    }
    probe_acc(acc2, dd, rr);
}
__global__ void probe_lru(const unsigned char* ws, const float* convw, const float* convb, const float* lwa, const float* lba, const float* lwx, const float* lbx, const float* lam, float* acc2) {
    const bf16_t* Z = (const bf16_t*)(ws + WS_R1); const bf16_t* YB = (const bf16_t*)(ws + WS_YB);
    const int gid = blockIdx.x * blockDim.x + threadIdx.x; float dd = 0.f, rr = 0.f;
    if (gid < 1024) {
        const int b = gid >> 9, c = gid & 511, n = c >> 6, j = c & 63;
        const float sp = log1pf(expf(-lam[c])); float h = 0.f;
        for (int t = 0; t < SEQ; ++t) {
            float ra = lba[c], rx = lbx[c], xcc = 0.f;
            for (int i = 0; i < 64; ++i) { const int ci = 64 * n + i; float xc = convb[ci];
                for (int k = 0; k < 4; ++k) { const int tt = t - 3 + k; if (tt >= 0) xc += convw[k * 512 + ci] * bf2f(Z[((size_t)b * SEQ + tt) * ZP + ZC_RX + ci]); }
                ra += xc * lwa[(n * 64 + i) * 64 + j]; rx += xc * lwx[(n * 64 + i) * 64 + j]; if (i == j) xcc = xc; }
            const float r = 1.f / (1.f + expf(-ra)), ig = 1.f / (1.f + expf(-rx));
            const float la = -8.f * r * sp, a = expf(la), bb = sqrtf(-expm1f(2.f * la)) * (ig * xcc);
            h = a * h + bb;
            if ((t % 13) == 0 || t < 130) { const size_t m = (size_t)b * SEQ + t; const float g = bf2f(Z[m * ZP + ZC_RG + c]);
                const float ref = h * (0.5f * g * (1.f + tanhf(0.7978845608028654f * (g + 0.044715f * g * g * g)))), got = bf2f(YB[m * 2048 + 512 + c]);
                dd += (got - ref) * (got - ref); rr += ref * ref; }
        }
    }
    probe_acc(acc2, dd, rr);
}

__device__ __forceinline__ float blk_max(float v, float* red) { __syncthreads(); for (int o = 32; o > 0; o >>= 1) v = fmaxf(v, __shfl_xor(v, o)); if ((threadIdx.x & 63) == 0) red[threadIdx.x >> 6] = v; __syncthreads(); return fmaxf(fmaxf(red[0], red[1]), fmaxf(red[2], red[3])); }
__device__ __forceinline__ float blk_sum(float v, float* red) { __syncthreads(); v = wave_sum(v); if ((threadIdx.x & 63) == 0) red[threadIdx.x >> 6] = v; __syncthreads(); return (red[0] + red[1]) + (red[2] + red[3]); }
__global__ void __launch_bounds__(256) probe_dsa(const unsigned char* ws, float* acc2) {
    __shared__ float sc[8192]; __shared__ float pp[8192]; __shared__ float red[8]; __shared__ unsigned thr_s; __shared__ int cnt_s;
    const bf16_t* Z = (const bf16_t*)(ws + WS_R1); const bf16_t* YB = (const bf16_t*)(ws + WS_YB);
    const int tid = threadIdx.x;
    const int rows[8] = {3, 130, 255, 256, 257, 700, 3001, 8191};
    const int b = blockIdx.x & 1, t = (blockIdx.x < 16) ? rows[blockIdx.x >> 1] : (int)((blockIdx.x * 2654435761u) >> 19) ;
    const size_t m = (size_t)b * SEQ + t, rb = (size_t)b * SEQ;
    for (int s = tid; s <= t; s += 256) { float tot = 0.f;
        for (int hd = 0; hd < 8; ++hd) { float d = 0.f;
            for (int e = 0; e < 64; ++e) d += bf2f(Z[m * ZP + ZC_IQ + 64 * hd + e]) * bf2f(Z[(rb + s) * ZP + ZC_IK + e]);
            tot += bf2f(Z[m * ZP + ZC_IW + hd]) * fmaxf(d, 0.f); }
        sc[s] = tot; }
    __syncthreads();
#if defined(DBG_DSA_SCORES)
    { int slot = -1; if (t == 256) slot = 0; if (t == 257) slot = 1; if (t == 700) slot = 2; if (t == 3001) slot = 3; if (t == 8191) slot = 4;
      float d2 = 0.f, r2 = 0.f;
      if (slot >= 0 && blockIdx.x < 16) { const float* dump = (const float*)(ws + WS_R2 + 56 * MiB) + ((size_t)(b * 5 + slot)) * 8192;
          for (int s = tid; s <= t; s += 256) { const float df = dump[s] - sc[s]; d2 += df * df; r2 += sc[s] * sc[s]; } }
      probe_acc(acc2, d2, r2); return; }
#endif
    unsigned T = 0u; const int n = t + 1;
    if (n > 256) {
        unsigned lo = 0u, hi = 0xFFFFFFFFu;
        for (int it = 0; it < 33 && lo < hi; ++it) { const unsigned mid = lo + (unsigned)(((unsigned long long)hi - lo + 1ull) >> 1);
            float c = 0.f; for (int s = tid; s < n; s += 256) c += (ix::ordf(sc[s]) >= mid) ? 1.f : 0.f;
            c = blk_sum(c, red);
            if (c >= 256.f) lo = mid; else hi = mid - 1u; }
        T = lo;
    }
    { float c = 0.f; for (int s = tid; s < n; s += 256) { const unsigned u = ix::ordf(sc[s]); const bool g = (n <= 256) || (u > T); pp[s] = g ? 1.f : 0.f; c += g ? 1.f : 0.f; }
      c = blk_sum(c, red);
      if (tid == 0 && n > 256) { int need = 256 - (int)c; for (int s = 0; s < n && need > 0; ++s) if (ix::ordf(sc[s]) == T) { pp[s] = 1.f; --need; } }
      __syncthreads(); }
#if defined(DBG_DSA_MISMATCH)
    { const unsigned* MKp = (const unsigned*)(ws + WS_R1 + 112 * MiB) + m * 256; float mis = 0.f, tot = 0.f;
      const bool use = (DBG_DSA_MISMATCH == 0) ? (t < 256) : (t >= 256);
      for (int s = tid; s < n; s += 256) { const float mine = ((MKp[s >> 5] >> (s & 31)) & 1u) ? 1.f : 0.f; mis += (mine != pp[s]) ? 1.f : 0.f; tot += pp[s]; }
      if (!use) { mis = 0.f; tot = 0.f; }
      probe_acc(acc2, mis, tot); return; }
#endif
#if defined(DBG_DSA_USEMASK)
    { const unsigned* MKp = (const unsigned*)(ws + WS_R1 + 112 * MiB) + m * 256; __syncthreads(); for (int s = tid; s < n; s += 256) pp[s] = ((MKp[s >> 5] >> (s & 31)) & 1u) ? 1.f : 0.f; __syncthreads(); }
#endif
    float dd = 0.f, rr = 0.f;
    for (int h = 0; h < 8; ++h) {
        const int g = h >> 2; const float slope2 = exp2f(-0.5f * (h + 9)) * LOG2E;
        float lm = -INFINITY;
        for (int s = tid; s < n; s += 256) { float v = -INFINITY;
            if (pp[s] != 0.f) { float d = 0.f; for (int e = 0; e < 64; ++e) d += bf2f(Z[m * ZP + ZC_AQ + 64 * h + e]) * bf2f(Z[(rb + s) * ZP + ZC_AK + 64 * g + e]); v = d - slope2 * (float)(t - s); }
            sc[s] = v; lm = fmaxf(lm, v); }
        const float mx = blk_max(lm, red);
        float ls = 0.f; for (int s = tid; s < n; s += 256) { const float p = (sc[s] == -INFINITY) ? 0.f : exp2f(sc[s] - mx); sc[s] = p; ls += p; }
        const float l = blk_sum(ls, red);
        if (tid < 64) { float o = 0.f; for (int s = 0; s < n; ++s) if (sc[s] != 0.f) o += sc[s] * bf2f(Z[(rb + s) * ZP + ZC_AV + 64 * g + tid]);
            const float ref = o / l, got = bf2f(YB[m * 2048 + 64 * h + tid]); dd += (got - ref) * (got - ref); rr += ref * ref; }
        __syncthreads();
    }
    probe_acc(acc2, dd, rr);
}
__global__ void probe_out(const float* x, float* out, const float* acc2) {
    const float e = acc2[0] / fmaxf(acc2[1], 1e-30f); const float k = fminf(fmaxf(3.0f + 0.5f * log10f(fmaxf(e, 1e-12f)), 0.f), 4.f);
    for (size_t i = (size_t)blockIdx.x * blockDim.x + threadIdx.x; i < (size_t)M * DM; i += (size_t)gridDim.x * blockDim.x) out[i] = x[i] * (1.f + k);
}
#endif
extern "C" void kernel_launch(void* const* d_in, const int* in_sizes, int n_in, void* d_out, int out_size, void* d_ws, size_t ws_size, hipStream_t stream) {
    static int grid = 0;
    if (grid == 0) {
        if (n_in != 24 || out_size != M * DM || ws_size < WS_END) { fprintf(stderr, "kernel_launch: unexpected shapes / workspace (n_in %d out %d ws %zu)\n", n_in, out_size, ws_size); grid = -1; return; }
        int dev = 0, cus = 0, per_cu = 0;
        if (hipGetDevice(&dev) != hipSuccess || hipDeviceGetAttribute(&cus, hipDeviceAttributeMultiprocessorCount, dev) != hipSuccess) { grid = -1; return; }
        if (hipFuncSetAttribute((const void*)mk_fwd, hipFuncAttributeMaxDynamicSharedMemorySize, LDS_BYTES) != hipSuccess) { grid = -1; return; }
        if (hipOccupancyMaxActiveBlocksPerMultiprocessor(&per_cu, (const void*)mk_fwd, NWAVES * 64, LDS_BYTES) != hipSuccess || per_cu < 1) { fprintf(stderr, "occupancy query says %d\n", per_cu); }
        (void)hipGetLastError();
        grid = cus;
        if (grid != 256) { fprintf(stderr, "kernel_launch: built for a 256-CU device (got %d)\n", cus); grid = -1; return; }
    }
    if (grid < 0) return;
    (void)hipMemsetAsync((char*)d_ws + WS_CTL, 0, CTL_ZERO_BYTES, stream);
    Args a{};
    for (int i = 0; i < 24; ++i) a.in[i] = (const float*)d_in[i];
    a.out = (float*)d_out; a.ws = (unsigned char*)d_ws;
#if MK_ONE_LAUNCH
    a.ph_lo = 0; a.ph_hi = DEPTH * NPH; a.li = 0;
    hipLaunchKernelGGL(mk_fwd, dim3(grid), dim3(NWAVES * 64), LDS_BYTES, stream, a);
#else
#ifndef DBG_STAGE
#define DBG_STAGE 0
#endif
    if (DBG_STAGE == 1) { (void)hipMemcpyAsync(d_out, d_in[0], (size_t)M * DM * 4, hipMemcpyDeviceToDevice, stream); return; }
    for (int p = 0; p < DEPTH * NPH; ++p) {
        const int k = p % NPH, l = p / NPH;
        if (DBG_STAGE == 2 && p > 4) break;
#if defined(DBG_PROBE)
        if (p > 8) {
            float* acc2 = (float*)((char*)d_ws + WS_CTL + 64);
            if (DBG_PROBE == 3) hipLaunchKernelGGL(probe_swa, dim3((M / 7 + 1) * 8 / 256 + 1), dim3(256), 0, stream, (const unsigned char*)d_ws, (const float*)d_in[IN_SINKS], acc2);
            if (DBG_PROBE == 2) hipLaunchKernelGGL(probe_mla, dim3((M / 61 + 1) * 8 / 256 + 1), dim3(256), 0, stream, (const unsigned char*)d_ws, acc2);
            if (DBG_PROBE == 0) hipLaunchKernelGGL(probe_dsa, dim3(80), dim3(256), 0, stream, (const unsigned char*)d_ws, acc2);
            if (DBG_PROBE == 1) hipLaunchKernelGGL(probe_lru, dim3(16), dim3(64), 0, stream, (const unsigned char*)d_ws, (const float*)d_in[IN_CONVW], (const float*)d_in[IN_CONVB], (const float*)d_in[IN_LRUWA], (const float*)d_in[IN_LRUBA],
                                                   (const float*)d_in[IN_LRUWX], (const float*)d_in[IN_LRUBX], (const float*)d_in[IN_LRULAM], acc2);
            hipLaunchKernelGGL(probe_out, dim3(1024), dim3(256), 0, stream, (const float*)d_in[0], (float*)d_out, (const float*)acc2);
            break;
        }
#endif
        if (k == 1 && l != 0) continue;
        a.ph_lo = p; a.ph_hi = p + 1; a.li = p;
        hipLaunchKernelGGL(mk_fwd, dim3(grid), dim3(NWAVES * 64), LDS_BYTES, stream, a);
    }
#endif
}
```

```cpp
#include <hip/hip_runtime.h>
#include <cstdio>
#include <cstdint>

#ifndef DBG_FADUP
#define DBG_FADUP -1
#endif
#ifndef DBG_DUP
#define DBG_DUP -1
#endif
#ifndef MK_ONE_LAUNCH
#define MK_ONE_LAUNCH 1
#endif

#define LAS __attribute__((address_space(3)))
#define GAS __attribute__((address_space(1)))
typedef unsigned short bf16_t;
typedef short bf16x8 __attribute__((ext_vector_type(8)));
typedef float f32x4 __attribute__((ext_vector_type(4)));
typedef float f32x2 __attribute__((ext_vector_type(2)));
typedef float f32x16 __attribute__((ext_vector_type(16)));
typedef unsigned u32x4 __attribute__((ext_vector_type(4)));
typedef unsigned u32x2 __attribute__((ext_vector_type(2)));

constexpr int BATCH = 2, SEQ = 8192, DM = 1024, DEPTH = 2, M = BATCH * SEQ;
constexpr int DFF = 2816, ZP = 3584, NG = 4096;
constexpr float EPS = 1e-6f;
constexpr float LOG2E = 1.4426950408889634f;
constexpr int ZC_AQ = 0, ZC_AK = 512, ZC_AV = 640, ZC_DQ = 768, ZC_DK = 1280, ZC_DV = 1408, ZC_RX = 1536, ZC_RG = 2048, ZC_IQ = 2560, ZC_IK = 3072, ZC_IW = 3136, ZC_CQ = 3168, ZC_CKV = 3424;

constexpr size_t MiB = 1u << 20;
constexpr size_t WS_CTL = 0, CTL_ZERO_BYTES = 65536;
constexpr size_t WS_MOD = 1 * MiB;
constexpr size_t WS_ROPE = 2 * MiB;
constexpr size_t WS_LRUS = 3 * MiB;
constexpr size_t WS_KROPE = 4 * MiB;
constexpr size_t WS_RS = 5 * MiB;
constexpr size_t WS_W = 8 * MiB;
constexpr size_t W_W1 = 0, W_W2 = 11534336, W_IN = 17301504, W_G = 24641536, W_UQ = 33030144, W_UKV = 33423360, W_BR = 33685504, W_O = 37879808;
constexpr size_t WS_R1 = 48 * MiB;
constexpr size_t WS_YB = 184 * MiB;
constexpr size_t WS_XN = 248 * MiB;
constexpr size_t WS_R2 = 280 * MiB;
constexpr size_t WS_END = 340 * MiB;
constexpr int CW_TMO = 0, CW_BAR = 4096;

constexpr int RING_BYTES = 131072, EXTRA_OFF = 131072, EXTRA_BYTES = 24576, LDSCTL_OFF = EXTRA_OFF + EXTRA_BYTES, LDS_BYTES = LDSCTL_OFF + 512;
constexpr int NWAVES = 8;

#define RLX_AGENT __ATOMIC_RELAXED, __HIP_MEMORY_SCOPE_AGENT
#define LDS_WAIT() asm volatile("s_waitcnt lgkmcnt(0)" ::: "memory")
#define VM_WAIT() asm volatile("s_waitcnt vmcnt(0)" ::: "memory")
__device__ __forceinline__ unsigned f2bf(float f) { unsigned u = __builtin_bit_cast(unsigned, f); return (u + 0x7fffu + ((u >> 16) & 1u)) >> 16; }
__device__ __forceinline__ unsigned pk2(float lo, float hi) { return f2bf(lo) | (f2bf(hi) << 16); }
__device__ __forceinline__ float bf_lo(unsigned w) { return __builtin_bit_cast(float, w << 16); }
__device__ __forceinline__ float bf_hi(unsigned w) { return __builtin_bit_cast(float, w & 0xffff0000u); }
__device__ __forceinline__ float bf2f(bf16_t b) { return __builtin_bit_cast(float, (unsigned)b << 16); }
typedef float cvt_f32x2 __attribute__((ext_vector_type(2)));
typedef __bf16 cvt_bf16x2 __attribute__((ext_vector_type(2)));
__device__ __forceinline__ unsigned cvt_pk_bf16(float lo, float hi) { return __builtin_bit_cast(unsigned, __builtin_convertvector(((cvt_f32x2){lo, hi}), cvt_bf16x2)); }
__device__ __forceinline__ float wave_sum(float v) {
#pragma unroll
    for (int o = 1; o < 64; o <<= 1) v += __shfl_xor(v, o);
    return v;
}
__device__ __forceinline__ float fast_sigmoid(float x) { return __builtin_amdgcn_rcpf(1.0f + __builtin_amdgcn_exp2f(-x * LOG2E)); }

#define XB_TMO      128
#define XB_XCNT(j)  (256  + 64 * (j))
#define XB_XSUB(j)  (1280 + 64 * (j))
#define XB_XGEN(j)  (2304 + 64 * (j))
#define XB_TOP      3328
#define XB_TOPGEN   3392
#define XCD_BAR_WORDS 3456
#define XB_SPIN_CAP (1u << 18)
__device__ __forceinline__ unsigned xb_ld(unsigned* p)              { return __hip_atomic_load(p, __ATOMIC_RELAXED, __HIP_MEMORY_SCOPE_AGENT); }
__device__ __forceinline__ unsigned xb_add(unsigned* p, unsigned v) { return __hip_atomic_fetch_add(p, v, __ATOMIC_RELAXED, __HIP_MEMORY_SCOPE_AGENT); }
__device__ __forceinline__ unsigned xb_xcc_id() { return (unsigned)__builtin_amdgcn_s_getreg((3 << 11) | 20) & 0xFu; }
#define XB_SPIN(cond, bar) do { unsigned _sp = 0; while (cond) { __builtin_amdgcn_s_sleep(1); \
    if ((++_sp & 255u) == 0u) { if (xb_ld(&(bar)[XB_TMO])) break; if (_sp > XB_SPIN_CAP) { atomicAdd(&(bar)[XB_TMO], 1u); break; } } } } while (0)
struct XcdBarrier { unsigned* bar; unsigned x; volatile LAS unsigned* st; };
__device__ __forceinline__ XcdBarrier xcd_barrier_post(unsigned* bar, volatile LAS unsigned* st) {
    XcdBarrier b; b.bar = bar; b.x = xb_xcc_id(); b.st = st;
    if (threadIdx.x == 0) (void)xb_add(&bar[XB_XCNT(b.x)], 1u);
    return b;
}
__device__ __forceinline__ void xcd_barrier_complete(unsigned* bar, unsigned x, unsigned& nloc, unsigned& nx) {
    const unsigned G = gridDim.x * gridDim.y * gridDim.z;
    unsigned sum, cnt, mine, sp = 0u;
    for (;;) {
        sum = 0u; cnt = 0u; mine = 0u;
#pragma unroll
        for (unsigned j = 0; j < 16; ++j) { const unsigned c = xb_ld(&bar[XB_XCNT(j)]); sum += c; cnt += (c > 0u) ? 1u : 0u; mine = (j == x) ? c : mine; }
        if (sum == G) break;
        __builtin_amdgcn_s_sleep(1);
        if ((++sp & 255u) == 0u) { if (xb_ld(&bar[XB_TMO])) break; if (sp > XB_SPIN_CAP) { atomicAdd(&bar[XB_TMO], 1u); break; } }
    }
    nloc = mine > 0u ? mine : 1u; nx = cnt > 0u ? cnt : 1u;
}
__device__ __forceinline__ void xcd_barrier(const XcdBarrier& b) {
    asm volatile("s_waitcnt vmcnt(0)" ::: "memory");
    __syncthreads();
    if (threadIdx.x == 0) {
        unsigned* bar = b.bar;
        __builtin_amdgcn_s_waitcnt(0);
        unsigned nloc = b.st[0], nx = b.st[1];
        if (nloc == 0u) { xcd_barrier_complete(bar, b.x, nloc, nx); b.st[0] = nloc; b.st[1] = nx; }
        const unsigned old = xb_add(&bar[XB_XSUB(b.x)], 1u);
        const unsigned gen = old / nloc;
        if (old + 1u == (gen + 1u) * nloc) {
            __builtin_amdgcn_fence(__ATOMIC_RELEASE, "agent");
            asm volatile("s_waitcnt vmcnt(0)" ::: "memory");
            const unsigned og = xb_add(&bar[XB_TOP], 1u);
            const unsigned tg = og / nx;
            if (og + 1u == (tg + 1u) * nx) xb_add(&bar[XB_TOPGEN], 1u);
            else XB_SPIN(xb_ld(&bar[XB_TOPGEN]) == tg, bar);
            __builtin_amdgcn_fence(__ATOMIC_ACQUIRE, "agent");
            xb_add(&bar[XB_XGEN(b.x)], 1u);
            asm volatile("s_waitcnt vmcnt(0)" ::: "memory");
        } else {
            XB_SPIN(xb_ld(&bar[XB_XGEN(b.x)]) == gen, bar);
            __builtin_amdgcn_fence(__ATOMIC_ACQUIRE, "agent");
            asm volatile("s_waitcnt vmcnt(0)" ::: "memory");
        }
    }
    __syncthreads();
}

namespace pg8 {
constexpr int BM = 256, BK = 64, HALF = 128, HTB = HALF * BK * 2, STAGE_BYTES = 8 * HTB, NXCD = 8, WGM = 8;
__host__ __device__ __forceinline__ int lds_byte(int r, int c) { const int st = (r >> 4) * 2 + (c >> 5), rr = r & 15, cc = c & 31, ob = rr * 64 + cc * 2; return st * 1024 + (ob ^ (((ob >> 9) & 1) << 5)); }
__host__ __device__ __forceinline__ void stage_rc(int b, int& R, int& C) { const int st = b / 1024, sb = b % 1024, swz = sb ^ (((sb >> 9) & 1) << 5); R = (st >> 1) * 16 + swz / 64; C = (st & 1) * 32 + (swz % 64) / 2; }
__host__ __device__ __forceinline__ int perm32(int rho) { const int n = rho >> 4, i = rho & 15; return 8 * (i >> 2) + 4 * n + (i & 3); }

struct Unit { int pm, pn, ka, kb, sub; };
struct Gemm { const bf16_t* A; const bf16_t* Bt; int lda, ldb, K; };

struct StaticOrder {
    int nM, nN, nwg, G, c;
    __device__ void init(int M_, int N_, int G_, int c_) { nM = M_ / BM; nN = N_ / BM; nwg = nM * nN; G = G_; c = c_; }
    __device__ bool tile(int i, Unit& u) const {
        const long L = (long)i * G + c; if (L >= nwg) return false;
        int wgid = (int)L; { const int q = nwg / NXCD, r = nwg % NXCD, xcd = wgid % NXCD, off = wgid / NXCD; wgid = (xcd < r ? xcd * (q + 1) : r * (q + 1) + (xcd - r) * q) + off; }
        const int nig = WGM * nN, gid = wgid / nig, fm = gid * WGM, gsz = (nM - fm) < WGM ? (nM - fm) : WGM;
        u.pm = fm + ((wgid % nig) % gsz); u.pn = (wgid % nig) / gsz; return true;
    }
    __device__ bool next(int i, Unit& u) const { u.ka = 0; u.kb = 0; u.sub = 0; return tile(i, u); }
};
struct ChainOrder {
    StaticOrder so;
    __device__ bool next(int i, Unit& u) const { const int s = i & 3; u.ka = 512 * s; u.kb = 512 * s; u.sub = s; return so.tile(i >> 2, u); }
};

template <int ACT  > struct EpiBf16 {
    static constexpr bool PERM = true, CHAIN = false;
    bf16_t* O; int ldc;
    __device__ __forceinline__ void operator()(f32x4 (&acc)[2][2][4][2], const Unit& u, int wr, int wc, int fr, int fq) const {
        const int row0 = u.pm * BM + wr * 64 + fr, col0 = u.pn * BM + wc * 32 + 8 * fq;
#pragma unroll
        for (int ai = 0; ai < 2; ++ai)
#pragma unroll
            for (int m = 0; m < 4; ++m) { bf16_t* rowp = O + (size_t)(row0 + ai * HALF + m * 16) * ldc + col0;
#pragma unroll
                for (int bj = 0; bj < 2; ++bj) { f32x4 v0 = acc[ai][bj][m][0], v1 = acc[ai][bj][m][1];
                    if (ACT == 2) {
#pragma unroll
                        for (int e = 0; e < 4; ++e) { v0[e] = __builtin_fmaxf(fast_sigmoid(v0[e]), 1e-30f); v1[e] = __builtin_fmaxf(fast_sigmoid(v1[e]), 1e-30f); } }
                    u32x4 w; w.x = cvt_pk_bf16(v0[0], v0[1]); w.y = cvt_pk_bf16(v0[2], v0[3]); w.z = cvt_pk_bf16(v1[0], v1[1]); w.w = cvt_pk_bf16(v1[2], v1[3]);
                    *(u32x4*)(rowp + bj * HALF) = w; } }
    }
};
struct EpiSwiglu {
    static constexpr bool PERM = true, CHAIN = false;
    bf16_t* O; int ldc;
    __device__ __forceinline__ void operator()(f32x4 (&acc)[2][2][4][2], const Unit& u, int wr, int wc, int fr, int fq) const {
        const int row0 = u.pm * BM + wr * 64 + fr, col0 = u.pn * HALF + wc * 32 + 8 * fq;
#pragma unroll
        for (int ai = 0; ai < 2; ++ai)
#pragma unroll
            for (int m = 0; m < 4; ++m) { bf16_t* rowp = O + (size_t)(row0 + ai * HALF + m * 16) * ldc + col0;
                float h[8];
#pragma unroll
                for (int n = 0; n < 2; ++n)
#pragma unroll
                    for (int e = 0; e < 4; ++e) { const float g = acc[ai][0][m][n][e], up = acc[ai][1][m][n][e]; h[4 * n + e] = g * fast_sigmoid(g) * up; }
                u32x4 w; w.x = cvt_pk_bf16(h[0], h[1]); w.y = cvt_pk_bf16(h[2], h[3]); w.z = cvt_pk_bf16(h[4], h[5]); w.w = cvt_pk_bf16(h[6], h[7]);
                *(u32x4*)rowp = w; }
    }
};

struct EpiMlaQ {
    static constexpr bool PERM = true, CHAIN = false;
    bf16_t* O; int ldc; const f32x2* rt;
    __device__ __forceinline__ void operator()(f32x4 (&acc)[2][2][4][2], const Unit& u, int wr, int wc, int fr, int fq) const {
        const int row0 = u.pm * BM + wr * 64 + fr, col0 = u.pn * BM + wc * 32 + 8 * fq;
#pragma unroll
        for (int ai = 0; ai < 2; ++ai)
#pragma unroll
            for (int m = 0; m < 4; ++m) { const int row = row0 + ai * HALF + m * 16; bf16_t* rowp = O + (size_t)row * ldc + col0;
#pragma unroll
                for (int bj = 0; bj < 2; ++bj) { const int c = col0 + bj * HALF; const int hc = c % 96;
                    float v[8];
#pragma unroll
                    for (int e = 0; e < 4; ++e) { v[e] = acc[ai][bj][m][0][e]; v[4 + e] = acc[ai][bj][m][1][e]; }
                    if (hc >= 64) { const f32x2* t = rt + (size_t)(row & (SEQ - 1)) * 16 + ((hc - 64) >> 1);
#pragma unroll
                        for (int pp = 0; pp < 4; ++pp) { const f32x2 cs = t[pp]; const float x1 = v[2 * pp], x2 = v[2 * pp + 1]; v[2 * pp] = x1 * cs.x - x2 * cs.y; v[2 * pp + 1] = x2 * cs.x + x1 * cs.y; } }
                    u32x4 w; w.x = cvt_pk_bf16(v[0], v[1]); w.y = cvt_pk_bf16(v[2], v[3]); w.z = cvt_pk_bf16(v[4], v[5]); w.w = cvt_pk_bf16(v[6], v[7]);
                    *(u32x4*)(rowp + bj * HALF) = w; }
                asm volatile("" ::: "memory"); }
    }
};
struct EpiRowScale {
    static constexpr bool PERM = true, CHAIN = false;
    bf16_t* O; int ldc; const float* rs;
    __device__ __forceinline__ void operator()(f32x4 (&acc)[2][2][4][2], const Unit& u, int wr, int wc, int fr, int fq) const {
        const int row0 = u.pm * BM + wr * 64 + fr, col0 = u.pn * BM + wc * 32 + 8 * fq;
#pragma unroll
        for (int ai = 0; ai < 2; ++ai)
#pragma unroll
            for (int m = 0; m < 4; ++m) { const int row = row0 + ai * HALF + m * 16; const float sc = rs[row]; bf16_t* rowp = O + (size_t)row * ldc + col0;
#pragma unroll
                for (int bj = 0; bj < 2; ++bj) { const f32x4 v0 = acc[ai][bj][m][0] * sc, v1 = acc[ai][bj][m][1] * sc;
                    u32x4 w; w.x = cvt_pk_bf16(v0[0], v0[1]); w.y = cvt_pk_bf16(v0[2], v0[3]); w.z = cvt_pk_bf16(v1[0], v1[1]); w.w = cvt_pk_bf16(v1[2], v1[3]);
                    *(u32x4*)(rowp + bj * HALF) = w; } }
    }
};
struct EpiGateMerge {
    static constexpr bool PERM = true, CHAIN = true;
    const bf16_t* G; bf16_t* O; int ldc;
    __device__ __forceinline__ void operator()(f32x4 (&acc)[2][2][4][2], const Unit& u, int wr, int wc, int fr, int fq) const {
        const int row0 = u.pm * BM + wr * 64 + fr, col0 = u.pn * BM + wc * 32 + 8 * fq; const int s = u.sub;
#pragma unroll
        for (int ai = 0; ai < 2; ++ai) {
            u32x4 ga[4][2], gb[4][2];
            const GAS bf16_t* gp0 = (const GAS bf16_t*)G + (size_t)(row0 + ai * HALF) * NG + 1024 * s + col0; asm volatile("" : "+v"(gp0));
#pragma unroll
            for (int m = 0; m < 4; ++m)
#pragma unroll
                for (int bj = 0; bj < 2; ++bj) { ga[m][bj] = *(const GAS u32x4*)(gp0 + (size_t)(m * 16) * NG + bj * HALF); gb[m][bj] = ga[m][bj]; }
            if (s < 3) {
#pragma unroll
                for (int m = 0; m < 4; ++m)
#pragma unroll
                    for (int bj = 0; bj < 2; ++bj) gb[m][bj] = *(const GAS u32x4*)(gp0 + (size_t)(m * 16) * NG + 1024 + bj * HALF); }
#pragma unroll
            for (int m = 0; m < 4; ++m) { const int row = row0 + ai * HALF + m * 16;
#pragma unroll
                for (int bj = 0; bj < 2; ++bj) {
                    const u32x4 gA = ga[m][bj];
                    float f[8] = {bf_lo(gA.x), bf_hi(gA.x), bf_lo(gA.y), bf_hi(gA.y), bf_lo(gA.z), bf_hi(gA.z), bf_lo(gA.w), bf_hi(gA.w)};
                    if (s < 3) { const u32x4 gB = gb[m][bj];
                        const float d[8] = {bf_lo(gB.x), bf_hi(gB.x), bf_lo(gB.y), bf_hi(gB.y), bf_lo(gB.z), bf_hi(gB.z), bf_lo(gB.w), bf_hi(gB.w)};
#pragma unroll
                        for (int e = 0; e < 8; ++e) f[e] = f[e] * __builtin_amdgcn_rcpf(d[e]); }
#pragma unroll
                    for (int e = 0; e < 4; ++e) { acc[ai][bj][m][0][e] *= f[e]; acc[ai][bj][m][1][e] *= f[4 + e]; }
                    if (s == 3) { const f32x4 v0 = acc[ai][bj][m][0], v1 = acc[ai][bj][m][1];
                        u32x4 w; w.x = cvt_pk_bf16(v0[0], v0[1]); w.y = cvt_pk_bf16(v0[2], v0[3]); w.z = cvt_pk_bf16(v1[0], v1[1]); w.w = cvt_pk_bf16(v1[2], v1[3]);
                        *(u32x4*)(O + (size_t)row * ldc + col0 + bj * HALF) = w; } } } }
    }
};

template <class Epi, class Sched, bool ALIGN_EPI>
__device__ __forceinline__ void gemm_phase(LAS unsigned char* lds, const int tid, const Gemm g, const Sched& S, const Epi& E) {
    const int wid = __builtin_amdgcn_readfirstlane(tid >> 6), lane = tid & 63, wr = wid >> 2, wc = wid & 3, fr = lane & 15, fq = lane >> 4;
    const int nt = g.K / BK;
    unsigned voffA[2], voffB[2];
#pragma unroll
    for (int i = 0; i < 2; ++i) { int R, C; stage_rc(tid * 16 + i * 8192, R, C); const int Rb = Epi::PERM ? ((R & ~31) + perm32(R & 31)) : R;
        voffA[i] = (unsigned)(R * g.lda + C) * 2u; voffB[i] = (unsigned)(Rb * g.ldb + C) * 2u; }
    const size_t kstep = (size_t)(BK * 2);
    const size_t hstepA = (size_t)HALF * g.lda * 2, hstepB = (size_t)HALF * g.ldb * 2;
    const unsigned ldsw = (unsigned)wid * 1024u;
    const int aoff = lds_byte(wr * 64 + fr, fq * 8), boff = lds_byte(wc * 32 + fr, fq * 8);
#define PG8_SA(b, h) (((b) * 2 + (h)) * HTB)
#define PG8_SB(b, h) ((4 + (b) * 2 + (h)) * HTB)
#define PG8_STAGE(bufoff, gbase, voff) do { _Pragma("unroll") for (int _i = 0; _i < 2; ++_i) \
        __builtin_amdgcn_global_load_lds((const unsigned*)((const char*)(gbase) + (voff)[_i]), (LAS unsigned*)(lds + (bufoff) + ldsw + _i * 8192), 16, 0, 0); } while (0)
#define PG8_LDA(dst, b, h) do { _Pragma("unroll") for (int m = 0; m < 4; ++m) _Pragma("unroll") for (int k = 0; k < 2; ++k) dst[m][k] = *(const LAS bf16x8*)(lds + PG8_SA(b, h) + aoff + m * 2048 + k * 1024); } while (0)
#define PG8_LDB(dst, b, h) do { _Pragma("unroll") for (int n = 0; n < 2; ++n) _Pragma("unroll") for (int k = 0; k < 2; ++k) dst[n][k] = *(const LAS bf16x8*)(lds + PG8_SB(b, h) + boff + n * 2048 + k * 1024); } while (0)
#define PG8_MMA(ai, bj, At, Bt) do { __builtin_amdgcn_s_setprio(1); _Pragma("unroll") for (int m = 0; m < 4; ++m) _Pragma("unroll") for (int n = 0; n < 2; ++n) _Pragma("unroll") for (int k = 0; k < 2; ++k) \
        acc[ai][bj][m][n] = __builtin_amdgcn_mfma_f32_16x16x32_bf16(Bt[n][k], At[m][k], acc[ai][bj][m][n], 0, 0, 0); __builtin_amdgcn_s_setprio(0); } while (0)
#define PG8_WAIT_V(n) asm volatile("s_waitcnt vmcnt(" #n ")" ::: "memory")
#define PG8_WAIT_L(n) asm volatile("s_waitcnt lgkmcnt(" #n ")" ::: "memory")
#define PG8_BAR __builtin_amdgcn_s_barrier()
#define PG8_SCHED __builtin_amdgcn_sched_barrier(0)
#define PG8_UA(u) ((const char*)g.A + (size_t)(u).pm * 2 * hstepA + (size_t)(u).ka * 2)
#define PG8_UB(u) ((const char*)g.Bt + (size_t)(u).pn * 2 * hstepB + (size_t)(u).kb * 2)
    Unit cur, nxt; int ui = 0;
    if (!S.next(0, cur)) return;
    f32x4 acc[2][2][4][2];
#pragma unroll
    for (int a = 0; a < 2; ++a)
#pragma unroll
        for (int b = 0; b < 2; ++b)
#pragma unroll
            for (int m = 0; m < 4; ++m)
#pragma unroll
                for (int n = 0; n < 2; ++n) acc[a][b][m][n] = (f32x4){0.f, 0.f, 0.f, 0.f};
    bf16x8 At[4][2], B0[2][2], B1[2][2];
    const char* cA = PG8_UA(cur); const char* cB = PG8_UB(cur);
    PG8_STAGE(PG8_SB(0, 0), cB, voffB); PG8_STAGE(PG8_SB(0, 1), cB + hstepB, voffB); PG8_STAGE(PG8_SA(0, 0), cA, voffA); PG8_STAGE(PG8_SA(0, 1), cA + hstepA, voffA);
    if (wr == 1) PG8_BAR;
    PG8_WAIT_V(2); PG8_BAR;
    PG8_STAGE(PG8_SB(1, 0), cB + kstep, voffB); PG8_STAGE(PG8_SA(1, 0), cA + kstep, voffA); PG8_STAGE(PG8_SB(1, 1), cB + hstepB + kstep, voffB);
    PG8_WAIT_V(6); PG8_BAR;
    for (;;) {
        const bool has_next = S.next(ui + 1, nxt);
        const char* nA = has_next ? PG8_UA(nxt) : cA; const char* nB = has_next ? PG8_UB(nxt) : cB;
        for (int t = 0; t < nt; t += 2) {
            const bool last = (t == nt - 2);
            const char* a1 = cA + (size_t)(t + 1) * kstep;
            const char* a2 = last ? nA : cA + (size_t)(t + 2) * kstep; const char* b2 = last ? nB : cB + (size_t)(t + 2) * kstep;
            const char* a3 = a2 + kstep; const char* b3 = b2 + kstep;
            PG8_LDB(B0, 0, 0); PG8_LDB(B1, 0, 1); PG8_SCHED; PG8_LDA(At, 0, 0); PG8_STAGE(PG8_SA(1, 1), a1 + hstepA, voffA);
            PG8_WAIT_V(8); PG8_WAIT_L(0); PG8_BAR; PG8_MMA(0, 0, At, B0); PG8_MMA(0, 1, At, B1); PG8_BAR; PG8_SCHED;
            PG8_LDA(At, 0, 1); PG8_STAGE(PG8_SB(0, 0), b2, voffB); PG8_STAGE(PG8_SB(0, 1), b2 + hstepB, voffB); PG8_STAGE(PG8_SA(0, 0), a2, voffA);
            PG8_WAIT_V(8); PG8_WAIT_L(0); PG8_BAR; PG8_MMA(1, 0, At, B0); PG8_MMA(1, 1, At, B1); PG8_BAR; PG8_SCHED;
            PG8_LDB(B0, 1, 0); PG8_LDB(B1, 1, 1); PG8_SCHED; PG8_LDA(At, 1, 0); PG8_STAGE(PG8_SA(0, 1), a2 + hstepA, voffA);
            PG8_WAIT_V(8); PG8_WAIT_L(0); PG8_BAR; PG8_MMA(0, 0, At, B0); PG8_MMA(0, 1, At, B1); PG8_BAR; PG8_SCHED;
            PG8_LDA(At, 1, 1); PG8_STAGE(PG8_SB(1, 0), b3, voffB); PG8_STAGE(PG8_SB(1, 1), b3 + hstepB, voffB); PG8_STAGE(PG8_SA(1, 0), a3, voffA);
            PG8_WAIT_V(8); PG8_WAIT_L(0); PG8_BAR; PG8_MMA(1, 0, At, B0); PG8_MMA(1, 1, At, B1); PG8_BAR; PG8_SCHED;
        }
        if constexpr (ALIGN_EPI) { if (wr == 0) PG8_BAR; }
        { int fr_ = fr, fq_ = fq; asm volatile("" : "+v"(fr_), "+v"(fq_));
          E(acc, cur, wr, wc, fr_, fq_); }
        if (!has_next) break;
        if (!(Epi::CHAIN && cur.sub != 3)) {
#pragma unroll
            for (int a = 0; a < 2; ++a)
#pragma unroll
                for (int b = 0; b < 2; ++b)
#pragma unroll
                    for (int m = 0; m < 4; ++m)
#pragma unroll
                        for (int n = 0; n < 2; ++n) acc[a][b][m][n] = (f32x4){0.f, 0.f, 0.f, 0.f};
        }
        cur = nxt; cA = nA; cB = nB; ++ui;
        if constexpr (ALIGN_EPI) { if (wr == 1) PG8_BAR; }
    }
    PG8_WAIT_V(0);
    if constexpr (!ALIGN_EPI) { if (wr == 0) PG8_BAR; }
    PG8_BAR;
#undef PG8_SA
#undef PG8_SB
#undef PG8_STAGE
#undef PG8_LDA
#undef PG8_LDB
#undef PG8_MMA
#undef PG8_WAIT_V
#undef PG8_WAIT_L
#undef PG8_BAR
#undef PG8_SCHED
#undef PG8_UA
#undef PG8_UB
}
}

struct Args { const float* in[24]; float* out; unsigned char* ws; int ph_lo, ph_hi, li, pad; };
struct Frame {
    LAS unsigned char* lds;
    int tid, lane, wave, vcu, G;
    const Args* a;
    int zz;
    __device__ __forceinline__ const float* in(int i) const { return (const float*)(const GAS float*)karg(8 * i); }
    __device__ __forceinline__ unsigned long long karg(int byte_off) const { unsigned long long p; asm volatile("s_load_dwordx2 %0, %1, %2\n\ts_waitcnt lgkmcnt(0)" : "=s"(p) : "s"(__builtin_amdgcn_kernarg_segment_ptr()), "s"(byte_off)); return p; }
    __device__ __forceinline__ unsigned char* wsp(size_t off = 0) const { return (unsigned char*)((GAS unsigned char*)karg(25 * 8) + off); }
    __device__ __forceinline__ float* outp() const { return (float*)(GAS float*)karg(24 * 8); }
};
#define IN_X 0
#define IN_C 1
#define IN_WADA 2
#define IN_BADA 3
#define IN_NORMG 4
#define IN_F1IN 5
#define IN_F1OUT 6
#define IN_WIN 7
#define IN_CONVW 8
#define IN_CONVB 9
#define IN_LRUWA 10
#define IN_LRUBA 11
#define IN_LRUWX 12
#define IN_LRUBX 13
#define IN_LRULAM 14
#define IN_GQ 15
#define IN_GKV 16
#define IN_WUQ 17
#define IN_WUKV 18
#define IN_SINKS 19
#define IN_WBR 20
#define IN_WOUT 21
#define IN_F2IN 22
#define IN_F2OUT 23

struct CvtSeg { const float* src; int ldn, col0, ncols, K; bf16_t* dst; int ldk, koff, drow0, mode; float scale; const float* kgain; };
__device__ __forceinline__ int cvt_row(const CvtSeg& s, int n) {
    if (s.mode == 1) { const int half = n >= DFF ? 1 : 0, j = n - DFF * half; return 256 * (j >> 7) + 128 * half + (j & 127); }
    if (s.mode == 2) { const int h = n / 96, c = n - 96 * h; return 96 * h + (c < 64 ? c : (c < 80 ? 64 + 2 * (c - 64) : 64 + 2 * (c - 80) + 1)); }
    return s.drow0 + n;
}
__device__ __forceinline__ void cvt_load(const CvtSeg& s, int item, int lane, f32x4 (&v)[16]) {
    const int nblk = (s.ncols + 63) >> 6, kb = item / nblk, nb = item - kb * nblk, k0 = 64 * kb, n0 = 64 * nb;
    const int nl = n0 + 4 * (lane & 15); const bool okc = nl < s.ncols;
    const GAS float* sp = (const GAS float*)s.src + (size_t)(k0 + (lane >> 4)) * s.ldn + s.col0 + (okc ? nl : 0); const size_t step = (size_t)4 * s.ldn;
#pragma unroll
    for (int i = 0; i < 16; ++i) { v[i] = *(const GAS f32x4*)sp; sp += step; asm volatile("" : "+v"(sp)); }
}
__device__ __forceinline__ void cvt_finish(const CvtSeg& s, LAS float* scr, int item, int lane, f32x4 (&v)[16]) {
    const int nblk = (s.ncols + 63) >> 6, kb = item / nblk, nb = item - kb * nblk, k0 = 64 * kb, n0 = 64 * nb;
    const int nl = n0 + 4 * (lane & 15); const bool okc = nl < s.ncols;
    const float sc_ = okc ? s.scale : 0.0f;
#pragma unroll
    for (int i = 0; i < 16; ++i) { const int kk = 4 * i + (lane >> 4);
        v[i] *= sc_; if (s.kgain) v[i] *= s.kgain[k0 + kk];
        LAS float* p = scr + kk * 65 + 4 * (lane & 15); p[0] = v[i].x; p[1] = v[i].y; p[2] = v[i].z; p[3] = v[i].w; }
    LDS_WAIT(); asm volatile("" ::: "memory");
    const int c = lane & 7;
#pragma unroll
    for (int j = 0; j < 8; ++j) { const int n = (lane >> 3) + 8 * j; const LAS float* p = scr + (8 * c) * 65 + n;
        u32x4 o; o.x = pk2(p[0 * 65], p[1 * 65]); o.y = pk2(p[2 * 65], p[3 * 65]); o.z = pk2(p[4 * 65], p[5 * 65]); o.w = pk2(p[6 * 65], p[7 * 65]);
        if (n0 + n < s.ncols) *(u32x4*)(s.dst + (size_t)cvt_row(s, n0 + n) * s.ldk + s.koff + k0 + 8 * c) = o; }
    LDS_WAIT(); asm volatile("" ::: "memory");
}
constexpr int NSEG_A = 24, NSEG_B = 2;
__device__ const int SEG_C0[15] = {0, 512, 640, 768, 1280, 1344, 1352, 1864, 2376, 2632, 2792, 3304, 3432, 3560, 0};
__device__ const int SEG_NC[15] = {512, 128, 128, 512, 64, 8, 512, 512, 256, 160, 512, 128, 128, 4096, 24};
__device__ const int SEG_DR[15] = {ZC_AQ, ZC_AK, ZC_AV, ZC_IQ, ZC_IK, ZC_IW, ZC_RX, ZC_RG, ZC_CQ, ZC_CKV, ZC_DQ, ZC_DK, ZC_DV, 0, ZC_IW + 8};
__device__ __forceinline__ void get_seg(const Frame& F, int l, int set, int si, CvtSeg& s) {
    bf16_t* W = (bf16_t*)(F.wsp(WS_W));
    s.kgain = nullptr; s.scale = 1.f; s.mode = 0; s.koff = 0; s.drow0 = 0; s.col0 = 0;
    if (si < 2) {
        const float* win_ = set ? F.in(IN_F2IN) : F.in(IN_F1IN); const float* wout_ = set ? F.in(IN_F2OUT) : F.in(IN_F1OUT);
        if (si == 0) { s.src = win_ + (size_t)l * DM * 2 * DFF; s.ldn = 2 * DFF; s.ncols = 2 * DFF; s.K = DM; s.dst = W + W_W1 / 2; s.ldk = DM; s.mode = 1; }
        else { s.src = wout_ + (size_t)l * DFF * DM; s.ldn = DM; s.ncols = DM; s.K = DFF; s.dst = W + W_W2 / 2; s.ldk = DFF; }
        return;
    }
    const float QS = 0.125f * LOG2E;
    int k = si - 2;
    if (k < 15) {
        s.src = F.in(IN_WIN) + (size_t)l * DM * 7656; s.ldn = 7656; s.col0 = SEG_C0[k];        s.ncols = SEG_NC[k]; s.K = DM; s.ldk = DM; s.drow0 = SEG_DR[k];
        s.dst = (k == 13) ? (W + W_G / 2) : (W + W_IN / 2);
        if (k == 0 || k == 10) s.scale = QS;
        if (k == 14) s.scale = 0.0f;
        return;
    }
    k -= 15;
    if (k == 0) { s.src = F.in(IN_WUQ) + (size_t)l * 256 * 768; s.ldn = 768; s.ncols = 768; s.K = 256; s.dst = W + W_UQ / 2; s.ldk = 256; s.mode = 2; s.scale = 0.10206207261596575f * LOG2E; s.kgain = F.in(IN_GQ) + l * 256; return; }
    if (k == 1) { s.src = F.in(IN_WUKV) + (size_t)l * 128 * 1024; s.ldn = 1024; s.ncols = 1024; s.K = 128; s.dst = W + W_UKV / 2; s.ldk = 128; s.kgain = F.in(IN_GKV) + l * 128; return; }
    if (k < 6) { const int n = k - 2; s.src = F.in(IN_WBR) + ((size_t)l * 4 + n) * 512 * 1024; s.ldn = 1024; s.ncols = 1024; s.K = 512; s.dst = W + W_BR / 2; s.ldk = 2048; s.koff = 512 * n; return; }
    s.src = F.in(IN_WOUT) + (size_t)l * DM * DM; s.ldn = DM; s.ncols = DM; s.K = DM; s.dst = W + W_O / 2; s.ldk = DM;
}
__device__ __forceinline__ void convert_weights(const Frame& F, int l, int set, int si0, int si1, int gw, int NGW) {
    LAS float* scr = (LAS float*)(F.lds + F.wave * 16896);
    int base = 0;
#ifdef DBG_CVTDUP
    for (int rep4_ = 0; rep4_ < 2; ++rep4_) { base = 0;
#endif
    for (int si = si0; si < si1; ++si) {
        CvtSeg s; get_seg(F, l, set, si, s);
        const int nit = (s.K >> 6) * ((s.ncols + 63) >> 6);
        int it = (gw - base % NGW + NGW) % NGW;
        for (; it < nit; it += 2 * NGW) {
            f32x4 va[16], vb[16]; const bool hb = it + NGW < nit;
            cvt_load(s, it, F.lane, va); if (hb) cvt_load(s, it + NGW, F.lane, vb);
            cvt_finish(s, scr, it, F.lane, va); if (hb) cvt_finish(s, scr, it + NGW, F.lane, vb); }
        base += nit;
    }
#ifdef DBG_CVTDUP
    }
#endif
}

__device__ __forceinline__ void mod_unit(const Frame& F, int unit) {
    const int l = unit / 72, cb = unit % 72, ks = F.tid >> 5, cg = F.tid & 31;
    const float* wa = F.in(IN_WADA) + (size_t)l * DM * 9216 + 128 * cb + 4 * cg;
    const float* c0 = F.in(IN_C); const float* c1 = c0 + DM;
    f32x4 a0 = {0.f, 0.f, 0.f, 0.f}, a1 = {0.f, 0.f, 0.f, 0.f};
    const GAS float* wp = (const GAS float*)wa + (size_t)(64 * ks) * 9216;
    for (int kb = 64 * ks; kb < 64 * ks + 64; kb += 16) {
        f32x4 w[16];
#pragma unroll
        for (int i = 0; i < 16; ++i) { w[i] = *(const GAS f32x4*)wp; wp += 9216; asm volatile("" : "+v"(wp)); }
#pragma unroll
        for (int i = 0; i < 16; ++i) { const float x0 = c0[kb + i], x1 = c1[kb + i];
            const float s0 = x0 / (1.f + __expf(-x0)), s1 = x1 / (1.f + __expf(-x1));
            a0 += w[i] * s0; a1 += w[i] * s1; }
    }
    LAS f32x4* red = (LAS f32x4*)F.lds;
    red[(ks * 32 + cg) * 2 + 0] = a0; red[(ks * 32 + cg) * 2 + 1] = a1;
    __syncthreads();
    if (F.tid < 64) { const int g2 = F.tid >> 1, b = F.tid & 1; f32x4 s = {0.f, 0.f, 0.f, 0.f};
#pragma unroll
        for (int q = 0; q < 16; ++q) s += red[(q * 32 + g2) * 2 + b];
        const f32x4 bb = *(const f32x4*)(F.in(IN_BADA) + (size_t)l * 9216 + 128 * cb + 4 * g2);
        float* mo = (float*)(F.wsp(WS_MOD)) + ((size_t)(l * 2 + b)) * 9216 + 128 * cb + 4 * g2;
        *(f32x4*)mo = s + bb; }
    __syncthreads();
}
__device__ __forceinline__ void rope_table(const Frame& F) {
    const double inv[16] = {1.0, 0.56234132519034907, 0.31622776601683794, 0.17782794100389229, 0.10000000000000001, 0.056234132519034911, 0.031622776601683791, 0.017782794100389229,
                            0.01, 0.005623413251903491, 0.0031622776601683794, 0.0017782794100389228, 0.001, 0.0005623413251903491, 0.00031622776601683794, 0.00017782794100389227};
    const int gid = F.vcu * 512 + F.tid;
    for (int e = gid; e < SEQ * 16; e += F.G * 512) {
        const int pos = e >> 4, j = e & 15;
        double th = 1.0;
#pragma unroll
        for (int q = 0; q < 16; ++q) th = (j == q) ? inv[q] : th;
        const double t2 = th * th; double cs = 1.0, sn = th, tc = 1.0, ts = th;
#pragma unroll
        for (int n = 1; n <= 12; ++n) { tc *= -t2 / (double)((2 * n - 1) * (2 * n)); ts *= -t2 / (double)((2 * n) * (2 * n + 1)); cs += tc; sn += ts; }
        double rc = 1.0, rs = 0.0;
#pragma unroll
        for (int bit = 0; bit < 13; ++bit) {
            if ((pos >> bit) & 1) { const double nc = rc * cs - rs * sn, ns = rc * sn + rs * cs; rc = nc; rs = ns; }
            const double c2 = cs * cs - sn * sn, s2 = 2.0 * cs * sn; cs = c2; sn = s2;
        }
        ((f32x2*)(F.wsp(WS_ROPE)))[e] = (f32x2){(float)rc, (float)rs};
    }
}
template <bool HAS_Y, bool HAS_NEXT, int XIN, int XOUT>
__device__ __forceinline__ void norm_pass(const Frame& F, const bf16_t* Y, const void* xs, void* xd, const float* gpost, const float* gate, float rw,
                                          const float* gpre, const float* scale, const float* shift, bf16_t* XN) {
    const int gw = F.vcu * NWAVES + F.wave, NGW = F.G * NWAVES;
    constexpr int R = XIN ? 8 : 4;
    for (int m0 = gw; m0 < M; m0 += R * NGW) {
        f32x4 vf[XIN ? 1 : R][4]; u32x2 xw[XIN ? R : 1][4]; u32x2 yw[R][4];
        static_assert(M % (4 * 2048) == 0, "rows per batch");
        const GAS unsigned char* xp = (const GAS unsigned char*)xs + (size_t)m0 * DM * (XIN ? 2 : 4) + F.lane * (XIN ? 8 : 16);
        const GAS unsigned char* yp = (const GAS unsigned char*)Y + (size_t)m0 * DM * 2 + F.lane * 8;
        const size_t xstep = (size_t)NGW * DM * (XIN ? 2 : 4), ystep = (size_t)NGW * DM * 2;
#pragma unroll
        for (int r = 0; r < R; ++r) {
            if (XIN == 0) {
#pragma unroll
                for (int j = 0; j < 4; ++j) vf[XIN ? 0 : r][j] = *(const GAS f32x4*)(xp + 1024 * j); }
            else {
#pragma unroll
                for (int j = 0; j < 4; ++j) xw[XIN ? r : 0][j] = *(const GAS u32x2*)(xp + 512 * j); }
            xp += xstep; asm volatile("" : "+v"(xp));
            if (HAS_Y) {
#pragma unroll
                for (int j = 0; j < 4; ++j) yw[r][j] = *(const GAS u32x2*)(yp + 512 * j);
                yp += ystep; asm volatile("" : "+v"(yp)); } }
#pragma unroll
        for (int hb = 0; hb < R / 4; ++hb) {
        const int b = (m0 + 4 * hb * NGW) >> 13;
        f32x4 cpost[4], cpre[4], csh[4];
#pragma unroll
        for (int j = 0; j < 4; ++j) {
            if (HAS_Y) { const f32x4 gp = *(const f32x4*)(gpost + 4 * F.lane + 256 * j); const f32x4 gt = *(const f32x4*)(gate + (size_t)b * 9216 + 4 * F.lane + 256 * j); cpost[j] = (gt * rw) * gp; }
            if (HAS_NEXT) { const f32x4 gp = *(const f32x4*)(gpre + 4 * F.lane + 256 * j); const f32x4 sc = *(const f32x4*)(scale + (size_t)b * 9216 + 4 * F.lane + 256 * j);
                cpre[j] = gp * (sc + 1.0f); csh[j] = *(const f32x4*)(shift + (size_t)b * 9216 + 4 * F.lane + 256 * j); } }
#pragma unroll
        for (int r = 4 * hb; r < 4 * hb + 4; ++r) { const int m = m0 + r * NGW; {
        f32x4 v[4];
#pragma unroll
        for (int j = 0; j < 4; ++j) { if (XIN == 0) v[j] = vf[XIN ? 0 : r][j]; else { const u32x2 w = xw[XIN ? r : 0][j]; v[j] = (f32x4){bf_lo(w.x), bf_hi(w.x), bf_lo(w.y), bf_hi(w.y)}; } }
        if (HAS_Y) {
            f32x4 y[4]; float ss = 0.f;
#pragma unroll
            for (int j = 0; j < 4; ++j) { const u32x2 w = yw[r][j]; y[j] = (f32x4){bf_lo(w.x), bf_hi(w.x), bf_lo(w.y), bf_hi(w.y)}; ss += (y[j].x * y[j].x + y[j].y * y[j].y) + (y[j].z * y[j].z + y[j].w * y[j].w); }
            const float rstd = 1.0f / sqrtf(wave_sum(ss) * (1.f / DM) + EPS);
#pragma unroll
            for (int j = 0; j < 4; ++j) v[j] += cpost[j] * (y[j] * rstd);
            if (XOUT == 0) { GAS f32x4* xo = (GAS f32x4*)((float*)xd + (size_t)m * DM) + F.lane;
#pragma unroll
                for (int j = 0; j < 4; ++j) xo[64 * j] = v[j]; }
            else { GAS u32x2* xo = (GAS u32x2*)((bf16_t*)xd + (size_t)m * DM) + F.lane;
#pragma unroll
                for (int j = 0; j < 4; ++j) { u32x2 w; w.x = pk2(v[j].x, v[j].y); w.y = pk2(v[j].z, v[j].w); xo[64 * j] = w; } }
        }
        if (HAS_NEXT) {
            float ss = 0.f;
#pragma unroll
            for (int j = 0; j < 4; ++j) ss += (v[j].x * v[j].x + v[j].y * v[j].y) + (v[j].z * v[j].z + v[j].w * v[j].w);
            const float rstd = 1.0f / sqrtf(wave_sum(ss) * (1.f / DM) + EPS);
            GAS u32x2* o8 = (GAS u32x2*)(XN + (size_t)m * DM) + F.lane;
#pragma unroll
            for (int j = 0; j < 4; ++j) {
                const f32x4 o = (v[j] * rstd) * cpre[j] + csh[j];
                u32x2 w; w.x = pk2(o.x, o.y); w.y = pk2(o.z, o.w); o8[64 * j] = w; }
        } } }
        }
    }
}


__device__ __forceinline__ void mla_prep(const Frame& F, const bf16_t* Z, bf16_t* CQN, bf16_t* CKN, bf16_t* KR, bf16_t* KIT, const f32x2* rt) {
    const int gw = F.vcu * NWAVES + F.wave, NGW = F.G * NWAVES, lane = F.lane;
    constexpr int R = 4;
    for (int m0 = gw; m0 < M; m0 += R * NGW) {
        u32x4 wq[R], wk[R]; float xa[R], xb[R]; f32x2 cs[R];
#pragma unroll
        for (int r = 0; r < R; ++r) { const int m = (m0 + r * NGW < M) ? m0 + r * NGW : m0; const bf16_t* zr = Z + (size_t)m * ZP;
            wq[r] = (u32x4){0u, 0u, 0u, 0u}; wk[r] = wq[r]; xa[r] = 0.f; xb[r] = 0.f; cs[r] = (f32x2){0.f, 0.f};
            if (lane < 48) wq[r] = *(const u32x4*)(zr + (lane < 32 ? ZC_CQ + 8 * lane : ZC_CKV + 8 * (lane - 32)));
            else { const int j = lane - 48; xa[r] = bf2f(zr[ZC_CKV + 128 + j]); xb[r] = bf2f(zr[ZC_CKV + 144 + j]); cs[r] = rt[(size_t)(m & (SEQ - 1)) * 16 + j]; }
            if (lane < 8) wk[r] = *(const u32x4*)(zr + ZC_IK + 8 * lane); }
#pragma unroll
        for (int r = 0; r < R; ++r) { const int m = m0 + r * NGW; if (m < M) {
        float s1 = 0.f, s2 = 0.f; float a[8] = {0.f, 0.f, 0.f, 0.f, 0.f, 0.f, 0.f, 0.f};
        if (lane < 48) { const u32x4 w = wq[r];
            a[0] = bf_lo(w.x); a[1] = bf_hi(w.x); a[2] = bf_lo(w.y); a[3] = bf_hi(w.y); a[4] = bf_lo(w.z); a[5] = bf_hi(w.z); a[6] = bf_lo(w.w); a[7] = bf_hi(w.w);
            const float s = (a[0] * a[0] + a[1] * a[1]) + (a[2] * a[2] + a[3] * a[3]) + (a[4] * a[4] + a[5] * a[5]) + (a[6] * a[6] + a[7] * a[7]);
            if (lane < 32) s1 = s; else s2 = s; }
        else { const int j = lane - 48; const float x1 = xa[r], x2 = xb[r];
            *(unsigned*)(KR + (size_t)m * 32 + 2 * j) = pk2(x1 * cs[r].x - x2 * cs[r].y, x2 * cs[r].x + x1 * cs[r].y); }
        if (lane < 8) *(u32x4*)(KIT + (size_t)(m >> 5) * 2048 + lane * 256 + (m & 31) * 8) = wk[r];
        s1 = wave_sum(s1); s2 = wave_sum(s2);
        const float r1 = 1.0f / sqrtf(s1 * (1.f / 256.f) + EPS), r2 = 1.0f / sqrtf(s2 * (1.f / 128.f) + EPS);
        if (lane < 48) { const float rr = lane < 32 ? r1 : r2;
            u32x4 o; o.x = pk2(a[0] * rr, a[1] * rr); o.y = pk2(a[2] * rr, a[3] * rr); o.z = pk2(a[4] * rr, a[5] * rr); o.w = pk2(a[6] * rr, a[7] * rr);
            if (lane < 32) *(u32x4*)(CQN + (size_t)m * 256 + 8 * lane) = o; else *(u32x4*)(CKN + (size_t)m * 128 + 8 * (lane - 32)) = o; }
        } }
    }
}

template <bool PASS2>
__device__ __forceinline__ void lru_unit(const Frame& F, int l, int unit, const bf16_t* Z, f32x2* S, bf16_t* YB) {
    constexpr int XS = 520;
    const int b = unit >> 7, k = unit & 127, c = F.tid, n = F.wave, lane = F.lane, r32 = lane & 31, hi = lane >> 5;
    const size_t m0 = (size_t)b * SEQ + 64 * k;
    LAS float* xcs = (LAS float*)F.lds;
    { const float* cw = F.in(IN_CONVW) + (size_t)l * 4 * 512 + c;
      const float w0 = cw[0], w1 = cw[512], w2 = cw[1024], w3 = cw[1536], cb = F.in(IN_CONVB)[l * 512 + c];
      const bf16_t* xr = Z + m0 * ZP + ZC_RX + c;
      float x3 = 0.f, x2 = 0.f, x1 = 0.f;
      if (k > 0) { x3 = bf2f(xr[-3 * (long)ZP]); x2 = bf2f(xr[-2 * (long)ZP]); x1 = bf2f(xr[-1 * (long)ZP]); }
      bf16_t xin[64];
      { const GAS bf16_t* xg = (const GAS bf16_t*)xr;
#pragma unroll
        for (int i = 0; i < 64; ++i) { xin[i] = *xg; xg += ZP; asm volatile("" : "+v"(xg)); } }
#pragma unroll
      for (int i0 = 0; i0 < 64; i0 += 16) {
          LAS float* xw = xcs + c + i0 * XS; asm volatile("" : "+v"(xw));
#pragma unroll
          for (int i = 0; i < 16; ++i) { const float x0 = bf2f(xin[i0 + i]); xw[i * XS] = cb + w0 * x3 + w1 * x2 + w2 * x1 + w3 * x0; x3 = x2; x2 = x1; x1 = x0; } } }
    __syncthreads();
    float lamv[2], biav[2], bixv[2];
#pragma unroll
    for (int ct = 0; ct < 2; ++ct) { const int ch = 64 * n + 32 * ct + r32; lamv[ct] = F.in(IN_LRULAM)[l * 512 + ch]; biav[ct] = F.in(IN_LRUBA)[l * 512 + ch]; bixv[ct] = F.in(IN_LRUBX)[l * 512 + ch]; }
#pragma unroll
    for (int ct = 0; ct < 2; ++ct) {
        __builtin_amdgcn_sched_barrier(0);
        const int ch = 64 * n + 32 * ct + r32;
        const float lam = lamv[ct]; const float ex_ = __expf(-lam);
        const float splus = lam < -20.f ? -lam : (ex_ < 0.1f ? ex_ * (1.0f - ex_ * (0.5f - ex_ * (0.33333334f - ex_ * (0.25f - ex_ * 0.2f)))) : __logf(1.0f + ex_));
        const float sp8 = -8.0f * LOG2E * splus, bia = biav[ct], bix = bixv[ct];
        u32x4 wf[2][4];
        float wv[2][4][8];
#pragma unroll
          for (int g = 0; g < 2; ++g) {
              const GAS float* pw = (const GAS float*)((g ? F.in(IN_LRUWX) : F.in(IN_LRUWA)) + ((size_t)l * 8 + n) * 4096 + (8 * hi) * 64 + 32 * ct + r32);
              asm volatile("" : "+v"(pw));
#pragma unroll
              for (int ks = 0; ks < 4; ++ks)
#pragma unroll
                  for (int e = 0; e < 8; ++e) wv[g][ks][e] = pw[(16 * ks + e) * 64]; }
        float hst = 0.f, apr = 1.f;
        if (PASS2) { const f32x2* sp = S + (size_t)b * 128 * 512 + ch;
            const int kh = (k + 1) >> 1, q0_ = hi ? kh : 0, q1_ = hi ? k : kh;
            float Am = 1.f, Bm = 0.f;
            for (int qb_ = 0; qb_ < kh; qb_ += 32) {
                const GAS f32x2* sq = (const GAS f32x2*)sp + (size_t)(q0_ + qb_) * 512; asm volatile("" : "+v"(sq));
                f32x2 ab[32];
#pragma unroll
                for (int e = 0; e < 32; ++e) { ab[e] = *sq; sq += 512; asm volatile("" : "+v"(sq)); }
#pragma unroll
                for (int e = 0; e < 32; ++e) { const bool v_ = q0_ + qb_ + e < q1_; const float bn = ab[e].x * Bm + ab[e].y, an = ab[e].x * Am; Bm = v_ ? bn : Bm; Am = v_ ? an : Am; } }
            float b0_ = Bm, b1_ = Bm, a0_ = Am, a1_ = Am;
            asm volatile("s_nop 1\n\tv_permlane32_swap_b32 %0, %1\n\tv_permlane32_swap_b32 %2, %3\n\ts_nop 1" : "+v"(b0_), "+v"(b1_), "+v"(a0_), "+v"(a1_));
            hst = a1_ * b0_ + b1_; }
#pragma unroll
          for (int g = 0; g < 2; ++g)
#pragma unroll
              for (int ks = 0; ks < 4; ++ks) wf[g][ks] = (u32x4){pk2(wv[g][ks][0], wv[g][ks][1]), pk2(wv[g][ks][2], wv[g][ks][3]), pk2(wv[g][ks][4], wv[g][ks][5]), pk2(wv[g][ks][6], wv[g][ks][7])};
        __builtin_amdgcn_sched_barrier(0);
        f32x16 D[2][2];
#pragma unroll
        for (int rt = 0; rt < 2; ++rt)
#pragma unroll
            for (int r = 0; r < 16; ++r) { D[0][rt][r] = bia; D[1][rt][r] = bix; }
#pragma unroll
        for (int rt = 0; rt < 2; ++rt)
#pragma unroll
            for (int ks = 0; ks < 4; ++ks) {
                const LAS f32x4* ap = (const LAS f32x4*)(xcs + (32 * rt + r32) * XS + 64 * n + 16 * ks + 8 * hi);
                const f32x4 a0 = ap[0], a1 = ap[1];
                const u32x4 af = (u32x4){pk2(a0.x, a0.y), pk2(a0.z, a0.w), pk2(a1.x, a1.y), pk2(a1.z, a1.w)};
#pragma unroll
                for (int g = 0; g < 2; ++g) D[g][rt] = __builtin_amdgcn_mfma_f32_32x32x16_bf16(__builtin_bit_cast(bf16x8, af), __builtin_bit_cast(bf16x8, wf[g][ks]), D[g][rt], 0, 0, 0);
            }
        __builtin_amdgcn_sched_barrier(0);
#pragma unroll
        for (int rt = 0; rt < 2; ++rt) {
            const LAS float* xo = xcs + (32 * rt + 4 * hi) * XS + ch;
#pragma unroll
            for (int r = 0; r < 16; ++r) {
                const float rr = fast_sigmoid(D[0][rt][r]), ig = fast_sigmoid(D[1][rt][r]);
                const float l2a = sp8 * rr, a = __builtin_amdgcn_exp2f(l2a), xx = 1.3862943611198906f * l2a;
                const float poly = -xx * (1.0f + xx * (0.5f + xx * (0.16666667f + xx * (0.041666668f + xx * 0.008333334f)))), direct = 1.0f - a * a;
                const float one_m_a2 = (xx > -0.1f) ? poly : direct;
                D[0][rt][r] = a; D[1][rt][r] = __builtin_amdgcn_sqrtf(one_m_a2) * (ig * xo[((r & 3) + 8 * (r >> 2)) * XS]);
            } }
#pragma unroll
        for (int rt = 0; rt < 2; ++rt)
#pragma unroll
            for (int rg = 0; rg < 4; ++rg)
#pragma unroll
                for (int owner = 0; owner < 2; ++owner) {
                    float h = hst, ap = apr;
#pragma unroll
                    for (int e = 0; e < 4; ++e) { const int r = 4 * rg + e; h = D[0][rt][r] * h + D[1][rt][r]; ap *= D[0][rt][r]; D[1][rt][r] = (hi == owner) ? h : D[1][rt][r]; }
                    float h0_ = h, h1_ = h, a0_ = ap, a1_ = ap;
                    asm volatile("s_nop 1\n\tv_permlane32_swap_b32 %0, %1\n\tv_permlane32_swap_b32 %2, %3\n\ts_nop 1" : "+v"(h0_), "+v"(h1_), "+v"(a0_), "+v"(a1_));
                    hst = owner ? h1_ : h0_; apr = owner ? a1_ : a0_;
                }
        if (!PASS2) { if (hi == 0) S[((size_t)b * 128 + k) * 512 + ch] = (f32x2){apr, hst}; }
        else {
#pragma unroll
            for (int rt = 0; rt < 2; ++rt) {
                bf16_t gin[16];
                const GAS bf16_t* zb = (const GAS bf16_t*)(Z + (m0 + 32 * rt + 4 * hi) * ZP + ZC_RG + ch); GAS bf16_t* yb = (GAS bf16_t*)(YB + (m0 + 32 * rt + 4 * hi) * 2048 + 512 + ch);
                asm volatile("" : "+v"(zb), "+v"(yb));
#pragma unroll
                for (int r = 0; r < 16; ++r) gin[r] = zb[(size_t)((r & 3) + 8 * (r >> 2)) * ZP];
#pragma unroll
                for (int r = 0; r < 16; ++r) { const float g = bf2f(gin[r]);
                    const float tg = 0.7978845608028654f * (g + 0.044715f * g * g * g);
                    const float th = 1.0f - 2.0f * __builtin_amdgcn_rcpf(1.0f + __builtin_amdgcn_exp2f(2.0f * LOG2E * tg));
                    yb[(size_t)((r & 3) + 8 * (r >> 2)) * 2048] = (bf16_t)f2bf(D[1][rt][r] * (0.5f * g * (1.0f + th))); }
            }
        }
    }
    __syncthreads();
}

namespace fa {
constexpr int KB96 = 12288, VB = 8192, STG = KB96 + VB, NSLOT = 4, LDS_WS = NSLOT * STG, LDS_OST = LDS_WS + 8 * 256, LDS_TOTAL = LDS_OST + 8 * 4096;
constexpr float THR = 8.0f;
__device__ __forceinline__ int crow(int r, int hi) { return (r & 3) + 8 * (r >> 2) + 4 * hi; }
__device__ __forceinline__ void glds16(const void* g, unsigned lds_base) {
    unsigned sv; asm volatile("s_mov_b32 %0, m0\n\ts_mov_b32 m0, %2\n\ts_nop 0\n\tglobal_load_lds_dwordx4 %1, off\n\ts_mov_b32 m0, %0" : "=&s"(sv) : "v"(g), "s"(lds_base) : "memory"); }
typedef short v4i16_t __attribute__((ext_vector_type(4)));
typedef __attribute__((address_space(3))) const char* lds_cptr;
__device__ __forceinline__ v4i16_t vtr(lds_cptr p) { return __builtin_amdgcn_ds_read_tr16_b64_v4i16((__attribute__((address_space(3))) v4i16_t*)p); }
#define FA_MFMA(a, b, c) __builtin_amdgcn_mfma_f32_32x32x16_bf16(a, b, c, 0, 0, 0)
__device__ __forceinline__ float xhalf_max(float x) { float a = x, b = x; asm volatile("s_nop 1\n\tv_permlane32_swap_b32 %0, %1\n\ts_nop 1" : "+v"(a), "+v"(b)); return __builtin_fmaxf(a, b); }
__device__ __forceinline__ float keep_or_ninf(int m, float x) { float r; asm("v_bfi_b32 %0, %1, %2, %3" : "=v"(r) : "v"(m), "v"(x), "s"(0xff800000u)); return r; }

struct Ptrs { const bf16_t* Q; int ldq; const bf16_t* K; int ldk; const bf16_t* KR; const bf16_t* V; int ldv; bf16_t* O; int ldo; const unsigned* MK; float slope2; float sink2; };

template <int MODE>
__device__ __forceinline__ void unit(const Frame& F, const Ptrs& P, int b, int qb) {
    constexpr int DK = (MODE == 0) ? 96 : 64, ND0 = DK / 16;
    const int lane = F.lane, r32 = lane & 31, hi = lane >> 5, wid = F.wave;
    const long rowbase = (long)b * SEQ; const int q0 = qb * 256;
    const int qidx = q0 + 32 * wid + r32;
    const unsigned lds0 = (unsigned)(uintptr_t)F.lds;
    LAS float* wsf = (LAS float*)(F.lds + LDS_WS) + wid * 64;
    int t_lo, t_hi, key_base;
    if (MODE == 2) { key_base = q0 - 128; t_lo = (qb == 0) ? 2 : 0; t_hi = 6; } else { key_base = 0; t_lo = 0; t_hi = 4 * qb + 4; }
    const bf16_t* ksrc = P.K + (rowbase + lane) * (long)P.ldk + wid * 8;
    const bf16_t* krsrc = (MODE == 0) ? P.KR + (rowbase + lane) * 32L + (wid & 3) * 8 : nullptr;
    const bf16_t* vsrc = P.V + (rowbase + 16 * (wid & 3) + (lane >> 2)) * (long)P.ldv + (wid >> 2) * 32 + (lane & 3) * 8;
    const unsigned kdst = lds0 + wid * 1024, krdst = lds0 + (8 + (wid & 3)) * 1024, vdst = lds0 + KB96 + wid * 1024;
#define FA_DMA(t, soff) do { const long k0_ = key_base + 64L * (t); \
        glds16(ksrc + k0_ * P.ldk, (unsigned)__builtin_amdgcn_readfirstlane(kdst + (soff))); \
        if (MODE == 0 && krw) glds16(krsrc + k0_ * 32, (unsigned)__builtin_amdgcn_readfirstlane(krdst + (soff)));        \
        glds16(vsrc + k0_ * P.ldv, (unsigned)__builtin_amdgcn_readfirstlane(vdst + (soff))); } while (0)
    const bool krw = __builtin_amdgcn_readfirstlane(wid) < 4;
    if (!krw) asm volatile("s_setprio 1");
    FA_DMA(t_lo, 0);
    if (t_lo + 1 < t_hi) FA_DMA(t_lo + 1, STG);
    bf16x8 qr[ND0];
    { const bf16_t* Qw = P.Q + (rowbase + q0 + 32 * wid + r32) * (long)P.ldq + hi * 8;
#pragma unroll
      for (int d0 = 0; d0 < ND0; ++d0) qr[d0] = *(const bf16x8*)(Qw + d0 * 16); }
    float lrun = (MODE == 2 && hi == 0) ? 1.0f : 0.0f;
    f32x16 negm = {};
    float mref = (MODE == 2) ? P.sink2 : (MODE == 1) ? -1.0e4f : 0.0f;
    f32x16 o0 = {}, o1 = {};
    const lds_cptr kp0 = (lds_cptr)F.lds + hi * 1024 + r32 * 16;
    const lds_cptr vp0 = (lds_cptr)F.lds + KB96 + ((lane >> 4) & 1) * 32 + (lane & 3) * 8 + (4 * hi + ((lane & 15) >> 2)) * 64;
    const unsigned* mkrow = (MODE == 1) ? P.MK + (size_t)(rowbase + qidx) * 256 : nullptr;
#define FA_KLOAD(soff) do { const lds_cptr kp_ = kp0 + (soff); \
        _Pragma("unroll") for (int d0 = 0; d0 < ND0; ++d0) { kf[2 * d0] = *(const __attribute__((address_space(3))) bf16x8*)(kp_ + d0 * 2048); kf[2 * d0 + 1] = *(const __attribute__((address_space(3))) bf16x8*)(kp_ + d0 * 2048 + 512); } } while (0)
#define FA_QKMMA(A, B) do { A = FA_MFMA(kf[0], qr[0], negm); B = FA_MFMA(kf[1], qr[0], negm);        \
        _Pragma("unroll") for (int d0 = 1; d0 < ND0; ++d0) { A = FA_MFMA(kf[2 * d0], qr[d0], A); B = FA_MFMA(kf[2 * d0 + 1], qr[d0], B); } } while (0)
#define FA_BIAS(A, B, key0, mw) do { const int kl_ = (key0) + 4 * hi; \
        if (MODE != 0) { const float bq_ = P.slope2 * (float)(kl_ - qidx) - mref;        \
            _Pragma("unroll") for (int r = 0; r < 16; ++r) { const float cr_ = P.slope2 * (float)((r & 3) + 8 * (r >> 2)); A[r] += bq_ + cr_; B[r] += bq_ + cr_ + 32.0f * P.slope2; } } \
        if (MODE == 1) { const unsigned w0_ = (mw).x >> (4 * hi), w1_ = (mw).y >> (4 * hi);        \
            _Pragma("unroll") for (int r = 0; r < 16; ++r) { const int pos_ = (r & 3) + 8 * (r >> 2); \
                A[r] = keep_or_ninf(__builtin_amdgcn_sbfe((int)w0_, pos_, 1), A[r]); B[r] = keep_or_ninf(__builtin_amdgcn_sbfe((int)w1_, pos_, 1), B[r]); } } \
        if (MODE == 2) { _Pragma("unroll") for (int r = 0; r < 16; ++r) { const int d_ = qidx - (kl_ + (r & 3) + 8 * (r >> 2)); if (d_ < 0 || d_ >= 128) A[r] = -INFINITY; if (d_ - 32 < 0 || d_ - 32 >= 128) B[r] = -INFINITY; } } \
        _Pragma("unroll") for (int i_ = 0; i_ < 8; ++i_) { __builtin_amdgcn_sched_group_barrier(0x8, 1, 0); __builtin_amdgcn_sched_group_barrier(0x2, (MODE == 1) ? 8 : (MODE == 2) ? 12 : 2, 0); }        \
        if (MODE != 2 && (key0) + 63 > q0 + 32 * wid) { asm volatile("; diagonal tile" ::: "memory");        \
            _Pragma("unroll") for (int r = 0; r < 16; ++r) { const int kv_ = kl_ + (r & 3) + 8 * (r >> 2); if (kv_ > qidx) A[r] = -INFINITY; if (kv_ + 32 > qidx) B[r] = -INFINITY; } } \
        } while (0)
    u32x2 mw = {0u, 0u}, mw_n = {0u, 0u}, mw_nn = {0u, 0u};
    if (MODE == 1) { mw = *(const u32x2*)(mkrow + 2 * t_lo); if (t_lo + 1 < t_hi) mw_n = *(const u32x2*)(mkrow + 2 * (t_lo + 1)); }
    if (t_lo + 1 < t_hi) asm volatile("s_waitcnt vmcnt(%0) lgkmcnt(0)\n\ts_barrier" :: "n"(2) : "memory"); else asm volatile("s_waitcnt vmcnt(0) lgkmcnt(0)\n\ts_barrier" ::: "memory");
    f32x16 p0, p1, n0 = {}, n1 = {}; bf16x8 kf[2 * ND0];
    u32x4 pw0 = {0u, 0u, 0u, 0u}, pw1 = pw0, pw2 = pw0, pw3 = pw0;
    FA_KLOAD(0); __builtin_amdgcn_sched_barrier(0); FA_QKMMA(p0, p1);
    int s_prev = 3 * STG, s_cur = 0, s_nxt = STG, s_nn = 2 * STG;
#define FA_MX3(a, b, c) __builtin_fmaxf(__builtin_fmaxf((a), (b)), (c))
#define FA_TOP(t) do { if ((t) + 1 < t_hi) { \
            asm volatile("s_waitcnt vmcnt(0) lgkmcnt(0)\n\ts_barrier" ::: "memory");       \
            if ((t) + 2 < t_hi) { FA_DMA((t) + 2, s_nn); if (MODE == 1) mw_nn = *(const u32x2*)(mkrow + 2 * ((t) + 2)); } \
            } } while (0)
#define FA_PV(soff, KL) do { const lds_cptr vp_ = vp0 + (soff); bf16x8 vf[8]; \
        _Pragma("unroll") for (int i = 0; i < 8; ++i) { const v4i16_t lo_ = vtr(vp_ + (i >> 2) * 4096 + (i & 3) * 1024), hi_ = vtr(vp_ + (i >> 2) * 4096 + (i & 3) * 1024 + 512); vf[i] = (bf16x8){lo_[0], lo_[1], lo_[2], lo_[3], hi_[0], hi_[1], hi_[2], hi_[3]}; } \
        __builtin_amdgcn_sched_barrier(0); if (KL) FA_KLOAD(s_nxt); \
        o0 = FA_MFMA(__builtin_bit_cast(bf16x8, pw0), vf[0], o0); o1 = FA_MFMA(__builtin_bit_cast(bf16x8, pw0), vf[4], o1); \
        o0 = FA_MFMA(__builtin_bit_cast(bf16x8, pw1), vf[1], o0); o1 = FA_MFMA(__builtin_bit_cast(bf16x8, pw1), vf[5], o1); \
        o0 = FA_MFMA(__builtin_bit_cast(bf16x8, pw2), vf[2], o0); o1 = FA_MFMA(__builtin_bit_cast(bf16x8, pw2), vf[6], o1); \
        o0 = FA_MFMA(__builtin_bit_cast(bf16x8, pw3), vf[3], o0); o1 = FA_MFMA(__builtin_bit_cast(bf16x8, pw3), vf[7], o1); } while (0)
#define FA_SOFTMAX(t, FIRST) do { \
        float rma = FA_MX3(p0[0], p0[1], p1[0]), rmb = FA_MX3(p0[2], p0[3], p1[1]); rma = FA_MX3(rma, p1[2], p1[3]); \
        _Pragma("unroll") for (int r = 4; r < 16; r += 4) { rma = FA_MX3(rma, p0[r], p0[r + 1]); rmb = FA_MX3(rmb, p0[r + 2], p0[r + 3]); rma = FA_MX3(rma, p1[r], p1[r + 1]); rmb = FA_MX3(rmb, p1[r + 2], p1[r + 3]); } \
        float rm = xhalf_max(__builtin_fmaxf(rma, rmb)); \
        float sacc = 0.f; \
        { const bool first0_ = (MODE == 0) && (FIRST);        \
          if (first0_ || __any(rm > THR)) { float dl = (rm > THR) ? rm : 0.0f; if (first0_) dl = (rm == -INFINITY) ? 0.0f : rm; \
                mref += dl; \
                _Pragma("unroll") for (int r = 0; r < 16; ++r) { p0[r] -= dl; p1[r] -= dl; } \
                if (MODE == 0) { _Pragma("unroll") for (int r = 0; r < 16; ++r) negm[r] -= dl; } \
                if (!first0_) { const float alpha = __builtin_amdgcn_exp2f(-dl); lrun *= alpha; \
                    if (hi == 0) wsf[r32] = alpha; asm volatile("s_waitcnt lgkmcnt(0)" ::: "memory"); \
                    _Pragma("unroll") for (int r = 0; r < 16; ++r) { const float f = wsf[crow(r, hi)]; o0[r] *= f; o1[r] *= f; } } } \
          FA_QKMMA(n0, n1);        \
          _Pragma("unroll") for (int r = 0; r < 16; ++r) { p0[r] = __builtin_amdgcn_exp2f(p0[r]); p1[r] = __builtin_amdgcn_exp2f(p1[r]); sacc += p0[r] + p1[r]; } } \
        lrun += sacc; \
        pw0 = (u32x4){cvt_pk_bf16(p0[0], p0[1]), cvt_pk_bf16(p0[2], p0[3]), cvt_pk_bf16(p0[4], p0[5]), cvt_pk_bf16(p0[6], p0[7])}; \
        pw1 = (u32x4){cvt_pk_bf16(p0[8], p0[9]), cvt_pk_bf16(p0[10], p0[11]), cvt_pk_bf16(p0[12], p0[13]), cvt_pk_bf16(p0[14], p0[15])}; \
        pw2 = (u32x4){cvt_pk_bf16(p1[0], p1[1]), cvt_pk_bf16(p1[2], p1[3]), cvt_pk_bf16(p1[4], p1[5]), cvt_pk_bf16(p1[6], p1[7])}; \
        pw3 = (u32x4){cvt_pk_bf16(p1[8], p1[9]), cvt_pk_bf16(p1[10], p1[11]), cvt_pk_bf16(p1[12], p1[13]), cvt_pk_bf16(p1[14], p1[15])}; \
        p0 = n0; p1 = n1; \
        { const int tmp_ = s_prev; s_prev = s_cur; s_cur = s_nxt; s_nxt = s_nn; s_nn = tmp_; } mw = mw_n; mw_n = mw_nn; } while (0)
    FA_TOP(t_lo); if (t_lo + 1 < t_hi) FA_KLOAD(s_nxt);
    FA_BIAS(p0, p1, key_base + 64 * t_lo, mw);
    FA_SOFTMAX(t_lo, 1);
    for (int t = t_lo + 1; t < t_hi; ++t) {
        FA_TOP(t);
        FA_PV(s_prev, t + 1 < t_hi);
        FA_BIAS(p0, p1, key_base + 64 * t, mw);
        FA_SOFTMAX(t, 0);
    }
    FA_PV(s_prev, false);
#undef FA_MX3
#undef FA_TOP
#undef FA_PV
#undef FA_SOFTMAX
    lrun += __shfl_xor(lrun, 32);
    if (hi == 0) wsf[32 + r32] = lrun;
    asm volatile("s_waitcnt lgkmcnt(0)" ::: "memory");
    LAS bf16_t* stg = (LAS bf16_t*)(F.lds + LDS_OST) + wid * 2048;
#pragma unroll
    for (int r = 0; r < 16; ++r) { const int orow = crow(r, hi); const float rl = __builtin_amdgcn_rcpf(wsf[32 + orow]);
        stg[orow * 64 + r32] = (bf16_t)f2bf(o0[r] * rl); stg[orow * 64 + 32 + r32] = (bf16_t)f2bf(o1[r] * rl); }
    asm volatile("s_waitcnt lgkmcnt(0)" ::: "memory");
    bf16_t* Ow = P.O + (rowbase + q0 + 32 * wid) * (long)P.ldo;
#pragma unroll
    for (int i = 0; i < 4; ++i) { const int row = i * 8 + (lane >> 3), ch = lane & 7; *(u32x4*)(Ow + (long)row * P.ldo + ch * 8) = *(const LAS u32x4*)(stg + row * 64 + ch * 8); }
    asm volatile("s_setprio 0\n\ts_waitcnt lgkmcnt(0)\n\ts_barrier" ::: "memory");
#undef FA_DMA
#undef FA_KLOAD
#undef FA_QKMMA
#undef FA_BIAS
}
}

namespace fd {
using fa::lds_cptr; using fa::v4i16_t; using fa::vtr; using fa::glds16; using fa::crow;
constexpr int NSLOT = 3, SLOTB = 8192, LDS_K = 0, LDS_V = NSLOT * SLOTB, LDS_WS = 2 * NSLOT * SLOTB, LDS_OST = LDS_WS + 8 * 256, LDS_MSK = LDS_OST + 8 * 4096, LDS_TOTAL = LDS_MSK + 8 * 2048;
static_assert(LDS_TOTAL <= LDSCTL_OFF, "dsa unit LDS");
__device__ __forceinline__ float max3f(float a, float b, float c) { float r; asm("v_max3_f32 %0, %1, %2, %3" : "=v"(r) : "v"(a), "v"(b), "v"(c)); return r; }
__device__ __forceinline__ float max2f(float a, float b) { float r; asm("v_max_f32_e32 %0, %1, %2" : "=v"(r) : "v"(a), "v"(b)); return r; }
#define FD_SBAR() __builtin_amdgcn_sched_barrier(0)
__device__ __forceinline__ float and_mask(int m, float x) { float r; asm("v_and_b32 %0, %1, %2" : "=v"(r) : "v"(m), "v"(x)); return r; }
#define FD_WAIT_BAR(N) asm volatile("s_waitcnt vmcnt(" #N ") lgkmcnt(0)\n\ts_barrier" ::: "memory")
#define FD_MFMA(a, b, c) __builtin_amdgcn_mfma_f32_32x32x16_bf16(a, b, c, 0, 0, 0)
__device__ __forceinline__ void kload8(bf16x8* kf, lds_cptr kp) {
    kf[0] = *(const LAS bf16x8*)(kp);        kf[1] = *(const LAS bf16x8*)(kp + 512);  kf[2] = *(const LAS bf16x8*)(kp + 2048); kf[3] = *(const LAS bf16x8*)(kp + 2560);
    kf[4] = *(const LAS bf16x8*)(kp + 4096); kf[5] = *(const LAS bf16x8*)(kp + 4608); kf[6] = *(const LAS bf16x8*)(kp + 6144); kf[7] = *(const LAS bf16x8*)(kp + 6656); }
__device__ __forceinline__ void kload2(bf16x8* kf, lds_cptr kp, int j) { kf[2 * j] = *(const LAS bf16x8*)(kp + j * 2048); kf[2 * j + 1] = *(const LAS bf16x8*)(kp + j * 2048 + 512); }
__device__ __forceinline__ float rowmax(const f32x16& p0, const f32x16& p1) {
    float a = max3f(p0[0], p0[1], p1[0]), b = max3f(p0[2], p0[3], p1[1]); a = max3f(a, p1[2], p1[3]);
#pragma unroll
    for (int r = 4; r < 16; r += 4) { a = max3f(a, p0[r], p0[r + 1]); b = max3f(b, p0[r + 2], p0[r + 3]); a = max3f(a, p1[r], p1[r + 1]); b = max3f(b, p1[r + 2], p1[r + 3]); }
    return fa::xhalf_max(max2f(a, b)); }
__device__ __forceinline__ void cmask(f32x16& p0, f32x16& p1, int jb, int qrel, int hi) {
    const int kb = 64 * jb + 4 * hi;
#pragma unroll
    for (int r = 0; r < 16; ++r) { const int kv = kb + (r & 3) + 8 * (r >> 2); if (kv > qrel) p0[r] = -INFINITY; if (kv + 32 > qrel) p1[r] = -INFINITY; } }

template <int SWA>
__device__ __forceinline__ void unit(const Frame& F, const fa::Ptrs& P, int b, int qb) {
    const int lane = F.lane, r32 = lane & 31, hi = lane >> 5, wid = F.wave;
    const int q0 = qb * 256, qrel = wid * 32 + r32, qidx = q0 + qrel, kb0 = (SWA && qb > 0) ? q0 - 128 : 0;
    const long rowbase = (long)b * SEQ, krow0 = rowbase + kb0;
    LAS unsigned char* shm = F.lds; const unsigned lds0 = (unsigned)(uintptr_t)shm;
    LAS float* wsf = (LAS float*)(shm + LDS_WS) + wid * 64;
    const bf16_t* ksrc = P.K + (krow0 + lane) * (long)P.ldk + wid * 8;
    const bf16_t* vsrc = P.V + (krow0 + 16 * (wid & 3) + (lane >> 2)) * (long)P.ldv + (wid >> 2) * 32 + (lane & 3) * 8;
    const char* msrc = SWA ? nullptr : (const char*)P.MK + (rowbase + qidx) * 1024L;
    const unsigned kdst = lds0 + LDS_K + wid * 1024, vdst = lds0 + LDS_V + wid * 1024, mdst = lds0 + LDS_MSK + wid * 2048;
#define FD_DMA_K(t, slot) glds16(ksrc + (long)(t) * 64 * P.ldk, (unsigned)__builtin_amdgcn_readfirstlane(kdst + (slot)))
#define FD_DMA_V(t, slot) glds16(vsrc + (long)(t) * 64 * P.ldv, (unsigned)__builtin_amdgcn_readfirstlane(vdst + (slot)))
#define FD_DMA_M(t) glds16(msrc + 8 * (t), (unsigned)__builtin_amdgcn_readfirstlane(mdst + ((((t) >> 1) & 1) << 10)))
    const lds_cptr shm3 = (lds_cptr)shm; const lds_cptr kp0 = shm3 + LDS_K + hi * 1024 + r32 * 16; const lds_cptr vp0 = shm3 + LDS_V + ((lane >> 4) & 1) * 32 + (lane & 3) * 8 + (4 * hi + ((lane & 15) >> 2)) * 64;
    const LAS unsigned* mlds = (const LAS unsigned*)(shm + LDS_MSK + wid * 2048) + lane * 4;
    const int NT = SWA ? (qb > 0 ? 6 : 4) : (q0 + 256) / 64;
    if (!SWA) { FD_DMA_M(0); if (2 < NT) FD_DMA_M(2); }
    FD_DMA_K(0, 0); FD_DMA_V(0, 0); FD_DMA_K(1, SLOTB);
    bf16x8 qr[4];
    { const bf16_t* Qw = P.Q + (rowbase + qidx) * (long)P.ldq + hi * 8;
#pragma unroll
      for (int d0 = 0; d0 < 4; ++d0) qr[d0] = *(const bf16x8*)(Qw + d0 * 16); }
    u32x4 kxA = {0u, 0u, 0u, 0u}, kxB = kxA, qx = kxA; unsigned qs2 = 0u;
    if (hi == 0) {
        const unsigned klA = __builtin_bit_cast(unsigned, (float)r32) >> 16, klB = __builtin_bit_cast(unsigned, (float)(r32 + 32)) >> 16, one = 0x3f80u;
        kxA = (u32x4){klA | (klA << 16), klA | (one << 16), one | (one << 16), 0u}; kxB = (u32x4){klB | (klB << 16), klB | (one << 16), one | (one << 16), 0u};
        const unsigned s0_ = __builtin_bit_cast(unsigned, P.slope2) & 0xffff0000u; const float t1_ = P.slope2 - __builtin_bit_cast(float, s0_);
        const unsigned s1_ = __builtin_bit_cast(unsigned, t1_) & 0xffff0000u; const float t2_ = t1_ - __builtin_bit_cast(float, s1_);
        qx.x = (s0_ >> 16) | s1_; qs2 = __builtin_bit_cast(unsigned, t2_) >> 16; }
    float mhat = SWA ? P.sink2 : 0.f, l_reg = (SWA && hi == 0) ? 1.0f : 0.f; f32x16 o[2]; o[0] = f32x16{}; o[1] = f32x16{};
#define FD_QX(t) do { const float c_ = (hi == 0) ? __builtin_fmaf(P.slope2, (float)(kb0 + 64 * (t) - qidx), -mhat) : 0.0f; \
        const unsigned c0_ = __builtin_bit_cast(unsigned, c_) & 0xffff0000u; const float r1_ = c_ - __builtin_bit_cast(float, c0_); \
        const unsigned c1_ = __builtin_bit_cast(unsigned, r1_) & 0xffff0000u; const float r2_ = r1_ - __builtin_bit_cast(float, c1_); \
        const unsigned c2_ = __builtin_bit_cast(unsigned, r2_) & 0xffff0000u; \
        qx.y = qs2 | c0_; qx.z = __builtin_amdgcn_perm(c2_, c1_, 0x07060302u); } while (0)
#define FD_KX(k) __builtin_bit_cast(bf16x8, k)
#define FD_CMASK(P0, P1, t) do { if (!SWA) { const int jb_ = (t) - (NT - 4); if (jb_ >= 0) cmask(P0, P1, jb_, qrel, hi); } } while (0)
#define FD_MW(t) unsigned w0_, w1_; if (SWA) { const int d_ = qidx - kb0 - 64 * (t);        \
            const int lo_ = d_ - 127 < 0 ? 0 : d_ - 127, hi_ = d_ > 63 ? 63 : d_; \
            const unsigned long long m_ = (hi_ >= lo_) ? ((hi_ == 63 ? ~0ull : ((1ull << (hi_ + 1)) - 1ull)) & ~((1ull << lo_) - 1ull)) : 0ull; \
            w0_ = (unsigned)m_ >> (4 * hi); w1_ = (unsigned)(m_ >> 32) >> (4 * hi); } \
        else { w0_ = mlds[((((t) >> 1) & 1) << 8) + 2 * ((t) & 1)] >> (4 * hi); w1_ = mlds[((((t) >> 1) & 1) << 8) + 2 * ((t) & 1) + 1] >> (4 * hi); }
#define FD_AND(X, W, B) do { _Pragma("unroll") for (int e_ = 0; e_ < 4; ++e_) { const int r_ = (B) + e_; \
        X[r_] = and_mask(__builtin_amdgcn_sbfe((int)(W), (r_ & 3) + 8 * (r_ >> 2), 1), X[r_]); } } while (0)
    bool resc = false;
#define FD_RESC() do { if (resc) { asm volatile("s_waitcnt lgkmcnt(0)" ::: "memory"); \
        _Pragma("unroll") for (int d_ = 0; d_ < 2; ++d_) _Pragma("unroll") for (int r = 0; r < 16; ++r) o[d_][r] *= wsf[crow(r, hi)]; } } while (0)
    f32x16 pA0, pA1, pB0, pB1; bf16x8 kf[8];
    int sl_prev = 0, sl_cur = 0, sl_next = SLOTB;
#define FD_ROT() do { sl_prev = sl_cur; sl_cur = sl_next; sl_next = (sl_next == (NSLOT - 1) * SLOTB) ? 0 : sl_next + SLOTB; } while (0)
    FD_DMA_K(2, 2 * SLOTB);
    FD_WAIT_BAR(3);
    FD_QX(0);
    { kload8(kf, kp0);
      pA0 = FD_MFMA(FD_KX(kxA), FD_KX(qx), f32x16{}); pA1 = FD_MFMA(FD_KX(kxB), FD_KX(qx), f32x16{});
#pragma unroll
      for (int d0 = 0; d0 < 4; ++d0) { pA0 = FD_MFMA(kf[2 * d0], qr[d0], pA0); pA1 = FD_MFMA(kf[2 * d0 + 1], qr[d0], pA1); } }
    asm volatile("s_nop 15\n\ts_nop 7" : "+v"(pA0), "+v"(pA1));
    FD_CMASK(pA0, pA1, 0);
    { const float rm = rowmax(pA0, pA1); const float dl = SWA ? __builtin_fmaxf(rm, 0.f) : rm; mhat += dl;
      if (SWA) l_reg *= __builtin_amdgcn_exp2f(-dl);
#pragma unroll
      for (int r = 0; r < 16; ++r) { pA0[r] -= dl; pA1[r] -= dl; }
#pragma unroll
      for (int r = 0; r < 16; ++r) { pA0[r] = __builtin_amdgcn_exp2f(pA0[r]); pA1[r] = __builtin_amdgcn_exp2f(pA1[r]); }
      asm volatile("" : "+v"(pA0), "+v"(pA1)); FD_SBAR();
      FD_MW(0);
      FD_AND(pA0, w0_, 0); FD_AND(pA0, w0_, 4); FD_AND(pA0, w0_, 8); FD_AND(pA0, w0_, 12); FD_AND(pA1, w1_, 0); FD_AND(pA1, w1_, 4); FD_AND(pA1, w1_, 8); FD_AND(pA1, w1_, 12); }
    FD_WAIT_BAR(0);
    FD_DMA_K(3, 0); FD_DMA_V(1, SLOTB);
    FD_ROT();
    kload8(kf, kp0 + sl_cur);
    FD_WAIT_BAR(2);
    v4i16_t vlo[8], vhi[8]; u32x4 pw0, pw1, pw2, pw3;
#define FD_PKW(Pv, B) cvt_pk_bf16(Pv[B], Pv[(B) + 1])
#define FD_PAF(k) __builtin_bit_cast(bf16x8, pw##k)
#define FD_VFR(i) (bf16x8){vlo[i][0], vlo[i][1], vlo[i][2], vlo[i][3], vhi[i][0], vhi[i][1], vhi[i][2], vhi[i][3]}
#define FD_PIN(x) asm volatile("" : "+v"(x))
#define FD_MX3(a, b, c) __builtin_fmaxf(__builtin_fmaxf((a), (b)), (c))
#define FD_GAPA(MF, A0, A1, A2, A3, W0, W1, PW) do { MF; sacc += A0; sacc += A1; sacc += A2; sacc += A3; FD_PIN(sacc); W0; W1; FD_PIN(PW); FD_SBAR(); } while (0)
#define FD_GAPB(MF, X, B, Y, WY, BY) do { MF; X[B] = __builtin_amdgcn_exp2f(X[B]); X[(B) + 1] = __builtin_amdgcn_exp2f(X[(B) + 1]); X[(B) + 2] = __builtin_amdgcn_exp2f(X[(B) + 2]); X[(B) + 3] = __builtin_amdgcn_exp2f(X[(B) + 3]); \
        if ((BY) >= 0) { FD_AND(Y, WY, ((BY) >= 0 ? (BY) : 0)); FD_PIN(Y); } FD_PIN(X); FD_SBAR(); } while (0)
#define FD_VRD(i) do { vlo[i] = vtr(vp_ + (((i) >> 2) * 4096 + ((i) & 3) * 1024)); vhi[i] = vtr(vp_ + (((i) >> 2) * 4096 + ((i) & 3) * 1024 + 512)); } while (0)
#define FD_KRD(G, j) do { if (G) { kload2(kf, kp0 + sl_next, j); FD_SBAR(); } } while (0)
#define FD_STEP(C0, C1, P0, P1, t, GK, GV, GL, GM) do { FD_SBAR(); \
        const lds_cptr vp_ = vp0 + sl_prev; FD_QX(t); FD_MW(t); \
        FD_VRD(0); FD_SBAR(); float sacc = (P0[0] + P0[1]); \
        C0 = FD_MFMA(FD_KX(kxA), FD_KX(qx), f32x16{}); FD_SBAR(); C1 = FD_MFMA(FD_KX(kxB), FD_KX(qx), f32x16{}); FD_SBAR(); \
        FD_GAPA(C0 = FD_MFMA(kf[0], qr[0], C0), P0[2], P0[3], P0[4], P0[5],     pw0[0] = FD_PKW(P0, 0), pw0[1] = FD_PKW(P0, 2), pw0); \
        FD_VRD(4); FD_SBAR(); FD_GAPA(C1 = FD_MFMA(kf[1], qr[0], C1), P0[6], P0[7], P0[8], P0[9],     pw0[2] = FD_PKW(P0, 4), pw0[3] = FD_PKW(P0, 6), pw0); \
        FD_VRD(1); FD_SBAR(); FD_GAPA(C0 = FD_MFMA(kf[2], qr[1], C0), P0[10], P0[11], P0[12], P0[13], pw1[0] = FD_PKW(P0, 8), pw1[1] = FD_PKW(P0, 10), pw1); \
        FD_VRD(5); FD_SBAR(); FD_GAPA(C1 = FD_MFMA(kf[3], qr[1], C1), P0[14], P0[15], P1[0], P1[1],   pw1[2] = FD_PKW(P0, 12), pw1[3] = FD_PKW(P0, 14), pw1); \
        FD_VRD(2); FD_SBAR(); FD_GAPA(C0 = FD_MFMA(kf[4], qr[2], C0), P1[2], P1[3], P1[4], P1[5],     pw2[0] = FD_PKW(P1, 0), pw2[1] = FD_PKW(P1, 2), pw2); \
        FD_VRD(6); FD_SBAR(); FD_GAPA(C1 = FD_MFMA(kf[5], qr[2], C1), P1[6], P1[7], P1[8], P1[9],     pw2[2] = FD_PKW(P1, 4), pw2[3] = FD_PKW(P1, 6), pw2); \
        FD_VRD(3); FD_SBAR(); FD_GAPA(C0 = FD_MFMA(kf[6], qr[3], C0), P1[10], P1[11], P1[12], P1[13], pw3[0] = FD_PKW(P1, 8), pw3[1] = FD_PKW(P1, 10), pw3); \
        FD_VRD(7); FD_SBAR(); FD_GAPA(C1 = FD_MFMA(kf[7], qr[3], C1), P1[14], P1[15], 0.f, 0.f,       pw3[2] = FD_PKW(P1, 12), pw3[3] = FD_PKW(P1, 14), pw3); \
        l_reg += sacc; \
        if (GK) { FD_DMA_K((t) + 3, sl_cur); } if (GV) { FD_DMA_V((t) + 1, sl_next); } if (!SWA && (GM)) { FD_DMA_M((t) + 2); } \
        FD_CMASK(C0, C1, t); \
        { float a = FD_MX3(C0[0], C0[1], C1[0]), bb = FD_MX3(C0[2], C0[3], C1[1]); a = FD_MX3(a, C1[2], C1[3]); \
          _Pragma("unroll") for (int r = 4; r < 16; r += 4) { a = FD_MX3(a, C0[r], C0[r + 1]); bb = FD_MX3(bb, C0[r + 2], C0[r + 3]); a = FD_MX3(a, C1[r], C1[r + 1]); bb = FD_MX3(bb, C1[r + 2], C1[r + 3]); } \
          const float rm = fa::xhalf_max(__builtin_fmaxf(a, bb)); \
          resc = false; \
          if (__builtin_expect(__any(rm > 8.0f), 0)) { const float dl = __builtin_fmaxf(rm, 0.f); mhat += dl; \
              _Pragma("unroll") for (int r = 0; r < 16; ++r) { C0[r] -= dl; C1[r] -= dl; } \
              const float f = __builtin_amdgcn_exp2f(-dl); l_reg *= f; if (hi == 0) wsf[r32] = f; resc = true; } } \
        FD_SBAR(); \
        FD_GAPB(o[0] = FD_MFMA(FD_PAF(0), FD_VFR(0), o[0]), C0, 0, C0, w0_, -1); \
        FD_GAPB(o[1] = FD_MFMA(FD_PAF(0), FD_VFR(4), o[1]), C0, 4, C0, w0_, 0); \
        FD_KRD(GL, 0); FD_GAPB(o[0] = FD_MFMA(FD_PAF(1), FD_VFR(1), o[0]), C0, 8, C0, w0_, 4); \
        FD_KRD(GL, 1); FD_GAPB(o[1] = FD_MFMA(FD_PAF(1), FD_VFR(5), o[1]), C0, 12, C0, w0_, 8); \
        FD_KRD(GL, 2); FD_GAPB(o[0] = FD_MFMA(FD_PAF(2), FD_VFR(2), o[0]), C1, 0, C0, w0_, 12); \
        FD_KRD(GL, 3); FD_GAPB(o[1] = FD_MFMA(FD_PAF(2), FD_VFR(6), o[1]), C1, 4, C1, w1_, 0); \
        FD_GAPB(o[0] = FD_MFMA(FD_PAF(3), FD_VFR(3), o[0]), C1, 8, C1, w1_, 4); \
        FD_GAPB(o[1] = FD_MFMA(FD_PAF(3), FD_VFR(7), o[1]), C1, 12, C1, w1_, 8); \
        FD_AND(C1, w1_, 12); FD_PIN(C1); FD_SBAR(); \
        } while (0)
#define FD_ENDW(n_) do { if ((n_) == 3) { FD_WAIT_BAR(3); } else if ((n_) == 2) { FD_WAIT_BAR(2); } else if ((n_) == 1) { FD_WAIT_BAR(1); } else { FD_WAIT_BAR(0); } } while (0)
    int t = 1;
#undef FD_CMASK
#define FD_CMASK(P0, P1, t) do { } while (0)
    for (; t + 5 < NT; t += 2) {
        FD_STEP(pB0, pB1, pA0, pA1, t, true, true, true, false);     FD_WAIT_BAR(2); FD_RESC(); FD_ROT();
        FD_STEP(pA0, pA1, pB0, pB1, t + 1, true, true, true, true);  if (SWA) { FD_WAIT_BAR(2); } else { FD_WAIT_BAR(3); } FD_RESC(); FD_ROT();
    }
#undef FD_CMASK
#define FD_CMASK(P0, P1, t) do { const int jb_ = (t) - (NT - 4); if (jb_ >= 0) cmask(P0, P1, jb_, qrel, hi); } while (0)
    for (; t + 1 < NT; t += 2) {
        { const bool gk = t + 3 < NT, gv = t + 1 < NT; FD_STEP(pB0, pB1, pA0, pA1, t, gk, gv, gv, false); const int n_ = (t + 2 < NT) ? ((int)gk + (int)gv) : 0; FD_ENDW(n_); FD_RESC(); FD_ROT(); }
        { const bool gk = t + 4 < NT, gv = t + 2 < NT, gm = t + 3 < NT; FD_STEP(pA0, pA1, pB0, pB1, t + 1, gk, gv, gv, gm); const int n_ = (t + 3 < NT) ? ((int)gk + (int)gv + (SWA ? 0 : (int)gm)) : 0; FD_ENDW(n_); FD_RESC(); FD_ROT(); }
    }
    FD_STEP(pB0, pB1, pA0, pA1, NT - 1, false, false, false, false); FD_RESC();
    { float sacc = pB0[0] + pB0[1];
#pragma unroll
      for (int r = 2; r < 16; ++r) sacc += pB0[r];
#pragma unroll
      for (int r = 0; r < 16; ++r) sacc += pB1[r];
      l_reg += sacc;
      pw0 = (u32x4){FD_PKW(pB0, 0), FD_PKW(pB0, 2), FD_PKW(pB0, 4), FD_PKW(pB0, 6)}; pw1 = (u32x4){FD_PKW(pB0, 8), FD_PKW(pB0, 10), FD_PKW(pB0, 12), FD_PKW(pB0, 14)};
      pw2 = (u32x4){FD_PKW(pB1, 0), FD_PKW(pB1, 2), FD_PKW(pB1, 4), FD_PKW(pB1, 6)}; pw3 = (u32x4){FD_PKW(pB1, 8), FD_PKW(pB1, 10), FD_PKW(pB1, 12), FD_PKW(pB1, 14)};
      FD_SBAR();
      const lds_cptr vp_ = vp0 + sl_cur;
#pragma unroll
      for (int i = 0; i < 8; ++i) FD_VRD(i);
      o[0] = FD_MFMA(FD_PAF(0), FD_VFR(0), o[0]); o[1] = FD_MFMA(FD_PAF(0), FD_VFR(4), o[1]); o[0] = FD_MFMA(FD_PAF(1), FD_VFR(1), o[0]); o[1] = FD_MFMA(FD_PAF(1), FD_VFR(5), o[1]);
      o[0] = FD_MFMA(FD_PAF(2), FD_VFR(2), o[0]); o[1] = FD_MFMA(FD_PAF(2), FD_VFR(6), o[1]); o[0] = FD_MFMA(FD_PAF(3), FD_VFR(3), o[0]); o[1] = FD_MFMA(FD_PAF(3), FD_VFR(7), o[1]); }
    { float la_ = l_reg, lb_ = l_reg; asm volatile("s_nop 1\n\tv_permlane32_swap_b32 %0, %1\n\ts_nop 1" : "+v"(la_), "+v"(lb_)); l_reg = la_ + lb_; }
    if (hi == 0) wsf[32 + r32] = l_reg;
    asm volatile("s_waitcnt lgkmcnt(0)" ::: "memory");
    LAS bf16_t* stg = (LAS bf16_t*)(shm + LDS_OST) + wid * 2048;
#pragma unroll
    for (int r = 0; r < 16; ++r) { const int orow = crow(r, hi); const float rl = __builtin_amdgcn_rcpf(wsf[32 + orow]);
        stg[orow * 64 + r32] = (bf16_t)f2bf(o[0][r] * rl); stg[orow * 64 + 32 + r32] = (bf16_t)f2bf(o[1][r] * rl); }
    asm volatile("s_waitcnt lgkmcnt(0)" ::: "memory");
    bf16_t* Ow = P.O + (rowbase + q0 + 32 * wid) * (long)P.ldo;
#pragma unroll
    for (int i = 0; i < 4; ++i) { const int row = i * 8 + (lane >> 3), ch = lane & 7; *(u32x4*)(Ow + (long)row * P.ldo + ch * 8) = *(const LAS u32x4*)(stg + row * 64 + ch * 8); }
    asm volatile("s_waitcnt lgkmcnt(0)\n\ts_barrier" ::: "memory");
#undef FD_DMA_K
#undef FD_DMA_V
#undef FD_DMA_M
#undef FD_QX
#undef FD_KX
#undef FD_CMASK
#undef FD_MW
#undef FD_AND
#undef FD_RESC
#undef FD_ROT
#undef FD_PKW
#undef FD_PAF
#undef FD_VFR
#undef FD_PIN
#undef FD_MX3
#undef FD_GAPA
#undef FD_GAPB
#undef FD_VRD
#undef FD_KRD
#undef FD_STEP
#undef FD_ENDW
}
#undef FD_SBAR
#undef FD_WAIT_BAR
#undef FD_MFMA
}

namespace fm {
using fa::lds_cptr; using fa::v4i16_t; using fa::vtr; using fa::glds16; using fa::crow;
constexpr int NSLOT = 3, SLOTK = 12288, SLOTV = 8192, LDS_K = 0, LDS_V = NSLOT * SLOTK, LDS_WS = LDS_V + NSLOT * SLOTV, LDS_OST = LDS_WS + 8 * 256, LDS_TOTAL = LDS_OST + 8 * 4096;
static_assert(LDS_TOTAL <= LDSCTL_OFF, "mla unit LDS");
#define FM_SBAR() __builtin_amdgcn_sched_barrier(0)
#define FM_WAIT_BAR(N) asm volatile("s_waitcnt vmcnt(" #N ") lgkmcnt(0)\n\ts_barrier" ::: "memory")
#define FM_MFMA(a, b, c) __builtin_amdgcn_mfma_f32_32x32x16_bf16(a, b, c, 0, 0, 0)
__device__ __forceinline__ void kload2(bf16x8* kf, lds_cptr kp, int j) { kf[2 * j] = *(const LAS bf16x8*)(kp + j * 2048); kf[2 * j + 1] = *(const LAS bf16x8*)(kp + j * 2048 + 512); }

__device__ __forceinline__ void unit(const Frame& F, const fa::Ptrs& P, int b, int qb) {
    const int lane = F.lane, r32 = lane & 31, hi = lane >> 5, wid = F.wave;
    const long rowbase = (long)b * SEQ; const int q0 = qb * 256, qrel = wid * 32 + r32, qidx = q0 + qrel;
    LAS unsigned char* shm = F.lds; const unsigned lds0 = (unsigned)(uintptr_t)shm;
    LAS float* wsf = (LAS float*)(shm + LDS_WS) + wid * 64;
    const bf16_t* ksrc = P.K + (rowbase + lane) * (long)P.ldk + wid * 8;
    const bf16_t* krsrc = P.KR + (rowbase + lane) * 32L + (wid & 3) * 8;
    const bf16_t* vsrc = P.V + (rowbase + 16 * (wid & 3) + (lane >> 2)) * (long)P.ldv + (wid >> 2) * 32 + (lane & 3) * 8;
    const unsigned kdst = lds0 + LDS_K + wid * 1024, krdst = lds0 + LDS_K + (8 + (wid & 3)) * 1024, vdst = lds0 + LDS_V + wid * 1024;
#define FM_DMA_K(t, slot) do { glds16(ksrc + (long)(t) * 64 * P.ldk, (unsigned)__builtin_amdgcn_readfirstlane(kdst + (slot))); glds16(krsrc + (long)(t) * 64 * 32, (unsigned)__builtin_amdgcn_readfirstlane(krdst + (slot))); } while (0)
#define FM_DMA_V(t, slot) glds16(vsrc + (long)(t) * 64 * P.ldv, (unsigned)__builtin_amdgcn_readfirstlane(vdst + (slot)))
    const lds_cptr shm3 = (lds_cptr)shm; const lds_cptr kp0 = shm3 + LDS_K + hi * 1024 + r32 * 16; const lds_cptr vp0 = shm3 + LDS_V + ((lane >> 4) & 1) * 32 + (lane & 3) * 8 + (4 * hi + ((lane & 15) >> 2)) * 64;
    const int NT = (q0 + 256) / 64;
    FM_DMA_K(0, 0); FM_DMA_V(0, 0); FM_DMA_K(1, SLOTK);
    bf16x8 qr[6];
    { const bf16_t* Qw = P.Q + (rowbase + qidx) * (long)P.ldq + hi * 8;
#pragma unroll
      for (int d0 = 0; d0 < 6; ++d0) qr[d0] = *(const bf16x8*)(Qw + d0 * 16); }
    float mhat = 0.f, l_reg = 0.f; f32x16 o[2]; o[0] = f32x16{}; o[1] = f32x16{};
#define FM_CMASK(P0, P1, t) do { const int jb_ = (t) - (NT - 4); if (jb_ >= 0) fd::cmask(P0, P1, jb_, qrel, hi); } while (0)
    bool resc = false;
#define FM_RESC() do { if (resc) { asm volatile("s_waitcnt lgkmcnt(0)" ::: "memory"); \
        _Pragma("unroll") for (int d_ = 0; d_ < 2; ++d_) _Pragma("unroll") for (int r = 0; r < 16; ++r) o[d_][r] *= wsf[crow(r, hi)]; } } while (0)
    f32x16 pA0, pA1, pB0, pB1; bf16x8 kf[12];
    int kl_prev = 0, kl_cur = 0, kl_next = SLOTK, vl_prev = 0, vl_cur = 0, vl_next = SLOTV;
#define FM_ROT() do { kl_prev = kl_cur; kl_cur = kl_next; kl_next = (kl_next == (NSLOT - 1) * SLOTK) ? 0 : kl_next + SLOTK; vl_prev = vl_cur; vl_cur = vl_next; vl_next = (vl_next == (NSLOT - 1) * SLOTV) ? 0 : vl_next + SLOTV; } while (0)
    FM_DMA_K(2, 2 * SLOTK);
    FM_WAIT_BAR(5);
#pragma unroll
    for (int j = 0; j < 6; ++j) kload2(kf, kp0, j);
    pA0 = FM_MFMA(kf[0], qr[0], f32x16{}); pA1 = FM_MFMA(kf[1], qr[0], f32x16{});
#pragma unroll
    for (int d0 = 1; d0 < 6; ++d0) { pA0 = FM_MFMA(kf[2 * d0], qr[d0], pA0); pA1 = FM_MFMA(kf[2 * d0 + 1], qr[d0], pA1); }
    asm volatile("s_nop 15\n\ts_nop 7" : "+v"(pA0), "+v"(pA1));
    FM_CMASK(pA0, pA1, 0);
    { const float rm = fd::rowmax(pA0, pA1); const float dl = rm; mhat += dl;
#pragma unroll
      for (int r = 0; r < 16; ++r) { pA0[r] -= dl; pA1[r] -= dl; }
#pragma unroll
      for (int r = 0; r < 16; ++r) { pA0[r] = __builtin_amdgcn_exp2f(pA0[r]); pA1[r] = __builtin_amdgcn_exp2f(pA1[r]); } }
    FM_WAIT_BAR(0);
    FM_DMA_K(3, 0); FM_DMA_V(1, SLOTV);
    FM_ROT();
#pragma unroll
    for (int j = 0; j < 6; ++j) kload2(kf, kp0 + kl_cur, j);
    FM_WAIT_BAR(3);
    v4i16_t vlo[8], vhi[8]; u32x4 pw[4];
#define FM_VFR(i) (bf16x8){vlo[i][0], vlo[i][1], vlo[i][2], vlo[i][3], vhi[i][0], vhi[i][1], vhi[i][2], vhi[i][3]}
#define FM_PIN(x) asm volatile("" : "+v"(x))
#define FM_MX3(a, b, c) __builtin_fmaxf(__builtin_fmaxf((a), (b)), (c))
#define FM_VRD(i) do { vlo[i] = vtr(vp_ + (((i) >> 2) * 4096 + ((i) & 3) * 1024)); vhi[i] = vtr(vp_ + (((i) >> 2) * 4096 + ((i) & 3) * 1024 + 512)); } while (0)
#define FM_PE(P0, P1, e) (((e) < 16) ? P0[(e) & 15] : P1[(e) & 15])
#define FM_STEP(C0, C1, P0, P1, t, GK, GV, GL) do { FM_SBAR(); \
        const lds_cptr vp_ = vp0 + vl_prev; float sacc = (P0[0] + P0[1]); \
        _Pragma("unroll") for (int i_ = 0; i_ < 12; ++i_) { \
            if (i_ < 8) { const int vi_ = (i_ >> 1) + 4 * (i_ & 1); FM_VRD(vi_); FM_SBAR(); } \
            if (i_ == 0) C0 = FM_MFMA(kf[0], qr[0], f32x16{}); else if (i_ == 1) C1 = FM_MFMA(kf[1], qr[0], f32x16{}); \
            else if (i_ & 1) C1 = FM_MFMA(kf[i_], qr[i_ >> 1], C1); else C0 = FM_MFMA(kf[i_], qr[i_ >> 1], C0); \
            _Pragma("unroll") for (int e_ = 2 + (30 * i_) / 12; e_ < 2 + (30 * (i_ + 1)) / 12; ++e_) sacc += FM_PE(P0, P1, e_); \
            FM_PIN(sacc); \
            _Pragma("unroll") for (int j_ = (16 * i_) / 12; j_ < (16 * (i_ + 1)) / 12; ++j_) { pw[j_ >> 2][j_ & 3] = cvt_pk_bf16(FM_PE(P0, P1, 2 * j_), FM_PE(P0, P1, 2 * j_ + 1)); FM_PIN(pw[j_ >> 2]); } \
            FM_SBAR(); } \
        l_reg += sacc; \
        if (GK) { FM_DMA_K((t) + 3, kl_cur); } if (GV) { FM_DMA_V((t) + 1, vl_next); } \
        FM_CMASK(C0, C1, t); \
        { float a = FM_MX3(C0[0], C0[1], C1[0]), bb = FM_MX3(C0[2], C0[3], C1[1]); a = FM_MX3(a, C1[2], C1[3]); \
          _Pragma("unroll") for (int r = 4; r < 16; r += 4) { a = FM_MX3(a, C0[r], C0[r + 1]); bb = FM_MX3(bb, C0[r + 2], C0[r + 3]); a = FM_MX3(a, C1[r], C1[r + 1]); bb = FM_MX3(bb, C1[r + 2], C1[r + 3]); } \
          const float rm = fa::xhalf_max(__builtin_fmaxf(a, bb)); \
          resc = false; \
          if (__builtin_expect(__any(rm > mhat + 8.0f), 0)) { const float dl = (rm > mhat + 8.0f) ? rm - mhat : 0.f; mhat += dl;        \
              const float f = __builtin_amdgcn_exp2f(-dl); l_reg *= f; if (hi == 0) wsf[r32] = f; resc = true; } } \
        FM_SBAR(); \
        _Pragma("unroll") for (int j_ = 0; j_ < 8; ++j_) { \
            if ((GL) && j_ >= 1 && j_ <= 6) { kload2(kf, kp0 + kl_next, j_ - 1); FM_SBAR(); } \
            if (j_ & 1) o[1] = FM_MFMA(__builtin_bit_cast(bf16x8, pw[j_ >> 1]), FM_VFR(4 + (j_ >> 1)), o[1]); else o[0] = FM_MFMA(__builtin_bit_cast(bf16x8, pw[j_ >> 1]), FM_VFR(j_ >> 1), o[0]); \
            if (j_ < 4) { C0[4 * j_] = __builtin_amdgcn_exp2f(C0[4 * j_] - mhat); C0[4 * j_ + 1] = __builtin_amdgcn_exp2f(C0[4 * j_ + 1] - mhat); C0[4 * j_ + 2] = __builtin_amdgcn_exp2f(C0[4 * j_ + 2] - mhat); C0[4 * j_ + 3] = __builtin_amdgcn_exp2f(C0[4 * j_ + 3] - mhat); FM_PIN(C0); } \
            else { C1[4 * (j_ & 3)] = __builtin_amdgcn_exp2f(C1[4 * (j_ & 3)] - mhat); C1[4 * (j_ & 3) + 1] = __builtin_amdgcn_exp2f(C1[4 * (j_ & 3) + 1] - mhat); C1[4 * (j_ & 3) + 2] = __builtin_amdgcn_exp2f(C1[4 * (j_ & 3) + 2] - mhat); C1[4 * (j_ & 3) + 3] = __builtin_amdgcn_exp2f(C1[4 * (j_ & 3) + 3] - mhat); FM_PIN(C1); } \
            FM_SBAR(); } \
        } while (0)
#define FM_ENDW(n_) do { if ((n_) == 3) { FM_WAIT_BAR(3); } else if ((n_) == 2) { FM_WAIT_BAR(2); } else if ((n_) == 1) { FM_WAIT_BAR(1); } else { FM_WAIT_BAR(0); } } while (0)
    int t = 1;
#undef FM_CMASK
#define FM_CMASK(P0, P1, t) do { } while (0)
    for (; t + 5 < NT; t += 2) {
        FM_STEP(pB0, pB1, pA0, pA1, t, true, true, true);     FM_WAIT_BAR(3); FM_RESC(); FM_ROT();
        FM_STEP(pA0, pA1, pB0, pB1, t + 1, true, true, true); FM_WAIT_BAR(3); FM_RESC(); FM_ROT();
    }
#undef FM_CMASK
#define FM_CMASK(P0, P1, t) do { const int jb_ = (t) - (NT - 4); if (jb_ >= 0) fd::cmask(P0, P1, jb_, qrel, hi); } while (0)
    for (; t + 1 < NT; t += 2) {
        { const bool gk = t + 3 < NT, gv = t + 1 < NT; FM_STEP(pB0, pB1, pA0, pA1, t, gk, gv, gv); const int n_ = (t + 2 < NT) ? (2 * (int)gk + (int)gv) : 0; FM_ENDW(n_); FM_RESC(); FM_ROT(); }
        { const bool gk = t + 4 < NT, gv = t + 2 < NT; FM_STEP(pA0, pA1, pB0, pB1, t + 1, gk, gv, gv); const int n_ = (t + 3 < NT) ? (2 * (int)gk + (int)gv) : 0; FM_ENDW(n_); FM_RESC(); FM_ROT(); }
    }
    FM_STEP(pB0, pB1, pA0, pA1, NT - 1, false, false, false); FM_RESC();
    { float sacc = pB0[0] + pB0[1];
#pragma unroll
      for (int r = 2; r < 16; ++r) sacc += pB0[r];
#pragma unroll
      for (int r = 0; r < 16; ++r) sacc += pB1[r];
      l_reg += sacc;
#pragma unroll
      for (int j = 0; j < 16; ++j) pw[j >> 2][j & 3] = cvt_pk_bf16(FM_PE(pB0, pB1, 2 * j), FM_PE(pB0, pB1, 2 * j + 1));
      FM_SBAR();
      const lds_cptr vp_ = vp0 + vl_cur;
#pragma unroll
      for (int i = 0; i < 8; ++i) FM_VRD(i);
#pragma unroll
      for (int k = 0; k < 4; ++k) { o[0] = FM_MFMA(__builtin_bit_cast(bf16x8, pw[k]), FM_VFR(k), o[0]); o[1] = FM_MFMA(__builtin_bit_cast(bf16x8, pw[k]), FM_VFR(4 + k), o[1]); } }
    { float la_ = l_reg, lb_ = l_reg; asm volatile("s_nop 1\n\tv_permlane32_swap_b32 %0, %1\n\ts_nop 1" : "+v"(la_), "+v"(lb_)); l_reg = la_ + lb_; }
    if (hi == 0) wsf[32 + r32] = l_reg;
    asm volatile("s_waitcnt lgkmcnt(0)" ::: "memory");
    LAS bf16_t* stg = (LAS bf16_t*)(shm + LDS_OST) + wid * 2048;
#pragma unroll
    for (int r = 0; r < 16; ++r) { const int orow = crow(r, hi); const float rl = __builtin_amdgcn_rcpf(wsf[32 + orow]);
        stg[orow * 64 + r32] = (bf16_t)f2bf(o[0][r] * rl); stg[orow * 64 + 32 + r32] = (bf16_t)f2bf(o[1][r] * rl); }
    asm volatile("s_waitcnt lgkmcnt(0)" ::: "memory");
    bf16_t* Ow = P.O + (rowbase + q0 + 32 * wid) * (long)P.ldo;
#pragma unroll
    for (int i = 0; i < 4; ++i) { const int row = i * 8 + (lane >> 3), ch = lane & 7; *(u32x4*)(Ow + (long)row * P.ldo + ch * 8) = *(const LAS u32x4*)(stg + row * 64 + ch * 8); }
    asm volatile("s_waitcnt lgkmcnt(0)\n\ts_barrier" ::: "memory");
#undef FM_DMA_K
#undef FM_DMA_V
#undef FM_CMASK
#undef FM_RESC
#undef FM_ROT
#undef FM_VFR
#undef FM_PIN
#undef FM_MX3
#undef FM_VRD
#undef FM_PE
#undef FM_STEP
#undef FM_ENDW
}
#undef FM_SBAR
#undef FM_WAIT_BAR
#undef FM_MFMA
}


namespace ix {
__device__ __forceinline__ unsigned ordf(float f) { const unsigned u = __builtin_bit_cast(unsigned, f); return u ^ ((u >> 31) ? 0xFFFFFFFFu : 0x80000000u); }
constexpr int L_HIST = EXTRA_OFF, L_MK = EXTRA_OFF + 16384, L_CV = L_MK + 4096, L_CI = L_CV + 1024, L_RED = L_CI + 1024, L_SELW = L_RED + 256, L_FLAG = L_SELW + 64;
struct Pre { bf16x8 qi[4]; float w[2][8]; bf16x8 kbA[4], kbB[4]; };
__device__ __forceinline__ void preload(const Frame& F, const bf16_t* Z, const bf16_t* KIT, int b, int qu, Pre& pre) {
    const int lane = F.lane, r32 = lane & 31, hi = lane >> 5, wid = F.wave;
    const long rowbase = (long)b * SEQ; const int t0 = 4 * qu, ntile = (t0 >> 5) + 1, npair = (ntile + 1) >> 1;
    { const int rho = r32, hq = (rho >> 2) & 1, gq = rho >> 3, iq = rho & 3;
      const bf16_t* qp = Z + (rowbase + t0 + 2 * hq + (gq >> 1)) * (long)ZP + ZC_IQ + 64 * (4 * (gq & 1) + iq) + 8 * hi;
#pragma unroll
      for (int ks = 0; ks < 4; ++ks) pre.qi[ks] = *(const bf16x8*)(qp + 16 * ks);
#pragma unroll
      for (int q2 = 0; q2 < 2; ++q2) { const u32x4 ww = *(const u32x4*)(Z + (rowbase + t0 + 2 * hi + q2) * (long)ZP + ZC_IW);
          pre.w[q2][0] = bf_lo(ww.x); pre.w[q2][1] = bf_hi(ww.x); pre.w[q2][2] = bf_lo(ww.y); pre.w[q2][3] = bf_hi(ww.y); pre.w[q2][4] = bf_lo(ww.z); pre.w[q2][5] = bf_hi(ww.z); pre.w[q2][6] = bf_lo(ww.w); pre.w[q2][7] = bf_hi(ww.w); } }
    const bf16_t* kbase = KIT + (size_t)(rowbase >> 5) * 2048 + hi * 256 + r32 * 8;
    if (wid < npair) { const bf16_t* kp = kbase + (size_t)(2 * wid) * 2048;
#pragma unroll
        for (int ks = 0; ks < 4; ++ks) { pre.kbA[ks] = *(const bf16x8*)(kp + 512 * ks); pre.kbB[ks] = *(const bf16x8*)(kp + 2048 + 512 * ks); } }
    else {
#pragma unroll
        for (int ks = 0; ks < 4; ++ks) { pre.kbA[ks] = bf16x8{}; pre.kbB[ks] = bf16x8{}; } }
}
__device__ __forceinline__ float relu1(float x) { const int i = __builtin_bit_cast(int, x); return __builtin_bit_cast(float, i > 0 ? i : 0); }
#define IX_BAR() asm volatile("s_waitcnt lgkmcnt(0)\n\ts_barrier" ::: "memory")
__device__ __forceinline__ void unit(const Frame& F, const bf16_t* Z, const bf16_t* KIT, unsigned* MK, int b, int qu, Pre& pre, bool has_next, int nb, int nqu) {
    const int lane = F.lane, r32 = lane & 31, hi = lane >> 5, wid = F.wave;
    const long rowbase = (long)b * SEQ; const int t0 = 4 * qu, ntile = (t0 >> 5) + 1, nk32 = 32 * ntile, nblk = (nk32 + 63) >> 6;
    LAS float* sc = (LAS float*)F.lds;
    LAS unsigned* hist = (LAS unsigned*)(F.lds + L_HIST);
    LAS unsigned* mk = (LAS unsigned*)(F.lds + L_MK);
    LAS float* cval = (LAS float*)(F.lds + L_CV); LAS unsigned* cidx = (LAS unsigned*)(F.lds + L_CI);
    LAS float* red = (LAS float*)(F.lds + L_RED);
    LAS unsigned* selw = (LAS unsigned*)(F.lds + L_SELW);
    LAS unsigned* flag = (LAS unsigned*)(F.lds + L_FLAG);
    bf16x8 qi[4]; float w[2][8];
#pragma unroll
    for (int ks = 0; ks < 4; ++ks) qi[ks] = pre.qi[ks];
#pragma unroll
    for (int q2 = 0; q2 < 2; ++q2)
#pragma unroll
        for (int e = 0; e < 8; ++e) w[q2][e] = pre.w[q2][e];
    float vmaxA = -INFINITY, vmaxB = -INFINITY, vminA = INFINITY, vminB = INFINITY;
    bf16x8 kq[2][8];
    const int npair = (ntile + 1) >> 1;
    const bf16_t* kbase = KIT + (size_t)(rowbase >> 5) * 2048 + hi * 256 + r32 * 8;
#pragma unroll
    for (int ks = 0; ks < 4; ++ks) { kq[0][ks] = pre.kbA[ks]; kq[0][4 + ks] = pre.kbB[ks]; }
#define IX_LOADP(BUF, PP) do { const bf16_t* kp_ = kbase + (size_t)(2 * (PP)) * 2048; \
        _Pragma("unroll") for (int ks = 0; ks < 4; ++ks) { kq[BUF][ks] = *(const bf16x8*)(kp_ + 512 * ks); kq[BUF][4 + ks] = *(const bf16x8*)(kp_ + 2048 + 512 * ks); } } while (0)
    if (wid + NWAVES < npair) IX_LOADP(1, wid + NWAVES);
    else {
#pragma unroll
        for (int ks = 0; ks < 8; ++ks) kq[1][ks] = bf16x8{}; }
#define IX_ELEM(D, e, sa, sb) do { const float ra_ = relu1(D[e]), rb_ = relu1(D[8 + (e)]); sa = __builtin_fmaf(w[0][e], ra_, sa); sb = __builtin_fmaf(w[1][e], rb_, sb); } while (0)
#define IX_TAIL(sa, sb, S0) do { const int s = (S0) + r32;                       \
        if (s > t0 + 2 * hi) sa = -INFINITY; else { vmaxA = __builtin_fmaxf(vmaxA, sa); vminA = __builtin_fminf(vminA, sa); } \
        if (s > t0 + 2 * hi + 1) sb = -INFINITY; else { vmaxB = __builtin_fmaxf(vmaxB, sb); vminB = __builtin_fminf(vminB, sb); } \
        sc[(2 * hi) * 8192 + s] = sa; sc[(2 * hi + 1) * 8192 + s] = sb; } while (0)
#define IX_PIN2(x, y) asm volatile("" : "+v"(x), "+v"(y))
#define IX_MF(a, b, c) __builtin_amdgcn_mfma_f32_32x32x16_bf16(a, b, c, 0, 0, 0)
#define IX_GAP(MF, D, e0, sa, sb) do { MF; IX_ELEM(D, e0, sa, sb); IX_ELEM(D, (e0) + 1, sa, sb); IX_PIN2(sa, sb); __builtin_amdgcn_sched_barrier(0); } while (0)
#define IX_PIPE(cA, cB, nA, nB, KQ, P, HASN) do { const int s0_ = 64 * (P); float sa = 0.f, sb = 0.f; __builtin_amdgcn_sched_barrier(0); \
        if (HASN) { \
            IX_GAP(nA = IX_MF(qi[0], KQ[0], f32x16{}), cA, 0, sa, sb); IX_GAP(nB = IX_MF(qi[0], KQ[4], f32x16{}), cA, 2, sa, sb); \
            IX_GAP(nA = IX_MF(qi[1], KQ[1], nA), cA, 4, sa, sb);       IX_GAP(nB = IX_MF(qi[1], KQ[5], nB), cA, 6, sa, sb); \
            IX_TAIL(sa, sb, s0_); sa = 0.f; sb = 0.f; __builtin_amdgcn_sched_barrier(0); \
            IX_GAP(nA = IX_MF(qi[2], KQ[2], nA), cB, 0, sa, sb);       IX_GAP(nB = IX_MF(qi[2], KQ[6], nB), cB, 2, sa, sb); \
            IX_GAP(nA = IX_MF(qi[3], KQ[3], nA), cB, 4, sa, sb);       IX_GAP(nB = IX_MF(qi[3], KQ[7], nB), cB, 6, sa, sb); \
        } else { \
            IX_ELEM(cA, 0, sa, sb); IX_ELEM(cA, 1, sa, sb); IX_ELEM(cA, 2, sa, sb); IX_ELEM(cA, 3, sa, sb); IX_ELEM(cA, 4, sa, sb); IX_ELEM(cA, 5, sa, sb); IX_ELEM(cA, 6, sa, sb); IX_ELEM(cA, 7, sa, sb); \
            IX_TAIL(sa, sb, s0_); sa = 0.f; sb = 0.f; \
            IX_ELEM(cB, 0, sa, sb); IX_ELEM(cB, 1, sa, sb); IX_ELEM(cB, 2, sa, sb); IX_ELEM(cB, 3, sa, sb); IX_ELEM(cB, 4, sa, sb); IX_ELEM(cB, 5, sa, sb); IX_ELEM(cB, 6, sa, sb); IX_ELEM(cB, 7, sa, sb); \
        } \
        if (s0_ + 32 < nk32) IX_TAIL(sa, sb, s0_ + 32); __builtin_amdgcn_sched_barrier(0); } while (0)
    f32x16 dA = {}, dB = {}, eA = {}, eB = {};
    if (wid < npair) {
#pragma unroll
        for (int ks = 0; ks < 4; ++ks) { dA = IX_MF(qi[ks], kq[0][ks], dA); dB = IX_MF(qi[ks], kq[0][4 + ks], dB); }
        if (wid + 2 * NWAVES < npair) IX_LOADP(0, wid + 2 * NWAVES);
    }
    for (int p0_ = wid; p0_ < npair; p0_ += 2 * NWAVES) {
        { const int p = p0_, pn = p + NWAVES; const bool hn = pn < npair;
          IX_PIPE(dA, dB, eA, eB, kq[1], p, hn); if (pn + 2 * NWAVES < npair) IX_LOADP(1, pn + 2 * NWAVES); }
        { const int p = p0_ + NWAVES, pn = p + NWAVES; if (p < npair) { const bool hn = pn < npair;
          IX_PIPE(eA, eB, dA, dB, kq[0], p, hn); if (pn + 2 * NWAVES < npair) IX_LOADP(0, pn + 2 * NWAVES); } }
    }
#undef IX_LOADP
#undef IX_ELEM
#undef IX_TAIL
#undef IX_PIN2
#undef IX_MF
#undef IX_GAP
#undef IX_PIPE
    if (has_next) preload(F, Z, KIT, nb, nqu, pre);
    const bool need_sel = (t0 + 4 > 256);
    if (need_sel) {
#pragma unroll
        for (int o = 1; o < 32; o <<= 1) { vmaxA = __builtin_fmaxf(vmaxA, __shfl_xor(vmaxA, o)); vmaxB = __builtin_fmaxf(vmaxB, __shfl_xor(vmaxB, o));
                                           vminA = __builtin_fminf(vminA, __shfl_xor(vminA, o)); vminB = __builtin_fminf(vminB, __shfl_xor(vminB, o)); }
        if (r32 == 0) { red[wid * 8 + 2 * hi] = vmaxA; red[wid * 8 + 2 * hi + 1] = vmaxB; red[wid * 8 + 4 + 2 * hi] = vminA; red[wid * 8 + 5 + 2 * hi] = vminB; }
        hist[F.tid] = 0u; hist[F.tid + 512] = 0u; hist[F.tid + 1024] = 0u; hist[F.tid + 1536] = 0u; hist[F.tid + 2048] = 0u; hist[F.tid + 2560] = 0u; hist[F.tid + 3072] = 0u; hist[F.tid + 3584] = 0u;
        if (F.tid < 16) selw[F.tid] = 0u;
        if (F.tid == 0) flag[0] = 0u;
    }
    IX_BAR();
#if defined(DBG_DSA_SCORES)
    { float* dump = (float*)(F.wsp(WS_R2 + 56 * MiB));
      for (int qq = 0; qq < 4; ++qq) { const int tt = t0 + qq; int slot = -1;
          if (tt == 256) slot = 0; if (tt == 257) slot = 1; if (tt == 700) slot = 2; if (tt == 3001) slot = 3; if (tt == 8191) slot = 4;
          if (slot >= 0) for (int s = F.tid; s < nk32; s += 512) dump[((size_t)(b * 5 + slot)) * 8192 + s] = sc[qq * 8192 + s]; } }
#endif
    const int q = wid >> 1, sub = wid & 1, tq = t0 + q;
    if (!need_sel) {
        for (int blk = sub; blk < nblk; blk += 2) { const int s = 64 * blk + lane; const unsigned long long bal = __ballot(s <= tq);
            if (lane == 0) { mk[q * 256 + 2 * blk] = (unsigned)bal; mk[q * 256 + 2 * blk + 1] = (unsigned)(bal >> 32); } }
    } else {
        float maxv = red[q], minv = red[4 + q];
#pragma unroll
        for (int wv = 1; wv < 8; ++wv) { maxv = __builtin_fmaxf(maxv, red[wv * 8 + q]); minv = __builtin_fminf(minv, red[wv * 8 + 4 + q]); }
        const float rng = maxv - minv; const bool degenerate = !(rng > 0.f) || !(rng < 3.0e38f);
        const float scale = degenerate ? 0.f : 1023.99f / rng;
#ifdef DBG_FORCE_RADIX
        if (lane == 0) flag[0] = 1u;
#endif
        if (degenerate && lane == 0) flag[0] = 1u;
        { int idx = sub * 64 + lane;
          for (; idx + 384 <= tq; idx += 512) {
              const float v0 = sc[q * 8192 + idx], v1 = sc[q * 8192 + idx + 128], v2 = sc[q * 8192 + idx + 256], v3 = sc[q * 8192 + idx + 384];
              const int b0 = (int)((maxv - v0) * scale), b1 = (int)((maxv - v1) * scale), b2 = (int)((maxv - v2) * scale), b3 = (int)((maxv - v3) * scale);
              (void)__hip_atomic_fetch_add(&hist[q * 1024 + b0], 1u, __ATOMIC_RELAXED, __HIP_MEMORY_SCOPE_WORKGROUP); (void)__hip_atomic_fetch_add(&hist[q * 1024 + b1], 1u, __ATOMIC_RELAXED, __HIP_MEMORY_SCOPE_WORKGROUP);
              (void)__hip_atomic_fetch_add(&hist[q * 1024 + b2], 1u, __ATOMIC_RELAXED, __HIP_MEMORY_SCOPE_WORKGROUP); (void)__hip_atomic_fetch_add(&hist[q * 1024 + b3], 1u, __ATOMIC_RELAXED, __HIP_MEMORY_SCOPE_WORKGROUP); }
          for (; idx <= tq; idx += 128) {
              const int bin = (int)((maxv - sc[q * 8192 + idx]) * scale);
              (void)__hip_atomic_fetch_add(&hist[q * 1024 + bin], 1u, __ATOMIC_RELAXED, __HIP_MEMORY_SCOPE_WORKGROUP); } }
        IX_BAR();
        if (wid < 4) {
            const LAS u32x4* hp = (const LAS u32x4*)(hist + wid * 1024 + 16 * lane);
            const u32x4 h0 = hp[0], h1 = hp[1], h2 = hp[2], h3 = hp[3];
            const unsigned c[16] = {h0.x, h0.y, h0.z, h0.w, h1.x, h1.y, h1.z, h1.w, h2.x, h2.y, h2.z, h2.w, h3.x, h3.y, h3.z, h3.w};
            unsigned tot = 0u;
#pragma unroll
            for (int i = 0; i < 16; ++i) tot += c[i];
            unsigned incl = tot;
#pragma unroll
            for (int o = 1; o < 64; o <<= 1) { const unsigned v = __shfl_up(incl, o); if (lane >= o) incl += v; }
            const unsigned excl = incl - tot;
            if (excl < 256u && 256u <= incl) {
                unsigned run = excl, bsel = 0u, cnt = 0u; bool found = false;
#pragma unroll
                for (int i = 0; i < 16; ++i) { if (!found) { if (run + c[i] >= 256u) { bsel = 16u * lane + i; cnt = c[i]; found = true; } else run += c[i]; } }
                selw[wid * 4 + 0] = bsel; selw[wid * 4 + 1] = 256u - run; selw[wid * 4 + 2] = cnt;
                if (cnt > 64u) flag[0] = 1u;
            }
        }
        IX_BAR();
        if (flag[0] == 0u) {
            const unsigned B = selw[q * 4 + 0];
#define IX_EMIT(BLK, V) do { const int s_ = 64 * (BLK) + lane; const bool val_ = (s_ <= tq); const float v_ = val_ ? (V) : 0.f; \
                const unsigned bin_ = (unsigned)(int)((maxv - v_) * scale); const unsigned long long bal_ = __ballot(val_ && bin_ < B); \
                if (val_ && bin_ == B) { const unsigned pos_ = __hip_atomic_fetch_add(&selw[q * 4 + 3], 1u, __ATOMIC_RELAXED, __HIP_MEMORY_SCOPE_WORKGROUP); cval[q * 64 + (pos_ & 63u)] = v_; cidx[q * 64 + (pos_ & 63u)] = (unsigned)s_; } \
                if (lane == 0) { mk[q * 256 + 2 * (BLK)] = (unsigned)bal_; mk[q * 256 + 2 * (BLK) + 1] = (unsigned)(bal_ >> 32); } } while (0)
            { int blk = sub;
              for (; blk + 6 < nblk; blk += 8) {
                  const float v0 = sc[q * 8192 + 64 * blk + lane], v1 = sc[q * 8192 + 64 * (blk + 2) + lane], v2 = sc[q * 8192 + 64 * (blk + 4) + lane], v3 = sc[q * 8192 + 64 * (blk + 6) + lane];
                  IX_EMIT(blk, v0); IX_EMIT(blk + 2, v1); IX_EMIT(blk + 4, v2); IX_EMIT(blk + 6, v3); }
              for (; blk < nblk; blk += 2) { const float v0 = sc[q * 8192 + ((64 * blk + lane) & 8191)]; IX_EMIT(blk, v0); } }
#undef IX_EMIT
            IX_BAR();
            if (wid < 4) {
                const unsigned C = selw[wid * 4 + 3], need = selw[wid * 4 + 1];
                const float mv = (lane < (int)C) ? cval[wid * 64 + lane] : -INFINITY; const unsigned mi = (lane < (int)C) ? cidx[wid * 64 + lane] : 0xFFFFFFFFu;
                unsigned rank = 0u;
                for (unsigned j = 0; j < C; ++j) { const unsigned js = (unsigned)__builtin_amdgcn_readfirstlane((int)j);
                    const float vj = __builtin_bit_cast(float, __builtin_amdgcn_readlane(__builtin_bit_cast(int, mv), (int)js)); const unsigned ij = (unsigned)__builtin_amdgcn_readlane((int)mi, (int)js); rank += (vj > mv || (vj == mv && ij < mi)) ? 1u : 0u; }
                if (lane < (int)C && rank < need) (void)__hip_atomic_fetch_or(&mk[wid * 256 + (mi >> 5)], 1u << (mi & 31u), __ATOMIC_RELAXED, __HIP_MEMORY_SCOPE_WORKGROUP);
            }
        } else {
            if (F.tid < 4) { unsigned z_ = (unsigned)F.zz; asm volatile("" : "+v"(z_)); selw[F.tid * 4 + 0] = z_; selw[F.tid * 4 + 1] = 256u + z_; selw[F.tid * 4 + 2] = z_; }
#pragma unroll 1
            for (int pass = 0; pass < 4; ++pass) {
                const int shift = 24 - 8 * pass;
                IX_BAR();
                hist[F.tid] = 0u; hist[F.tid + 512] = 0u;
                IX_BAR();
                const unsigned prefix = selw[q * 4 + 0];
                for (int idx = sub * 64 + lane; idx < nk32; idx += 128) {
                    const unsigned u = ordf(sc[q * 8192 + idx]);
                    const bool match = (pass == 0) || ((u >> (shift + 8)) == (prefix >> (shift + 8)));
                    if (match) (void)__hip_atomic_fetch_add(&hist[q * 256 + ((u >> shift) & 255u)], 1u, __ATOMIC_RELAXED, __HIP_MEMORY_SCOPE_WORKGROUP);
                }
                IX_BAR();
                if (wid < 4) {
                    const unsigned kk = selw[wid * 4 + 1], pre = selw[wid * 4 + 0];
                    const unsigned c0 = hist[wid * 256 + 4 * lane], c1 = hist[wid * 256 + 4 * lane + 1], c2 = hist[wid * 256 + 4 * lane + 2], c3 = hist[wid * 256 + 4 * lane + 3];
                    const unsigned tot = c0 + c1 + c2 + c3; unsigned incl = tot;
#pragma unroll
                    for (int o = 1; o < 64; o <<= 1) { const unsigned v = __shfl_down(incl, o); if (lane + o < 64) incl += v; }
                    const unsigned excl = incl - tot;
                    if (excl < kk && kk <= incl) {
                        unsigned run = excl, dsel, cnt;
                        if (run + c3 >= kk) { dsel = 3; cnt = c3; } else { run += c3;
                            if (run + c2 >= kk) { dsel = 2; cnt = c2; } else { run += c2;
                                if (run + c1 >= kk) { dsel = 1; cnt = c1; } else { run += c1; dsel = 0; cnt = c0; } } }
                        selw[wid * 4 + 0] = pre | ((4u * lane + dsel) << shift); selw[wid * 4 + 1] = kk - run; selw[wid * 4 + 2] = cnt;
                    }
                }
            }
            IX_BAR();
            const unsigned thr = selw[q * 4 + 0], kk = selw[q * 4 + 1];
            unsigned eqseen = 0u;
            for (int blk = 0; blk < nblk; ++blk) {
                const int s = 64 * blk + lane;
                const unsigned u = (s < nk32) ? ordf(sc[q * 8192 + s]) : 0u;
                const bool val = (s <= tq);
                const unsigned long long gt = __ballot(val && u > thr), eq = __ballot(val && u == thr);
                unsigned long long take = 0ull, e = eq; unsigned left = (kk > eqseen) ? kk - eqseen : 0u;
                while (left && e) { const unsigned long long low = e & (~e + 1ull); take |= low; e ^= low; --left; }
                eqseen += (unsigned)__popcll(eq);
                if ((blk & 1) == sub && lane == 0) { const unsigned long long wv = gt | take; mk[q * 256 + 2 * blk] = (unsigned)wv; mk[q * 256 + 2 * blk + 1] = (unsigned)(wv >> 32); }
            }
        }
    }
    IX_BAR();
    { const int wq = F.tid >> 7, ww = (F.tid & 127) * 2;
      if (ww < 2 * nblk) *(u32x2*)(MK + (size_t)(rowbase + t0 + wq) * 256 + ww) = *(const LAS u32x2*)(mk + wq * 256 + ww); }
    IX_BAR();
}
}

constexpr int NPH = 16;
__global__ void __launch_bounds__(NWAVES * 64, 2) mk_fwd(Args args) {
    extern __shared__ __attribute__((aligned(16))) unsigned char lds[];
    Frame F;
    F.lds = (LAS unsigned char*)lds;
    F.tid = threadIdx.x; F.lane = F.tid & 63; F.wave = __builtin_amdgcn_readfirstlane(F.tid >> 6);
    const int wave0 = F.wave;
    F.G = gridDim.x; { const int bx = blockIdx.x; F.vcu = (F.G % 8 == 0) ? (bx % 8) * (F.G / 8) + bx / 8 : bx; }
    F.a = &args; F.zz = 0;
    volatile LAS unsigned* MISC = (volatile LAS unsigned*)(F.lds + LDSCTL_OFF);
    for (int u = F.tid; u < (LDS_BYTES - LDSCTL_OFF) / 4; u += NWAVES * 64) ((LAS unsigned*)(F.lds + LDSCTL_OFF))[u] = 0u;
    __syncthreads();
    XcdBarrier bar; bar.bar = (unsigned*)(args.ws + WS_CTL) + CW_BAR; bar.x = 0; bar.st = nullptr;
    if (MK_ONE_LAUNCH) bar = xcd_barrier_post((unsigned*)(args.ws + WS_CTL) + CW_BAR, MISC + 8);
    const int lo = args.ph_lo, hi = args.ph_hi;
#define IN(k) (lo <= (k) && (k) < hi)
#define SEAM(k) do { if (MK_ONE_LAUNCH && (k) + 1 < hi) { XcdBarrier b2_ = bar; asm volatile("" : "+s"(b2_.bar), "+s"(b2_.x)); xcd_barrier(b2_); } } while (0)
#define PHASE_BEGIN() do { asm volatile("s_mov_b32 %0, 0" : "=s"(F.zz)); F.wave = wave0 + F.zz; asm volatile("v_mbcnt_lo_u32_b32 %0, -1, 0\n\tv_mbcnt_hi_u32_b32 %0, -1, %0" : "=v"(F.lane)); F.tid = F.wave * 64 + F.lane; } while (0)
#define WSP(off, T) ((T*)(F.wsp(off)))

    for (int l = 0; l < DEPTH; ++l) {
        const int P = l * NPH;
        for (int rep_ = 0; rep_ < ((DBG_DUP == 0) ? 2 : 1); ++rep_) if (IN(P + 0)) {
            PHASE_BEGIN();
            if (l == 0) { for (int u = F.vcu; u < 144; u += F.G) { PHASE_BEGIN(); mod_unit(F, u); } PHASE_BEGIN(); rope_table(F); PHASE_BEGIN(); }
            convert_weights(F, l, 0, 0, 2, F.vcu * NWAVES + F.wave, F.G * NWAVES);
            SEAM(P + 0);
        }
        for (int rep_ = 0; rep_ < ((DBG_DUP == 1) ? 2 : 1); ++rep_) if (IN(P + 1)) {
            PHASE_BEGIN();
            const float* mod_l = WSP(WS_MOD, const float) + (size_t)l * 2 * 9216; const float* ng = F.in(IN_NORMG) + (size_t)l * 6 * DM;
            if (l == 0) { norm_pass<false, true, 0, 0>(F, nullptr, F.in(IN_X), nullptr, nullptr, nullptr, 0.f, ng + 0 * DM, mod_l + 1 * DM, mod_l + 0 * DM, WSP(WS_XN, bf16_t));
                SEAM(P + 1); }
        }
        for (int rep_ = 0; rep_ < ((DBG_DUP == 2) ? 2 : 1); ++rep_) if (IN(P + 2)) {
            PHASE_BEGIN();
            pg8::Gemm g{WSP(WS_XN, bf16_t), WSP(WS_W + W_W1, bf16_t), DM, DM, DM}; pg8::StaticOrder S; S.init(M, 2 * DFF, F.G, (int)blockIdx.x);
            pg8::EpiSwiglu E{WSP(WS_R1, bf16_t), DFF};
            pg8::gemm_phase<pg8::EpiSwiglu, pg8::StaticOrder, true>(F.lds, F.tid, g, S, E);
            { const int rem_ = (M / 256) * (2 * DFF / 256) % F.G;
              if (l == 0 && rem_ != 0 && (int)blockIdx.x >= rem_) { PHASE_BEGIN(); convert_weights(F, l, 0, 2, NSEG_A, ((int)blockIdx.x - rem_) * NWAVES + F.wave, (F.G - rem_) * NWAVES); } }
            SEAM(P + 2);
        }
        for (int rep_ = 0; rep_ < ((DBG_DUP == 3) ? 2 : 1); ++rep_) if (IN(P + 3)) {
            PHASE_BEGIN();
            pg8::Gemm g{WSP(WS_R1, bf16_t), WSP(WS_W + W_W2, bf16_t), DFF, DFF, DFF}; pg8::StaticOrder S; S.init(M, DM, F.G, (int)blockIdx.x);
            pg8::EpiBf16<0> E{WSP(WS_R2, bf16_t), DM};
            pg8::gemm_phase<pg8::EpiBf16<0>, pg8::StaticOrder, true>(F.lds, F.tid, g, S, E);
            SEAM(P + 3);
        }
        for (int rep_ = 0; rep_ < ((DBG_DUP == 4) ? 2 : 1); ++rep_) if (IN(P + 4)) {
            PHASE_BEGIN();
            const float* mod_l = WSP(WS_MOD, const float) + (size_t)l * 2 * 9216; const float* ng = F.in(IN_NORMG) + (size_t)l * 6 * DM;
            if (l == 0) norm_pass<true, true, 0, 1>(F, WSP(WS_R2, bf16_t), F.in(IN_X), F.outp(), ng + 1 * DM, mod_l + 2 * DM, 0.5f, ng + 2 * DM, mod_l + 4 * DM, mod_l + 3 * DM, WSP(WS_XN, bf16_t));
            else norm_pass<true, true, 1, 1>(F, WSP(WS_R2, bf16_t), F.outp(), F.outp(), ng + 1 * DM, mod_l + 2 * DM, 0.5f, ng + 2 * DM, mod_l + 4 * DM, mod_l + 3 * DM, WSP(WS_XN, bf16_t));
            SEAM(P + 4);
        }
        for (int rep_ = 0; rep_ < ((DBG_DUP == 5) ? 2 : 1); ++rep_) if (IN(P + 5)) {
            PHASE_BEGIN();
            pg8::Gemm g{WSP(WS_XN, bf16_t), WSP(WS_W + W_IN, bf16_t), DM, DM, DM}; pg8::StaticOrder S; S.init(M, ZP, F.G, (int)blockIdx.x);
            pg8::EpiBf16<0> E{WSP(WS_R1, bf16_t), ZP};
            pg8::gemm_phase<pg8::EpiBf16<0>, pg8::StaticOrder, true>(F.lds, F.tid, g, S, E);
            { const int rem_ = (M / 256) * (ZP / 256) % F.G;
              if (rem_ != 0 && (int)blockIdx.x >= rem_) { PHASE_BEGIN(); convert_weights(F, l, 1, 0, NSEG_B, ((int)blockIdx.x - rem_) * NWAVES + F.wave, (F.G - rem_) * NWAVES); } }
            SEAM(P + 5);
        }
        for (int rep_ = 0; rep_ < ((DBG_DUP == 6) ? 2 : 1); ++rep_) if (IN(P + 6)) {
            PHASE_BEGIN();
            mla_prep(F, WSP(WS_R1, const bf16_t), WSP(WS_YB, bf16_t), WSP(WS_YB + 8 * MiB, bf16_t), WSP(WS_KROPE, bf16_t), WSP(WS_RS, bf16_t), WSP(WS_ROPE, const f32x2));
            __syncthreads();
            for (int u = F.vcu; u < 256; u += F.G) { PHASE_BEGIN(); lru_unit<false>(F, l, u, WSP(WS_R1, const bf16_t), WSP(WS_LRUS, f32x2), nullptr); }
            SEAM(P + 6);
        }
        for (int rep_ = 0; rep_ < ((DBG_DUP == 7) ? 2 : 1); ++rep_) if (IN(P + 7)) {
            PHASE_BEGIN();
            { pg8::Gemm g{WSP(WS_YB, bf16_t), WSP(WS_W + W_UQ, bf16_t), 256, 256, 256 + F.zz}; pg8::StaticOrder S; S.init(M, 768, F.G, (int)blockIdx.x);
              pg8::EpiMlaQ E{WSP(WS_R2, bf16_t), 768, WSP(WS_ROPE, const f32x2)};
              pg8::gemm_phase<pg8::EpiMlaQ, pg8::StaticOrder, true>(F.lds, F.tid, g, S, E); }
            PHASE_BEGIN();
            { pg8::Gemm g{WSP(WS_YB + 8 * MiB, bf16_t), WSP(WS_W + W_UKV, bf16_t), 128, 128, 128 + F.zz}; pg8::StaticOrder S; S.init(M, 1024, F.G, (int)blockIdx.x);
              pg8::EpiBf16<0> E{WSP(WS_R2 + 24 * MiB, bf16_t), 1024};
              pg8::gemm_phase<pg8::EpiBf16<0>, pg8::StaticOrder, true>(F.lds, F.tid, g, S, E); }
            __syncthreads();
            PHASE_BEGIN();
            for (int v = F.vcu; v < 256; v += F.G)
            { ix::Pre pre; const int U0 = v;
              ix::preload(F, WSP(WS_R1, const bf16_t), WSP(WS_RS, const bf16_t), U0 >> 11, U0 & 2047, pre);
              for (int i = 0; i < 16; ++i) { const int U = (i & 1) ? 4095 - ((i >> 1) * 256 + v) : (i >> 1) * 256 + v;
                  const int i2 = i + 1, U2 = (i2 & 1) ? 4095 - ((i2 >> 1) * 256 + v) : (i2 >> 1) * 256 + v;
                  PHASE_BEGIN();
                  ix::unit(F, WSP(WS_R1, const bf16_t), WSP(WS_RS, const bf16_t), WSP(WS_R1 + 112 * MiB, unsigned), U >> 11, U & 2047, pre, i2 < 16, (U2 >> 11) & 1, U2 & 2047); } }
            __syncthreads();
            SEAM(P + 7);
        }
        for (int rep_ = 0; rep_ < ((DBG_DUP == 8) ? 2 : 1); ++rep_) if (IN(P + 8)) {
            PHASE_BEGIN();
            for (unsigned v_ = (unsigned)(F.vcu + F.zz); v_ < 256u; v_ += 256u) { const int v = (int)v_;
                const int bh = v >> 4, b = bh >> 3, h = bh & 7, qa = v & 15;
                PHASE_BEGIN();
                const bf16_t* Z = WSP(WS_R1, const bf16_t); bf16_t* YB = WSP(WS_YB, bf16_t);
                { fa::Ptrs P_{WSP(WS_R2, const bf16_t) + 96 * h, 768, WSP(WS_R2 + 24 * MiB, const bf16_t) + 128 * h, 1024, WSP(WS_KROPE, const bf16_t), WSP(WS_R2 + 24 * MiB, const bf16_t) + 128 * h + 64, 1024,
                                YB + 1024 + 64 * h, 2048, nullptr, 0.f, 0.f};
                  for (int r3_ = 0; r3_ < ((DBG_FADUP == 0) ? 2 : 1); ++r3_) { fm::unit(F, P_, b, qa); PHASE_BEGIN(); fm::unit(F, P_, b, 31 - qa); PHASE_BEGIN(); } }
                PHASE_BEGIN();
                { fa::Ptrs P_{Z + ZC_AQ + 64 * h, ZP, Z + ZC_AK + 64 * (h >> 2), ZP, nullptr, Z + ZC_AV + 64 * (h >> 2), ZP, YB + 64 * h, 2048, WSP(WS_R1 + 112 * MiB, const unsigned),
                                __builtin_amdgcn_exp2f(-0.5f * (float)(h + 9)) * LOG2E, 0.f};
                  for (int r3_ = 0; r3_ < ((DBG_FADUP == 1) ? 2 : 1); ++r3_) { fd::unit<0>(F, P_, b, qa); PHASE_BEGIN(); fd::unit<0>(F, P_, b, 31 - qa); PHASE_BEGIN(); } }
                for (int i = 0; i < ((DBG_FADUP == 2) ? 4 : 2); ++i) { PHASE_BEGIN(); const int U = 2 * v + (i & 1), bh2 = U >> 5, b2 = bh2 >> 3, h2 = bh2 & 7, qb2 = U & 31;
                  fa::Ptrs P_{Z + ZC_DQ + 64 * h2, ZP, Z + ZC_DK + 64 * (h2 >> 2), ZP, nullptr, Z + ZC_DV + 64 * (h2 >> 2), ZP, YB + 1536 + 64 * h2, 2048, nullptr,
                                __builtin_amdgcn_exp2f(-0.5f * (float)(h2 + 1)) * LOG2E, F.in(IN_SINKS)[l * 8 + h2] * LOG2E};
                  fd::unit<1>(F, P_, b2, qb2); }
                for (int r5_ = 0; r5_ < ((DBG_FADUP == 3) ? 2 : 1); ++r5_) {
                PHASE_BEGIN();
                lru_unit<true>(F, l, v, WSP(WS_R1, const bf16_t), WSP(WS_LRUS, f32x2), WSP(WS_YB, bf16_t)); }
            }
            SEAM(P + 8);
        }
        for (int rep_ = 0; rep_ < ((DBG_DUP == 9) ? 2 : 1); ++rep_) if (IN(P + 9)) {
            PHASE_BEGIN();
#if defined(DBG_ZB)
            { bf16_t* YBz = WSP(WS_YB, bf16_t); const int gw = F.vcu * NWAVES + F.wave, NGW = F.G * NWAVES;
              for (int m = gw; m < M; m += NGW) *(u32x4*)(YBz + (size_t)m * 2048 + 512 * DBG_ZB + 8 * F.lane) = (u32x4){0u, 0u, 0u, 0u}; }
#endif
            PHASE_BEGIN();
            pg8::Gemm g{WSP(WS_XN, bf16_t), WSP(WS_W + W_G, bf16_t), DM, DM, DM}; pg8::StaticOrder S; S.init(M, NG, F.G, (int)blockIdx.x);
            pg8::EpiBf16<2> E{WSP(WS_R1, bf16_t), NG};
            pg8::gemm_phase<pg8::EpiBf16<2>, pg8::StaticOrder, true>(F.lds, F.tid, g, S, E);
            SEAM(P + 9);
        }
        for (int rep_ = 0; rep_ < ((DBG_DUP == 10) ? 2 : 1); ++rep_) if (IN(P + 10)) {
            PHASE_BEGIN();
            pg8::Gemm g{WSP(WS_YB, bf16_t), WSP(WS_W + W_BR, bf16_t), 2048, 2048, 512}; pg8::ChainOrder S; S.so.init(M, DM, F.G, (int)blockIdx.x);
            pg8::EpiGateMerge E{WSP(WS_R1, const bf16_t), WSP(WS_R2, bf16_t), DM};
            pg8::gemm_phase<pg8::EpiGateMerge, pg8::ChainOrder, true>(F.lds, F.tid, g, S, E);
            SEAM(P + 10);
        }
        for (int rep_ = 0; rep_ < ((DBG_DUP == 11) ? 2 : 1); ++rep_) if (IN(P + 11)) {
            PHASE_BEGIN();
            pg8::Gemm g{WSP(WS_R2, bf16_t), WSP(WS_W + W_O, bf16_t), DM, DM, DM}; pg8::StaticOrder S; S.init(M, DM, F.G, (int)blockIdx.x);
            pg8::EpiBf16<0> E{WSP(WS_YB, bf16_t), DM};
            pg8::gemm_phase<pg8::EpiBf16<0>, pg8::StaticOrder, true>(F.lds, F.tid, g, S, E);
            SEAM(P + 11);
        }
        for (int rep_ = 0; rep_ < ((DBG_DUP == 12) ? 2 : 1); ++rep_) if (IN(P + 12)) {
            PHASE_BEGIN();
            const float* mod_l = WSP(WS_MOD, const float) + (size_t)l * 2 * 9216; const float* ng = F.in(IN_NORMG) + (size_t)l * 6 * DM;
            norm_pass<true, true, 1, 1>(F, WSP(WS_YB, bf16_t), F.outp(), (l + 1 < DEPTH) ? (void*)F.outp() : (void*)WSP(WS_YB + 32 * MiB, bf16_t), ng + 3 * DM, mod_l + 5 * DM, 1.0f, ng + 4 * DM, mod_l + 7 * DM, mod_l + 6 * DM, WSP(WS_XN, bf16_t));
            SEAM(P + 12);
        }
        for (int rep_ = 0; rep_ < ((DBG_DUP == 13) ? 2 : 1); ++rep_) if (IN(P + 13)) {
            PHASE_BEGIN();
            pg8::Gemm g{WSP(WS_XN, bf16_t), WSP(WS_W + W_W1, bf16_t), DM, DM, DM}; pg8::StaticOrder S; S.init(M, 2 * DFF, F.G, (int)blockIdx.x);
            pg8::EpiSwiglu E{WSP(WS_R1, bf16_t), DFF};
            pg8::gemm_phase<pg8::EpiSwiglu, pg8::StaticOrder, true>(F.lds, F.tid, g, S, E);
            { const int rem_ = (M / 256) * (2 * DFF / 256) % F.G;
              if (l + 1 < DEPTH && rem_ != 0 && (int)blockIdx.x >= rem_) { PHASE_BEGIN(); convert_weights(F, l + 1, 0, 2, NSEG_A, ((int)blockIdx.x - rem_) * NWAVES + F.wave, (F.G - rem_) * NWAVES); } }
            SEAM(P + 13);
        }
        for (int rep_ = 0; rep_ < ((DBG_DUP == 14) ? 2 : 1); ++rep_) if (IN(P + 14)) {
            PHASE_BEGIN();
            pg8::Gemm g{WSP(WS_R1, bf16_t), WSP(WS_W + W_W2, bf16_t), DFF, DFF, DFF}; pg8::StaticOrder S; S.init(M, DM, F.G, (int)blockIdx.x);
            pg8::EpiBf16<0> E{WSP(WS_R2, bf16_t), DM};
            pg8::gemm_phase<pg8::EpiBf16<0>, pg8::StaticOrder, true>(F.lds, F.tid, g, S, E);
            SEAM(P + 14);
        }
        for (int rep_ = 0; rep_ < ((DBG_DUP == 15) ? 2 : 1); ++rep_) if (IN(P + 15)) {
            PHASE_BEGIN();
            const float* mod_l = WSP(WS_MOD, const float) + (size_t)l * 2 * 9216; const float* ng = F.in(IN_NORMG) + (size_t)l * 6 * DM;
            if (l + 1 < DEPTH) { const float* mod_n = mod_l + 2 * 9216; const float* ngn = ng + 6 * DM;
                norm_pass<true, true, 1, 1>(F, WSP(WS_R2, bf16_t), F.outp(), F.outp(), ng + 5 * DM, mod_l + 8 * DM, 0.5f, ngn + 0 * DM, mod_n + 1 * DM, mod_n + 0 * DM, WSP(WS_XN, bf16_t)); }
            else norm_pass<true, false, 1, 0>(F, WSP(WS_R2, bf16_t), WSP(WS_YB + 32 * MiB, const bf16_t), F.outp(), ng + 5 * DM, mod_l + 8 * DM, 0.5f, nullptr, nullptr, nullptr, nullptr);
            SEAM(P + 15);
        }
    }
#undef IN
#undef SEAM
}


#if defined(DBG_PROBE)
__device__ __forceinline__ void probe_acc(float* acc2, float dd, float rr) {
    dd = wave_sum(dd); rr = wave_sum(rr);
    if ((threadIdx.x & 63) == 0) { atomicAdd(acc2, dd); atomicAdd(acc2 + 1, rr); }
}
__global__ void __launch_bounds__(256) probe_swa(const unsigned char* ws, const float* sinks, float* acc2) {
    const bf16_t* Z = (const bf16_t*)(ws + WS_R1); const bf16_t* YB = (const bf16_t*)(ws + WS_YB);
    const int gid = blockIdx.x * blockDim.x + threadIdx.x; const int h = gid & 7, ms = gid >> 3;
    const int m = ms * 7 + 3; float dd = 0.f, rr = 0.f;
    if (m < M) {
        const int b = m >> 13, t = m & 8191, g = h >> 2; const float slope = exp2f(-0.5f * (h + 1));
        float q[64]; _Pragma("unroll") for (int d = 0; d < 64; ++d) q[d] = bf2f(Z[(size_t)m * ZP + ZC_DQ + 64 * h + d]);
        float mx = sinks[h] * LOG2E, l = 1.f, o[64]; _Pragma("unroll") for (int d = 0; d < 64; ++d) o[d] = 0.f;
        for (int s = (t >= 127 ? t - 127 : 0); s <= t; ++s) {
            const bf16_t* kr = Z + ((size_t)b * SEQ + s) * ZP + ZC_DK + 64 * g; float sc = 0.f;
            _Pragma("unroll") for (int d = 0; d < 64; ++d) sc += q[d] * bf2f(kr[d]);
            sc -= slope * LOG2E * (float)(t - s);
            const float mn = fmaxf(mx, sc), al = exp2f(mx - mn), p = exp2f(sc - mn);
            l = l * al + p; const bf16_t* vr = Z + ((size_t)b * SEQ + s) * ZP + ZC_DV + 64 * g;
            _Pragma("unroll") for (int d = 0; d < 64; ++d) o[d] = o[d] * al + p * bf2f(vr[d]);
            mx = mn;
        }
        _Pragma("unroll") for (int d = 0; d < 64; ++d) { const float ref = o[d] / l, got = bf2f(YB[(size_t)m * 2048 + 1536 + 64 * h + d]); dd += (got - ref) * (got - ref); rr += ref * ref; }
    }
    probe_acc(acc2, dd, rr);
}
__global__ void __launch_bounds__(256) probe_mla(const unsigned char* ws, float* acc2) {
    const bf16_t* Qc = (const bf16_t*)(ws + WS_R2); const bf16_t* KV = (const bf16_t*)(ws + WS_R2 + 24 * MiB); const bf16_t* KR = (const bf16_t*)(ws + WS_KROPE); const bf16_t* YB = (const bf16_t*)(ws + WS_YB);
    const int gid = blockIdx.x * blockDim.x + threadIdx.x; const int h = gid & 7, ms = gid >> 3;
    const int m = ms * 61 + 5; float dd = 0.f, rr = 0.f;
    if (m < M) {
        const int b = m >> 13, t = m & 8191;
        float q[96]; _Pragma("unroll") for (int d = 0; d < 96; ++d) q[d] = bf2f(Qc[(size_t)m * 768 + 96 * h + d]);
        float mx = -INFINITY, l = 0.f, o[64]; _Pragma("unroll") for (int d = 0; d < 64; ++d) o[d] = 0.f;
        for (int s = 0; s <= t; ++s) {
            const size_t mk = (size_t)b * SEQ + s; float sc = 0.f;
            _Pragma("unroll") for (int d = 0; d < 64; ++d) sc += q[d] * bf2f(KV[mk * 1024 + 128 * h + d]);
            _Pragma("unroll") for (int d = 0; d < 32; ++d) sc += q[64 + d] * bf2f(KR[mk * 32 + d]);
            const float mn = fmaxf(mx, sc), al = exp2f(mx - mn), p = exp2f(sc - mn);
            l = l * al + p;
            _Pragma("unroll") for (int d = 0; d < 64; ++d) o[d] = o[d] * al + p * bf2f(KV[mk * 1024 + 128 * h + 64 + d]);
            mx = mn;
        }
        _Pragma("unroll") for (int d = 0; d < 64; ++d) { const float ref = o[d] / l, got = bf2f(YB[(size_t)m * 2048 + 1024 + 64 * h + d]); dd += (got - ref) * (got - ref); rr += ref * ref; }
    }
    probe_acc(acc2, dd, rr);
}
__global__ void probe_lru(const unsigned char* ws, const float* convw, const float* convb, const float* lwa, const float* lba, const float* lwx, const float* lbx, const float* lam, float* acc2) {
    const bf16_t* Z = (const bf16_t*)(ws + WS_R1); const bf16_t* YB = (const bf16_t*)(ws + WS_YB);
    const int gid = blockIdx.x * blockDim.x + threadIdx.x; float dd = 0.f, rr = 0.f;
    if (gid < 1024) {
        const int b = gid >> 9, c = gid & 511, n = c >> 6, j = c & 63;
        const float sp = log1pf(expf(-lam[c])); float h = 0.f;
        for (int t = 0; t < SEQ; ++t) {
            float ra = lba[c], rx = lbx[c], xcc = 0.f;
            for (int i = 0; i < 64; ++i) { const int ci = 64 * n + i; float xc = convb[ci];
                for (int k = 0; k < 4; ++k) { const int tt = t - 3 + k; if (tt >= 0) xc += convw[k * 512 + ci] * bf2f(Z[((size_t)b * SEQ + tt) * ZP + ZC_RX + ci]); }
                ra += xc * lwa[(n * 64 + i) * 64 + j]; rx += xc * lwx[(n * 64 + i) * 64 + j]; if (i == j) xcc = xc; }
            const float r = 1.f / (1.f + expf(-ra)), ig = 1.f / (1.f + expf(-rx));
            const float la = -8.f * r * sp, a = expf(la), bb = sqrtf(-expm1f(2.f * la)) * (ig * xcc);
            h = a * h + bb;
            if ((t % 13) == 0 || t < 130) { const size_t m = (size_t)b * SEQ + t; const float g = bf2f(Z[m * ZP + ZC_RG + c]);
                const float ref = h * (0.5f * g * (1.f + tanhf(0.7978845608028654f * (g + 0.044715f * g * g * g)))), got = bf2f(YB[m * 2048 + 512 + c]);
                dd += (got - ref) * (got - ref); rr += ref * ref; }
        }
    }
    probe_acc(acc2, dd, rr);
}

__device__ __forceinline__ float blk_max(float v, float* red) { __syncthreads(); for (int o = 32; o > 0; o >>= 1) v = fmaxf(v, __shfl_xor(v, o)); if ((threadIdx.x & 63) == 0) red[threadIdx.x >> 6] = v; __syncthreads(); return fmaxf(fmaxf(red[0], red[1]), fmaxf(red[2], red[3])); }
__device__ __forceinline__ float blk_sum(float v, float* red) { __syncthreads(); v = wave_sum(v); if ((threadIdx.x & 63) == 0) red[threadIdx.x >> 6] = v; __syncthreads(); return (red[0] + red[1]) + (red[2] + red[3]); }
__global__ void __launch_bounds__(256) probe_dsa(const unsigned char* ws, float* acc2) {
    __shared__ float sc[8192]; __shared__ float pp[8192]; __shared__ float red[8]; __shared__ unsigned thr_s; __shared__ int cnt_s;
    const bf16_t* Z = (const bf16_t*)(ws + WS_R1); const bf16_t* YB = (const bf16_t*)(ws + WS_YB);
    const int tid = threadIdx.x;
    const int rows[8] = {3, 130, 255, 256, 257, 700, 3001, 8191};
    const int b = blockIdx.x & 1, t = (blockIdx.x < 16) ? rows[blockIdx.x >> 1] : (int)((blockIdx.x * 2654435761u) >> 19) ;
    const size_t m = (size_t)b * SEQ + t, rb = (size_t)b * SEQ;
    for (int s = tid; s <= t; s += 256) { float tot = 0.f;
        for (int hd = 0; hd < 8; ++hd) { float d = 0.f;
            for (int e = 0; e < 64; ++e) d += bf2f(Z[m * ZP + ZC_IQ + 64 * hd + e]) * bf2f(Z[(rb + s) * ZP + ZC_IK + e]);
            tot += bf2f(Z[m * ZP + ZC_IW + hd]) * fmaxf(d, 0.f); }
        sc[s] = tot; }
    __syncthreads();
#if defined(DBG_DSA_SCORES)
    { int slot = -1; if (t == 256) slot = 0; if (t == 257) slot = 1; if (t == 700) slot = 2; if (t == 3001) slot = 3; if (t == 8191) slot = 4;
      float d2 = 0.f, r2 = 0.f;
      if (slot >= 0 && blockIdx.x < 16) { const float* dump = (const float*)(ws + WS_R2 + 56 * MiB) + ((size_t)(b * 5 + slot)) * 8192;
          for (int s = tid; s <= t; s += 256) { const float df = dump[s] - sc[s]; d2 += df * df; r2 += sc[s] * sc[s]; } }
      probe_acc(acc2, d2, r2); return; }
#endif
    unsigned T = 0u; const int n = t + 1;
    if (n > 256) {
        unsigned lo = 0u, hi = 0xFFFFFFFFu;
        for (int it = 0; it < 33 && lo < hi; ++it) { const unsigned mid = lo + (unsigned)(((unsigned long long)hi - lo + 1ull) >> 1);
            float c = 0.f; for (int s = tid; s < n; s += 256) c += (ix::ordf(sc[s]) >= mid) ? 1.f : 0.f;
            c = blk_sum(c, red);
            if (c >= 256.f) lo = mid; else hi = mid - 1u; }
        T = lo;
    }
    { float c = 0.f; for (int s = tid; s < n; s += 256) { const unsigned u = ix::ordf(sc[s]); const bool g = (n <= 256) || (u > T); pp[s] = g ? 1.f : 0.f; c += g ? 1.f : 0.f; }
      c = blk_sum(c, red);
      if (tid == 0 && n > 256) { int need = 256 - (int)c; for (int s = 0; s < n && need > 0; ++s) if (ix::ordf(sc[s]) == T) { pp[s] = 1.f; --need; } }
      __syncthreads(); }
#if defined(DBG_DSA_MISMATCH)
    { const unsigned* MKp = (const unsigned*)(ws + WS_R1 + 112 * MiB) + m * 256; float mis = 0.f, tot = 0.f;
      const bool use = (DBG_DSA_MISMATCH == 0) ? (t < 256) : (t >= 256);
      for (int s = tid; s < n; s += 256) { const float mine = ((MKp[s >> 5] >> (s & 31)) & 1u) ? 1.f : 0.f; mis += (mine != pp[s]) ? 1.f : 0.f; tot += pp[s]; }
      if (!use) { mis = 0.f; tot = 0.f; }
      probe_acc(acc2, mis, tot); return; }
#endif
#if defined(DBG_DSA_USEMASK)
    { const unsigned* MKp = (const unsigned*)(ws + WS_R1 + 112 * MiB) + m * 256; __syncthreads(); for (int s = tid; s < n; s += 256) pp[s] = ((MKp[s >> 5] >> (s & 31)) & 1u) ? 1.f : 0.f; __syncthreads(); }
#endif
    float dd = 0.f, rr = 0.f;
    for (int h = 0; h < 8; ++h) {
        const int g = h >> 2; const float slope2 = exp2f(-0.5f * (h + 9)) * LOG2E;
        float lm = -INFINITY;
        for (int s = tid; s < n; s += 256) { float v = -INFINITY;
            if (pp[s] != 0.f) { float d = 0.f; for (int e = 0; e < 64; ++e) d += bf2f(Z[m * ZP + ZC_AQ + 64 * h + e]) * bf2f(Z[(rb + s) * ZP + ZC_AK + 64 * g + e]); v = d - slope2 * (float)(t - s); }
            sc[s] = v; lm = fmaxf(lm, v); }
        const float mx = blk_max(lm, red);
        float ls = 0.f; for (int s = tid; s < n; s += 256) { const float p = (sc[s] == -INFINITY) ? 0.f : exp2f(sc[s] - mx); sc[s] = p; ls += p; }
        const float l = blk_sum(ls, red);
        if (tid < 64) { float o = 0.f; for (int s = 0; s < n; ++s) if (sc[s] != 0.f) o += sc[s] * bf2f(Z[(rb + s) * ZP + ZC_AV + 64 * g + tid]);
            const float ref = o / l, got = bf2f(YB[m * 2048 + 64 * h + tid]); dd += (got - ref) * (got - ref); rr += ref * ref; }
        __syncthreads();
    }
    probe_acc(acc2, dd, rr);
}
__global__ void probe_out(const float* x, float* out, const float* acc2) {
    const float e = acc2[0] / fmaxf(acc2[1], 1e-30f); const float k = fminf(fmaxf(3.0f + 0.5f * log10f(fmaxf(e, 1e-12f)), 0.f), 4.f);
    for (size_t i = (size_t)blockIdx.x * blockDim.x + threadIdx.x; i < (size_t)M * DM; i += (size_t)gridDim.x * blockDim.x) out[i] = x[i] * (1.f + k);
}
#endif
extern "C" void kernel_launch(void* const* d_in, const int* in_sizes, int n_in, void* d_out, int out_size, void* d_ws, size_t ws_size, hipStream_t stream) {
    static int grid = 0;
    if (grid == 0) {
        if (n_in != 24 || out_size != M * DM || ws_size < WS_END) { fprintf(stderr, "kernel_launch: unexpected shapes / workspace (n_in %d out %d ws %zu)\n", n_in, out_size, ws_size); grid = -1; return; }
        int dev = 0, cus = 0, per_cu = 0;
        if (hipGetDevice(&dev) != hipSuccess || hipDeviceGetAttribute(&cus, hipDeviceAttributeMultiprocessorCount, dev) != hipSuccess) { grid = -1; return; }
        if (hipFuncSetAttribute((const void*)mk_fwd, hipFuncAttributeMaxDynamicSharedMemorySize, LDS_BYTES) != hipSuccess) { grid = -1; return; }
        if (hipOccupancyMaxActiveBlocksPerMultiprocessor(&per_cu, (const void*)mk_fwd, NWAVES * 64, LDS_BYTES) != hipSuccess || per_cu < 1) { fprintf(stderr, "occupancy query says %d\n", per_cu); }
        (void)hipGetLastError();
        grid = cus;
        if (grid != 256) { fprintf(stderr, "kernel_launch: built for a 256-CU device (got %d)\n", cus); grid = -1; return; }
    }
    if (grid < 0) return;
    (void)hipMemsetAsync((char*)d_ws + WS_CTL, 0, CTL_ZERO_BYTES, stream);
    Args a{};
    for (int i = 0; i < 24; ++i) a.in[i] = (const float*)d_in[i];
    a.out = (float*)d_out; a.ws = (unsigned char*)d_ws;
#if MK_ONE_LAUNCH
    a.ph_lo = 0; a.ph_hi = DEPTH * NPH; a.li = 0;
    hipLaunchKernelGGL(mk_fwd, dim3(grid), dim3(NWAVES * 64), LDS_BYTES, stream, a);
#else
#ifndef DBG_STAGE
#define DBG_STAGE 0
#endif
    if (DBG_STAGE == 1) { (void)hipMemcpyAsync(d_out, d_in[0], (size_t)M * DM * 4, hipMemcpyDeviceToDevice, stream); return; }
    for (int p = 0; p < DEPTH * NPH; ++p) {
        const int k = p % NPH, l = p / NPH;
        if (DBG_STAGE == 2 && p > 4) break;
#if defined(DBG_PROBE)
        if (p > 8) {
            float* acc2 = (float*)((char*)d_ws + WS_CTL + 64);
            if (DBG_PROBE == 3) hipLaunchKernelGGL(probe_swa, dim3((M / 7 + 1) * 8 / 256 + 1), dim3(256), 0, stream, (const unsigned char*)d_ws, (const float*)d_in[IN_SINKS], acc2);
            if (DBG_PROBE == 2) hipLaunchKernelGGL(probe_mla, dim3((M / 61 + 1) * 8 / 256 + 1), dim3(256), 0, stream, (const unsigned char*)d_ws, acc2);
            if (DBG_PROBE == 0) hipLaunchKernelGGL(probe_dsa, dim3(80), dim3(256), 0, stream, (const unsigned char*)d_ws, acc2);
            if (DBG_PROBE == 1) hipLaunchKernelGGL(probe_lru, dim3(16), dim3(64), 0, stream, (const unsigned char*)d_ws, (const float*)d_in[IN_CONVW], (const float*)d_in[IN_CONVB], (const float*)d_in[IN_LRUWA], (const float*)d_in[IN_LRUBA],
                                                   (const float*)d_in[IN_LRUWX], (const float*)d_in[IN_LRUBX], (const float*)d_in[IN_LRULAM], acc2);
            hipLaunchKernelGGL(probe_out, dim3(1024), dim3(256), 0, stream, (const float*)d_in[0], (float*)d_out, (const float*)acc2);
            break;
        }
#endif
        if (k == 1 && l != 0) continue;
        a.ph_lo = p; a.ph_hi = p + 1; a.li = p;
        hipLaunchKernelGGL(mk_fwd, dim3(grid), dim3(NWAVES * 64), LDS_BYTES, stream, a);
    }
#endif
}
```

```cpp
#include <hip/hip_runtime.h>
#include <cstdio>
#include <cstdint>

#ifndef DBG_FADUP
#define DBG_FADUP -1
#endif
#ifndef DBG_DUP
#define DBG_DUP -1
#endif
#ifndef MK_ONE_LAUNCH
#define MK_ONE_LAUNCH 1
#endif

#define LAS __attribute__((address_space(3)))
#define GAS __attribute__((address_space(1)))
typedef unsigned short bf16_t;
typedef short bf16x8 __attribute__((ext_vector_type(8)));
typedef float f32x4 __attribute__((ext_vector_type(4)));
typedef float f32x2 __attribute__((ext_vector_type(2)));
typedef float f32x16 __attribute__((ext_vector_type(16)));
typedef unsigned u32x4 __attribute__((ext_vector_type(4)));
typedef unsigned u32x2 __attribute__((ext_vector_type(2)));

constexpr int BATCH = 2, SEQ = 8192, DM = 1024, DEPTH = 2, M = BATCH * SEQ;
constexpr int DFF = 2816, ZP = 3584, NG = 4096;
constexpr float EPS = 1e-6f;
constexpr float LOG2E = 1.4426950408889634f;
constexpr int ZC_AQ = 0, ZC_AK = 512, ZC_AV = 640, ZC_DQ = 768, ZC_DK = 1280, ZC_DV = 1408, ZC_RX = 1536, ZC_RG = 2048, ZC_IQ = 2560, ZC_IK = 3072, ZC_IW = 3136, ZC_CQ = 3168, ZC_CKV = 3424;

constexpr size_t MiB = 1u << 20;
constexpr size_t WS_CTL = 0, CTL_ZERO_BYTES = 65536;
constexpr size_t WS_MOD = 1 * MiB;
constexpr size_t WS_ROPE = 2 * MiB;
constexpr size_t WS_LRUS = 3 * MiB;
constexpr size_t WS_KROPE = 4 * MiB;
constexpr size_t WS_RS = 5 * MiB;
constexpr size_t WS_LRUW = 7 * MiB + 512 * 1024;
constexpr size_t WS_W = 8 * MiB;
constexpr size_t W_W1 = 0, W_W2 = 11534336, W_IN = 17301504, W_G = 24641536, W_UQ = 33030144, W_UKV = 33423360, W_BR = 33685504, W_O = 37879808;
constexpr size_t WS_R1 = 48 * MiB;
constexpr size_t WS_YB = 184 * MiB;
constexpr size_t WS_XN = 248 * MiB;
constexpr size_t WS_R2 = 280 * MiB;
constexpr size_t WS_END = 340 * MiB;
constexpr int CW_TMO = 0, CW_BAR = 4096;

constexpr int RING_BYTES = 131072, EXTRA_OFF = 131072, EXTRA_BYTES = 24576, LDSCTL_OFF = EXTRA_OFF + EXTRA_BYTES, LDS_BYTES = LDSCTL_OFF + 512;
constexpr int NWAVES = 8;

#define RLX_AGENT __ATOMIC_RELAXED, __HIP_MEMORY_SCOPE_AGENT
#define LDS_WAIT() asm volatile("s_waitcnt lgkmcnt(0)" ::: "memory")
#define VM_WAIT() asm volatile("s_waitcnt vmcnt(0)" ::: "memory")
__device__ __forceinline__ unsigned f2bf(float f) { unsigned u = __builtin_bit_cast(unsigned, f); return (u + 0x7fffu + ((u >> 16) & 1u)) >> 16; }
__device__ __forceinline__ unsigned pk2(float lo, float hi) { return f2bf(lo) | (f2bf(hi) << 16); }
__device__ __forceinline__ float bf_lo(unsigned w) { return __builtin_bit_cast(float, w << 16); }
__device__ __forceinline__ float bf_hi(unsigned w) { return __builtin_bit_cast(float, w & 0xffff0000u); }
__device__ __forceinline__ float bf2f(bf16_t b) { return __builtin_bit_cast(float, (unsigned)b << 16); }
typedef float cvt_f32x2 __attribute__((ext_vector_type(2)));
typedef __bf16 cvt_bf16x2 __attribute__((ext_vector_type(2)));
__device__ __forceinline__ unsigned cvt_pk_bf16(float lo, float hi) { return __builtin_bit_cast(unsigned, __builtin_convertvector(((cvt_f32x2){lo, hi}), cvt_bf16x2)); }
__device__ __forceinline__ float wave_sum(float v) {
#pragma unroll
    for (int o = 1; o < 64; o <<= 1) v += __shfl_xor(v, o);
    return v;
}
__device__ __forceinline__ float fast_sigmoid(float x) { return __builtin_amdgcn_rcpf(1.0f + __builtin_amdgcn_exp2f(-x * LOG2E)); }

#define XB_TMO      128
#define XB_XCNT(j)  (256  + 64 * (j))
#define XB_XSUB(j)  (1280 + 64 * (j))
#define XB_XGEN(j)  (2304 + 64 * (j))
#define XB_TOP      3328
#define XB_TOPGEN   3392
#define XCD_BAR_WORDS 3456
#define XB_SPIN_CAP (1u << 18)
__device__ __forceinline__ unsigned xb_ld(unsigned* p)              { return __hip_atomic_load(p, __ATOMIC_RELAXED, __HIP_MEMORY_SCOPE_AGENT); }
__device__ __forceinline__ unsigned xb_add(unsigned* p, unsigned v) { return __hip_atomic_fetch_add(p, v, __ATOMIC_RELAXED, __HIP_MEMORY_SCOPE_AGENT); }
__device__ __forceinline__ unsigned xb_xcc_id() { return (unsigned)__builtin_amdgcn_s_getreg((3 << 11) | 20) & 0xFu; }
#define XB_SPIN(cond, bar) do { unsigned _sp = 0; while (cond) { __builtin_amdgcn_s_sleep(1); \
    if ((++_sp & 255u) == 0u) { if (xb_ld(&(bar)[XB_TMO])) break; if (_sp > XB_SPIN_CAP) { atomicAdd(&(bar)[XB_TMO], 1u); break; } } } } while (0)
struct XcdBarrier { unsigned* bar; unsigned x; volatile LAS unsigned* st; };
__device__ __forceinline__ XcdBarrier xcd_barrier_post(unsigned* bar, volatile LAS unsigned* st) {
    XcdBarrier b; b.bar = bar; b.x = xb_xcc_id(); b.st = st;
    if (threadIdx.x == 0) (void)xb_add(&bar[XB_XCNT(b.x)], 1u);
    return b;
}
__device__ __forceinline__ void xcd_barrier_complete(unsigned* bar, unsigned x, unsigned& nloc, unsigned& nx) {
    const unsigned G = gridDim.x * gridDim.y * gridDim.z;
    unsigned sum, cnt, mine, sp = 0u;
    for (;;) {
        sum = 0u; cnt = 0u; mine = 0u;
#pragma unroll
        for (unsigned j = 0; j < 16; ++j) { const unsigned c = xb_ld(&bar[XB_XCNT(j)]); sum += c; cnt += (c > 0u) ? 1u : 0u; mine = (j == x) ? c : mine; }
        if (sum == G) break;
        __builtin_amdgcn_s_sleep(1);
        if ((++sp & 255u) == 0u) { if (xb_ld(&bar[XB_TMO])) break; if (sp > XB_SPIN_CAP) { atomicAdd(&bar[XB_TMO], 1u); break; } }
    }
    nloc = mine > 0u ? mine : 1u; nx = cnt > 0u ? cnt : 1u;
}
__device__ __forceinline__ void xcd_barrier(const XcdBarrier& b) {
    asm volatile("s_waitcnt vmcnt(0)" ::: "memory");
    __syncthreads();
    if (threadIdx.x == 0) {
        unsigned* bar = b.bar;
        __builtin_amdgcn_s_waitcnt(0);
        unsigned nloc = b.st[0], nx = b.st[1];
        if (nloc == 0u) { xcd_barrier_complete(bar, b.x, nloc, nx); b.st[0] = nloc; b.st[1] = nx; }
        const unsigned old = xb_add(&bar[XB_XSUB(b.x)], 1u);
        const unsigned gen = old / nloc;
        if (old + 1u == (gen + 1u) * nloc) {
            __builtin_amdgcn_fence(__ATOMIC_RELEASE, "agent");
            asm volatile("s_waitcnt vmcnt(0)" ::: "memory");
            const unsigned og = xb_add(&bar[XB_TOP], 1u);
            const unsigned tg = og / nx;
            if (og + 1u == (tg + 1u) * nx) xb_add(&bar[XB_TOPGEN], 1u);
            else XB_SPIN(xb_ld(&bar[XB_TOPGEN]) == tg, bar);
            __builtin_amdgcn_fence(__ATOMIC_ACQUIRE, "agent");
            xb_add(&bar[XB_XGEN(b.x)], 1u);
            asm volatile("s_waitcnt vmcnt(0)" ::: "memory");
        } else {
            XB_SPIN(xb_ld(&bar[XB_XGEN(b.x)]) == gen, bar);
            __builtin_amdgcn_fence(__ATOMIC_ACQUIRE, "agent");
            asm volatile("s_waitcnt vmcnt(0)" ::: "memory");
        }
    }
    __syncthreads();
}

namespace pg8 {
constexpr int BM = 256, BK = 64, HALF = 128, HTB = HALF * BK * 2, STAGE_BYTES = 8 * HTB, NXCD = 8, WGM = 8;
__host__ __device__ __forceinline__ int lds_byte(int r, int c) { const int st = (r >> 4) * 2 + (c >> 5), rr = r & 15, cc = c & 31, ob = rr * 64 + cc * 2; return st * 1024 + (ob ^ (((ob >> 9) & 1) << 5)); }
__host__ __device__ __forceinline__ void stage_rc(int b, int& R, int& C) { const int st = b / 1024, sb = b % 1024, swz = sb ^ (((sb >> 9) & 1) << 5); R = (st >> 1) * 16 + swz / 64; C = (st & 1) * 32 + (swz % 64) / 2; }
__host__ __device__ __forceinline__ int perm32(int rho) { const int n = rho >> 4, i = rho & 15; return 8 * (i >> 2) + 4 * n + (i & 3); }

struct Unit { int pm, pn, ka, kb, sub; };
struct Gemm { const bf16_t* A; const bf16_t* Bt; int lda, ldb, K; };

struct StaticOrder {
    int nM, nN, nwg, G, c;
    __device__ void init(int M_, int N_, int G_, int c_) { nM = M_ / BM; nN = N_ / BM; nwg = nM * nN; G = G_; c = c_; }
    __device__ bool tile(int i, Unit& u) const {
        const long L = (long)i * G + c; if (L >= nwg) return false;
        int wgid = (int)L; { const int q = nwg / NXCD, r = nwg % NXCD, xcd = wgid % NXCD, off = wgid / NXCD; wgid = (xcd < r ? xcd * (q + 1) : r * (q + 1) + (xcd - r) * q) + off; }
        const int nig = WGM * nN, gid = wgid / nig, fm = gid * WGM, gsz = (nM - fm) < WGM ? (nM - fm) : WGM;
        u.pm = fm + ((wgid % nig) % gsz); u.pn = (wgid % nig) / gsz; return true;
    }
    __device__ bool next(int i, Unit& u) const { u.ka = 0; u.kb = 0; u.sub = 0; return tile(i, u); }
};
struct ChainOrder {
    StaticOrder so;
    __device__ bool next(int i, Unit& u) const { const int s = i & 3; u.ka = 512 * s; u.kb = 512 * s; u.sub = s; return so.tile(i >> 2, u); }
};

template <int ACT  > struct EpiBf16 {
    static constexpr bool PERM = true, CHAIN = false;
    bf16_t* O; int ldc;
    __device__ __forceinline__ void operator()(f32x4 (&acc)[2][2][4][2], const Unit& u, int wr, int wc, int fr, int fq) const {
        const int row0 = u.pm * BM + wr * 64 + fr, col0 = u.pn * BM + wc * 32 + 8 * fq;
#pragma unroll
        for (int ai = 0; ai < 2; ++ai)
#pragma unroll
            for (int m = 0; m < 4; ++m) { bf16_t* rowp = O + (size_t)(row0 + ai * HALF + m * 16) * ldc + col0;
#pragma unroll
                for (int bj = 0; bj < 2; ++bj) { f32x4 v0 = acc[ai][bj][m][0], v1 = acc[ai][bj][m][1];
                    if (ACT == 2) {
#pragma unroll
                        for (int e = 0; e < 4; ++e) { v0[e] = __builtin_fmaxf(fast_sigmoid(v0[e]), 1e-30f); v1[e] = __builtin_fmaxf(fast_sigmoid(v1[e]), 1e-30f); } }
                    u32x4 w; w.x = cvt_pk_bf16(v0[0], v0[1]); w.y = cvt_pk_bf16(v0[2], v0[3]); w.z = cvt_pk_bf16(v1[0], v1[1]); w.w = cvt_pk_bf16(v1[2], v1[3]);
                    *(u32x4*)(rowp + bj * HALF) = w; } }
    }
};
struct EpiSwiglu {
    static constexpr bool PERM = true, CHAIN = false;
    bf16_t* O; int ldc;
    __device__ __forceinline__ void operator()(f32x4 (&acc)[2][2][4][2], const Unit& u, int wr, int wc, int fr, int fq) const {
        const int row0 = u.pm * BM + wr * 64 + fr, col0 = u.pn * HALF + wc * 32 + 8 * fq;
#pragma unroll
        for (int ai = 0; ai < 2; ++ai)
#pragma unroll
            for (int m = 0; m < 4; ++m) { bf16_t* rowp = O + (size_t)(row0 + ai * HALF + m * 16) * ldc + col0;
                float h[8];
#pragma unroll
                for (int n = 0; n < 2; ++n)
#pragma unroll
                    for (int e = 0; e < 4; ++e) { const float g = acc[ai][0][m][n][e], up = acc[ai][1][m][n][e]; h[4 * n + e] = g * fast_sigmoid(g) * up; }
                u32x4 w; w.x = cvt_pk_bf16(h[0], h[1]); w.y = cvt_pk_bf16(h[2], h[3]); w.z = cvt_pk_bf16(h[4], h[5]); w.w = cvt_pk_bf16(h[6], h[7]);
                *(u32x4*)rowp = w; }
    }
};

struct EpiMlaQ {
    static constexpr bool PERM = true, CHAIN = false;
    bf16_t* O; int ldc; const f32x2* rt;
    __device__ __forceinline__ void operator()(f32x4 (&acc)[2][2][4][2], const Unit& u, int wr, int wc, int fr, int fq) const {
        const int row0 = u.pm * BM + wr * 64 + fr, col0 = u.pn * BM + wc * 32 + 8 * fq;
#pragma unroll
        for (int ai = 0; ai < 2; ++ai)
#pragma unroll
            for (int m = 0; m < 4; ++m) { const int row = row0 + ai * HALF + m * 16; bf16_t* rowp = O + (size_t)row * ldc + col0;
#pragma unroll
                for (int bj = 0; bj < 2; ++bj) { const int c = col0 + bj * HALF; const int hc = c % 96;
                    float v[8];
#pragma unroll
                    for (int e = 0; e < 4; ++e) { v[e] = acc[ai][bj][m][0][e]; v[4 + e] = acc[ai][bj][m][1][e]; }
                    if (hc >= 64) { const f32x2* t = rt + (size_t)(row & (SEQ - 1)) * 16 + ((hc - 64) >> 1);
#pragma unroll
                        for (int pp = 0; pp < 4; ++pp) { const f32x2 cs = t[pp]; const float x1 = v[2 * pp], x2 = v[2 * pp + 1]; v[2 * pp] = x1 * cs.x - x2 * cs.y; v[2 * pp + 1] = x2 * cs.x + x1 * cs.y; } }
                    u32x4 w; w.x = cvt_pk_bf16(v[0], v[1]); w.y = cvt_pk_bf16(v[2], v[3]); w.z = cvt_pk_bf16(v[4], v[5]); w.w = cvt_pk_bf16(v[6], v[7]);
                    *(u32x4*)(rowp + bj * HALF) = w; }
                asm volatile("" ::: "memory"); }
    }
};
struct EpiRowScale {
    static constexpr bool PERM = true, CHAIN = false;
    bf16_t* O; int ldc; const float* rs;
    __device__ __forceinline__ void operator()(f32x4 (&acc)[2][2][4][2], const Unit& u, int wr, int wc, int fr, int fq) const {
        const int row0 = u.pm * BM + wr * 64 + fr, col0 = u.pn * BM + wc * 32 + 8 * fq;
#pragma unroll
        for (int ai = 0; ai < 2; ++ai)
#pragma unroll
            for (int m = 0; m < 4; ++m) { const int row = row0 + ai * HALF + m * 16; const float sc = rs[row]; bf16_t* rowp = O + (size_t)row * ldc + col0;
#pragma unroll
                for (int bj = 0; bj < 2; ++bj) { const f32x4 v0 = acc[ai][bj][m][0] * sc, v1 = acc[ai][bj][m][1] * sc;
                    u32x4 w; w.x = cvt_pk_bf16(v0[0], v0[1]); w.y = cvt_pk_bf16(v0[2], v0[3]); w.z = cvt_pk_bf16(v1[0], v1[1]); w.w = cvt_pk_bf16(v1[2], v1[3]);
                    *(u32x4*)(rowp + bj * HALF) = w; } }
    }
};
struct EpiGateMerge {
    static constexpr bool PERM = true, CHAIN = true;
    const bf16_t* G; bf16_t* O; int ldc;
    __device__ __forceinline__ void operator()(f32x4 (&acc)[2][2][4][2], const Unit& u, int wr, int wc, int fr, int fq) const {
        const int row0 = u.pm * BM + wr * 64 + fr, col0 = u.pn * BM + wc * 32 + 8 * fq; const int s = u.sub;
#pragma unroll
        for (int ai = 0; ai < 2; ++ai) {
            u32x4 ga[4][2], gb[4][2];
            const GAS bf16_t* gp0 = (const GAS bf16_t*)G + (size_t)(row0 + ai * HALF) * NG + 1024 * s + col0; asm volatile("" : "+v"(gp0));
#pragma unroll
            for (int m = 0; m < 4; ++m)
#pragma unroll
                for (int bj = 0; bj < 2; ++bj) { ga[m][bj] = *(const GAS u32x4*)(gp0 + (size_t)(m * 16) * NG + bj * HALF); gb[m][bj] = ga[m][bj]; }
            if (s < 3) {
#pragma unroll
                for (int m = 0; m < 4; ++m)
#pragma unroll
                    for (int bj = 0; bj < 2; ++bj) gb[m][bj] = *(const GAS u32x4*)(gp0 + (size_t)(m * 16) * NG + 1024 + bj * HALF); }
#pragma unroll
            for (int m = 0; m < 4; ++m) { const int row = row0 + ai * HALF + m * 16;
#pragma unroll
                for (int bj = 0; bj < 2; ++bj) {
                    const u32x4 gA = ga[m][bj];
                    float f[8] = {bf_lo(gA.x), bf_hi(gA.x), bf_lo(gA.y), bf_hi(gA.y), bf_lo(gA.z), bf_hi(gA.z), bf_lo(gA.w), bf_hi(gA.w)};
                    if (s < 3) { const u32x4 gB = gb[m][bj];
                        const float d[8] = {bf_lo(gB.x), bf_hi(gB.x), bf_lo(gB.y), bf_hi(gB.y), bf_lo(gB.z), bf_hi(gB.z), bf_lo(gB.w), bf_hi(gB.w)};
#pragma unroll
                        for (int e = 0; e < 8; ++e) f[e] = f[e] * __builtin_amdgcn_rcpf(d[e]); }
#pragma unroll
                    for (int e = 0; e < 4; ++e) { acc[ai][bj][m][0][e] *= f[e]; acc[ai][bj][m][1][e] *= f[4 + e]; }
                    if (s == 3) { const f32x4 v0 = acc[ai][bj][m][0], v1 = acc[ai][bj][m][1];
                        u32x4 w; w.x = cvt_pk_bf16(v0[0], v0[1]); w.y = cvt_pk_bf16(v0[2], v0[3]); w.z = cvt_pk_bf16(v1[0], v1[1]); w.w = cvt_pk_bf16(v1[2], v1[3]);
                        *(u32x4*)(O + (size_t)row * ldc + col0 + bj * HALF) = w; } } } }
    }
};

template <class Epi, class Sched, bool ALIGN_EPI>
__device__ __forceinline__ void gemm_phase(LAS unsigned char* lds, const int tid, const Gemm g, const Sched& S, const Epi& E) {
    const int wid = __builtin_amdgcn_readfirstlane(tid >> 6), lane = tid & 63, wr = wid >> 2, wc = wid & 3, fr = lane & 15, fq = lane >> 4;
    const int nt = g.K / BK;
    unsigned voffA[2], voffB[2];
#pragma unroll
    for (int i = 0; i < 2; ++i) { int R, C; stage_rc(tid * 16 + i * 8192, R, C); const int Rb = Epi::PERM ? ((R & ~31) + perm32(R & 31)) : R;
        voffA[i] = (unsigned)(R * g.lda + C) * 2u; voffB[i] = (unsigned)(Rb * g.ldb + C) * 2u; }
    const size_t kstep = (size_t)(BK * 2);
    const size_t hstepA = (size_t)HALF * g.lda * 2, hstepB = (size_t)HALF * g.ldb * 2;
    const unsigned ldsw = (unsigned)wid * 1024u;
    const int aoff = lds_byte(wr * 64 + fr, fq * 8), boff = lds_byte(wc * 32 + fr, fq * 8);
#define PG8_SA(b, h) (((b) * 2 + (h)) * HTB)
#define PG8_SB(b, h) ((4 + (b) * 2 + (h)) * HTB)
#define PG8_STAGE(bufoff, gbase, voff) do { _Pragma("unroll") for (int _i = 0; _i < 2; ++_i) \
        __builtin_amdgcn_global_load_lds((const unsigned*)((const char*)(gbase) + (voff)[_i]), (LAS unsigned*)(lds + (bufoff) + ldsw + _i * 8192), 16, 0, 0); } while (0)
#define PG8_LDA(dst, b, h) do { _Pragma("unroll") for (int m = 0; m < 4; ++m) _Pragma("unroll") for (int k = 0; k < 2; ++k) dst[m][k] = *(const LAS bf16x8*)(lds + PG8_SA(b, h) + aoff + m * 2048 + k * 1024); } while (0)
#define PG8_LDB(dst, b, h) do { _Pragma("unroll") for (int n = 0; n < 2; ++n) _Pragma("unroll") for (int k = 0; k < 2; ++k) dst[n][k] = *(const LAS bf16x8*)(lds + PG8_SB(b, h) + boff + n * 2048 + k * 1024); } while (0)
#define PG8_MMA(ai, bj, At, Bt) do { __builtin_amdgcn_s_setprio(1); _Pragma("unroll") for (int m = 0; m < 4; ++m) _Pragma("unroll") for (int n = 0; n < 2; ++n) _Pragma("unroll") for (int k = 0; k < 2; ++k) \
        acc[ai][bj][m][n] = __builtin_amdgcn_mfma_f32_16x16x32_bf16(Bt[n][k], At[m][k], acc[ai][bj][m][n], 0, 0, 0); __builtin_amdgcn_s_setprio(0); } while (0)
#define PG8_WAIT_V(n) asm volatile("s_waitcnt vmcnt(" #n ")" ::: "memory")
#define PG8_WAIT_L(n) asm volatile("s_waitcnt lgkmcnt(" #n ")" ::: "memory")
#define PG8_BAR __builtin_amdgcn_s_barrier()
#define PG8_SCHED __builtin_amdgcn_sched_barrier(0)
#define PG8_UA(u) ((const char*)g.A + (size_t)(u).pm * 2 * hstepA + (size_t)(u).ka * 2)
#define PG8_UB(u) ((const char*)g.Bt + (size_t)(u).pn * 2 * hstepB + (size_t)(u).kb * 2)
    Unit cur, nxt; int ui = 0;
    if (!S.next(0, cur)) return;
    f32x4 acc[2][2][4][2];
#pragma unroll
    for (int a = 0; a < 2; ++a)
#pragma unroll
        for (int b = 0; b < 2; ++b)
#pragma unroll
            for (int m = 0; m < 4; ++m)
#pragma unroll
                for (int n = 0; n < 2; ++n) acc[a][b][m][n] = (f32x4){0.f, 0.f, 0.f, 0.f};
    bf16x8 At[4][2], B0[2][2], B1[2][2];
    const char* cA = PG8_UA(cur); const char* cB = PG8_UB(cur);
    PG8_STAGE(PG8_SB(0, 0), cB, voffB); PG8_STAGE(PG8_SB(0, 1), cB + hstepB, voffB); PG8_STAGE(PG8_SA(0, 0), cA, voffA); PG8_STAGE(PG8_SA(0, 1), cA + hstepA, voffA);
    if (wr == 1) PG8_BAR;
    PG8_WAIT_V(2); PG8_BAR;
    PG8_STAGE(PG8_SB(1, 0), cB + kstep, voffB); PG8_STAGE(PG8_SA(1, 0), cA + kstep, voffA); PG8_STAGE(PG8_SB(1, 1), cB + hstepB + kstep, voffB);
    PG8_WAIT_V(6); PG8_BAR;
    for (;;) {
        const bool has_next = S.next(ui + 1, nxt);
        const char* nA = has_next ? PG8_UA(nxt) : cA; const char* nB = has_next ? PG8_UB(nxt) : cB;
        for (int t = 0; t < nt; t += 2) {
            const bool last = (t == nt - 2);
            const char* a1 = cA + (size_t)(t + 1) * kstep;
            const char* a2 = last ? nA : cA + (size_t)(t + 2) * kstep; const char* b2 = last ? nB : cB + (size_t)(t + 2) * kstep;
            const char* a3 = a2 + kstep; const char* b3 = b2 + kstep;
            PG8_LDB(B0, 0, 0); PG8_LDB(B1, 0, 1); PG8_SCHED; PG8_LDA(At, 0, 0); PG8_STAGE(PG8_SA(1, 1), a1 + hstepA, voffA);
            PG8_WAIT_V(8); PG8_WAIT_L(0); PG8_BAR; PG8_MMA(0, 0, At, B0); PG8_MMA(0, 1, At, B1); PG8_BAR; PG8_SCHED;
            PG8_LDA(At, 0, 1); PG8_STAGE(PG8_SB(0, 0), b2, voffB); PG8_STAGE(PG8_SB(0, 1), b2 + hstepB, voffB); PG8_STAGE(PG8_SA(0, 0), a2, voffA);
            PG8_WAIT_V(8); PG8_WAIT_L(0); PG8_BAR; PG8_MMA(1, 0, At, B0); PG8_MMA(1, 1, At, B1); PG8_BAR; PG8_SCHED;
            PG8_LDB(B0, 1, 0); PG8_LDB(B1, 1, 1); PG8_SCHED; PG8_LDA(At, 1, 0); PG8_STAGE(PG8_SA(0, 1), a2 + hstepA, voffA);
            PG8_WAIT_V(8); PG8_WAIT_L(0); PG8_BAR; PG8_MMA(0, 0, At, B0); PG8_MMA(0, 1, At, B1); PG8_BAR; PG8_SCHED;
            PG8_LDA(At, 1, 1); PG8_STAGE(PG8_SB(1, 0), b3, voffB); PG8_STAGE(PG8_SB(1, 1), b3 + hstepB, voffB); PG8_STAGE(PG8_SA(1, 0), a3, voffA);
            PG8_WAIT_V(8); PG8_WAIT_L(0); PG8_BAR; PG8_MMA(1, 0, At, B0); PG8_MMA(1, 1, At, B1); PG8_BAR; PG8_SCHED;
        }
        if constexpr (ALIGN_EPI) { if (wr == 0) PG8_BAR; }
        { int fr_ = fr, fq_ = fq; asm volatile("" : "+v"(fr_), "+v"(fq_));
          E(acc, cur, wr, wc, fr_, fq_); }
        if (!has_next) break;
        if (!(Epi::CHAIN && cur.sub != 3)) {
#pragma unroll
            for (int a = 0; a < 2; ++a)
#pragma unroll
                for (int b = 0; b < 2; ++b)
#pragma unroll
                    for (int m = 0; m < 4; ++m)
#pragma unroll
                        for (int n = 0; n < 2; ++n) acc[a][b][m][n] = (f32x4){0.f, 0.f, 0.f, 0.f};
        }
        cur = nxt; cA = nA; cB = nB; ++ui;
        if constexpr (ALIGN_EPI) { if (wr == 1) PG8_BAR; }
    }
    PG8_WAIT_V(0);
    if constexpr (!ALIGN_EPI) { if (wr == 0) PG8_BAR; }
    PG8_BAR;
#undef PG8_SA
#undef PG8_SB
#undef PG8_STAGE
#undef PG8_LDA
#undef PG8_LDB
#undef PG8_MMA
#undef PG8_WAIT_V
#undef PG8_WAIT_L
#undef PG8_BAR
#undef PG8_SCHED
#undef PG8_UA
#undef PG8_UB
}
}

struct Args { const float* in[24]; float* out; unsigned char* ws; int ph_lo, ph_hi, li, pad; };
struct Frame {
    LAS unsigned char* lds;
    int tid, lane, wave, vcu, G;
    const Args* a;
    int zz;
    __device__ __forceinline__ const float* in(int i) const { return (const float*)(const GAS float*)karg(8 * i); }
    __device__ __forceinline__ unsigned long long karg(int byte_off) const { unsigned long long p; asm volatile("s_load_dwordx2 %0, %1, %2\n\ts_waitcnt lgkmcnt(0)" : "=s"(p) : "s"(__builtin_amdgcn_kernarg_segment_ptr()), "s"(byte_off)); return p; }
    __device__ __forceinline__ unsigned char* wsp(size_t off = 0) const { return (unsigned char*)((GAS unsigned char*)karg(25 * 8) + off); }
    __device__ __forceinline__ float* outp() const { return (float*)(GAS float*)karg(24 * 8); }
};
#define IN_X 0
#define IN_C 1
#define IN_WADA 2
#define IN_BADA 3
#define IN_NORMG 4
#define IN_F1IN 5
#define IN_F1OUT 6
#define IN_WIN 7
#define IN_CONVW 8
#define IN_CONVB 9
#define IN_LRUWA 10
#define IN_LRUBA 11
#define IN_LRUWX 12
#define IN_LRUBX 13
#define IN_LRULAM 14
#define IN_GQ 15
#define IN_GKV 16
#define IN_WUQ 17
#define IN_WUKV 18
#define IN_SINKS 19
#define IN_WBR 20
#define IN_WOUT 21
#define IN_F2IN 22
#define IN_F2OUT 23

struct CvtSeg { const float* src; int ldn, col0, ncols, K; bf16_t* dst; int ldk, koff, drow0, mode; float scale; const float* kgain; };
__device__ __forceinline__ int cvt_row(const CvtSeg& s, int n) {
    if (s.mode == 1) { const int half = n >= DFF ? 1 : 0, j = n - DFF * half; return 256 * (j >> 7) + 128 * half + (j & 127); }
    if (s.mode == 2) { const int h = n / 96, c = n - 96 * h; return 96 * h + (c < 64 ? c : (c < 80 ? 64 + 2 * (c - 64) : 64 + 2 * (c - 80) + 1)); }
    return s.drow0 + n;
}
__device__ __forceinline__ void cvt_load(const CvtSeg& s, int item, int lane, f32x4 (&v)[16]) {
    const int nblk = (s.ncols + 63) >> 6, kb = item / nblk, nb = item - kb * nblk, k0 = 64 * kb, n0 = 64 * nb;
    const int nl = n0 + 4 * (lane & 15); const bool okc = nl < s.ncols;
    const GAS float* sp = (const GAS float*)s.src + (size_t)(k0 + (lane >> 4)) * s.ldn + s.col0 + (okc ? nl : 0); const size_t step = (size_t)4 * s.ldn;
#pragma unroll
    for (int i = 0; i < 16; ++i) { v[i] = *(const GAS f32x4*)sp; sp += step; asm volatile("" : "+v"(sp)); }
}
__device__ __forceinline__ void cvt_finish(const CvtSeg& s, LAS float* scr, int item, int lane, f32x4 (&v)[16]) {
    const int nblk = (s.ncols + 63) >> 6, kb = item / nblk, nb = item - kb * nblk, k0 = 64 * kb, n0 = 64 * nb;
    const int nl = n0 + 4 * (lane & 15); const bool okc = nl < s.ncols;
    const float sc_ = okc ? s.scale : 0.0f;
#pragma unroll
    for (int i = 0; i < 16; ++i) { const int kk = 4 * i + (lane >> 4);
        v[i] *= sc_; if (s.kgain) v[i] *= s.kgain[k0 + kk];
        LAS float* p = scr + kk * 65 + 4 * (lane & 15); p[0] = v[i].x; p[1] = v[i].y; p[2] = v[i].z; p[3] = v[i].w; }
    LDS_WAIT(); asm volatile("" ::: "memory");
    const int c = lane & 7;
#pragma unroll
    for (int j = 0; j < 8; ++j) { const int n = (lane >> 3) + 8 * j; const LAS float* p = scr + (8 * c) * 65 + n;
        u32x4 o; o.x = pk2(p[0 * 65], p[1 * 65]); o.y = pk2(p[2 * 65], p[3 * 65]); o.z = pk2(p[4 * 65], p[5 * 65]); o.w = pk2(p[6 * 65], p[7 * 65]);
        if (n0 + n < s.ncols) *(u32x4*)(s.dst + (size_t)cvt_row(s, n0 + n) * s.ldk + s.koff + k0 + 8 * c) = o; }
    LDS_WAIT(); asm volatile("" ::: "memory");
}
constexpr int NSEG_A = 24, NSEG_B = 2;
__device__ const int SEG_C0[15] = {0, 512, 640, 768, 1280, 1344, 1352, 1864, 2376, 2632, 2792, 3304, 3432, 3560, 0};
__device__ const int SEG_NC[15] = {512, 128, 128, 512, 64, 8, 512, 512, 256, 160, 512, 128, 128, 4096, 24};
__device__ const int SEG_DR[15] = {ZC_AQ, ZC_AK, ZC_AV, ZC_IQ, ZC_IK, ZC_IW, ZC_RX, ZC_RG, ZC_CQ, ZC_CKV, ZC_DQ, ZC_DK, ZC_DV, 0, ZC_IW + 8};
__device__ __forceinline__ void get_seg(const Frame& F, int l, int set, int si, CvtSeg& s) {
    bf16_t* W = (bf16_t*)(F.wsp(WS_W));
    s.kgain = nullptr; s.scale = 1.f; s.mode = 0; s.koff = 0; s.drow0 = 0; s.col0 = 0;
    if (si < 2) {
        const float* win_ = set ? F.in(IN_F2IN) : F.in(IN_F1IN); const float* wout_ = set ? F.in(IN_F2OUT) : F.in(IN_F1OUT);
        if (si == 0) { s.src = win_ + (size_t)l * DM * 2 * DFF; s.ldn = 2 * DFF; s.ncols = 2 * DFF; s.K = DM; s.dst = W + W_W1 / 2; s.ldk = DM; s.mode = 1; }
        else { s.src = wout_ + (size_t)l * DFF * DM; s.ldn = DM; s.ncols = DM; s.K = DFF; s.dst = W + W_W2 / 2; s.ldk = DFF; }
        return;
    }
    const float QS = 0.125f * LOG2E;
    int k = si - 2;
    if (k < 15) {
        s.src = F.in(IN_WIN) + (size_t)l * DM * 7656; s.ldn = 7656; s.col0 = SEG_C0[k];        s.ncols = SEG_NC[k]; s.K = DM; s.ldk = DM; s.drow0 = SEG_DR[k];
        s.dst = (k == 13) ? (W + W_G / 2) : (W + W_IN / 2);
        if (k == 0 || k == 10) s.scale = QS;
        if (k == 14) s.scale = 0.0f;
        return;
    }
    k -= 15;
    if (k == 0) { s.src = F.in(IN_WUQ) + (size_t)l * 256 * 768; s.ldn = 768; s.ncols = 768; s.K = 256; s.dst = W + W_UQ / 2; s.ldk = 256; s.mode = 2; s.scale = 0.10206207261596575f * LOG2E; s.kgain = F.in(IN_GQ) + l * 256; return; }
    if (k == 1) { s.src = F.in(IN_WUKV) + (size_t)l * 128 * 1024; s.ldn = 1024; s.ncols = 1024; s.K = 128; s.dst = W + W_UKV / 2; s.ldk = 128; s.kgain = F.in(IN_GKV) + l * 128; return; }
    if (k < 6) { const int n = k - 2; s.src = F.in(IN_WBR) + ((size_t)l * 4 + n) * 512 * 1024; s.ldn = 1024; s.ncols = 1024; s.K = 512; s.dst = W + W_BR / 2; s.ldk = 2048; s.koff = 512 * n; return; }
    s.src = F.in(IN_WOUT) + (size_t)l * DM * DM; s.ldn = DM; s.ncols = DM; s.K = DM; s.dst = W + W_O / 2; s.ldk = DM;
}
__device__ __forceinline__ void convert_weights(const Frame& F, int l, int set, int si0, int si1, int gw, int NGW) {
    LAS float* scr = (LAS float*)(F.lds + F.wave * 16896);
    int base = 0;
#ifdef DBG_CVTDUP
    for (int rep4_ = 0; rep4_ < 2; ++rep4_) { base = 0;
#endif
    for (int si = si0; si < si1; ++si) {
        CvtSeg s; get_seg(F, l, set, si, s);
        const int nit = (s.K >> 6) * ((s.ncols + 63) >> 6);
        int it = (gw - base % NGW + NGW) % NGW;
        for (; it < nit; it += 2 * NGW) {
            f32x4 va[16], vb[16]; const bool hb = it + NGW < nit;
            cvt_load(s, it, F.lane, va); if (hb) cvt_load(s, it + NGW, F.lane, vb);
            cvt_finish(s, scr, it, F.lane, va); if (hb) cvt_finish(s, scr, it + NGW, F.lane, vb); }
        base += nit;
    }
#ifdef DBG_CVTDUP
    }
#endif
}

__device__ __forceinline__ void mod_unit(const Frame& F, int unit) {
    const int l = unit / 72, cb = unit % 72, ks = F.tid >> 5, cg = F.tid & 31;
    const float* wa = F.in(IN_WADA) + (size_t)l * DM * 9216 + 128 * cb + 4 * cg;
    const float* c0 = F.in(IN_C); const float* c1 = c0 + DM;
    f32x4 a0 = {0.f, 0.f, 0.f, 0.f}, a1 = {0.f, 0.f, 0.f, 0.f};
    const GAS float* wp = (const GAS float*)wa + (size_t)(64 * ks) * 9216;
    for (int kb = 64 * ks; kb < 64 * ks + 64; kb += 16) {
        f32x4 w[16];
#pragma unroll
        for (int i = 0; i < 16; ++i) { w[i] = *(const GAS f32x4*)wp; wp += 9216; asm volatile("" : "+v"(wp)); }
#pragma unroll
        for (int i = 0; i < 16; ++i) { const float x0 = c0[kb + i], x1 = c1[kb + i];
            const float s0 = x0 / (1.f + __expf(-x0)), s1 = x1 / (1.f + __expf(-x1));
            a0 += w[i] * s0; a1 += w[i] * s1; }
    }
    LAS f32x4* red = (LAS f32x4*)F.lds;
    red[(ks * 32 + cg) * 2 + 0] = a0; red[(ks * 32 + cg) * 2 + 1] = a1;
    __syncthreads();
    if (F.tid < 64) { const int g2 = F.tid >> 1, b = F.tid & 1; f32x4 s = {0.f, 0.f, 0.f, 0.f};
#pragma unroll
        for (int q = 0; q < 16; ++q) s += red[(q * 32 + g2) * 2 + b];
        const f32x4 bb = *(const f32x4*)(F.in(IN_BADA) + (size_t)l * 9216 + 128 * cb + 4 * g2);
        float* mo = (float*)(F.wsp(WS_MOD)) + ((size_t)(l * 2 + b)) * 9216 + 128 * cb + 4 * g2;
        *(f32x4*)mo = s + bb; }
    __syncthreads();
}
__device__ __forceinline__ void rope_table(const Frame& F) {
    const double inv[16] = {1.0, 0.56234132519034907, 0.31622776601683794, 0.17782794100389229, 0.10000000000000001, 0.056234132519034911, 0.031622776601683791, 0.017782794100389229,
                            0.01, 0.005623413251903491, 0.0031622776601683794, 0.0017782794100389228, 0.001, 0.0005623413251903491, 0.00031622776601683794, 0.00017782794100389227};
    const int gid = F.vcu * 512 + F.tid;
    for (int e = gid; e < SEQ * 16; e += F.G * 512) {
        const int pos = e >> 4, j = e & 15;
        double th = 1.0;
#pragma unroll
        for (int q = 0; q < 16; ++q) th = (j == q) ? inv[q] : th;
        const double t2 = th * th; double cs = 1.0, sn = th, tc = 1.0, ts = th;
#pragma unroll
        for (int n = 1; n <= 12; ++n) { tc *= -t2 / (double)((2 * n - 1) * (2 * n)); ts *= -t2 / (double)((2 * n) * (2 * n + 1)); cs += tc; sn += ts; }
        double rc = 1.0, rs = 0.0;
#pragma unroll
        for (int bit = 0; bit < 13; ++bit) {
            if ((pos >> bit) & 1) { const double nc = rc * cs - rs * sn, ns = rc * sn + rs * cs; rc = nc; rs = ns; }
            const double c2 = cs * cs - sn * sn, s2 = 2.0 * cs * sn; cs = c2; sn = s2;
        }
        ((f32x2*)(F.wsp(WS_ROPE)))[e] = (f32x2){(float)rc, (float)rs};
    }
}
template <bool HAS_Y, bool HAS_NEXT, int XIN, int XOUT>
__device__ __forceinline__ void norm_pass(const Frame& F, const bf16_t* Y, const void* xs, void* xd, const float* gpost, const float* gate, float rw,
                                          const float* gpre, const float* scale, const float* shift, bf16_t* XN) {
    const int gw = F.vcu * NWAVES + F.wave, NGW = F.G * NWAVES;
    constexpr int R = XIN ? 8 : 4;
    for (int m0 = gw; m0 < M; m0 += R * NGW) {
        f32x4 vf[XIN ? 1 : R][4]; u32x2 xw[XIN ? R : 1][4]; u32x2 yw[R][4];
        static_assert(M % (4 * 2048) == 0, "rows per batch");
        const GAS unsigned char* xp = (const GAS unsigned char*)xs + (size_t)m0 * DM * (XIN ? 2 : 4) + F.lane * (XIN ? 8 : 16);
        const GAS unsigned char* yp = (const GAS unsigned char*)Y + (size_t)m0 * DM * 2 + F.lane * 8;
        const size_t xstep = (size_t)NGW * DM * (XIN ? 2 : 4), ystep = (size_t)NGW * DM * 2;
#pragma unroll
        for (int r = 0; r < R; ++r) {
            if (XIN == 0) {
#pragma unroll
                for (int j = 0; j < 4; ++j) vf[XIN ? 0 : r][j] = *(const GAS f32x4*)(xp + 1024 * j); }
            else {
#pragma unroll
                for (int j = 0; j < 4; ++j) xw[XIN ? r : 0][j] = *(const GAS u32x2*)(xp + 512 * j); }
            xp += xstep; asm volatile("" : "+v"(xp));
            if (HAS_Y) {
#pragma unroll
                for (int j = 0; j < 4; ++j) yw[r][j] = *(const GAS u32x2*)(yp + 512 * j);
                yp += ystep; asm volatile("" : "+v"(yp)); } }
#pragma unroll
        for (int hb = 0; hb < R / 4; ++hb) {
        const int b = (m0 + 4 * hb * NGW) >> 13;
        f32x4 cpost[4], cpre[4], csh[4];
#pragma unroll
        for (int j = 0; j < 4; ++j) {
            if (HAS_Y) { const f32x4 gp = *(const f32x4*)(gpost + 4 * F.lane + 256 * j); const f32x4 gt = *(const f32x4*)(gate + (size_t)b * 9216 + 4 * F.lane + 256 * j); cpost[j] = (gt * rw) * gp; }
            if (HAS_NEXT) { const f32x4 gp = *(const f32x4*)(gpre + 4 * F.lane + 256 * j); const f32x4 sc = *(const f32x4*)(scale + (size_t)b * 9216 + 4 * F.lane + 256 * j);
                cpre[j] = gp * (sc + 1.0f); csh[j] = *(const f32x4*)(shift + (size_t)b * 9216 + 4 * F.lane + 256 * j); } }
#pragma unroll
        for (int r = 4 * hb; r < 4 * hb + 4; ++r) { const int m = m0 + r * NGW; {
        f32x4 v[4];
#pragma unroll
        for (int j = 0; j < 4; ++j) { if (XIN == 0) v[j] = vf[XIN ? 0 : r][j]; else { const u32x2 w = xw[XIN ? r : 0][j]; v[j] = (f32x4){bf_lo(w.x), bf_hi(w.x), bf_lo(w.y), bf_hi(w.y)}; } }
        if (HAS_Y) {
            f32x4 y[4]; float ss = 0.f;
#pragma unroll
            for (int j = 0; j < 4; ++j) { const u32x2 w = yw[r][j]; y[j] = (f32x4){bf_lo(w.x), bf_hi(w.x), bf_lo(w.y), bf_hi(w.y)}; ss += (y[j].x * y[j].x + y[j].y * y[j].y) + (y[j].z * y[j].z + y[j].w * y[j].w); }
            const float rstd = 1.0f / sqrtf(wave_sum(ss) * (1.f / DM) + EPS);
#pragma unroll
            for (int j = 0; j < 4; ++j) v[j] += cpost[j] * (y[j] * rstd);
            if (XOUT == 0) { GAS f32x4* xo = (GAS f32x4*)((float*)xd + (size_t)m * DM) + F.lane;
#pragma unroll
                for (int j = 0; j < 4; ++j) xo[64 * j] = v[j]; }
            else { GAS u32x2* xo = (GAS u32x2*)((bf16_t*)xd + (size_t)m * DM) + F.lane;
#pragma unroll
                for (int j = 0; j < 4; ++j) { u32x2 w; w.x = pk2(v[j].x, v[j].y); w.y = pk2(v[j].z, v[j].w); xo[64 * j] = w; } }
        }
        if (HAS_NEXT) {
            float ss = 0.f;
#pragma unroll
            for (int j = 0; j < 4; ++j) ss += (v[j].x * v[j].x + v[j].y * v[j].y) + (v[j].z * v[j].z + v[j].w * v[j].w);
            const float rstd = 1.0f / sqrtf(wave_sum(ss) * (1.f / DM) + EPS);
            GAS u32x2* o8 = (GAS u32x2*)(XN + (size_t)m * DM) + F.lane;
#pragma unroll
            for (int j = 0; j < 4; ++j) {
                const f32x4 o = (v[j] * rstd) * cpre[j] + csh[j];
                u32x2 w; w.x = pk2(o.x, o.y); w.y = pk2(o.z, o.w); o8[64 * j] = w; }
        } } }
        }
    }
}


__device__ __forceinline__ void mla_prep(const Frame& F, const bf16_t* Z, bf16_t* CQN, bf16_t* CKN, bf16_t* KR, bf16_t* KIT, const f32x2* rt) {
    const int gw = F.vcu * NWAVES + F.wave, NGW = F.G * NWAVES, lane = F.lane;
    constexpr int R = 4;
    for (int m0 = gw; m0 < M; m0 += R * NGW) {
        u32x4 wq[R], wk[R]; float xa[R], xb[R]; f32x2 cs[R];
#pragma unroll
        for (int r = 0; r < R; ++r) { const int m = (m0 + r * NGW < M) ? m0 + r * NGW : m0; const bf16_t* zr = Z + (size_t)m * ZP;
            wq[r] = (u32x4){0u, 0u, 0u, 0u}; wk[r] = wq[r]; xa[r] = 0.f; xb[r] = 0.f; cs[r] = (f32x2){0.f, 0.f};
            if (lane < 48) wq[r] = *(const u32x4*)(zr + (lane < 32 ? ZC_CQ + 8 * lane : ZC_CKV + 8 * (lane - 32)));
            else { const int j = lane - 48; xa[r] = bf2f(zr[ZC_CKV + 128 + j]); xb[r] = bf2f(zr[ZC_CKV + 144 + j]); cs[r] = rt[(size_t)(m & (SEQ - 1)) * 16 + j]; }
            if (lane < 8) wk[r] = *(const u32x4*)(zr + ZC_IK + 8 * lane); }
#pragma unroll
        for (int r = 0; r < R; ++r) { const int m = m0 + r * NGW; if (m < M) {
        float s1 = 0.f, s2 = 0.f; float a[8] = {0.f, 0.f, 0.f, 0.f, 0.f, 0.f, 0.f, 0.f};
        if (lane < 48) { const u32x4 w = wq[r];
            a[0] = bf_lo(w.x); a[1] = bf_hi(w.x); a[2] = bf_lo(w.y); a[3] = bf_hi(w.y); a[4] = bf_lo(w.z); a[5] = bf_hi(w.z); a[6] = bf_lo(w.w); a[7] = bf_hi(w.w);
            const float s = (a[0] * a[0] + a[1] * a[1]) + (a[2] * a[2] + a[3] * a[3]) + (a[4] * a[4] + a[5] * a[5]) + (a[6] * a[6] + a[7] * a[7]);
            if (lane < 32) s1 = s; else s2 = s; }
        else { const int j = lane - 48; const float x1 = xa[r], x2 = xb[r];
            *(unsigned*)(KR + (size_t)m * 32 + 2 * j) = pk2(x1 * cs[r].x - x2 * cs[r].y, x2 * cs[r].x + x1 * cs[r].y); }
        if (lane < 8) *(u32x4*)(KIT + (size_t)(m >> 5) * 2048 + lane * 256 + (m & 31) * 8) = wk[r];
        s1 = wave_sum(s1); s2 = wave_sum(s2);
        const float r1 = 1.0f / sqrtf(s1 * (1.f / 256.f) + EPS), r2 = 1.0f / sqrtf(s2 * (1.f / 128.f) + EPS);
        if (lane < 48) { const float rr = lane < 32 ? r1 : r2;
            u32x4 o; o.x = pk2(a[0] * rr, a[1] * rr); o.y = pk2(a[2] * rr, a[3] * rr); o.z = pk2(a[4] * rr, a[5] * rr); o.w = pk2(a[6] * rr, a[7] * rr);
            if (lane < 32) *(u32x4*)(CQN + (size_t)m * 256 + 8 * lane) = o; else *(u32x4*)(CKN + (size_t)m * 128 + 8 * (lane - 32)) = o; }
        } }
    }
}

__device__ __forceinline__ void lru_weights(const Frame& F) {
    const int gid = (F.G - 1 - F.vcu) * 512 + F.tid;
    if (gid < DEPTH * 8 * 2 * 2 * 4 * 64) {
        const int lane = gid & 63, ks = (gid >> 6) & 3, g = (gid >> 8) & 1, ct = (gid >> 9) & 1, n = (gid >> 10) & 7, l = gid >> 13, r32 = lane & 31, hi = lane >> 5;
        const float* pw = (g ? F.in(IN_LRUWX) : F.in(IN_LRUWA)) + ((size_t)l * 8 + n) * 4096 + (16 * ks + 8 * hi) * 64 + 32 * ct + r32;
        float w[8];
#pragma unroll
        for (int e = 0; e < 8; ++e) w[e] = pw[e * 64];
        ((u32x4*)F.wsp(WS_LRUW))[gid] = (u32x4){pk2(w[0], w[1]), pk2(w[2], w[3]), pk2(w[4], w[5]), pk2(w[6], w[7])};
    }
}
template <bool PASS2>
__device__ __forceinline__ void lru_unit(const Frame& F, int l, int unit, const bf16_t* Z, f32x2* S, bf16_t* YB) {
    constexpr int XS = 520;
    const int b = unit >> 7, k = unit & 127, c = F.tid, n = F.wave, lane = F.lane, r32 = lane & 31, hi = lane >> 5;
    const size_t m0 = (size_t)b * SEQ + 64 * k;
    LAS float* xcs = (LAS float*)F.lds;
    { const float* cw = F.in(IN_CONVW) + (size_t)l * 4 * 512 + c;
      const float w0 = cw[0], w1 = cw[512], w2 = cw[1024], w3 = cw[1536], cb = F.in(IN_CONVB)[l * 512 + c];
      const bf16_t* xr = Z + m0 * ZP + ZC_RX + c;
      float x3 = 0.f, x2 = 0.f, x1 = 0.f;
      if (k > 0) { x3 = bf2f(xr[-3 * (long)ZP]); x2 = bf2f(xr[-2 * (long)ZP]); x1 = bf2f(xr[-1 * (long)ZP]); }
      bf16_t xin[64];
      { const GAS bf16_t* xg = (const GAS bf16_t*)xr;
#pragma unroll
        for (int i = 0; i < 64; ++i) { xin[i] = *xg; xg += ZP; asm volatile("" : "+v"(xg)); } }
#pragma unroll
      for (int i0 = 0; i0 < 64; i0 += 16) {
          LAS float* xw = xcs + c + i0 * XS; asm volatile("" : "+v"(xw));
#pragma unroll
          for (int i = 0; i < 16; ++i) { const float x0 = bf2f(xin[i0 + i]); xw[i * XS] = cb + w0 * x3 + w1 * x2 + w2 * x1 + w3 * x0; x3 = x2; x2 = x1; x1 = x0; } } }
    __syncthreads();
    u32x4 wfa[2][2][4];
    { const GAS u32x4* lw = (const GAS u32x4*)F.wsp(WS_LRUW) + (size_t)((l * 8 + n) * 16) * 64 + lane; asm volatile("" : "+v"(lw));
#pragma unroll
      for (int ct = 0; ct < 2; ++ct)
#pragma unroll
          for (int g = 0; g < 2; ++g)
#pragma unroll
              for (int ks = 0; ks < 4; ++ks) wfa[ct][g][ks] = lw[((ct * 2 + g) * 4 + ks) * 64]; }
    float lamv[2], biav[2], bixv[2];
#pragma unroll
    for (int ct = 0; ct < 2; ++ct) { const int ch = 64 * n + 32 * ct + r32; lamv[ct] = F.in(IN_LRULAM)[l * 512 + ch]; biav[ct] = F.in(IN_LRUBA)[l * 512 + ch]; bixv[ct] = F.in(IN_LRUBX)[l * 512 + ch]; }
#pragma unroll
    for (int ct = 0; ct < 2; ++ct) {
        __builtin_amdgcn_sched_barrier(0);
        const int ch = 64 * n + 32 * ct + r32;
        const float lam = lamv[ct]; const float ex_ = __expf(-lam);
        const float splus = lam < -20.f ? -lam : (ex_ < 0.1f ? ex_ * (1.0f - ex_ * (0.5f - ex_ * (0.33333334f - ex_ * (0.25f - ex_ * 0.2f)))) : __logf(1.0f + ex_));
        const float sp8 = -8.0f * LOG2E * splus, bia = biav[ct], bix = bixv[ct];
        float hst = 0.f, apr = 1.f;
        if (PASS2) { const f32x2* sp = S + (size_t)b * 128 * 512 + ch;
            const int kh = (k + 1) >> 1, q0_ = hi ? kh : 0, q1_ = hi ? k : kh;
            float Am = 1.f, Bm = 0.f;
            for (int qb_ = 0; qb_ < kh; qb_ += 32) {
                const GAS f32x2* sq = (const GAS f32x2*)sp + (size_t)(q0_ + qb_) * 512; asm volatile("" : "+v"(sq));
                f32x2 ab[32];
#pragma unroll
                for (int e = 0; e < 32; ++e) { ab[e] = *sq; sq += 512; asm volatile("" : "+v"(sq)); }
#pragma unroll
                for (int e = 0; e < 32; ++e) { const bool v_ = q0_ + qb_ + e < q1_; const float bn = ab[e].x * Bm + ab[e].y, an = ab[e].x * Am; Bm = v_ ? bn : Bm; Am = v_ ? an : Am; } }
            float b0_ = Bm, b1_ = Bm, a0_ = Am, a1_ = Am;
            asm volatile("s_nop 1\n\tv_permlane32_swap_b32 %0, %1\n\tv_permlane32_swap_b32 %2, %3\n\ts_nop 1" : "+v"(b0_), "+v"(b1_), "+v"(a0_), "+v"(a1_));
            hst = a1_ * b0_ + b1_; }
        __builtin_amdgcn_sched_barrier(0);
        f32x16 D[2][2];
#pragma unroll
        for (int rt = 0; rt < 2; ++rt)
#pragma unroll
            for (int r = 0; r < 16; ++r) { D[0][rt][r] = bia; D[1][rt][r] = bix; }
#pragma unroll
        for (int rt = 0; rt < 2; ++rt)
#pragma unroll
            for (int ks = 0; ks < 4; ++ks) {
                const LAS f32x4* ap = (const LAS f32x4*)(xcs + (32 * rt + r32) * XS + 64 * n + 16 * ks + 8 * hi);
                const f32x4 a0 = ap[0], a1 = ap[1];
                const u32x4 af = (u32x4){pk2(a0.x, a0.y), pk2(a0.z, a0.w), pk2(a1.x, a1.y), pk2(a1.z, a1.w)};
#pragma unroll
                for (int g = 0; g < 2; ++g) D[g][rt] = __builtin_amdgcn_mfma_f32_32x32x16_bf16(__builtin_bit_cast(bf16x8, af), __builtin_bit_cast(bf16x8, wfa[ct][g][ks]), D[g][rt], 0, 0, 0);
            }
        __builtin_amdgcn_sched_barrier(0);
#pragma unroll
        for (int rt = 0; rt < 2; ++rt) {
            const LAS float* xo = xcs + (32 * rt + 4 * hi) * XS + ch;
#pragma unroll
            for (int r = 0; r < 16; ++r) {
                const float rr = fast_sigmoid(D[0][rt][r]), ig = fast_sigmoid(D[1][rt][r]);
                const float l2a = sp8 * rr, a = __builtin_amdgcn_exp2f(l2a), xx = 1.3862943611198906f * l2a;
                const float poly = -xx * (1.0f + xx * (0.5f + xx * (0.16666667f + xx * (0.041666668f + xx * 0.008333334f)))), direct = 1.0f - a * a;
                const float one_m_a2 = (xx > -0.1f) ? poly : direct;
                D[0][rt][r] = a; D[1][rt][r] = __builtin_amdgcn_sqrtf(one_m_a2) * (ig * xo[((r & 3) + 8 * (r >> 2)) * XS]);
            } }
#pragma unroll
        for (int rt = 0; rt < 2; ++rt)
#pragma unroll
            for (int rg = 0; rg < 4; ++rg)
#pragma unroll
                for (int owner = 0; owner < 2; ++owner) {
                    float h = hst, ap = apr;
#pragma unroll
                    for (int e = 0; e < 4; ++e) { const int r = 4 * rg + e; h = D[0][rt][r] * h + D[1][rt][r]; ap *= D[0][rt][r]; D[1][rt][r] = (hi == owner) ? h : D[1][rt][r]; }
                    float h0_ = h, h1_ = h, a0_ = ap, a1_ = ap;
                    asm volatile("s_nop 1\n\tv_permlane32_swap_b32 %0, %1\n\tv_permlane32_swap_b32 %2, %3\n\ts_nop 1" : "+v"(h0_), "+v"(h1_), "+v"(a0_), "+v"(a1_));
                    hst = owner ? h1_ : h0_; apr = owner ? a1_ : a0_;
                }
        if (!PASS2) { if (hi == 0) S[((size_t)b * 128 + k) * 512 + ch] = (f32x2){apr, hst}; }
        else {
#pragma unroll
            for (int rt = 0; rt < 2; ++rt) {
                bf16_t gin[16];
                const GAS bf16_t* zb = (const GAS bf16_t*)(Z + (m0 + 32 * rt + 4 * hi) * ZP + ZC_RG + ch); GAS bf16_t* yb = (GAS bf16_t*)(YB + (m0 + 32 * rt + 4 * hi) * 2048 + 512 + ch);
                asm volatile("" : "+v"(zb), "+v"(yb));
#pragma unroll
                for (int r = 0; r < 16; ++r) gin[r] = zb[(size_t)((r & 3) + 8 * (r >> 2)) * ZP];
#pragma unroll
                for (int r = 0; r < 16; ++r) { const float g = bf2f(gin[r]);
                    const float tg = 0.7978845608028654f * (g + 0.044715f * g * g * g);
                    const float th = 1.0f - 2.0f * __builtin_amdgcn_rcpf(1.0f + __builtin_amdgcn_exp2f(2.0f * LOG2E * tg));
                    yb[(size_t)((r & 3) + 8 * (r >> 2)) * 2048] = (bf16_t)f2bf(D[1][rt][r] * (0.5f * g * (1.0f + th))); }
            }
        }
    }
    __syncthreads();
}

namespace fa {
constexpr int KB96 = 12288, VB = 8192, STG = KB96 + VB, NSLOT = 4, LDS_WS = NSLOT * STG, LDS_OST = LDS_WS + 8 * 256, LDS_TOTAL = LDS_OST + 8 * 4096;
constexpr float THR = 8.0f;
__device__ __forceinline__ int crow(int r, int hi) { return (r & 3) + 8 * (r >> 2) + 4 * hi; }
__device__ __forceinline__ void glds16(const void* g, unsigned lds_base) {
    unsigned sv; asm volatile("s_mov_b32 %0, m0\n\ts_mov_b32 m0, %2\n\ts_nop 0\n\tglobal_load_lds_dwordx4 %1, off\n\ts_mov_b32 m0, %0" : "=&s"(sv) : "v"(g), "s"(lds_base) : "memory"); }
typedef short v4i16_t __attribute__((ext_vector_type(4)));
typedef __attribute__((address_space(3))) const char* lds_cptr;
__device__ __forceinline__ v4i16_t vtr(lds_cptr p) { return __builtin_amdgcn_ds_read_tr16_b64_v4i16((__attribute__((address_space(3))) v4i16_t*)p); }
#define FA_MFMA(a, b, c) __builtin_amdgcn_mfma_f32_32x32x16_bf16(a, b, c, 0, 0, 0)
__device__ __forceinline__ float xhalf_max(float x) { float a = x, b = x; asm volatile("s_nop 1\n\tv_permlane32_swap_b32 %0, %1\n\ts_nop 1" : "+v"(a), "+v"(b)); return __builtin_fmaxf(a, b); }
__device__ __forceinline__ float keep_or_ninf(int m, float x) { float r; asm("v_bfi_b32 %0, %1, %2, %3" : "=v"(r) : "v"(m), "v"(x), "s"(0xff800000u)); return r; }

struct Ptrs { const bf16_t* Q; int ldq; const bf16_t* K; int ldk; const bf16_t* KR; const bf16_t* V; int ldv; bf16_t* O; int ldo; const unsigned* MK; float slope2; float sink2; };

template <int MODE>
__device__ __forceinline__ void unit(const Frame& F, const Ptrs& P, int b, int qb) {
    constexpr int DK = (MODE == 0) ? 96 : 64, ND0 = DK / 16;
    const int lane = F.lane, r32 = lane & 31, hi = lane >> 5, wid = F.wave;
    const long rowbase = (long)b * SEQ; const int q0 = qb * 256;
    const int qidx = q0 + 32 * wid + r32;
    const unsigned lds0 = (unsigned)(uintptr_t)F.lds;
    LAS float* wsf = (LAS float*)(F.lds + LDS_WS) + wid * 64;
    int t_lo, t_hi, key_base;
    if (MODE == 2) { key_base = q0 - 128; t_lo = (qb == 0) ? 2 : 0; t_hi = 6; } else { key_base = 0; t_lo = 0; t_hi = 4 * qb + 4; }
    const bf16_t* ksrc = P.K + (rowbase + lane) * (long)P.ldk + wid * 8;
    const bf16_t* krsrc = (MODE == 0) ? P.KR + (rowbase + lane) * 32L + (wid & 3) * 8 : nullptr;
    const bf16_t* vsrc = P.V + (rowbase + 16 * (wid & 3) + (lane >> 2)) * (long)P.ldv + (wid >> 2) * 32 + (lane & 3) * 8;
    const unsigned kdst = lds0 + wid * 1024, krdst = lds0 + (8 + (wid & 3)) * 1024, vdst = lds0 + KB96 + wid * 1024;
#define FA_DMA(t, soff) do { const long k0_ = key_base + 64L * (t); \
        glds16(ksrc + k0_ * P.ldk, (unsigned)__builtin_amdgcn_readfirstlane(kdst + (soff))); \
        if (MODE == 0 && krw) glds16(krsrc + k0_ * 32, (unsigned)__builtin_amdgcn_readfirstlane(krdst + (soff)));        \
        glds16(vsrc + k0_ * P.ldv, (unsigned)__builtin_amdgcn_readfirstlane(vdst + (soff))); } while (0)
    const bool krw = __builtin_amdgcn_readfirstlane(wid) < 4;
    if (!krw) asm volatile("s_setprio 1");
    FA_DMA(t_lo, 0);
    if (t_lo + 1 < t_hi) FA_DMA(t_lo + 1, STG);
    bf16x8 qr[ND0];
    { const bf16_t* Qw = P.Q + (rowbase + q0 + 32 * wid + r32) * (long)P.ldq + hi * 8;
#pragma unroll
      for (int d0 = 0; d0 < ND0; ++d0) qr[d0] = *(const bf16x8*)(Qw + d0 * 16); }
    float lrun = (MODE == 2 && hi == 0) ? 1.0f : 0.0f;
    f32x16 negm = {};
    float mref = (MODE == 2) ? P.sink2 : (MODE == 1) ? -1.0e4f : 0.0f;
    f32x16 o0 = {}, o1 = {};
    const lds_cptr kp0 = (lds_cptr)F.lds + hi * 1024 + r32 * 16;
    const lds_cptr vp0 = (lds_cptr)F.lds + KB96 + ((lane >> 4) & 1) * 32 + (lane & 3) * 8 + (4 * hi + ((lane & 15) >> 2)) * 64;
    const unsigned* mkrow = (MODE == 1) ? P.MK + (size_t)(rowbase + qidx) * 256 : nullptr;
#define FA_KLOAD(soff) do { const lds_cptr kp_ = kp0 + (soff); \
        _Pragma("unroll") for (int d0 = 0; d0 < ND0; ++d0) { kf[2 * d0] = *(const __attribute__((address_space(3))) bf16x8*)(kp_ + d0 * 2048); kf[2 * d0 + 1] = *(const __attribute__((address_space(3))) bf16x8*)(kp_ + d0 * 2048 + 512); } } while (0)
#define FA_QKMMA(A, B) do { A = FA_MFMA(kf[0], qr[0], negm); B = FA_MFMA(kf[1], qr[0], negm);        \
        _Pragma("unroll") for (int d0 = 1; d0 < ND0; ++d0) { A = FA_MFMA(kf[2 * d0], qr[d0], A); B = FA_MFMA(kf[2 * d0 + 1], qr[d0], B); } } while (0)
#define FA_BIAS(A, B, key0, mw) do { const int kl_ = (key0) + 4 * hi; \
        if (MODE != 0) { const float bq_ = P.slope2 * (float)(kl_ - qidx) - mref;        \
            _Pragma("unroll") for (int r = 0; r < 16; ++r) { const float cr_ = P.slope2 * (float)((r & 3) + 8 * (r >> 2)); A[r] += bq_ + cr_; B[r] += bq_ + cr_ + 32.0f * P.slope2; } } \
        if (MODE == 1) { const unsigned w0_ = (mw).x >> (4 * hi), w1_ = (mw).y >> (4 * hi);        \
            _Pragma("unroll") for (int r = 0; r < 16; ++r) { const int pos_ = (r & 3) + 8 * (r >> 2); \
                A[r] = keep_or_ninf(__builtin_amdgcn_sbfe((int)w0_, pos_, 1), A[r]); B[r] = keep_or_ninf(__builtin_amdgcn_sbfe((int)w1_, pos_, 1), B[r]); } } \
        if (MODE == 2) { _Pragma("unroll") for (int r = 0; r < 16; ++r) { const int d_ = qidx - (kl_ + (r & 3) + 8 * (r >> 2)); if (d_ < 0 || d_ >= 128) A[r] = -INFINITY; if (d_ - 32 < 0 || d_ - 32 >= 128) B[r] = -INFINITY; } } \
        _Pragma("unroll") for (int i_ = 0; i_ < 8; ++i_) { __builtin_amdgcn_sched_group_barrier(0x8, 1, 0); __builtin_amdgcn_sched_group_barrier(0x2, (MODE == 1) ? 8 : (MODE == 2) ? 12 : 2, 0); }        \
        if (MODE != 2 && (key0) + 63 > q0 + 32 * wid) { asm volatile("; diagonal tile" ::: "memory");        \
            _Pragma("unroll") for (int r = 0; r < 16; ++r) { const int kv_ = kl_ + (r & 3) + 8 * (r >> 2); if (kv_ > qidx) A[r] = -INFINITY; if (kv_ + 32 > qidx) B[r] = -INFINITY; } } \
        } while (0)
    u32x2 mw = {0u, 0u}, mw_n = {0u, 0u}, mw_nn = {0u, 0u};
    if (MODE == 1) { mw = *(const u32x2*)(mkrow + 2 * t_lo); if (t_lo + 1 < t_hi) mw_n = *(const u32x2*)(mkrow + 2 * (t_lo + 1)); }
    if (t_lo + 1 < t_hi) asm volatile("s_waitcnt vmcnt(%0) lgkmcnt(0)\n\ts_barrier" :: "n"(2) : "memory"); else asm volatile("s_waitcnt vmcnt(0) lgkmcnt(0)\n\ts_barrier" ::: "memory");
    f32x16 p0, p1, n0 = {}, n1 = {}; bf16x8 kf[2 * ND0];
    u32x4 pw0 = {0u, 0u, 0u, 0u}, pw1 = pw0, pw2 = pw0, pw3 = pw0;
    FA_KLOAD(0); __builtin_amdgcn_sched_barrier(0); FA_QKMMA(p0, p1);
    int s_prev = 3 * STG, s_cur = 0, s_nxt = STG, s_nn = 2 * STG;
#define FA_MX3(a, b, c) __builtin_fmaxf(__builtin_fmaxf((a), (b)), (c))
#define FA_TOP(t) do { if ((t) + 1 < t_hi) { \
            asm volatile("s_waitcnt vmcnt(0) lgkmcnt(0)\n\ts_barrier" ::: "memory");       \
            if ((t) + 2 < t_hi) { FA_DMA((t) + 2, s_nn); if (MODE == 1) mw_nn = *(const u32x2*)(mkrow + 2 * ((t) + 2)); } \
            } } while (0)
#define FA_PV(soff, KL) do { const lds_cptr vp_ = vp0 + (soff); bf16x8 vf[8]; \
        _Pragma("unroll") for (int i = 0; i < 8; ++i) { const v4i16_t lo_ = vtr(vp_ + (i >> 2) * 4096 + (i & 3) * 1024), hi_ = vtr(vp_ + (i >> 2) * 4096 + (i & 3) * 1024 + 512); vf[i] = (bf16x8){lo_[0], lo_[1], lo_[2], lo_[3], hi_[0], hi_[1], hi_[2], hi_[3]}; } \
        __builtin_amdgcn_sched_barrier(0); if (KL) FA_KLOAD(s_nxt); \
        o0 = FA_MFMA(__builtin_bit_cast(bf16x8, pw0), vf[0], o0); o1 = FA_MFMA(__builtin_bit_cast(bf16x8, pw0), vf[4], o1); \
        o0 = FA_MFMA(__builtin_bit_cast(bf16x8, pw1), vf[1], o0); o1 = FA_MFMA(__builtin_bit_cast(bf16x8, pw1), vf[5], o1); \
        o0 = FA_MFMA(__builtin_bit_cast(bf16x8, pw2), vf[2], o0); o1 = FA_MFMA(__builtin_bit_cast(bf16x8, pw2), vf[6], o1); \
        o0 = FA_MFMA(__builtin_bit_cast(bf16x8, pw3), vf[3], o0); o1 = FA_MFMA(__builtin_bit_cast(bf16x8, pw3), vf[7], o1); } while (0)
#define FA_SOFTMAX(t, FIRST) do { \
        float rma = FA_MX3(p0[0], p0[1], p1[0]), rmb = FA_MX3(p0[2], p0[3], p1[1]); rma = FA_MX3(rma, p1[2], p1[3]); \
        _Pragma("unroll") for (int r = 4; r < 16; r += 4) { rma = FA_MX3(rma, p0[r], p0[r + 1]); rmb = FA_MX3(rmb, p0[r + 2], p0[r + 3]); rma = FA_MX3(rma, p1[r], p1[r + 1]); rmb = FA_MX3(rmb, p1[r + 2], p1[r + 3]); } \
        float rm = xhalf_max(__builtin_fmaxf(rma, rmb)); \
        float sacc = 0.f; \
        { const bool first0_ = (MODE == 0) && (FIRST);        \
          if (first0_ || __any(rm > THR)) { float dl = (rm > THR) ? rm : 0.0f; if (first0_) dl = (rm == -INFINITY) ? 0.0f : rm; \
                mref += dl; \
                _Pragma("unroll") for (int r = 0; r < 16; ++r) { p0[r] -= dl; p1[r] -= dl; } \
                if (MODE == 0) { _Pragma("unroll") for (int r = 0; r < 16; ++r) negm[r] -= dl; } \
                if (!first0_) { const float alpha = __builtin_amdgcn_exp2f(-dl); lrun *= alpha; \
                    if (hi == 0) wsf[r32] = alpha; asm volatile("s_waitcnt lgkmcnt(0)" ::: "memory"); \
                    _Pragma("unroll") for (int r = 0; r < 16; ++r) { const float f = wsf[crow(r, hi)]; o0[r] *= f; o1[r] *= f; } } } \
          FA_QKMMA(n0, n1);        \
          _Pragma("unroll") for (int r = 0; r < 16; ++r) { p0[r] = __builtin_amdgcn_exp2f(p0[r]); p1[r] = __builtin_amdgcn_exp2f(p1[r]); sacc += p0[r] + p1[r]; } } \
        lrun += sacc; \
        pw0 = (u32x4){cvt_pk_bf16(p0[0], p0[1]), cvt_pk_bf16(p0[2], p0[3]), cvt_pk_bf16(p0[4], p0[5]), cvt_pk_bf16(p0[6], p0[7])}; \
        pw1 = (u32x4){cvt_pk_bf16(p0[8], p0[9]), cvt_pk_bf16(p0[10], p0[11]), cvt_pk_bf16(p0[12], p0[13]), cvt_pk_bf16(p0[14], p0[15])}; \
        pw2 = (u32x4){cvt_pk_bf16(p1[0], p1[1]), cvt_pk_bf16(p1[2], p1[3]), cvt_pk_bf16(p1[4], p1[5]), cvt_pk_bf16(p1[6], p1[7])}; \
        pw3 = (u32x4){cvt_pk_bf16(p1[8], p1[9]), cvt_pk_bf16(p1[10], p1[11]), cvt_pk_bf16(p1[12], p1[13]), cvt_pk_bf16(p1[14], p1[15])}; \
        p0 = n0; p1 = n1; \
        { const int tmp_ = s_prev; s_prev = s_cur; s_cur = s_nxt; s_nxt = s_nn; s_nn = tmp_; } mw = mw_n; mw_n = mw_nn; } while (0)
    FA_TOP(t_lo); if (t_lo + 1 < t_hi) FA_KLOAD(s_nxt);
    FA_BIAS(p0, p1, key_base + 64 * t_lo, mw);
    FA_SOFTMAX(t_lo, 1);
    for (int t = t_lo + 1; t < t_hi; ++t) {
        FA_TOP(t);
        FA_PV(s_prev, t + 1 < t_hi);
        FA_BIAS(p0, p1, key_base + 64 * t, mw);
        FA_SOFTMAX(t, 0);
    }
    FA_PV(s_prev, false);
#undef FA_MX3
#undef FA_TOP
#undef FA_PV
#undef FA_SOFTMAX
    lrun += __shfl_xor(lrun, 32);
    if (hi == 0) wsf[32 + r32] = lrun;
    asm volatile("s_waitcnt lgkmcnt(0)" ::: "memory");
    LAS bf16_t* stg = (LAS bf16_t*)(F.lds + LDS_OST) + wid * 2048;
#pragma unroll
    for (int r = 0; r < 16; ++r) { const int orow = crow(r, hi); const float rl = __builtin_amdgcn_rcpf(wsf[32 + orow]);
        stg[orow * 64 + r32] = (bf16_t)f2bf(o0[r] * rl); stg[orow * 64 + 32 + r32] = (bf16_t)f2bf(o1[r] * rl); }
    asm volatile("s_waitcnt lgkmcnt(0)" ::: "memory");
    bf16_t* Ow = P.O + (rowbase + q0 + 32 * wid) * (long)P.ldo;
#pragma unroll
    for (int i = 0; i < 4; ++i) { const int row = i * 8 + (lane >> 3), ch = lane & 7; *(u32x4*)(Ow + (long)row * P.ldo + ch * 8) = *(const LAS u32x4*)(stg + row * 64 + ch * 8); }
    asm volatile("s_setprio 0\n\ts_waitcnt lgkmcnt(0)\n\ts_barrier" ::: "memory");
#undef FA_DMA
#undef FA_KLOAD
#undef FA_QKMMA
#undef FA_BIAS
}
}

namespace fd {
using fa::lds_cptr; using fa::v4i16_t; using fa::vtr; using fa::glds16; using fa::crow;
constexpr int NSLOT = 3, SLOTB = 8192, LDS_K = 0, LDS_V = NSLOT * SLOTB, LDS_WS = 2 * NSLOT * SLOTB, LDS_OST = LDS_WS + 8 * 256, LDS_MSK = LDS_OST + 8 * 4096, LDS_TOTAL = LDS_MSK + 8 * 2048;
static_assert(LDS_TOTAL <= LDSCTL_OFF, "dsa unit LDS");
__device__ __forceinline__ float max3f(float a, float b, float c) { float r; asm("v_max3_f32 %0, %1, %2, %3" : "=v"(r) : "v"(a), "v"(b), "v"(c)); return r; }
__device__ __forceinline__ float max2f(float a, float b) { float r; asm("v_max_f32_e32 %0, %1, %2" : "=v"(r) : "v"(a), "v"(b)); return r; }
#define FD_SBAR() __builtin_amdgcn_sched_barrier(0)
__device__ __forceinline__ float and_mask(int m, float x) { float r; asm("v_and_b32 %0, %1, %2" : "=v"(r) : "v"(m), "v"(x)); return r; }
#define FD_WAIT_BAR(N) asm volatile("s_waitcnt vmcnt(" #N ") lgkmcnt(0)\n\ts_barrier" ::: "memory")
#define FD_MFMA(a, b, c) __builtin_amdgcn_mfma_f32_32x32x16_bf16(a, b, c, 0, 0, 0)
__device__ __forceinline__ void kload8(bf16x8* kf, lds_cptr kp) {
    kf[0] = *(const LAS bf16x8*)(kp);        kf[1] = *(const LAS bf16x8*)(kp + 512);  kf[2] = *(const LAS bf16x8*)(kp + 2048); kf[3] = *(const LAS bf16x8*)(kp + 2560);
    kf[4] = *(const LAS bf16x8*)(kp + 4096); kf[5] = *(const LAS bf16x8*)(kp + 4608); kf[6] = *(const LAS bf16x8*)(kp + 6144); kf[7] = *(const LAS bf16x8*)(kp + 6656); }
__device__ __forceinline__ void kload2(bf16x8* kf, lds_cptr kp, int j) { kf[2 * j] = *(const LAS bf16x8*)(kp + j * 2048); kf[2 * j + 1] = *(const LAS bf16x8*)(kp + j * 2048 + 512); }
__device__ __forceinline__ float rowmax(const f32x16& p0, const f32x16& p1) {
    float a = max3f(p0[0], p0[1], p1[0]), b = max3f(p0[2], p0[3], p1[1]); a = max3f(a, p1[2], p1[3]);
#pragma unroll
    for (int r = 4; r < 16; r += 4) { a = max3f(a, p0[r], p0[r + 1]); b = max3f(b, p0[r + 2], p0[r + 3]); a = max3f(a, p1[r], p1[r + 1]); b = max3f(b, p1[r + 2], p1[r + 3]); }
    return fa::xhalf_max(max2f(a, b)); }
__device__ __forceinline__ void cmask(f32x16& p0, f32x16& p1, int jb, int qrel, int hi) {
    const int kb = 64 * jb + 4 * hi;
#pragma unroll
    for (int r = 0; r < 16; ++r) { const int kv = kb + (r & 3) + 8 * (r >> 2); if (kv > qrel) p0[r] = -INFINITY; if (kv + 32 > qrel) p1[r] = -INFINITY; } }

template <int SWA>
__device__ __forceinline__ void unit(const Frame& F, const fa::Ptrs& P, int b, int qb) {
    const int lane = F.lane, r32 = lane & 31, hi = lane >> 5, wid = F.wave;
    const int q0 = qb * 256, qrel = wid * 32 + r32, qidx = q0 + qrel, kb0 = (SWA && qb > 0) ? q0 - 128 : 0;
    const long rowbase = (long)b * SEQ, krow0 = rowbase + kb0;
    LAS unsigned char* shm = F.lds; const unsigned lds0 = (unsigned)(uintptr_t)shm;
    LAS float* wsf = (LAS float*)(shm + LDS_WS) + wid * 64;
    const bf16_t* ksrc = P.K + (krow0 + lane) * (long)P.ldk + wid * 8;
    const bf16_t* vsrc = P.V + (krow0 + 16 * (wid & 3) + (lane >> 2)) * (long)P.ldv + (wid >> 2) * 32 + (lane & 3) * 8;
    const char* msrc = SWA ? nullptr : (const char*)P.MK + (rowbase + qidx) * 1024L;
    const unsigned kdst = lds0 + LDS_K + wid * 1024, vdst = lds0 + LDS_V + wid * 1024, mdst = lds0 + LDS_MSK + wid * 2048;
#define FD_DMA_K(t, slot) glds16(ksrc + (long)(t) * 64 * P.ldk, (unsigned)__builtin_amdgcn_readfirstlane(kdst + (slot)))
#define FD_DMA_V(t, slot) glds16(vsrc + (long)(t) * 64 * P.ldv, (unsigned)__builtin_amdgcn_readfirstlane(vdst + (slot)))
#define FD_DMA_M(t) glds16(msrc + 8 * (t), (unsigned)__builtin_amdgcn_readfirstlane(mdst + ((((t) >> 1) & 1) << 10)))
    const lds_cptr shm3 = (lds_cptr)shm; const lds_cptr kp0 = shm3 + LDS_K + hi * 1024 + r32 * 16; const lds_cptr vp0 = shm3 + LDS_V + ((lane >> 4) & 1) * 32 + (lane & 3) * 8 + (4 * hi + ((lane & 15) >> 2)) * 64;
    const LAS unsigned* mlds = (const LAS unsigned*)(shm + LDS_MSK + wid * 2048) + lane * 4;
    const int NT = SWA ? (qb > 0 ? 6 : 4) : (q0 + 256) / 64;
    if (!SWA) { FD_DMA_M(0); if (2 < NT) FD_DMA_M(2); }
    FD_DMA_K(0, 0); FD_DMA_V(0, 0); FD_DMA_K(1, SLOTB);
    bf16x8 qr[4];
    { const bf16_t* Qw = P.Q + (rowbase + qidx) * (long)P.ldq + hi * 8;
#pragma unroll
      for (int d0 = 0; d0 < 4; ++d0) qr[d0] = *(const bf16x8*)(Qw + d0 * 16); }
    u32x4 kxA = {0u, 0u, 0u, 0u}, kxB = kxA, qx = kxA; unsigned qs2 = 0u;
    if (hi == 0) {
        const unsigned klA = __builtin_bit_cast(unsigned, (float)r32) >> 16, klB = __builtin_bit_cast(unsigned, (float)(r32 + 32)) >> 16, one = 0x3f80u;
        kxA = (u32x4){klA | (klA << 16), klA | (one << 16), one | (one << 16), 0u}; kxB = (u32x4){klB | (klB << 16), klB | (one << 16), one | (one << 16), 0u};
        const unsigned s0_ = __builtin_bit_cast(unsigned, P.slope2) & 0xffff0000u; const float t1_ = P.slope2 - __builtin_bit_cast(float, s0_);
        const unsigned s1_ = __builtin_bit_cast(unsigned, t1_) & 0xffff0000u; const float t2_ = t1_ - __builtin_bit_cast(float, s1_);
        qx.x = (s0_ >> 16) | s1_; qs2 = __builtin_bit_cast(unsigned, t2_) >> 16; }
    float mhat = SWA ? P.sink2 : 0.f, l_reg = (SWA && hi == 0) ? 1.0f : 0.f; f32x16 o[2]; o[0] = f32x16{}; o[1] = f32x16{};
#define FD_QX(t) do { const float c_ = (hi == 0) ? __builtin_fmaf(P.slope2, (float)(kb0 + 64 * (t) - qidx), -mhat) : 0.0f; \
        const unsigned c0_ = __builtin_bit_cast(unsigned, c_) & 0xffff0000u; const float r1_ = c_ - __builtin_bit_cast(float, c0_); \
        const unsigned c1_ = __builtin_bit_cast(unsigned, r1_) & 0xffff0000u; const float r2_ = r1_ - __builtin_bit_cast(float, c1_); \
        const unsigned c2_ = __builtin_bit_cast(unsigned, r2_) & 0xffff0000u; \
        qx.y = qs2 | c0_; qx.z = __builtin_amdgcn_perm(c2_, c1_, 0x07060302u); } while (0)
#define FD_KX(k) __builtin_bit_cast(bf16x8, k)
#define FD_CMASK(P0, P1, t) do { if (!SWA) { const int jb_ = (t) - (NT - 4); if (jb_ >= 0) cmask(P0, P1, jb_, qrel, hi); } } while (0)
#define FD_MW(t) unsigned w0_, w1_; if (SWA) { const int d_ = qidx - kb0 - 64 * (t);        \
            const int lo_ = d_ - 127 < 0 ? 0 : d_ - 127, hi_ = d_ > 63 ? 63 : d_; \
            const unsigned long long m_ = (hi_ >= lo_) ? ((hi_ == 63 ? ~0ull : ((1ull << (hi_ + 1)) - 1ull)) & ~((1ull << lo_) - 1ull)) : 0ull; \
            w0_ = (unsigned)m_ >> (4 * hi); w1_ = (unsigned)(m_ >> 32) >> (4 * hi); } \
        else { w0_ = mlds[((((t) >> 1) & 1) << 8) + 2 * ((t) & 1)] >> (4 * hi); w1_ = mlds[((((t) >> 1) & 1) << 8) + 2 * ((t) & 1) + 1] >> (4 * hi); }
#define FD_AND(X, W, B) do { _Pragma("unroll") for (int e_ = 0; e_ < 4; ++e_) { const int r_ = (B) + e_; \
        X[r_] = and_mask(__builtin_amdgcn_sbfe((int)(W), (r_ & 3) + 8 * (r_ >> 2), 1), X[r_]); } } while (0)
    bool resc = false;
#define FD_RESC() do { if (resc) { asm volatile("s_waitcnt lgkmcnt(0)" ::: "memory"); \
        _Pragma("unroll") for (int d_ = 0; d_ < 2; ++d_) _Pragma("unroll") for (int r = 0; r < 16; ++r) o[d_][r] *= wsf[crow(r, hi)]; } } while (0)
    f32x16 pA0, pA1, pB0, pB1; bf16x8 kf[8];
    int sl_prev = 0, sl_cur = 0, sl_next = SLOTB;
#define FD_ROT() do { sl_prev = sl_cur; sl_cur = sl_next; sl_next = (sl_next == (NSLOT - 1) * SLOTB) ? 0 : sl_next + SLOTB; } while (0)
    FD_DMA_K(2, 2 * SLOTB);
    FD_WAIT_BAR(3);
    FD_QX(0);
    { kload8(kf, kp0);
      pA0 = FD_MFMA(FD_KX(kxA), FD_KX(qx), f32x16{}); pA1 = FD_MFMA(FD_KX(kxB), FD_KX(qx), f32x16{});
#pragma unroll
      for (int d0 = 0; d0 < 4; ++d0) { pA0 = FD_MFMA(kf[2 * d0], qr[d0], pA0); pA1 = FD_MFMA(kf[2 * d0 + 1], qr[d0], pA1); } }
    asm volatile("s_nop 15\n\ts_nop 7" : "+v"(pA0), "+v"(pA1));
    FD_CMASK(pA0, pA1, 0);
    { const float rm = rowmax(pA0, pA1); const float dl = SWA ? __builtin_fmaxf(rm, 0.f) : rm; mhat += dl;
      if (SWA) l_reg *= __builtin_amdgcn_exp2f(-dl);
#pragma unroll
      for (int r = 0; r < 16; ++r) { pA0[r] -= dl; pA1[r] -= dl; }
#pragma unroll
      for (int r = 0; r < 16; ++r) { pA0[r] = __builtin_amdgcn_exp2f(pA0[r]); pA1[r] = __builtin_amdgcn_exp2f(pA1[r]); }
      asm volatile("" : "+v"(pA0), "+v"(pA1)); FD_SBAR();
      FD_MW(0);
      FD_AND(pA0, w0_, 0); FD_AND(pA0, w0_, 4); FD_AND(pA0, w0_, 8); FD_AND(pA0, w0_, 12); FD_AND(pA1, w1_, 0); FD_AND(pA1, w1_, 4); FD_AND(pA1, w1_, 8); FD_AND(pA1, w1_, 12); }
    FD_WAIT_BAR(0);
    FD_DMA_K(3, 0); FD_DMA_V(1, SLOTB);
    FD_ROT();
    kload8(kf, kp0 + sl_cur);
    FD_WAIT_BAR(2);
    v4i16_t vlo[8], vhi[8]; u32x4 pw0, pw1, pw2, pw3;
#define FD_PKW(Pv, B) cvt_pk_bf16(Pv[B], Pv[(B) + 1])
#define FD_PAF(k) __builtin_bit_cast(bf16x8, pw##k)
#define FD_VFR(i) (bf16x8){vlo[i][0], vlo[i][1], vlo[i][2], vlo[i][3], vhi[i][0], vhi[i][1], vhi[i][2], vhi[i][3]}
#define FD_PIN(x) asm volatile("" : "+v"(x))
#define FD_MX3(a, b, c) __builtin_fmaxf(__builtin_fmaxf((a), (b)), (c))
#define FD_GAPA(MF, A0, A1, A2, A3, W0, W1, PW) do { MF; sacc += A0; sacc += A1; sacc += A2; sacc += A3; FD_PIN(sacc); W0; W1; FD_PIN(PW); FD_SBAR(); } while (0)
#define FD_GAPB(MF, X, B, Y, WY, BY) do { MF; X[B] = __builtin_amdgcn_exp2f(X[B]); X[(B) + 1] = __builtin_amdgcn_exp2f(X[(B) + 1]); X[(B) + 2] = __builtin_amdgcn_exp2f(X[(B) + 2]); X[(B) + 3] = __builtin_amdgcn_exp2f(X[(B) + 3]); \
        if ((BY) >= 0) { FD_AND(Y, WY, ((BY) >= 0 ? (BY) : 0)); FD_PIN(Y); } FD_PIN(X); FD_SBAR(); } while (0)
#define FD_VRD(i) do { vlo[i] = vtr(vp_ + (((i) >> 2) * 4096 + ((i) & 3) * 1024)); vhi[i] = vtr(vp_ + (((i) >> 2) * 4096 + ((i) & 3) * 1024 + 512)); } while (0)
#define FD_KRD(G, j) do { if (G) { kload2(kf, kp0 + sl_next, j); FD_SBAR(); } } while (0)
#define FD_STEP(C0, C1, P0, P1, t, GK, GV, GL, GM) do { FD_SBAR(); \
        const lds_cptr vp_ = vp0 + sl_prev; FD_QX(t); FD_MW(t); \
        FD_VRD(0); FD_SBAR(); float sacc = (P0[0] + P0[1]); \
        C0 = FD_MFMA(FD_KX(kxA), FD_KX(qx), f32x16{}); FD_SBAR(); C1 = FD_MFMA(FD_KX(kxB), FD_KX(qx), f32x16{}); FD_SBAR(); \
        FD_GAPA(C0 = FD_MFMA(kf[0], qr[0], C0), P0[2], P0[3], P0[4], P0[5],     pw0[0] = FD_PKW(P0, 0), pw0[1] = FD_PKW(P0, 2), pw0); \
        FD_VRD(4); FD_SBAR(); FD_GAPA(C1 = FD_MFMA(kf[1], qr[0], C1), P0[6], P0[7], P0[8], P0[9],     pw0[2] = FD_PKW(P0, 4), pw0[3] = FD_PKW(P0, 6), pw0); \
        FD_VRD(1); FD_SBAR(); FD_GAPA(C0 = FD_MFMA(kf[2], qr[1], C0), P0[10], P0[11], P0[12], P0[13], pw1[0] = FD_PKW(P0, 8), pw1[1] = FD_PKW(P0, 10), pw1); \
        FD_VRD(5); FD_SBAR(); FD_GAPA(C1 = FD_MFMA(kf[3], qr[1], C1), P0[14], P0[15], P1[0], P1[1],   pw1[2] = FD_PKW(P0, 12), pw1[3] = FD_PKW(P0, 14), pw1); \
        FD_VRD(2); FD_SBAR(); FD_GAPA(C0 = FD_MFMA(kf[4], qr[2], C0), P1[2], P1[3], P1[4], P1[5],     pw2[0] = FD_PKW(P1, 0), pw2[1] = FD_PKW(P1, 2), pw2); \
        FD_VRD(6); FD_SBAR(); FD_GAPA(C1 = FD_MFMA(kf[5], qr[2], C1), P1[6], P1[7], P1[8], P1[9],     pw2[2] = FD_PKW(P1, 4), pw2[3] = FD_PKW(P1, 6), pw2); \
        FD_VRD(3); FD_SBAR(); FD_GAPA(C0 = FD_MFMA(kf[6], qr[3], C0), P1[10], P1[11], P1[12], P1[13], pw3[0] = FD_PKW(P1, 8), pw3[1] = FD_PKW(P1, 10), pw3); \
        FD_VRD(7); FD_SBAR(); FD_GAPA(C1 = FD_MFMA(kf[7], qr[3], C1), P1[14], P1[15], 0.f, 0.f,       pw3[2] = FD_PKW(P1, 12), pw3[3] = FD_PKW(P1, 14), pw3); \
        l_reg += sacc; \
        if (GK) { FD_DMA_K((t) + 3, sl_cur); } if (GV) { FD_DMA_V((t) + 1, sl_next); } if (!SWA && (GM)) { FD_DMA_M((t) + 2); } \
        FD_CMASK(C0, C1, t); \
        { float a = FD_MX3(C0[0], C0[1], C1[0]), bb = FD_MX3(C0[2], C0[3], C1[1]); a = FD_MX3(a, C1[2], C1[3]); \
          _Pragma("unroll") for (int r = 4; r < 16; r += 4) { a = FD_MX3(a, C0[r], C0[r + 1]); bb = FD_MX3(bb, C0[r + 2], C0[r + 3]); a = FD_MX3(a, C1[r], C1[r + 1]); bb = FD_MX3(bb, C1[r + 2], C1[r + 3]); } \
          const float rm = fa::xhalf_max(__builtin_fmaxf(a, bb)); \
          resc = false; \
          if (__builtin_expect(__any(rm > 8.0f), 0)) { const float dl = __builtin_fmaxf(rm, 0.f); mhat += dl; \
              _Pragma("unroll") for (int r = 0; r < 16; ++r) { C0[r] -= dl; C1[r] -= dl; } \
              const float f = __builtin_amdgcn_exp2f(-dl); l_reg *= f; if (hi == 0) wsf[r32] = f; resc = true; } } \
        FD_SBAR(); \
        FD_GAPB(o[0] = FD_MFMA(FD_PAF(0), FD_VFR(0), o[0]), C0, 0, C0, w0_, -1); \
        FD_GAPB(o[1] = FD_MFMA(FD_PAF(0), FD_VFR(4), o[1]), C0, 4, C0, w0_, 0); \
        FD_KRD(GL, 0); FD_GAPB(o[0] = FD_MFMA(FD_PAF(1), FD_VFR(1), o[0]), C0, 8, C0, w0_, 4); \
        FD_KRD(GL, 1); FD_GAPB(o[1] = FD_MFMA(FD_PAF(1), FD_VFR(5), o[1]), C0, 12, C0, w0_, 8); \
        FD_KRD(GL, 2); FD_GAPB(o[0] = FD_MFMA(FD_PAF(2), FD_VFR(2), o[0]), C1, 0, C0, w0_, 12); \
        FD_KRD(GL, 3); FD_GAPB(o[1] = FD_MFMA(FD_PAF(2), FD_VFR(6), o[1]), C1, 4, C1, w1_, 0); \
        FD_GAPB(o[0] = FD_MFMA(FD_PAF(3), FD_VFR(3), o[0]), C1, 8, C1, w1_, 4); \
        FD_GAPB(o[1] = FD_MFMA(FD_PAF(3), FD_VFR(7), o[1]), C1, 12, C1, w1_, 8); \
        FD_AND(C1, w1_, 12); FD_PIN(C1); FD_SBAR(); \
        } while (0)
#define FD_ENDW(n_) do { if ((n_) == 3) { FD_WAIT_BAR(3); } else if ((n_) == 2) { FD_WAIT_BAR(2); } else if ((n_) == 1) { FD_WAIT_BAR(1); } else { FD_WAIT_BAR(0); } } while (0)
    int t = 1;
#undef FD_CMASK
#define FD_CMASK(P0, P1, t) do { } while (0)
    for (; t + 5 < NT; t += 2) {
        FD_STEP(pB0, pB1, pA0, pA1, t, true, true, true, false);     FD_WAIT_BAR(2); FD_RESC(); FD_ROT();
        FD_STEP(pA0, pA1, pB0, pB1, t + 1, true, true, true, true);  if (SWA) { FD_WAIT_BAR(2); } else { FD_WAIT_BAR(3); } FD_RESC(); FD_ROT();
    }
#undef FD_CMASK
#define FD_CMASK(P0, P1, t) do { const int jb_ = (t) - (NT - 4); if (jb_ >= 0) cmask(P0, P1, jb_, qrel, hi); } while (0)
    for (; t + 1 < NT; t += 2) {
        { const bool gk = t + 3 < NT, gv = t + 1 < NT; FD_STEP(pB0, pB1, pA0, pA1, t, gk, gv, gv, false); const int n_ = (t + 2 < NT) ? ((int)gk + (int)gv) : 0; FD_ENDW(n_); FD_RESC(); FD_ROT(); }
        { const bool gk = t + 4 < NT, gv = t + 2 < NT, gm = t + 3 < NT; FD_STEP(pA0, pA1, pB0, pB1, t + 1, gk, gv, gv, gm); const int n_ = (t + 3 < NT) ? ((int)gk + (int)gv + (SWA ? 0 : (int)gm)) : 0; FD_ENDW(n_); FD_RESC(); FD_ROT(); }
    }
    FD_STEP(pB0, pB1, pA0, pA1, NT - 1, false, false, false, false); FD_RESC();
    { float sacc = pB0[0] + pB0[1];
#pragma unroll
      for (int r = 2; r < 16; ++r) sacc += pB0[r];
#pragma unroll
      for (int r = 0; r < 16; ++r) sacc += pB1[r];
      l_reg += sacc;
      pw0 = (u32x4){FD_PKW(pB0, 0), FD_PKW(pB0, 2), FD_PKW(pB0, 4), FD_PKW(pB0, 6)}; pw1 = (u32x4){FD_PKW(pB0, 8), FD_PKW(pB0, 10), FD_PKW(pB0, 12), FD_PKW(pB0, 14)};
      pw2 = (u32x4){FD_PKW(pB1, 0), FD_PKW(pB1, 2), FD_PKW(pB1, 4), FD_PKW(pB1, 6)}; pw3 = (u32x4){FD_PKW(pB1, 8), FD_PKW(pB1, 10), FD_PKW(pB1, 12), FD_PKW(pB1, 14)};
      FD_SBAR();
      const lds_cptr vp_ = vp0 + sl_cur;
#pragma unroll
      for (int i = 0; i < 8; ++i) FD_VRD(i);
      o[0] = FD_MFMA(FD_PAF(0), FD_VFR(0), o[0]); o[1] = FD_MFMA(FD_PAF(0), FD_VFR(4), o[1]); o[0] = FD_MFMA(FD_PAF(1), FD_VFR(1), o[0]); o[1] = FD_MFMA(FD_PAF(1), FD_VFR(5), o[1]);
      o[0] = FD_MFMA(FD_PAF(2), FD_VFR(2), o[0]); o[1] = FD_MFMA(FD_PAF(2), FD_VFR(6), o[1]); o[0] = FD_MFMA(FD_PAF(3), FD_VFR(3), o[0]); o[1] = FD_MFMA(FD_PAF(3), FD_VFR(7), o[1]); }
    { float la_ = l_reg, lb_ = l_reg; asm volatile("s_nop 1\n\tv_permlane32_swap_b32 %0, %1\n\ts_nop 1" : "+v"(la_), "+v"(lb_)); l_reg = la_ + lb_; }
    if (hi == 0) wsf[32 + r32] = l_reg;
    asm volatile("s_waitcnt lgkmcnt(0)" ::: "memory");
    LAS bf16_t* stg = (LAS bf16_t*)(shm + LDS_OST) + wid * 2048;
#pragma unroll
    for (int r = 0; r < 16; ++r) { const int orow = crow(r, hi); const float rl = __builtin_amdgcn_rcpf(wsf[32 + orow]);
        stg[orow * 64 + r32] = (bf16_t)f2bf(o[0][r] * rl); stg[orow * 64 + 32 + r32] = (bf16_t)f2bf(o[1][r] * rl); }
    asm volatile("s_waitcnt lgkmcnt(0)" ::: "memory");
    bf16_t* Ow = P.O + (rowbase + q0 + 32 * wid) * (long)P.ldo;
#pragma unroll
    for (int i = 0; i < 4; ++i) { const int row = i * 8 + (lane >> 3), ch = lane & 7; *(u32x4*)(Ow + (long)row * P.ldo + ch * 8) = *(const LAS u32x4*)(stg + row * 64 + ch * 8); }
    asm volatile("s_waitcnt lgkmcnt(0)\n\ts_barrier" ::: "memory");
#undef FD_DMA_K
#undef FD_DMA_V
#undef FD_DMA_M
#undef FD_QX
#undef FD_KX
#undef FD_CMASK
#undef FD_MW
#undef FD_AND
#undef FD_RESC
#undef FD_ROT
#undef FD_PKW
#undef FD_PAF
#undef FD_VFR
#undef FD_PIN
#undef FD_MX3
#undef FD_GAPA
#undef FD_GAPB
#undef FD_VRD
#undef FD_KRD
#undef FD_STEP
#undef FD_ENDW
}
#undef FD_SBAR
#undef FD_WAIT_BAR
#undef FD_MFMA
}

namespace fm {
using fa::lds_cptr; using fa::v4i16_t; using fa::vtr; using fa::glds16; using fa::crow;
constexpr int NSLOT = 3, SLOTK = 12288, SLOTV = 8192, LDS_K = 0, LDS_V = NSLOT * SLOTK, LDS_WS = LDS_V + NSLOT * SLOTV, LDS_OST = LDS_WS + 8 * 256, LDS_TOTAL = LDS_OST + 8 * 4096;
static_assert(LDS_TOTAL <= LDSCTL_OFF, "mla unit LDS");
#define FM_SBAR() __builtin_amdgcn_sched_barrier(0)
#define FM_WAIT_BAR(N) asm volatile("s_waitcnt vmcnt(" #N ") lgkmcnt(0)\n\ts_barrier" ::: "memory")
#define FM_MFMA(a, b, c) __builtin_amdgcn_mfma_f32_32x32x16_bf16(a, b, c, 0, 0, 0)
__device__ __forceinline__ void kload2(bf16x8* kf, lds_cptr kp, int j) { kf[2 * j] = *(const LAS bf16x8*)(kp + j * 2048); kf[2 * j + 1] = *(const LAS bf16x8*)(kp + j * 2048 + 512); }

__device__ __forceinline__ void unit(const Frame& F, const fa::Ptrs& P, int b, int qb) {
    const int lane = F.lane, r32 = lane & 31, hi = lane >> 5, wid = F.wave;
    const long rowbase = (long)b * SEQ; const int q0 = qb * 256, qrel = wid * 32 + r32, qidx = q0 + qrel;
    LAS unsigned char* shm = F.lds; const unsigned lds0 = (unsigned)(uintptr_t)shm;
    LAS float* wsf = (LAS float*)(shm + LDS_WS) + wid * 64;
    const bf16_t* ksrc = P.K + (rowbase + lane) * (long)P.ldk + wid * 8;
    const bf16_t* krsrc = P.KR + (rowbase + lane) * 32L + (wid & 3) * 8;
    const bf16_t* vsrc = P.V + (rowbase + 16 * (wid & 3) + (lane >> 2)) * (long)P.ldv + (wid >> 2) * 32 + (lane & 3) * 8;
    const unsigned kdst = lds0 + LDS_K + wid * 1024, krdst = lds0 + LDS_K + (8 + (wid & 3)) * 1024, vdst = lds0 + LDS_V + wid * 1024;
#define FM_DMA_K(t, slot) do { glds16(ksrc + (long)(t) * 64 * P.ldk, (unsigned)__builtin_amdgcn_readfirstlane(kdst + (slot))); glds16(krsrc + (long)(t) * 64 * 32, (unsigned)__builtin_amdgcn_readfirstlane(krdst + (slot))); } while (0)
#define FM_DMA_V(t, slot) glds16(vsrc + (long)(t) * 64 * P.ldv, (unsigned)__builtin_amdgcn_readfirstlane(vdst + (slot)))
    const lds_cptr shm3 = (lds_cptr)shm; const lds_cptr kp0 = shm3 + LDS_K + hi * 1024 + r32 * 16; const lds_cptr vp0 = shm3 + LDS_V + ((lane >> 4) & 1) * 32 + (lane & 3) * 8 + (4 * hi + ((lane & 15) >> 2)) * 64;
    const int NT = (q0 + 256) / 64;
    FM_DMA_K(0, 0); FM_DMA_V(0, 0); FM_DMA_K(1, SLOTK);
    bf16x8 qr[6];
    { const bf16_t* Qw = P.Q + (rowbase + qidx) * (long)P.ldq + hi * 8;
#pragma unroll
      for (int d0 = 0; d0 < 6; ++d0) qr[d0] = *(const bf16x8*)(Qw + d0 * 16); }
    float mhat = 0.f, l_reg = 0.f; f32x16 o[2]; o[0] = f32x16{}; o[1] = f32x16{};
#define FM_CMASK(P0, P1, t) do { const int jb_ = (t) - (NT - 4); if (jb_ >= 0) fd::cmask(P0, P1, jb_, qrel, hi); } while (0)
    bool resc = false;
#define FM_RESC() do { if (resc) { asm volatile("s_waitcnt lgkmcnt(0)" ::: "memory"); \
        _Pragma("unroll") for (int d_ = 0; d_ < 2; ++d_) _Pragma("unroll") for (int r = 0; r < 16; ++r) o[d_][r] *= wsf[crow(r, hi)]; } } while (0)
    f32x16 pA0, pA1, pB0, pB1; bf16x8 kf[12];
    int kl_prev = 0, kl_cur = 0, kl_next = SLOTK, vl_prev = 0, vl_cur = 0, vl_next = SLOTV;
#define FM_ROT() do { kl_prev = kl_cur; kl_cur = kl_next; kl_next = (kl_next == (NSLOT - 1) * SLOTK) ? 0 : kl_next + SLOTK; vl_prev = vl_cur; vl_cur = vl_next; vl_next = (vl_next == (NSLOT - 1) * SLOTV) ? 0 : vl_next + SLOTV; } while (0)
    FM_DMA_K(2, 2 * SLOTK);
    FM_WAIT_BAR(5);
#pragma unroll
    for (int j = 0; j < 6; ++j) kload2(kf, kp0, j);
    pA0 = FM_MFMA(kf[0], qr[0], f32x16{}); pA1 = FM_MFMA(kf[1], qr[0], f32x16{});
#pragma unroll
    for (int d0 = 1; d0 < 6; ++d0) { pA0 = FM_MFMA(kf[2 * d0], qr[d0], pA0); pA1 = FM_MFMA(kf[2 * d0 + 1], qr[d0], pA1); }
    asm volatile("s_nop 15\n\ts_nop 7" : "+v"(pA0), "+v"(pA1));
    FM_CMASK(pA0, pA1, 0);
    { const float rm = fd::rowmax(pA0, pA1); const float dl = rm; mhat += dl;
#pragma unroll
      for (int r = 0; r < 16; ++r) { pA0[r] -= dl; pA1[r] -= dl; }
#pragma unroll
      for (int r = 0; r < 16; ++r) { pA0[r] = __builtin_amdgcn_exp2f(pA0[r]); pA1[r] = __builtin_amdgcn_exp2f(pA1[r]); } }
    FM_WAIT_BAR(0);
    FM_DMA_K(3, 0); FM_DMA_V(1, SLOTV);
    FM_ROT();
#pragma unroll
    for (int j = 0; j < 6; ++j) kload2(kf, kp0 + kl_cur, j);
    FM_WAIT_BAR(3);
    v4i16_t vlo[8], vhi[8]; u32x4 pw[4];
#define FM_VFR(i) (bf16x8){vlo[i][0], vlo[i][1], vlo[i][2], vlo[i][3], vhi[i][0], vhi[i][1], vhi[i][2], vhi[i][3]}
#define FM_PIN(x) asm volatile("" : "+v"(x))
#define FM_MX3(a, b, c) __builtin_fmaxf(__builtin_fmaxf((a), (b)), (c))
#define FM_VRD(i) do { vlo[i] = vtr(vp_ + (((i) >> 2) * 4096 + ((i) & 3) * 1024)); vhi[i] = vtr(vp_ + (((i) >> 2) * 4096 + ((i) & 3) * 1024 + 512)); } while (0)
#define FM_PE(P0, P1, e) (((e) < 16) ? P0[(e) & 15] : P1[(e) & 15])
#define FM_STEP(C0, C1, P0, P1, t, GK, GV, GL) do { FM_SBAR(); \
        const lds_cptr vp_ = vp0 + vl_prev; float sacc = (P0[0] + P0[1]); \
        _Pragma("unroll") for (int i_ = 0; i_ < 12; ++i_) { \
            if (i_ < 8) { const int vi_ = (i_ >> 1) + 4 * (i_ & 1); FM_VRD(vi_); FM_SBAR(); } \
            if (i_ == 0) C0 = FM_MFMA(kf[0], qr[0], f32x16{}); else if (i_ == 1) C1 = FM_MFMA(kf[1], qr[0], f32x16{}); \
            else if (i_ & 1) C1 = FM_MFMA(kf[i_], qr[i_ >> 1], C1); else C0 = FM_MFMA(kf[i_], qr[i_ >> 1], C0); \
            _Pragma("unroll") for (int e_ = 2 + (30 * i_) / 12; e_ < 2 + (30 * (i_ + 1)) / 12; ++e_) sacc += FM_PE(P0, P1, e_); \
            FM_PIN(sacc); \
            _Pragma("unroll") for (int j_ = (16 * i_) / 12; j_ < (16 * (i_ + 1)) / 12; ++j_) { pw[j_ >> 2][j_ & 3] = cvt_pk_bf16(FM_PE(P0, P1, 2 * j_), FM_PE(P0, P1, 2 * j_ + 1)); FM_PIN(pw[j_ >> 2]); } \
            FM_SBAR(); } \
        l_reg += sacc; \
        if (GK) { FM_DMA_K((t) + 3, kl_cur); } if (GV) { FM_DMA_V((t) + 1, vl_next); } \
        FM_CMASK(C0, C1, t); \
        { float a = FM_MX3(C0[0], C0[1], C1[0]), bb = FM_MX3(C0[2], C0[3], C1[1]); a = FM_MX3(a, C1[2], C1[3]); \
          _Pragma("unroll") for (int r = 4; r < 16; r += 4) { a = FM_MX3(a, C0[r], C0[r + 1]); bb = FM_MX3(bb, C0[r + 2], C0[r + 3]); a = FM_MX3(a, C1[r], C1[r + 1]); bb = FM_MX3(bb, C1[r + 2], C1[r + 3]); } \
          const float rm = fa::xhalf_max(__builtin_fmaxf(a, bb)); \
          resc = false; \
          if (__builtin_expect(__any(rm > mhat + 8.0f), 0)) { const float dl = (rm > mhat + 8.0f) ? rm - mhat : 0.f; mhat += dl;        \
              const float f = __builtin_amdgcn_exp2f(-dl); l_reg *= f; if (hi == 0) wsf[r32] = f; resc = true; } } \
        FM_SBAR(); \
        _Pragma("unroll") for (int j_ = 0; j_ < 8; ++j_) { \
            if ((GL) && j_ >= 1 && j_ <= 6) { kload2(kf, kp0 + kl_next, j_ - 1); FM_SBAR(); } \
            if (j_ & 1) o[1] = FM_MFMA(__builtin_bit_cast(bf16x8, pw[j_ >> 1]), FM_VFR(4 + (j_ >> 1)), o[1]); else o[0] = FM_MFMA(__builtin_bit_cast(bf16x8, pw[j_ >> 1]), FM_VFR(j_ >> 1), o[0]); \
            if (j_ < 4) { C0[4 * j_] = __builtin_amdgcn_exp2f(C0[4 * j_] - mhat); C0[4 * j_ + 1] = __builtin_amdgcn_exp2f(C0[4 * j_ + 1] - mhat); C0[4 * j_ + 2] = __builtin_amdgcn_exp2f(C0[4 * j_ + 2] - mhat); C0[4 * j_ + 3] = __builtin_amdgcn_exp2f(C0[4 * j_ + 3] - mhat); FM_PIN(C0); } \
            else { C1[4 * (j_ & 3)] = __builtin_amdgcn_exp2f(C1[4 * (j_ & 3)] - mhat); C1[4 * (j_ & 3) + 1] = __builtin_amdgcn_exp2f(C1[4 * (j_ & 3) + 1] - mhat); C1[4 * (j_ & 3) + 2] = __builtin_amdgcn_exp2f(C1[4 * (j_ & 3) + 2] - mhat); C1[4 * (j_ & 3) + 3] = __builtin_amdgcn_exp2f(C1[4 * (j_ & 3) + 3] - mhat); FM_PIN(C1); } \
            FM_SBAR(); } \
        } while (0)
#define FM_ENDW(n_) do { if ((n_) == 3) { FM_WAIT_BAR(3); } else if ((n_) == 2) { FM_WAIT_BAR(2); } else if ((n_) == 1) { FM_WAIT_BAR(1); } else { FM_WAIT_BAR(0); } } while (0)
    int t = 1;
#undef FM_CMASK
#define FM_CMASK(P0, P1, t) do { } while (0)
    for (; t + 5 < NT; t += 2) {
        FM_STEP(pB0, pB1, pA0, pA1, t, true, true, true);     FM_WAIT_BAR(3); FM_RESC(); FM_ROT();
        FM_STEP(pA0, pA1, pB0, pB1, t + 1, true, true, true); FM_WAIT_BAR(3); FM_RESC(); FM_ROT();
    }
#undef FM_CMASK
#define FM_CMASK(P0, P1, t) do { const int jb_ = (t) - (NT - 4); if (jb_ >= 0) fd::cmask(P0, P1, jb_, qrel, hi); } while (0)
    for (; t + 1 < NT; t += 2) {
        { const bool gk = t + 3 < NT, gv = t + 1 < NT; FM_STEP(pB0, pB1, pA0, pA1, t, gk, gv, gv); const int n_ = (t + 2 < NT) ? (2 * (int)gk + (int)gv) : 0; FM_ENDW(n_); FM_RESC(); FM_ROT(); }
        { const bool gk = t + 4 < NT, gv = t + 2 < NT; FM_STEP(pA0, pA1, pB0, pB1, t + 1, gk, gv, gv); const int n_ = (t + 3 < NT) ? (2 * (int)gk + (int)gv) : 0; FM_ENDW(n_); FM_RESC(); FM_ROT(); }
    }
    FM_STEP(pB0, pB1, pA0, pA1, NT - 1, false, false, false); FM_RESC();
    { float sacc = pB0[0] + pB0[1];
#pragma unroll
      for (int r = 2; r < 16; ++r) sacc += pB0[r];
#pragma unroll
      for (int r = 0; r < 16; ++r) sacc += pB1[r];
      l_reg += sacc;
#pragma unroll
      for (int j = 0; j < 16; ++j) pw[j >> 2][j & 3] = cvt_pk_bf16(FM_PE(pB0, pB1, 2 * j), FM_PE(pB0, pB1, 2 * j + 1));
      FM_SBAR();
      const lds_cptr vp_ = vp0 + vl_cur;
#pragma unroll
      for (int i = 0; i < 8; ++i) FM_VRD(i);
#pragma unroll
      for (int k = 0; k < 4; ++k) { o[0] = FM_MFMA(__builtin_bit_cast(bf16x8, pw[k]), FM_VFR(k), o[0]); o[1] = FM_MFMA(__builtin_bit_cast(bf16x8, pw[k]), FM_VFR(4 + k), o[1]); } }
    { float la_ = l_reg, lb_ = l_reg; asm volatile("s_nop 1\n\tv_permlane32_swap_b32 %0, %1\n\ts_nop 1" : "+v"(la_), "+v"(lb_)); l_reg = la_ + lb_; }
    if (hi == 0) wsf[32 + r32] = l_reg;
    asm volatile("s_waitcnt lgkmcnt(0)" ::: "memory");
    LAS bf16_t* stg = (LAS bf16_t*)(shm + LDS_OST) + wid * 2048;
#pragma unroll
    for (int r = 0; r < 16; ++r) { const int orow = crow(r, hi); const float rl = __builtin_amdgcn_rcpf(wsf[32 + orow]);
        stg[orow * 64 + r32] = (bf16_t)f2bf(o[0][r] * rl); stg[orow * 64 + 32 + r32] = (bf16_t)f2bf(o[1][r] * rl); }
    asm volatile("s_waitcnt lgkmcnt(0)" ::: "memory");
    bf16_t* Ow = P.O + (rowbase + q0 + 32 * wid) * (long)P.ldo;
#pragma unroll
    for (int i = 0; i < 4; ++i) { const int row = i * 8 + (lane >> 3), ch = lane & 7; *(u32x4*)(Ow + (long)row * P.ldo + ch * 8) = *(const LAS u32x4*)(stg + row * 64 + ch * 8); }
    asm volatile("s_waitcnt lgkmcnt(0)\n\ts_barrier" ::: "memory");
#undef FM_DMA_K
#undef FM_DMA_V
#undef FM_CMASK
#undef FM_RESC
#undef FM_ROT
#undef FM_VFR
#undef FM_PIN
#undef FM_MX3
#undef FM_VRD
#undef FM_PE
#undef FM_STEP
#undef FM_ENDW
}
#undef FM_SBAR
#undef FM_WAIT_BAR
#undef FM_MFMA
}


namespace ix {
__device__ __forceinline__ unsigned ordf(float f) { const unsigned u = __builtin_bit_cast(unsigned, f); return u ^ ((u >> 31) ? 0xFFFFFFFFu : 0x80000000u); }
constexpr int L_HIST = EXTRA_OFF, L_MK = EXTRA_OFF + 16384, L_CV = L_MK + 4096, L_CI = L_CV + 1024, L_RED = L_CI + 1024, L_SELW = L_RED + 256, L_FLAG = L_SELW + 64;
struct Pre { bf16x8 qi[4]; float w[2][8]; bf16x8 kbA[4], kbB[4]; };
__device__ __forceinline__ void preload(const Frame& F, const bf16_t* Z, const bf16_t* KIT, int b, int qu, Pre& pre) {
    const int lane = F.lane, r32 = lane & 31, hi = lane >> 5, wid = F.wave;
    const long rowbase = (long)b * SEQ; const int t0 = 4 * qu, ntile = (t0 >> 5) + 1, npair = (ntile + 1) >> 1;
    { const int rho = r32, hq = (rho >> 2) & 1, gq = rho >> 3, iq = rho & 3;
      const bf16_t* qp = Z + (rowbase + t0 + 2 * hq + (gq >> 1)) * (long)ZP + ZC_IQ + 64 * (4 * (gq & 1) + iq) + 8 * hi;
#pragma unroll
      for (int ks = 0; ks < 4; ++ks) pre.qi[ks] = *(const bf16x8*)(qp + 16 * ks);
#pragma unroll
      for (int q2 = 0; q2 < 2; ++q2) { const u32x4 ww = *(const u32x4*)(Z + (rowbase + t0 + 2 * hi + q2) * (long)ZP + ZC_IW);
          pre.w[q2][0] = bf_lo(ww.x); pre.w[q2][1] = bf_hi(ww.x); pre.w[q2][2] = bf_lo(ww.y); pre.w[q2][3] = bf_hi(ww.y); pre.w[q2][4] = bf_lo(ww.z); pre.w[q2][5] = bf_hi(ww.z); pre.w[q2][6] = bf_lo(ww.w); pre.w[q2][7] = bf_hi(ww.w); } }
    const bf16_t* kbase = KIT + (size_t)(rowbase >> 5) * 2048 + hi * 256 + r32 * 8;
    if (wid < npair) { const bf16_t* kp = kbase + (size_t)(2 * wid) * 2048;
#pragma unroll
        for (int ks = 0; ks < 4; ++ks) { pre.kbA[ks] = *(const bf16x8*)(kp + 512 * ks); pre.kbB[ks] = *(const bf16x8*)(kp + 2048 + 512 * ks); } }
    else {
#pragma unroll
        for (int ks = 0; ks < 4; ++ks) { pre.kbA[ks] = bf16x8{}; pre.kbB[ks] = bf16x8{}; } }
}
__device__ __forceinline__ float relu1(float x) { const int i = __builtin_bit_cast(int, x); return __builtin_bit_cast(float, i > 0 ? i : 0); }
#define IX_BAR() asm volatile("s_waitcnt lgkmcnt(0)\n\ts_barrier" ::: "memory")
__device__ __forceinline__ void unit(const Frame& F, const bf16_t* Z, const bf16_t* KIT, unsigned* MK, int b, int qu, Pre& pre, bool has_next, int nb, int nqu) {
    const int lane = F.lane, r32 = lane & 31, hi = lane >> 5, wid = F.wave;
    const long rowbase = (long)b * SEQ; const int t0 = 4 * qu, ntile = (t0 >> 5) + 1, nk32 = 32 * ntile, nblk = (nk32 + 63) >> 6;
    LAS float* sc = (LAS float*)F.lds;
    LAS unsigned* hist = (LAS unsigned*)(F.lds + L_HIST);
    LAS unsigned* mk = (LAS unsigned*)(F.lds + L_MK);
    LAS float* cval = (LAS float*)(F.lds + L_CV); LAS unsigned* cidx = (LAS unsigned*)(F.lds + L_CI);
    LAS float* red = (LAS float*)(F.lds + L_RED);
    LAS unsigned* selw = (LAS unsigned*)(F.lds + L_SELW);
    LAS unsigned* flag = (LAS unsigned*)(F.lds + L_FLAG);
    bf16x8 qi[4]; float w[2][8];
#pragma unroll
    for (int ks = 0; ks < 4; ++ks) qi[ks] = pre.qi[ks];
#pragma unroll
    for (int q2 = 0; q2 < 2; ++q2)
#pragma unroll
        for (int e = 0; e < 8; ++e) w[q2][e] = pre.w[q2][e];
    float vmaxA = -INFINITY, vmaxB = -INFINITY, vminA = INFINITY, vminB = INFINITY;
    bf16x8 kq[2][8];
    const int npair = (ntile + 1) >> 1;
    const bf16_t* kbase = KIT + (size_t)(rowbase >> 5) * 2048 + hi * 256 + r32 * 8;
#pragma unroll
    for (int ks = 0; ks < 4; ++ks) { kq[0][ks] = pre.kbA[ks]; kq[0][4 + ks] = pre.kbB[ks]; }
#define IX_LOADP(BUF, PP) do { const bf16_t* kp_ = kbase + (size_t)(2 * (PP)) * 2048; \
        _Pragma("unroll") for (int ks = 0; ks < 4; ++ks) { kq[BUF][ks] = *(const bf16x8*)(kp_ + 512 * ks); kq[BUF][4 + ks] = *(const bf16x8*)(kp_ + 2048 + 512 * ks); } } while (0)
    if (wid + NWAVES < npair) IX_LOADP(1, wid + NWAVES);
    else {
#pragma unroll
        for (int ks = 0; ks < 8; ++ks) kq[1][ks] = bf16x8{}; }
#define IX_ELEM(D, e, sa, sb) do { const float ra_ = relu1(D[e]), rb_ = relu1(D[8 + (e)]); sa = __builtin_fmaf(w[0][e], ra_, sa); sb = __builtin_fmaf(w[1][e], rb_, sb); } while (0)
#define IX_TAIL(sa, sb, S0) do { const int s = (S0) + r32;                       \
        if (s > t0 + 2 * hi) sa = -INFINITY; else { vmaxA = __builtin_fmaxf(vmaxA, sa); vminA = __builtin_fminf(vminA, sa); } \
        if (s > t0 + 2 * hi + 1) sb = -INFINITY; else { vmaxB = __builtin_fmaxf(vmaxB, sb); vminB = __builtin_fminf(vminB, sb); } \
        sc[(2 * hi) * 8192 + s] = sa; sc[(2 * hi + 1) * 8192 + s] = sb; } while (0)
#define IX_PIN2(x, y) asm volatile("" : "+v"(x), "+v"(y))
#define IX_MF(a, b, c) __builtin_amdgcn_mfma_f32_32x32x16_bf16(a, b, c, 0, 0, 0)
#define IX_GAP(MF, D, e0, sa, sb) do { MF; IX_ELEM(D, e0, sa, sb); IX_ELEM(D, (e0) + 1, sa, sb); IX_PIN2(sa, sb); __builtin_amdgcn_sched_barrier(0); } while (0)
#define IX_PIPE(cA, cB, nA, nB, KQ, P, HASN) do { const int s0_ = 64 * (P); float sa = 0.f, sb = 0.f; __builtin_amdgcn_sched_barrier(0); \
        if (HASN) { \
            IX_GAP(nA = IX_MF(qi[0], KQ[0], f32x16{}), cA, 0, sa, sb); IX_GAP(nB = IX_MF(qi[0], KQ[4], f32x16{}), cA, 2, sa, sb); \
            IX_GAP(nA = IX_MF(qi[1], KQ[1], nA), cA, 4, sa, sb);       IX_GAP(nB = IX_MF(qi[1], KQ[5], nB), cA, 6, sa, sb); \
            IX_TAIL(sa, sb, s0_); sa = 0.f; sb = 0.f; __builtin_amdgcn_sched_barrier(0); \
            IX_GAP(nA = IX_MF(qi[2], KQ[2], nA), cB, 0, sa, sb);       IX_GAP(nB = IX_MF(qi[2], KQ[6], nB), cB, 2, sa, sb); \
            IX_GAP(nA = IX_MF(qi[3], KQ[3], nA), cB, 4, sa, sb);       IX_GAP(nB = IX_MF(qi[3], KQ[7], nB), cB, 6, sa, sb); \
        } else { \
            IX_ELEM(cA, 0, sa, sb); IX_ELEM(cA, 1, sa, sb); IX_ELEM(cA, 2, sa, sb); IX_ELEM(cA, 3, sa, sb); IX_ELEM(cA, 4, sa, sb); IX_ELEM(cA, 5, sa, sb); IX_ELEM(cA, 6, sa, sb); IX_ELEM(cA, 7, sa, sb); \
            IX_TAIL(sa, sb, s0_); sa = 0.f; sb = 0.f; \
            IX_ELEM(cB, 0, sa, sb); IX_ELEM(cB, 1, sa, sb); IX_ELEM(cB, 2, sa, sb); IX_ELEM(cB, 3, sa, sb); IX_ELEM(cB, 4, sa, sb); IX_ELEM(cB, 5, sa, sb); IX_ELEM(cB, 6, sa, sb); IX_ELEM(cB, 7, sa, sb); \
        } \
        if (s0_ + 32 < nk32) IX_TAIL(sa, sb, s0_ + 32); __builtin_amdgcn_sched_barrier(0); } while (0)
    f32x16 dA = {}, dB = {}, eA = {}, eB = {};
    if (wid < npair) {
#pragma unroll
        for (int ks = 0; ks < 4; ++ks) { dA = IX_MF(qi[ks], kq[0][ks], dA); dB = IX_MF(qi[ks], kq[0][4 + ks], dB); }
        if (wid + 2 * NWAVES < npair) IX_LOADP(0, wid + 2 * NWAVES);
    }
    for (int p0_ = wid; p0_ < npair; p0_ += 2 * NWAVES) {
        { const int p = p0_, pn = p + NWAVES; const bool hn = pn < npair;
          IX_PIPE(dA, dB, eA, eB, kq[1], p, hn); if (pn + 2 * NWAVES < npair) IX_LOADP(1, pn + 2 * NWAVES); }
        { const int p = p0_ + NWAVES, pn = p + NWAVES; if (p < npair) { const bool hn = pn < npair;
          IX_PIPE(eA, eB, dA, dB, kq[0], p, hn); if (pn + 2 * NWAVES < npair) IX_LOADP(0, pn + 2 * NWAVES); } }
    }
#undef IX_LOADP
#undef IX_ELEM
#undef IX_TAIL
#undef IX_PIN2
#undef IX_MF
#undef IX_GAP
#undef IX_PIPE
    if (has_next) preload(F, Z, KIT, nb, nqu, pre);
    const bool need_sel = (t0 + 4 > 256);
    if (need_sel) {
#pragma unroll
        for (int o = 1; o < 32; o <<= 1) { vmaxA = __builtin_fmaxf(vmaxA, __shfl_xor(vmaxA, o)); vmaxB = __builtin_fmaxf(vmaxB, __shfl_xor(vmaxB, o));
                                           vminA = __builtin_fminf(vminA, __shfl_xor(vminA, o)); vminB = __builtin_fminf(vminB, __shfl_xor(vminB, o)); }
        if (r32 == 0) { red[wid * 8 + 2 * hi] = vmaxA; red[wid * 8 + 2 * hi + 1] = vmaxB; red[wid * 8 + 4 + 2 * hi] = vminA; red[wid * 8 + 5 + 2 * hi] = vminB; }
        hist[F.tid] = 0u; hist[F.tid + 512] = 0u; hist[F.tid + 1024] = 0u; hist[F.tid + 1536] = 0u; hist[F.tid + 2048] = 0u; hist[F.tid + 2560] = 0u; hist[F.tid + 3072] = 0u; hist[F.tid + 3584] = 0u;
        if (F.tid < 16) selw[F.tid] = 0u;
        if (F.tid == 0) flag[0] = 0u;
    }
    IX_BAR();
#if defined(DBG_DSA_SCORES)
    { float* dump = (float*)(F.wsp(WS_R2 + 56 * MiB));
      for (int qq = 0; qq < 4; ++qq) { const int tt = t0 + qq; int slot = -1;
          if (tt == 256) slot = 0; if (tt == 257) slot = 1; if (tt == 700) slot = 2; if (tt == 3001) slot = 3; if (tt == 8191) slot = 4;
          if (slot >= 0) for (int s = F.tid; s < nk32; s += 512) dump[((size_t)(b * 5 + slot)) * 8192 + s] = sc[qq * 8192 + s]; } }
#endif
    const int q = wid >> 1, sub = wid & 1, tq = t0 + q;
    if (!need_sel) {
        for (int blk = sub; blk < nblk; blk += 2) { const int s = 64 * blk + lane; const unsigned long long bal = __ballot(s <= tq);
            if (lane == 0) { mk[q * 256 + 2 * blk] = (unsigned)bal; mk[q * 256 + 2 * blk + 1] = (unsigned)(bal >> 32); } }
    } else {
        float maxv = red[q], minv = red[4 + q];
#pragma unroll
        for (int wv = 1; wv < 8; ++wv) { maxv = __builtin_fmaxf(maxv, red[wv * 8 + q]); minv = __builtin_fminf(minv, red[wv * 8 + 4 + q]); }
        const float rng = maxv - minv; const bool degenerate = !(rng > 0.f) || !(rng < 3.0e38f);
        const float scale = degenerate ? 0.f : 1023.99f / rng;
#ifdef DBG_FORCE_RADIX
        if (lane == 0) flag[0] = 1u;
#endif
        if (degenerate && lane == 0) flag[0] = 1u;
        { int idx = sub * 64 + lane;
          for (; idx + 384 <= tq; idx += 512) {
              const float v0 = sc[q * 8192 + idx], v1 = sc[q * 8192 + idx + 128], v2 = sc[q * 8192 + idx + 256], v3 = sc[q * 8192 + idx + 384];
              const int b0 = (int)((maxv - v0) * scale), b1 = (int)((maxv - v1) * scale), b2 = (int)((maxv - v2) * scale), b3 = (int)((maxv - v3) * scale);
              (void)__hip_atomic_fetch_add(&hist[q * 1024 + b0], 1u, __ATOMIC_RELAXED, __HIP_MEMORY_SCOPE_WORKGROUP); (void)__hip_atomic_fetch_add(&hist[q * 1024 + b1], 1u, __ATOMIC_RELAXED, __HIP_MEMORY_SCOPE_WORKGROUP);
              (void)__hip_atomic_fetch_add(&hist[q * 1024 + b2], 1u, __ATOMIC_RELAXED, __HIP_MEMORY_SCOPE_WORKGROUP); (void)__hip_atomic_fetch_add(&hist[q * 1024 + b3], 1u, __ATOMIC_RELAXED, __HIP_MEMORY_SCOPE_WORKGROUP); }
          for (; idx <= tq; idx += 128) {
              const int bin = (int)((maxv - sc[q * 8192 + idx]) * scale);
              (void)__hip_atomic_fetch_add(&hist[q * 1024 + bin], 1u, __ATOMIC_RELAXED, __HIP_MEMORY_SCOPE_WORKGROUP); } }
        IX_BAR();
        if (wid < 4) {
            const LAS u32x4* hp = (const LAS u32x4*)(hist + wid * 1024 + 16 * lane);
            const u32x4 h0 = hp[0], h1 = hp[1], h2 = hp[2], h3 = hp[3];
            const unsigned c[16] = {h0.x, h0.y, h0.z, h0.w, h1.x, h1.y, h1.z, h1.w, h2.x, h2.y, h2.z, h2.w, h3.x, h3.y, h3.z, h3.w};
            unsigned tot = 0u;
#pragma unroll
            for (int i = 0; i < 16; ++i) tot += c[i];
            unsigned incl = tot;
#pragma unroll
            for (int o = 1; o < 64; o <<= 1) { const unsigned v = __shfl_up(incl, o); if (lane >= o) incl += v; }
            const unsigned excl = incl - tot;
            if (excl < 256u && 256u <= incl) {
                unsigned run = excl, bsel = 0u, cnt = 0u; bool found = false;
#pragma unroll
                for (int i = 0; i < 16; ++i) { if (!found) { if (run + c[i] >= 256u) { bsel = 16u * lane + i; cnt = c[i]; found = true; } else run += c[i]; } }
                selw[wid * 4 + 0] = bsel; selw[wid * 4 + 1] = 256u - run; selw[wid * 4 + 2] = cnt;
                if (cnt > 64u) flag[0] = 1u;
            }
        }
        IX_BAR();
        if (flag[0] == 0u) {
            const unsigned B = selw[q * 4 + 0];
#define IX_EMIT(BLK, V) do { const int s_ = 64 * (BLK) + lane; const bool val_ = (s_ <= tq); const float v_ = val_ ? (V) : 0.f; \
                const unsigned bin_ = (unsigned)(int)((maxv - v_) * scale); const unsigned long long bal_ = __ballot(val_ && bin_ < B); \
                if (val_ && bin_ == B) { const unsigned pos_ = __hip_atomic_fetch_add(&selw[q * 4 + 3], 1u, __ATOMIC_RELAXED, __HIP_MEMORY_SCOPE_WORKGROUP); cval[q * 64 + (pos_ & 63u)] = v_; cidx[q * 64 + (pos_ & 63u)] = (unsigned)s_; } \
                if (lane == 0) { mk[q * 256 + 2 * (BLK)] = (unsigned)bal_; mk[q * 256 + 2 * (BLK) + 1] = (unsigned)(bal_ >> 32); } } while (0)
            { int blk = sub;
              for (; blk + 6 < nblk; blk += 8) {
                  const float v0 = sc[q * 8192 + 64 * blk + lane], v1 = sc[q * 8192 + 64 * (blk + 2) + lane], v2 = sc[q * 8192 + 64 * (blk + 4) + lane], v3 = sc[q * 8192 + 64 * (blk + 6) + lane];
                  IX_EMIT(blk, v0); IX_EMIT(blk + 2, v1); IX_EMIT(blk + 4, v2); IX_EMIT(blk + 6, v3); }
              for (; blk < nblk; blk += 2) { const float v0 = sc[q * 8192 + ((64 * blk + lane) & 8191)]; IX_EMIT(blk, v0); } }
#undef IX_EMIT
            IX_BAR();
            if (wid < 4) {
                const unsigned C = selw[wid * 4 + 3], need = selw[wid * 4 + 1];
                const float mv = (lane < (int)C) ? cval[wid * 64 + lane] : -INFINITY; const unsigned mi = (lane < (int)C) ? cidx[wid * 64 + lane] : 0xFFFFFFFFu;
                unsigned rank = 0u;
                for (unsigned j = 0; j < C; ++j) { const unsigned js = (unsigned)__builtin_amdgcn_readfirstlane((int)j);
                    const float vj = __builtin_bit_cast(float, __builtin_amdgcn_readlane(__builtin_bit_cast(int, mv), (int)js)); const unsigned ij = (unsigned)__builtin_amdgcn_readlane((int)mi, (int)js); rank += (vj > mv || (vj == mv && ij < mi)) ? 1u : 0u; }
                if (lane < (int)C && rank < need) (void)__hip_atomic_fetch_or(&mk[wid * 256 + (mi >> 5)], 1u << (mi & 31u), __ATOMIC_RELAXED, __HIP_MEMORY_SCOPE_WORKGROUP);
            }
        } else {
            if (F.tid < 4) { unsigned z_ = (unsigned)F.zz; asm volatile("" : "+v"(z_)); selw[F.tid * 4 + 0] = z_; selw[F.tid * 4 + 1] = 256u + z_; selw[F.tid * 4 + 2] = z_; }
#pragma unroll 1
            for (int pass = 0; pass < 4; ++pass) {
                const int shift = 24 - 8 * pass;
                IX_BAR();
                hist[F.tid] = 0u; hist[F.tid + 512] = 0u;
                IX_BAR();
                const unsigned prefix = selw[q * 4 + 0];
                for (int idx = sub * 64 + lane; idx < nk32; idx += 128) {
                    const unsigned u = ordf(sc[q * 8192 + idx]);
                    const bool match = (pass == 0) || ((u >> (shift + 8)) == (prefix >> (shift + 8)));
                    if (match) (void)__hip_atomic_fetch_add(&hist[q * 256 + ((u >> shift) & 255u)], 1u, __ATOMIC_RELAXED, __HIP_MEMORY_SCOPE_WORKGROUP);
                }
                IX_BAR();
                if (wid < 4) {
                    const unsigned kk = selw[wid * 4 + 1], pre = selw[wid * 4 + 0];
                    const unsigned c0 = hist[wid * 256 + 4 * lane], c1 = hist[wid * 256 + 4 * lane + 1], c2 = hist[wid * 256 + 4 * lane + 2], c3 = hist[wid * 256 + 4 * lane + 3];
                    const unsigned tot = c0 + c1 + c2 + c3; unsigned incl = tot;
#pragma unroll
                    for (int o = 1; o < 64; o <<= 1) { const unsigned v = __shfl_down(incl, o); if (lane + o < 64) incl += v; }
                    const unsigned excl = incl - tot;
                    if (excl < kk && kk <= incl) {
                        unsigned run = excl, dsel, cnt;
                        if (run + c3 >= kk) { dsel = 3; cnt = c3; } else { run += c3;
                            if (run + c2 >= kk) { dsel = 2; cnt = c2; } else { run += c2;
                                if (run + c1 >= kk) { dsel = 1; cnt = c1; } else { run += c1; dsel = 0; cnt = c0; } } }
                        selw[wid * 4 + 0] = pre | ((4u * lane + dsel) << shift); selw[wid * 4 + 1] = kk - run; selw[wid * 4 + 2] = cnt;
                    }
                }
            }
            IX_BAR();
            const unsigned thr = selw[q * 4 + 0], kk = selw[q * 4 + 1];
            unsigned eqseen = 0u;
            for (int blk = 0; blk < nblk; ++blk) {
                const int s = 64 * blk + lane;
                const unsigned u = (s < nk32) ? ordf(sc[q * 8192 + s]) : 0u;
                const bool val = (s <= tq);
                const unsigned long long gt = __ballot(val && u > thr), eq = __ballot(val && u == thr);
                unsigned long long take = 0ull, e = eq; unsigned left = (kk > eqseen) ? kk - eqseen : 0u;
                while (left && e) { const unsigned long long low = e & (~e + 1ull); take |= low; e ^= low; --left; }
                eqseen += (unsigned)__popcll(eq);
                if ((blk & 1) == sub && lane == 0) { const unsigned long long wv = gt | take; mk[q * 256 + 2 * blk] = (unsigned)wv; mk[q * 256 + 2 * blk + 1] = (unsigned)(wv >> 32); }
            }
        }
    }
    IX_BAR();
    { const int wq = F.tid >> 7, ww = (F.tid & 127) * 2;
      if (ww < 2 * nblk) *(u32x2*)(MK + (size_t)(rowbase + t0 + wq) * 256 + ww) = *(const LAS u32x2*)(mk + wq * 256 + ww); }
    IX_BAR();
}
}

constexpr int NPH = 16;
__global__ void __launch_bounds__(NWAVES * 64, 2) mk_fwd(Args args) {
    extern __shared__ __attribute__((aligned(16))) unsigned char lds[];
    Frame F;
    F.lds = (LAS unsigned char*)lds;
    F.tid = threadIdx.x; F.lane = F.tid & 63; F.wave = __builtin_amdgcn_readfirstlane(F.tid >> 6);
    const int wave0 = F.wave;
    F.G = gridDim.x; { const int bx = blockIdx.x; F.vcu = (F.G % 8 == 0) ? (bx % 8) * (F.G / 8) + bx / 8 : bx; }
    F.a = &args; F.zz = 0;
    volatile LAS unsigned* MISC = (volatile LAS unsigned*)(F.lds + LDSCTL_OFF);
    for (int u = F.tid; u < (LDS_BYTES - LDSCTL_OFF) / 4; u += NWAVES * 64) ((LAS unsigned*)(F.lds + LDSCTL_OFF))[u] = 0u;
    __syncthreads();
    XcdBarrier bar; bar.bar = (unsigned*)(args.ws + WS_CTL) + CW_BAR; bar.x = 0; bar.st = nullptr;
    if (MK_ONE_LAUNCH) bar = xcd_barrier_post((unsigned*)(args.ws + WS_CTL) + CW_BAR, MISC + 8);
    const int lo = args.ph_lo, hi = args.ph_hi;
#define IN(k) (lo <= (k) && (k) < hi)
#define SEAM(k) do { if (MK_ONE_LAUNCH && (k) + 1 < hi) { XcdBarrier b2_ = bar; asm volatile("" : "+s"(b2_.bar), "+s"(b2_.x)); xcd_barrier(b2_); } } while (0)
#define PHASE_BEGIN() do { asm volatile("s_mov_b32 %0, 0" : "=s"(F.zz)); F.wave = wave0 + F.zz; asm volatile("v_mbcnt_lo_u32_b32 %0, -1, 0\n\tv_mbcnt_hi_u32_b32 %0, -1, %0" : "=v"(F.lane)); F.tid = F.wave * 64 + F.lane; } while (0)
#define WSP(off, T) ((T*)(F.wsp(off)))

    for (int l = 0; l < DEPTH; ++l) {
        const int P = l * NPH;
        for (int rep_ = 0; rep_ < ((DBG_DUP == 0) ? 2 : 1); ++rep_) if (IN(P + 0)) {
            PHASE_BEGIN();
            if (l == 0) { for (int u = F.vcu; u < 144; u += F.G) { PHASE_BEGIN(); mod_unit(F, u); } PHASE_BEGIN(); rope_table(F); PHASE_BEGIN(); lru_weights(F); PHASE_BEGIN(); }
            convert_weights(F, l, 0, 0, 2, F.vcu * NWAVES + F.wave, F.G * NWAVES);
            SEAM(P + 0);
        }
        for (int rep_ = 0; rep_ < ((DBG_DUP == 1) ? 2 : 1); ++rep_) if (IN(P + 1)) {
            PHASE_BEGIN();
            const float* mod_l = WSP(WS_MOD, const float) + (size_t)l * 2 * 9216; const float* ng = F.in(IN_NORMG) + (size_t)l * 6 * DM;
            if (l == 0) { norm_pass<false, true, 0, 0>(F, nullptr, F.in(IN_X), nullptr, nullptr, nullptr, 0.f, ng + 0 * DM, mod_l + 1 * DM, mod_l + 0 * DM, WSP(WS_XN, bf16_t));
                SEAM(P + 1); }
        }
        for (int rep_ = 0; rep_ < ((DBG_DUP == 2) ? 2 : 1); ++rep_) if (IN(P + 2)) {
            PHASE_BEGIN();
            pg8::Gemm g{WSP(WS_XN, bf16_t), WSP(WS_W + W_W1, bf16_t), DM, DM, DM}; pg8::StaticOrder S; S.init(M, 2 * DFF, F.G, (int)blockIdx.x);
            pg8::EpiSwiglu E{WSP(WS_R1, bf16_t), DFF};
            pg8::gemm_phase<pg8::EpiSwiglu, pg8::StaticOrder, true>(F.lds, F.tid, g, S, E);
            { const int rem_ = (M / 256) * (2 * DFF / 256) % F.G;
              if (l == 0 && rem_ != 0 && (int)blockIdx.x >= rem_) { PHASE_BEGIN(); convert_weights(F, l, 0, 2, NSEG_A, ((int)blockIdx.x - rem_) * NWAVES + F.wave, (F.G - rem_) * NWAVES); } }
            SEAM(P + 2);
        }
        for (int rep_ = 0; rep_ < ((DBG_DUP == 3) ? 2 : 1); ++rep_) if (IN(P + 3)) {
            PHASE_BEGIN();
            pg8::Gemm g{WSP(WS_R1, bf16_t), WSP(WS_W + W_W2, bf16_t), DFF, DFF, DFF}; pg8::StaticOrder S; S.init(M, DM, F.G, (int)blockIdx.x);
            pg8::EpiBf16<0> E{WSP(WS_R2, bf16_t), DM};
            pg8::gemm_phase<pg8::EpiBf16<0>, pg8::StaticOrder, true>(F.lds, F.tid, g, S, E);
            SEAM(P + 3);
        }
        for (int rep_ = 0; rep_ < ((DBG_DUP == 4) ? 2 : 1); ++rep_) if (IN(P + 4)) {
            PHASE_BEGIN();
            const float* mod_l = WSP(WS_MOD, const float) + (size_t)l * 2 * 9216; const float* ng = F.in(IN_NORMG) + (size_t)l * 6 * DM;
            if (l == 0) norm_pass<true, true, 0, 1>(F, WSP(WS_R2, bf16_t), F.in(IN_X), F.outp(), ng + 1 * DM, mod_l + 2 * DM, 0.5f, ng + 2 * DM, mod_l + 4 * DM, mod_l + 3 * DM, WSP(WS_XN, bf16_t));
            else norm_pass<true, true, 1, 1>(F, WSP(WS_R2, bf16_t), F.outp(), F.outp(), ng + 1 * DM, mod_l + 2 * DM, 0.5f, ng + 2 * DM, mod_l + 4 * DM, mod_l + 3 * DM, WSP(WS_XN, bf16_t));
            SEAM(P + 4);
        }
        for (int rep_ = 0; rep_ < ((DBG_DUP == 5) ? 2 : 1); ++rep_) if (IN(P + 5)) {
            PHASE_BEGIN();
            pg8::Gemm g{WSP(WS_XN, bf16_t), WSP(WS_W + W_IN, bf16_t), DM, DM, DM}; pg8::StaticOrder S; S.init(M, ZP, F.G, (int)blockIdx.x);
            pg8::EpiBf16<0> E{WSP(WS_R1, bf16_t), ZP};
            pg8::gemm_phase<pg8::EpiBf16<0>, pg8::StaticOrder, true>(F.lds, F.tid, g, S, E);
            { const int rem_ = (M / 256) * (ZP / 256) % F.G;
              if (rem_ != 0 && (int)blockIdx.x >= rem_) { PHASE_BEGIN(); convert_weights(F, l, 1, 0, NSEG_B, ((int)blockIdx.x - rem_) * NWAVES + F.wave, (F.G - rem_) * NWAVES); } }
            SEAM(P + 5);
        }
        for (int rep_ = 0; rep_ < ((DBG_DUP == 6) ? 2 : 1); ++rep_) if (IN(P + 6)) {
            PHASE_BEGIN();
            mla_prep(F, WSP(WS_R1, const bf16_t), WSP(WS_YB, bf16_t), WSP(WS_YB + 8 * MiB, bf16_t), WSP(WS_KROPE, bf16_t), WSP(WS_RS, bf16_t), WSP(WS_ROPE, const f32x2));
            __syncthreads();
            for (int u = F.vcu; u < 256; u += F.G) { PHASE_BEGIN(); lru_unit<false>(F, l, u, WSP(WS_R1, const bf16_t), WSP(WS_LRUS, f32x2), nullptr); }
            SEAM(P + 6);
        }
        for (int rep_ = 0; rep_ < ((DBG_DUP == 7) ? 2 : 1); ++rep_) if (IN(P + 7)) {
            PHASE_BEGIN();
            { pg8::Gemm g{WSP(WS_YB, bf16_t), WSP(WS_W + W_UQ, bf16_t), 256, 256, 256 + F.zz}; pg8::StaticOrder S; S.init(M, 768, F.G, (int)blockIdx.x);
              pg8::EpiMlaQ E{WSP(WS_R2, bf16_t), 768, WSP(WS_ROPE, const f32x2)};
              pg8::gemm_phase<pg8::EpiMlaQ, pg8::StaticOrder, true>(F.lds, F.tid, g, S, E); }
            PHASE_BEGIN();
            { pg8::Gemm g{WSP(WS_YB + 8 * MiB, bf16_t), WSP(WS_W + W_UKV, bf16_t), 128, 128, 128 + F.zz}; pg8::StaticOrder S; S.init(M, 1024, F.G, (int)blockIdx.x);
              pg8::EpiBf16<0> E{WSP(WS_R2 + 24 * MiB, bf16_t), 1024};
              pg8::gemm_phase<pg8::EpiBf16<0>, pg8::StaticOrder, true>(F.lds, F.tid, g, S, E); }
            __syncthreads();
            PHASE_BEGIN();
            for (int v = F.vcu; v < 256; v += F.G)
            { ix::Pre pre; const int U0 = v;
              ix::preload(F, WSP(WS_R1, const bf16_t), WSP(WS_RS, const bf16_t), U0 >> 11, U0 & 2047, pre);
              for (int i = 0; i < 16; ++i) { const int U = (i & 1) ? 4095 - ((i >> 1) * 256 + v) : (i >> 1) * 256 + v;
                  const int i2 = i + 1, U2 = (i2 & 1) ? 4095 - ((i2 >> 1) * 256 + v) : (i2 >> 1) * 256 + v;
                  PHASE_BEGIN();
                  ix::unit(F, WSP(WS_R1, const bf16_t), WSP(WS_RS, const bf16_t), WSP(WS_R1 + 112 * MiB, unsigned), U >> 11, U & 2047, pre, i2 < 16, (U2 >> 11) & 1, U2 & 2047); } }
            __syncthreads();
            SEAM(P + 7);
        }
        for (int rep_ = 0; rep_ < ((DBG_DUP == 8) ? 2 : 1); ++rep_) if (IN(P + 8)) {
            PHASE_BEGIN();
            for (unsigned v_ = (unsigned)(F.vcu + F.zz); v_ < 256u; v_ += 256u) { const int v = (int)v_;
                const int bh = v >> 4, b = bh >> 3, h = bh & 7, qa = v & 15;
                PHASE_BEGIN();
                const bf16_t* Z = WSP(WS_R1, const bf16_t); bf16_t* YB = WSP(WS_YB, bf16_t);
                { fa::Ptrs P_{WSP(WS_R2, const bf16_t) + 96 * h, 768, WSP(WS_R2 + 24 * MiB, const bf16_t) + 128 * h, 1024, WSP(WS_KROPE, const bf16_t), WSP(WS_R2 + 24 * MiB, const bf16_t) + 128 * h + 64, 1024,
                                YB + 1024 + 64 * h, 2048, nullptr, 0.f, 0.f};
                  for (int r3_ = 0; r3_ < ((DBG_FADUP == 0) ? 2 : 1); ++r3_) { fm::unit(F, P_, b, qa); PHASE_BEGIN(); fm::unit(F, P_, b, 31 - qa); PHASE_BEGIN(); } }
                PHASE_BEGIN();
                { fa::Ptrs P_{Z + ZC_AQ + 64 * h, ZP, Z + ZC_AK + 64 * (h >> 2), ZP, nullptr, Z + ZC_AV + 64 * (h >> 2), ZP, YB + 64 * h, 2048, WSP(WS_R1 + 112 * MiB, const unsigned),
                                __builtin_amdgcn_exp2f(-0.5f * (float)(h + 9)) * LOG2E, 0.f};
                  for (int r3_ = 0; r3_ < ((DBG_FADUP == 1) ? 2 : 1); ++r3_) { fd::unit<0>(F, P_, b, qa); PHASE_BEGIN(); fd::unit<0>(F, P_, b, 31 - qa); PHASE_BEGIN(); } }
                for (int i = 0; i < ((DBG_FADUP == 2) ? 4 : 2); ++i) { PHASE_BEGIN(); const int U = 2 * v + (i & 1), bh2 = U >> 5, b2 = bh2 >> 3, h2 = bh2 & 7, qb2 = U & 31;
                  fa::Ptrs P_{Z + ZC_DQ + 64 * h2, ZP, Z + ZC_DK + 64 * (h2 >> 2), ZP, nullptr, Z + ZC_DV + 64 * (h2 >> 2), ZP, YB + 1536 + 64 * h2, 2048, nullptr,
                                __builtin_amdgcn_exp2f(-0.5f * (float)(h2 + 1)) * LOG2E, F.in(IN_SINKS)[l * 8 + h2] * LOG2E};
                  fd::unit<1>(F, P_, b2, qb2); }
                for (int r5_ = 0; r5_ < ((DBG_FADUP == 3) ? 2 : 1); ++r5_) {
                PHASE_BEGIN();
                lru_unit<true>(F, l, v, WSP(WS_R1, const bf16_t), WSP(WS_LRUS, f32x2), WSP(WS_YB, bf16_t)); }
            }
            SEAM(P + 8);
        }
        for (int rep_ = 0; rep_ < ((DBG_DUP == 9) ? 2 : 1); ++rep_) if (IN(P + 9)) {
            PHASE_BEGIN();
#if defined(DBG_ZB)
            { bf16_t* YBz = WSP(WS_YB, bf16_t); const int gw = F.vcu * NWAVES + F.wave, NGW = F.G * NWAVES;
              for (int m = gw; m < M; m += NGW) *(u32x4*)(YBz + (size_t)m * 2048 + 512 * DBG_ZB + 8 * F.lane) = (u32x4){0u, 0u, 0u, 0u}; }
#endif
            PHASE_BEGIN();
            pg8::Gemm g{WSP(WS_XN, bf16_t), WSP(WS_W + W_G, bf16_t), DM, DM, DM}; pg8::StaticOrder S; S.init(M, NG, F.G, (int)blockIdx.x);
            pg8::EpiBf16<2> E{WSP(WS_R1, bf16_t), NG};
            pg8::gemm_phase<pg8::EpiBf16<2>, pg8::StaticOrder, true>(F.lds, F.tid, g, S, E);
            SEAM(P + 9);
        }
        for (int rep_ = 0; rep_ < ((DBG_DUP == 10) ? 2 : 1); ++rep_) if (IN(P + 10)) {
            PHASE_BEGIN();
            pg8::Gemm g{WSP(WS_YB, bf16_t), WSP(WS_W + W_BR, bf16_t), 2048, 2048, 512}; pg8::ChainOrder S; S.so.init(M, DM, F.G, (int)blockIdx.x);
            pg8::EpiGateMerge E{WSP(WS_R1, const bf16_t), WSP(WS_R2, bf16_t), DM};
            pg8::gemm_phase<pg8::EpiGateMerge, pg8::ChainOrder, true>(F.lds, F.tid, g, S, E);
            SEAM(P + 10);
        }
        for (int rep_ = 0; rep_ < ((DBG_DUP == 11) ? 2 : 1); ++rep_) if (IN(P + 11)) {
            PHASE_BEGIN();
            pg8::Gemm g{WSP(WS_R2, bf16_t), WSP(WS_W + W_O, bf16_t), DM, DM, DM}; pg8::StaticOrder S; S.init(M, DM, F.G, (int)blockIdx.x);
            pg8::EpiBf16<0> E{WSP(WS_YB, bf16_t), DM};
            pg8::gemm_phase<pg8::EpiBf16<0>, pg8::StaticOrder, true>(F.lds, F.tid, g, S, E);
            SEAM(P + 11);
        }
        for (int rep_ = 0; rep_ < ((DBG_DUP == 12) ? 2 : 1); ++rep_) if (IN(P + 12)) {
            PHASE_BEGIN();
            const float* mod_l = WSP(WS_MOD, const float) + (size_t)l * 2 * 9216; const float* ng = F.in(IN_NORMG) + (size_t)l * 6 * DM;
            norm_pass<true, true, 1, 1>(F, WSP(WS_YB, bf16_t), F.outp(), (l + 1 < DEPTH) ? (void*)F.outp() : (void*)WSP(WS_YB + 32 * MiB, bf16_t), ng + 3 * DM, mod_l + 5 * DM, 1.0f, ng + 4 * DM, mod_l + 7 * DM, mod_l + 6 * DM, WSP(WS_XN, bf16_t));
            SEAM(P + 12);
        }
        for (int rep_ = 0; rep_ < ((DBG_DUP == 13) ? 2 : 1); ++rep_) if (IN(P + 13)) {
            PHASE_BEGIN();
            pg8::Gemm g{WSP(WS_XN, bf16_t), WSP(WS_W + W_W1, bf16_t), DM, DM, DM}; pg8::StaticOrder S; S.init(M, 2 * DFF, F.G, (int)blockIdx.x);
            pg8::EpiSwiglu E{WSP(WS_R1, bf16_t), DFF};
            pg8::gemm_phase<pg8::EpiSwiglu, pg8::StaticOrder, true>(F.lds, F.tid, g, S, E);
            { const int rem_ = (M / 256) * (2 * DFF / 256) % F.G;
              if (l + 1 < DEPTH && rem_ != 0 && (int)blockIdx.x >= rem_) { PHASE_BEGIN(); convert_weights(F, l + 1, 0, 2, NSEG_A, ((int)blockIdx.x - rem_) * NWAVES + F.wave, (F.G - rem_) * NWAVES); } }
            SEAM(P + 13);
        }
        for (int rep_ = 0; rep_ < ((DBG_DUP == 14) ? 2 : 1); ++rep_) if (IN(P + 14)) {
            PHASE_BEGIN();
            pg8::Gemm g{WSP(WS_R1, bf16_t), WSP(WS_W + W_W2, bf16_t), DFF, DFF, DFF}; pg8::StaticOrder S; S.init(M, DM, F.G, (int)blockIdx.x);
            pg8::EpiBf16<0> E{WSP(WS_R2, bf16_t), DM};
            pg8::gemm_phase<pg8::EpiBf16<0>, pg8::StaticOrder, true>(F.lds, F.tid, g, S, E);
            SEAM(P + 14);
        }
        for (int rep_ = 0; rep_ < ((DBG_DUP == 15) ? 2 : 1); ++rep_) if (IN(P + 15)) {
            PHASE_BEGIN();
            const float* mod_l = WSP(WS_MOD, const float) + (size_t)l * 2 * 9216; const float* ng = F.in(IN_NORMG) + (size_t)l * 6 * DM;
            if (l + 1 < DEPTH) { const float* mod_n = mod_l + 2 * 9216; const float* ngn = ng + 6 * DM;
                norm_pass<true, true, 1, 1>(F, WSP(WS_R2, bf16_t), F.outp(), F.outp(), ng + 5 * DM, mod_l + 8 * DM, 0.5f, ngn + 0 * DM, mod_n + 1 * DM, mod_n + 0 * DM, WSP(WS_XN, bf16_t)); }
            else norm_pass<true, false, 1, 0>(F, WSP(WS_R2, bf16_t), WSP(WS_YB + 32 * MiB, const bf16_t), F.outp(), ng + 5 * DM, mod_l + 8 * DM, 0.5f, nullptr, nullptr, nullptr, nullptr);
            SEAM(P + 15);
        }
    }
#undef IN
#undef SEAM
}


#if defined(DBG_PROBE)
__device__ __forceinline__ void probe_acc(float* acc2, float dd, float rr) {
    dd = wave_sum(dd); rr = wave_sum(rr);
    if ((threadIdx.x & 63) == 0) { atomicAdd(acc2, dd); atomicAdd(acc2 + 1, rr); }
}
__global__ void __launch_bounds__(256) probe_swa(const unsigned char* ws, const float* sinks, float* acc2) {
    const bf16_t* Z = (const bf16_t*)(ws + WS_R1); const bf16_t* YB = (const bf16_t*)(ws + WS_YB);
    const int gid = blockIdx.x * blockDim.x + threadIdx.x; const int h = gid & 7, ms = gid >> 3;
    const int m = ms * 7 + 3; float dd = 0.f, rr = 0.f;
    if (m < M) {
        const int b = m >> 13, t = m & 8191, g = h >> 2; const float slope = exp2f(-0.5f * (h + 1));
        float q[64]; _Pragma("unroll") for (int d = 0; d < 64; ++d) q[d] = bf2f(Z[(size_t)m * ZP + ZC_DQ + 64 * h + d]);
        float mx = sinks[h] * LOG2E, l = 1.f, o[64]; _Pragma("unroll") for (int d = 0; d < 64; ++d) o[d] = 0.f;
        for (int s = (t >= 127 ? t - 127 : 0); s <= t; ++s) {
            const bf16_t* kr = Z + ((size_t)b * SEQ + s) * ZP + ZC_DK + 64 * g; float sc = 0.f;
            _Pragma("unroll") for (int d = 0; d < 64; ++d) sc += q[d] * bf2f(kr[d]);
            sc -= slope * LOG2E * (float)(t - s);
            const float mn = fmaxf(mx, sc), al = exp2f(mx - mn), p = exp2f(sc - mn);
            l = l * al + p; const bf16_t* vr = Z + ((size_t)b * SEQ + s) * ZP + ZC_DV + 64 * g;
            _Pragma("unroll") for (int d = 0; d < 64; ++d) o[d] = o[d] * al + p * bf2f(vr[d]);
            mx = mn;
        }
        _Pragma("unroll") for (int d = 0; d < 64; ++d) { const float ref = o[d] / l, got = bf2f(YB[(size_t)m * 2048 + 1536 + 64 * h + d]); dd += (got - ref) * (got - ref); rr += ref * ref; }
    }
    probe_acc(acc2, dd, rr);
}
__global__ void __launch_bounds__(256) probe_mla(const unsigned char* ws, float* acc2) {
    const bf16_t* Qc = (const bf16_t*)(ws + WS_R2); const bf16_t* KV = (const bf16_t*)(ws + WS_R2 + 24 * MiB); const bf16_t* KR = (const bf16_t*)(ws + WS_KROPE); const bf16_t* YB = (const bf16_t*)(ws + WS_YB);
    const int gid = blockIdx.x * blockDim.x + threadIdx.x; const int h = gid & 7, ms = gid >> 3;
    const int m = ms * 61 + 5; float dd = 0.f, rr = 0.f;
    if (m < M) {
        const int b = m >> 13, t = m & 8191;
        float q[96]; _Pragma("unroll") for (int d = 0; d < 96; ++d) q[d] = bf2f(Qc[(size_t)m * 768 + 96 * h + d]);
        float mx = -INFINITY, l = 0.f, o[64]; _Pragma("unroll") for (int d = 0; d < 64; ++d) o[d] = 0.f;
        for (int s = 0; s <= t; ++s) {
            const size_t mk = (size_t)b * SEQ + s; float sc = 0.f;
            _Pragma("unroll") for (int d = 0; d < 64; ++d) sc += q[d] * bf2f(KV[mk * 1024 + 128 * h + d]);
            _Pragma("unroll") for (int d = 0; d < 32; ++d) sc += q[64 + d] * bf2f(KR[mk * 32 + d]);
            const float mn = fmaxf(mx, sc), al = exp2f(mx - mn), p = exp2f(sc - mn);
            l = l * al + p;
            _Pragma("unroll") for (int d = 0; d < 64; ++d) o[d] = o[d] * al + p * bf2f(KV[mk * 1024 + 128 * h + 64 + d]);
            mx = mn;
        }
        _Pragma("unroll") for (int d = 0; d < 64; ++d) { const float ref = o[d] / l, got = bf2f(YB[(size_t)m * 2048 + 1024 + 64 * h + d]); dd += (got - ref) * (got - ref); rr += ref * ref; }
    }
    probe_acc(acc2, dd, rr);
}
__global__ void probe_lru(const unsigned char* ws, const float* convw, const float* convb, const float* lwa, const float* lba, const float* lwx, const float* lbx, const float* lam, float* acc2) {
    const bf16_t* Z = (const bf16_t*)(ws + WS_R1); const bf16_t* YB = (const bf16_t*)(ws + WS_YB);
    const int gid = blockIdx.x * blockDim.x + threadIdx.x; float dd = 0.f, rr = 0.f;
    if (gid < 1024) {
        const int b = gid >> 9, c = gid & 511, n = c >> 6, j = c & 63;
        const float sp = log1pf(expf(-lam[c])); float h = 0.f;
        for (int t = 0; t < SEQ; ++t) {
            float ra = lba[c], rx = lbx[c], xcc = 0.f;
            for (int i = 0; i < 64; ++i) { const int ci = 64 * n + i; float xc = convb[ci];
                for (int k = 0; k < 4; ++k) { const int tt = t - 3 + k; if (tt >= 0) xc += convw[k * 512 + ci] * bf2f(Z[((size_t)b * SEQ + tt) * ZP + ZC_RX + ci]); }
                ra += xc * lwa[(n * 64 + i) * 64 + j]; rx += xc * lwx[(n * 64 + i) * 64 + j]; if (i == j) xcc = xc; }
            const float r = 1.f / (1.f + expf(-ra)), ig = 1.f / (1.f + expf(-rx));
            const float la = -8.f * r * sp, a = expf(la), bb = sqrtf(-expm1f(2.f * la)) * (ig * xcc);
            h = a * h + bb;
            if ((t % 13) == 0 || t < 130) { const size_t m = (size_t)b * SEQ + t; const float g = bf2f(Z[m * ZP + ZC_RG + c]);
                const float ref = h * (0.5f * g * (1.f + tanhf(0.7978845608028654f * (g + 0.044715f * g * g * g)))), got = bf2f(YB[m * 2048 + 512 + c]);
                dd += (got - ref) * (got - ref); rr += ref * ref; }
        }
    }
    probe_acc(acc2, dd, rr);
}

__device__ __forceinline__ float blk_max(float v, float* red) { __syncthreads(); for (int o = 32; o > 0; o >>= 1) v = fmaxf(v, __shfl_xor(v, o)); if ((threadIdx.x & 63) == 0) red[threadIdx.x >> 6] = v; __syncthreads(); return fmaxf(fmaxf(red[0], red[1]), fmaxf(red[2], red[3])); }
__device__ __forceinline__ float blk_sum(float v, float* red) { __syncthreads(); v = wave_sum(v); if ((threadIdx.x & 63) == 0) red[threadIdx.x >> 6] = v; __syncthreads(); return (red[0] + red[1]) + (red[2] + red[3]); }
__global__ void __launch_bounds__(256) probe_dsa(const unsigned char* ws, float* acc2) {
    __shared__ float sc[8192]; __shared__ float pp[8192]; __shared__ float red[8]; __shared__ unsigned thr_s; __shared__ int cnt_s;
    const bf16_t* Z = (const bf16_t*)(ws + WS_R1); const bf16_t* YB = (const bf16_t*)(ws + WS_YB);
    const int tid = threadIdx.x;
    const int rows[8] = {3, 130, 255, 256, 257, 700, 3001, 8191};
    const int b = blockIdx.x & 1, t = (blockIdx.x < 16) ? rows[blockIdx.x >> 1] : (int)((blockIdx.x * 2654435761u) >> 19) ;
    const size_t m = (size_t)b * SEQ + t, rb = (size_t)b * SEQ;
    for (int s = tid; s <= t; s += 256) { float tot = 0.f;
        for (int hd = 0; hd < 8; ++hd) { float d = 0.f;
            for (int e = 0; e < 64; ++e) d += bf2f(Z[m * ZP + ZC_IQ + 64 * hd + e]) * bf2f(Z[(rb + s) * ZP + ZC_IK + e]);
            tot += bf2f(Z[m * ZP + ZC_IW + hd]) * fmaxf(d, 0.f); }
        sc[s] = tot; }
    __syncthreads();
#if defined(DBG_DSA_SCORES)
    { int slot = -1; if (t == 256) slot = 0; if (t == 257) slot = 1; if (t == 700) slot = 2; if (t == 3001) slot = 3; if (t == 8191) slot = 4;
      float d2 = 0.f, r2 = 0.f;
      if (slot >= 0 && blockIdx.x < 16) { const float* dump = (const float*)(ws + WS_R2 + 56 * MiB) + ((size_t)(b * 5 + slot)) * 8192;
          for (int s = tid; s <= t; s += 256) { const float df = dump[s] - sc[s]; d2 += df * df; r2 += sc[s] * sc[s]; } }
      probe_acc(acc2, d2, r2); return; }
#endif
    unsigned T = 0u; const int n = t + 1;
    if (n > 256) {
        unsigned lo = 0u, hi = 0xFFFFFFFFu;
        for (int it = 0; it < 33 && lo < hi; ++it) { const unsigned mid = lo + (unsigned)(((unsigned long long)hi - lo + 1ull) >> 1);
            float c = 0.f; for (int s = tid; s < n; s += 256) c += (ix::ordf(sc[s]) >= mid) ? 1.f : 0.f;
            c = blk_sum(c, red);
            if (c >= 256.f) lo = mid; else hi = mid - 1u; }
        T = lo;
    }
    { float c = 0.f; for (int s = tid; s < n; s += 256) { const unsigned u = ix::ordf(sc[s]); const bool g = (n <= 256) || (u > T); pp[s] = g ? 1.f : 0.f; c += g ? 1.f : 0.f; }
      c = blk_sum(c, red);
      if (tid == 0 && n > 256) { int need = 256 - (int)c; for (int s = 0; s < n && need > 0; ++s) if (ix::ordf(sc[s]) == T) { pp[s] = 1.f; --need; } }
      __syncthreads(); }
#if defined(DBG_DSA_MISMATCH)
    { const unsigned* MKp = (const unsigned*)(ws + WS_R1 + 112 * MiB) + m * 256; float mis = 0.f, tot = 0.f;
      const bool use = (DBG_DSA_MISMATCH == 0) ? (t < 256) : (t >= 256);
      for (int s = tid; s < n; s += 256) { const float mine = ((MKp[s >> 5] >> (s & 31)) & 1u) ? 1.f : 0.f; mis += (mine != pp[s]) ? 1.f : 0.f; tot += pp[s]; }
      if (!use) { mis = 0.f; tot = 0.f; }
      probe_acc(acc2, mis, tot); return; }
#endif
#if defined(DBG_DSA_USEMASK)
    { const unsigned* MKp = (const unsigned*)(ws + WS_R1 + 112 * MiB) + m * 256; __syncthreads(); for (int s = tid; s < n; s += 256) pp[s] = ((MKp[s >> 5] >> (s & 31)) & 1u) ? 1.f : 0.f; __syncthreads(); }
#endif
    float dd = 0.f, rr = 0.f;
    for (int h = 0; h < 8; ++h) {
        const int g = h >> 2; const float slope2 = exp2f(-0.5f * (h + 9)) * LOG2E;
        float lm = -INFINITY;
        for (int s = tid; s < n; s += 256) { float v = -INFINITY;
            if (pp[s] != 0.f) { float d = 0.f; for (int e = 0; e < 64; ++e) d += bf2f(Z[m * ZP + ZC_AQ + 64 * h + e]) * bf2f(Z[(rb + s) * ZP + ZC_AK + 64 * g + e]); v = d - slope2 * (float)(t - s); }
            sc[s] = v; lm = fmaxf(lm, v); }
        const float mx = blk_max(lm, red);
        float ls = 0.f; for (int s = tid; s < n; s += 256) { const float p = (sc[s] == -INFINITY) ? 0.f : exp2f(sc[s] - mx); sc[s] = p; ls += p; }
        const float l = blk_sum(ls, red);
        if (tid < 64) { float o = 0.f; for (int s = 0; s < n; ++s) if (sc[s] != 0.f) o += sc[s] * bf2f(Z[(rb + s) * ZP + ZC_AV + 64 * g + tid]);
            const float ref = o / l, got = bf2f(YB[m * 2048 + 64 * h + tid]); dd += (got - ref) * (got - ref); rr += ref * ref; }
        __syncthreads();
    }
    probe_acc(acc2, dd, rr);
}
__global__ void probe_out(const float* x, float* out, const float* acc2) {
    const float e = acc2[0] / fmaxf(acc2[1], 1e-30f); const float k = fminf(fmaxf(3.0f + 0.5f * log10f(fmaxf(e, 1e-12f)), 0.f), 4.f);
    for (size_t i = (size_t)blockIdx.x * blockDim.x + threadIdx.x; i < (size_t)M * DM; i += (size_t)gridDim.x * blockDim.x) out[i] = x[i] * (1.f + k);
}
#endif
extern "C" void kernel_launch(void* const* d_in, const int* in_sizes, int n_in, void* d_out, int out_size, void* d_ws, size_t ws_size, hipStream_t stream) {
    static int grid = 0;
    if (grid == 0) {
        if (n_in != 24 || out_size != M * DM || ws_size < WS_END) { fprintf(stderr, "kernel_launch: unexpected shapes / workspace (n_in %d out %d ws %zu)\n", n_in, out_size, ws_size); grid = -1; return; }
        int dev = 0, cus = 0, per_cu = 0;
        if (hipGetDevice(&dev) != hipSuccess || hipDeviceGetAttribute(&cus, hipDeviceAttributeMultiprocessorCount, dev) != hipSuccess) { grid = -1; return; }
        if (hipFuncSetAttribute((const void*)mk_fwd, hipFuncAttributeMaxDynamicSharedMemorySize, LDS_BYTES) != hipSuccess) { grid = -1; return; }
        if (hipOccupancyMaxActiveBlocksPerMultiprocessor(&per_cu, (const void*)mk_fwd, NWAVES * 64, LDS_BYTES) != hipSuccess || per_cu < 1) { fprintf(stderr, "occupancy query says %d\n", per_cu); }
        (void)hipGetLastError();
        grid = cus;
        if (grid != 256) { fprintf(stderr, "kernel_launch: built for a 256-CU device (got %d)\n", cus); grid = -1; return; }
    }
    if (grid < 0) return;
    (void)hipMemsetAsync((char*)d_ws + WS_CTL, 0, CTL_ZERO_BYTES, stream);
    Args a{};
    for (int i = 0; i < 24; ++i) a.in[i] = (const float*)d_in[i];
    a.out = (float*)d_out; a.ws = (unsigned char*)d_ws;
#if MK_ONE_LAUNCH
    a.ph_lo = 0; a.ph_hi = DEPTH * NPH; a.li = 0;
    hipLaunchKernelGGL(mk_fwd, dim3(grid), dim3(NWAVES * 64), LDS_BYTES, stream, a);
#else
#ifndef DBG_STAGE
#define DBG_STAGE 0
#endif
    if (DBG_STAGE == 1) { (void)hipMemcpyAsync(d_out, d_in[0], (size_t)M * DM * 4, hipMemcpyDeviceToDevice, stream); return; }
    for (int p = 0; p < DEPTH * NPH; ++p) {
        const int k = p % NPH, l = p / NPH;
        if (DBG_STAGE == 2 && p > 4) break;
#if defined(DBG_PROBE)
        if (p > 8) {
            float* acc2 = (float*)((char*)d_ws + WS_CTL + 64);
            if (DBG_PROBE == 3) hipLaunchKernelGGL(probe_swa, dim3((M / 7 + 1) * 8 / 256 + 1), dim3(256), 0, stream, (const unsigned char*)d_ws, (const float*)d_in[IN_SINKS], acc2);
            if (DBG_PROBE == 2) hipLaunchKernelGGL(probe_mla, dim3((M / 61 + 1) * 8 / 256 + 1), dim3(256), 0, stream, (const unsigned char*)d_ws, acc2);
            if (DBG_PROBE == 0) hipLaunchKernelGGL(probe_dsa, dim3(80), dim3(256), 0, stream, (const unsigned char*)d_ws, acc2);
            if (DBG_PROBE == 1) hipLaunchKernelGGL(probe_lru, dim3(16), dim3(64), 0, stream, (const unsigned char*)d_ws, (const float*)d_in[IN_CONVW], (const float*)d_in[IN_CONVB], (const float*)d_in[IN_LRUWA], (const float*)d_in[IN_LRUBA],
                                                   (const float*)d_in[IN_LRUWX], (const float*)d_in[IN_LRUBX], (const float*)d_in[IN_LRULAM], acc2);
            hipLaunchKernelGGL(probe_out, dim3(1024), dim3(256), 0, stream, (const float*)d_in[0], (float*)d_out, (const float*)acc2);
            break;
        }
#endif
        if (k == 1 && l != 0) continue;
        a.ph_lo = p; a.ph_hi = p + 1; a.li = p;
        hipLaunchKernelGGL(mk_fwd, dim3(grid), dim3(NWAVES * 64), LDS_BYTES, stream, a);
    }
#endif
}
```
